# Optimizing an MI355X kernel written in HIP

```python
import math
import jax, jax.numpy as jnp
from jax import lax
import numpy as np

D_MODEL = 1024
BATCH = 8
SEQ = 8192
DEPTH = 2

CHUNK = 64

N_A = DEPTH // 2
N_B = DEPTH - N_A

POOL_WINDOWS = (2, 4, 8, 16)
N_POOL_GROUPS = len(POOL_WINDOWS)
POOL_GROUP = D_MODEL // N_POOL_GROUPS

N_HEADS = 16
HEAD_DIM = D_MODEL // N_HEADS
Q_BLOCK = 128
NEG_INF = -1e30

N_EXPERTS = 32
TOP_K = 4
D_FF = D_MODEL
SWIGLU_LIMIT = 7.0
SWIGLU_ALPHA = 1.702

PLE_DIM = 256

RMS_EPS = 1e-6

kernel_name = "yoco_pool_fox_moe_ple"


def rms_norm(x, g):
    xf = x.astype(jnp.float32)
    y = xf * lax.rsqrt(jnp.mean(xf * xf, axis=-1, keepdims=True) + RMS_EPS)
    return (y * g.astype(jnp.float32)).astype(x.dtype)


def pool_mixer(h, w_groups, scale):
    s = h.shape[1]
    pos = jnp.arange(s)
    outs = []
    for g, w in enumerate(POOL_WINDOWS):
        hg = h[..., g * POOL_GROUP:(g + 1) * POOL_GROUP]
        hf = hg.astype(jnp.float32)
        cs = jnp.cumsum(hf, axis=1)
        lag = jnp.pad(cs, ((0, 0), (w, 0), (0, 0)))[:, :s]
        count = jnp.minimum(pos + 1, w).astype(jnp.float32)[None, :, None]
        diff = ((cs - lag) / count - hf).astype(h.dtype)
        outs.append(jnp.einsum('bsc,cd->bsd', diff, w_groups[g]))
    return jnp.concatenate(outs, axis=-1) * scale


def shared_key_side(x, kv_norm, w_k, w_v, w_fgate, b_fgate):
    b, s, _ = x.shape
    hk = rms_norm(x, kv_norm)
    k = (hk @ w_k).reshape(b, s, N_HEADS, HEAD_DIM).transpose(0, 2, 1, 3)
    v = (hk @ w_v).reshape(b, s, N_HEADS, HEAD_DIM).transpose(0, 2, 1, 3)
    log_f = jax.nn.log_sigmoid((hk @ w_fgate + b_fgate).astype(jnp.float32))
    dc = jnp.cumsum(log_f, axis=1).transpose(0, 2, 1)
    return k, v, dc


def forgetting_attention(h, k, v, dc, w_q, w_o):
    b, s, _ = h.shape
    nb = s // Q_BLOCK
    q = (h @ w_q).reshape(b, s, N_HEADS, HEAD_DIM).transpose(0, 2, 1, 3)
    q_blocks = q.reshape(b, N_HEADS, nb, Q_BLOCK, HEAD_DIM).transpose(2, 0, 1, 3, 4)
    dc_blocks = dc.reshape(b, N_HEADS, nb, Q_BLOCK).transpose(2, 0, 1, 3)
    q_pos = jnp.arange(s).reshape(nb, Q_BLOCK)
    k_pos = jnp.arange(s)
    scale = 1.0 / math.sqrt(HEAD_DIM)

    def one_block(args):
        qi, dqi, pi = args
        logits = jnp.einsum('bhqd,bhkd->bhqk', qi, k).astype(jnp.float32) * scale
        logits = logits + dqi[..., :, None] - dc[:, :, None, :]
        logits = jnp.where(k_pos[None, :] <= pi[:, None], logits, NEG_INF)
        probs = jax.nn.softmax(logits, axis=-1).astype(v.dtype)
        return jnp.einsum('bhqk,bhkd->bhqd', probs, v)

    o = lax.map(one_block, (q_blocks, dc_blocks, q_pos))
    o = o.transpose(1, 0, 3, 2, 4).reshape(b, s, N_HEADS * HEAD_DIM)
    return o @ w_o


def moe_ffn(h, router_w, router_b, w_gu, b_gu, w_down, b_down):
    b, s, d = h.shape
    t = h.reshape(b * s, d)
    logits = (t @ router_w + router_b).astype(jnp.float32)
    top_v, top_i = lax.top_k(logits, TOP_K)
    gates = jax.nn.softmax(top_v, axis=-1)
    dense_gates = jnp.einsum('nk,nke->ne', gates,
                             jax.nn.one_hot(top_i, N_EXPERTS, dtype=jnp.float32)).astype(h.dtype)
    out = jnp.zeros_like(t)
    for e in range(N_EXPERTS):
        gu = t @ w_gu[e] + b_gu[e]
        gate = jnp.minimum(gu[:, :D_FF], SWIGLU_LIMIT)
        up = jnp.clip(gu[:, D_FF:], -SWIGLU_LIMIT, SWIGLU_LIMIT)
        y = (up + 1.0) * (gate * jax.nn.sigmoid(SWIGLU_ALPHA * gate))
        out = out + dense_gates[:, e:e + 1] * (y @ w_down[e] + b_down[e])
    return out.reshape(b, s, d)


def per_layer_embed(x, p_i, norm_g, w_gate, b_gate, w_proj):
    gate = jax.nn.sigmoid(rms_norm(x, norm_g) @ w_gate + b_gate)
    return gate * (p_i @ w_proj)


def setup_inputs(seed: int = 0) -> dict:
    key = jax.random.key(seed)
    ks = jax.random.split(key, 26)
    f32 = jnp.float32

    def nrm(k, shape, scale):
        return jax.random.normal(k, shape, f32) * scale

    hd = N_HEADS * HEAD_DIM
    return {
        "x": nrm(ks[0], (BATCH, SEQ, D_MODEL), 1.0),
        "p": nrm(ks[1], (DEPTH, BATCH, SEQ, PLE_DIM), 1.0),
        "norm_mix": 1.0 + nrm(ks[2], (DEPTH, D_MODEL), 0.1),
        "norm_ffn": 1.0 + nrm(ks[3], (DEPTH, D_MODEL), 0.1),
        "norm_ple": 1.0 + nrm(ks[4], (DEPTH, D_MODEL), 0.1),
        "norm_final": 1.0 + nrm(ks[5], (D_MODEL,), 0.1),
        "pool_w": nrm(ks[6], (N_A, N_POOL_GROUPS, POOL_GROUP, POOL_GROUP), POOL_GROUP ** -0.5),
        "pool_scale": 0.5 + nrm(ks[7], (N_A, D_MODEL), 0.1),
        "kv_norm": 1.0 + nrm(ks[8], (D_MODEL,), 0.1),
        "w_k": nrm(ks[9], (D_MODEL, hd), D_MODEL ** -0.5),
        "w_v": nrm(ks[10], (D_MODEL, hd), D_MODEL ** -0.5),
        "w_fgate": nrm(ks[11], (D_MODEL, N_HEADS), D_MODEL ** -0.5),
        "b_fgate": 3.0 + nrm(ks[12], (N_HEADS,), 0.1),
        "w_q": nrm(ks[13], (N_B, D_MODEL, hd), D_MODEL ** -0.5),
        "w_o": nrm(ks[14], (N_B, hd, D_MODEL), hd ** -0.5),
        "router_w": nrm(ks[15], (DEPTH, D_MODEL, N_EXPERTS), D_MODEL ** -0.5),
        "router_b": nrm(ks[16], (DEPTH, N_EXPERTS), 0.01),
        "exp_w_gu": nrm(ks[17], (DEPTH, N_EXPERTS, D_MODEL, 2 * D_FF), D_MODEL ** -0.5),
        "exp_b_gu": nrm(ks[18], (DEPTH, N_EXPERTS, 2 * D_FF), 0.02),
        "exp_w_down": nrm(ks[19], (DEPTH, N_EXPERTS, D_FF, D_MODEL), D_FF ** -0.5),
        "exp_b_down": nrm(ks[20], (DEPTH, N_EXPERTS, D_MODEL), 0.02),
        "ple_w_gate": nrm(ks[21], (DEPTH, D_MODEL, D_MODEL), D_MODEL ** -0.5),
        "ple_b_gate": nrm(ks[22], (DEPTH, D_MODEL), 0.02),
        "ple_w_proj": nrm(ks[23], (DEPTH, PLE_DIM, D_MODEL), PLE_DIM ** -0.5),
    }


def reference(x, p, norm_mix, norm_ffn, norm_ple, norm_final, pool_w, pool_scale,
              kv_norm, w_k, w_v, w_fgate, b_fgate, w_q, w_o,
              router_w, router_b, exp_w_gu, exp_b_gu, exp_w_down, exp_b_down,
              ple_w_gate, ple_b_gate, ple_w_proj):
    k_sh = v_sh = dc_sh = None
    for i in range(DEPTH):
        h = rms_norm(x, norm_mix[i])
        if i < N_A:
            x = x + pool_mixer(h, pool_w[i], pool_scale[i])
        else:
            j = i - N_A
            x = x + forgetting_attention(h, k_sh, v_sh, dc_sh, w_q[j], w_o[j])
        x = x + moe_ffn(rms_norm(x, norm_ffn[i]), router_w[i], router_b[i],
                        exp_w_gu[i], exp_b_gu[i], exp_w_down[i], exp_b_down[i])
        x = x + per_layer_embed(x, p[i], norm_ple[i], ple_w_gate[i], ple_b_gate[i], ple_w_proj[i])
        if i == N_A - 1:
            k_sh, v_sh, dc_sh = shared_key_side(x, kv_norm, w_k, w_v, w_fgate, b_fgate)
    return rms_norm(x, norm_final)
```

```cpp
#include <hip/hip_runtime.h>
#include <cstdio>
#include <cstdint>
namespace pg8 {
#define PG8_LAS __attribute__((address_space(3)))
typedef unsigned short bf16_t;
typedef short bf16x8 __attribute__((ext_vector_type(8)));
typedef float f32x4 __attribute__((ext_vector_type(4)));
typedef unsigned u32x4 __attribute__((ext_vector_type(4)));
constexpr int BM = 256, BK = 64, HALF = 128, HTB = HALF * BK * 2  , STAGE_BYTES = 8 * HTB, NXCD = 8, WGM = 8;

__host__ __device__ __forceinline__ int lds_byte(int r, int c) { const int st = (r >> 4) * 2 + (c >> 5), rr = r & 15, cc = c & 31, ob = rr * 64 + cc * 2; return st * 1024 + (ob ^ (((ob >> 9) & 1) << 5)); }
__host__ __device__ __forceinline__ void stage_rc(int b, int& R, int& C) { const int st = b / 1024, sb = b % 1024, swz = sb ^ (((sb >> 9) & 1) << 5); R = (st >> 1) * 16 + swz / 64; C = (st & 1) * 32 + (swz % 64) / 2; }
__host__ __device__ __forceinline__ int perm32(int rho) { const int n = rho >> 4, i = rho & 15; return 8 * (i >> 2) + 4 * n + (i & 3); }

struct Unit { int pm, pn, e; };
struct Gemm { const bf16_t* A; const bf16_t* Bt; int lda, ldb, K; };

struct DenseOrder {
    int nM, nN, nwg, G, c; size_t a_row, a_col, b_tile;
    __device__ __forceinline__ void init(int nM_, int nN_, int G_, int c_, int lda, int ldb, int a_col_elems) { nM = nM_; nN = nN_; nwg = nM * nN; G = G_; c = c_; a_row = (size_t)BM * lda * 2; a_col = (size_t)a_col_elems * 2; b_tile = (size_t)BM * ldb * 2; }
    __device__ __forceinline__ bool next(int i, Unit& u) const {
        const long L = (long)i * G + c; if (L >= nwg) return false;
        int wgid = (int)L; { const int q = nwg / NXCD, r = nwg % NXCD, xcd = wgid % NXCD, off = wgid / NXCD; wgid = (xcd < r ? xcd * (q + 1) : r * (q + 1) + (xcd - r) * q) + off; }
        const int nig = WGM * nN, gid = wgid / nig, fm = gid * WGM, gsz = (nM - fm) < WGM ? (nM - fm) : WGM;
        u.pm = fm + ((wgid % nig) % gsz); u.pn = (wgid % nig) / gsz; u.e = 0; return true;
    }
    __device__ __forceinline__ size_t a_off(const Unit& u) const { return (size_t)u.pm * a_row + (size_t)u.pn * a_col; }
    __device__ __forceinline__ size_t b_off(const Unit& u) const { return (size_t)u.pn * b_tile; }
    __device__ __forceinline__ void a_ready(const Unit&) const {}
    __device__ __forceinline__ void done(const Unit&) const {}
};
struct GroupedOrder {
    int nM, nN, nwg, G, c; const PG8_LAS int* tp; size_t a_row, b_exp, b_tile;
    __device__ __forceinline__ void init(const PG8_LAS int* tp_, int nN_, int G_, int c_, int lda, int ldb, int n_w_rows) { tp = tp_; nM = __builtin_amdgcn_readfirstlane(tp_[32]); nN = nN_; nwg = nM * nN; G = G_; c = c_; a_row = (size_t)BM * lda * 2; b_exp = (size_t)n_w_rows * ldb * 2; b_tile = (size_t)BM * ldb * 2; }
    __device__ __forceinline__ bool next(int i, Unit& u) const {
        const long L = (long)i * G + c; if (L >= nwg) return false;
        int wgid = (int)L; { const int q = nwg / NXCD, r = nwg % NXCD, xcd = wgid % NXCD, off = wgid / NXCD; wgid = (xcd < r ? xcd * (q + 1) : r * (q + 1) + (xcd - r) * q) + off; }
        const int nig = WGM * nN, gid = wgid / nig, fm = gid * WGM, gsz = (nM - fm) < WGM ? (nM - fm) : WGM;
        u.pm = fm + ((wgid % nig) % gsz); u.pn = (wgid % nig) / gsz;
        int e = 0;
#pragma unroll 1
        for (int k = 1; k < 32; ++k) e += (tp[k] <= u.pm) ? 1 : 0;
        u.e = __builtin_amdgcn_readfirstlane(e); u.pm = __builtin_amdgcn_readfirstlane(u.pm); u.pn = __builtin_amdgcn_readfirstlane(u.pn); return true;
    }
    __device__ __forceinline__ size_t a_off(const Unit& u) const { return (size_t)u.pm * a_row; }
    __device__ __forceinline__ size_t b_off(const Unit& u) const { return (size_t)u.e * b_exp + (size_t)u.pn * b_tile; }
    __device__ __forceinline__ void a_ready(const Unit&) const {}
    __device__ __forceinline__ void done(const Unit&) const {}
};

__device__ __forceinline__ unsigned cvt_pk_bf16(float lo, float hi) { unsigned r; asm volatile("v_cvt_pk_bf16_f32 %0, %1, %2" : "=v"(r) : "v"(lo), "v"(hi)); return r; }
__device__ __forceinline__ float bf_lo(unsigned w) { return __builtin_bit_cast(float, w << 16); }
__device__ __forceinline__ float bf_hi(unsigned w) { return __builtin_bit_cast(float, w & 0xffff0000u); }
__device__ __forceinline__ float rstd_of(float ss) { return __builtin_amdgcn_rsqf(ss * (1.f / 1024.f) + 1e-6f); }
__device__ __forceinline__ u32x4 pack8(const f32x4& a, const f32x4& b) { u32x4 w; w.x = cvt_pk_bf16(a[0], a[1]); w.y = cvt_pk_bf16(a[2], a[3]); w.z = cvt_pk_bf16(b[0], b[1]); w.w = cvt_pk_bf16(b[2], b[3]); return w; }
__device__ __forceinline__ void unpack8(const u32x4& w, f32x4& a, f32x4& b) { a = (f32x4){bf_lo(w.x), bf_hi(w.x), bf_lo(w.y), bf_hi(w.y)}; b = (f32x4){bf_lo(w.z), bf_hi(w.z), bf_lo(w.w), bf_hi(w.w)}; }
__device__ __forceinline__ float dot4(const f32x4& a) { return (a[0] * a[0] + a[1] * a[1]) + (a[2] * a[2] + a[3] * a[3]); }
__device__ __forceinline__ void ss_store(float* ssp, int row0  , const float (&sq)[2][4], int fq, int slot) {
#pragma unroll
    for (int ai = 0; ai < 2; ++ai) { float s[4];
#pragma unroll
        for (int m = 0; m < 4; ++m) { float v = sq[ai][m]; v += __shfl_xor(v, 16); v += __shfl_xor(v, 32); s[m] = v; }
        const float v = fq == 0 ? s[0] : fq == 1 ? s[1] : fq == 2 ? s[2] : s[3];
        ssp[(size_t)(row0 + ai * HALF + fq * 16) * 16 + slot] = v; }
}
__device__ __forceinline__ float rstd_row(const float* ssp, int row, int fq) {
    const f32x4 v = *(const f32x4*)(ssp + (size_t)row * 16 + fq * 4);
    float s = (v[0] + v[1]) + (v[2] + v[3]); s += __shfl_xor(s, 16); s += __shfl_xor(s, 32);
    return rstd_of(s);
}
struct EpiPool {
    static constexpr bool PERM = true, AFTER_DRAIN = false;
    const float* xin; const float* scale; bf16_t* Xo; float* ss;
    __device__ __forceinline__ void operator()(const f32x4 (&acc)[2][2][4][2], const Unit& u, int wr, int wc, int fr, int fq) const {
        const int row0 = u.pm * BM + wr * 64 + fr, col0 = u.pn * BM + wc * 32 + 8 * fq;
        float sq[2][4];
#pragma unroll
        for (int ai = 0; ai < 2; ++ai)
#pragma unroll
            for (int m = 0; m < 4; ++m) { const size_t ro = (size_t)(row0 + ai * HALF + m * 16) * 1024 + col0; float s = 0.f;
#pragma unroll
                for (int bj = 0; bj < 2; ++bj) { const f32x4 x0 = *(const f32x4*)(xin + ro + bj * HALF), x1 = *(const f32x4*)(xin + ro + bj * HALF + 4);
                    const f32x4 s0 = *(const f32x4*)(scale + col0 + bj * HALF), s1 = *(const f32x4*)(scale + col0 + bj * HALF + 4);
                    const f32x4 v0 = x0 + s0 * acc[ai][bj][m][0], v1 = x1 + s1 * acc[ai][bj][m][1];
                    s += dot4(v0) + dot4(v1); *(u32x4*)(Xo + ro + bj * HALF) = pack8(v0, v1); }
                sq[ai][m] = s; asm volatile("" ::: "memory"); }
        ss_store(ss, row0, sq, fq, u.pn * 4 + wc);
    }
};
struct EpiRouter {
    static constexpr bool PERM = true, AFTER_DRAIN = false;
    const float* ssin; const float* rb; float* logits;
    __device__ __forceinline__ void operator()(const f32x4 (&acc)[2][2][4][2], const Unit& u, int wr, int wc, int fr, int fq) const {
        if (wc != 0) return;
        const int row0 = u.pm * BM + wr * 64 + fr;
        const f32x4 b0 = *(const f32x4*)(rb + 8 * fq), b1 = *(const f32x4*)(rb + 8 * fq + 4);
#pragma unroll
        for (int ai = 0; ai < 2; ++ai)
#pragma unroll
            for (int m = 0; m < 4; ++m) { const int row = row0 + ai * HALF + m * 16; const float rs = rstd_row(ssin, row, fq);
                float* o = logits + (size_t)row * 32 + 8 * fq;
                *(f32x4*)o = acc[ai][0][m][0] * rs + b0; *(f32x4*)(o + 4) = acc[ai][0][m][1] * rs + b1; }
    }
};
struct EpiSwiGLU {
    static constexpr bool PERM = true, AFTER_DRAIN = false;
    const float* rowscale; const float* bgu; bf16_t* act;
    __device__ __forceinline__ void operator()(const f32x4 (&acc)[2][2][4][2], const Unit& u, int wr, int wc, int fr, int fq) const {
        const int row0 = u.pm * BM + wr * 64 + fr, cc = u.pn * HALF + wc * 32 + 8 * fq;
        const float* bg = bgu + (size_t)u.e * 2048 + cc;
        f32x4 bgt[2], bup[2];
#pragma unroll
        for (int n = 0; n < 2; ++n) { bgt[n] = *(const f32x4*)(bg + 4 * n); bup[n] = *(const f32x4*)(bg + 1024 + 4 * n); }
#pragma unroll
        for (int ai = 0; ai < 2; ++ai)
#pragma unroll
            for (int m = 0; m < 4; ++m) { const int row = row0 + ai * HALF + m * 16; const float rs = rowscale[row]; f32x4 y[2];
#pragma unroll
                for (int n = 0; n < 2; ++n) { const f32x4 g = acc[ai][0][m][n] * rs + bgt[n], up = acc[ai][1][m][n] * rs + bup[n];
#pragma unroll
                    for (int j = 0; j < 4; ++j) { const float gc = fminf(g[j], 7.0f), uc = fminf(fmaxf(up[j], -7.0f), 7.0f);
                        const float sg = __builtin_amdgcn_rcpf(1.0f + __builtin_amdgcn_exp2f(gc * (-1.702f * 1.4426950408889634f)));
                        y[n][j] = (uc + 1.0f) * (gc * sg); } }
                *(u32x4*)(act + (size_t)row * 1024 + cc) = pack8(y[0], y[1]); }
    }
};
struct EpiDown {
    static constexpr bool PERM = true, AFTER_DRAIN = false;
    const float* rowgate; const float* bd; bf16_t* Y;
    __device__ __forceinline__ void operator()(const f32x4 (&acc)[2][2][4][2], const Unit& u, int wr, int wc, int fr, int fq) const {
        const int row0 = u.pm * BM + wr * 64 + fr, col0 = u.pn * BM + wc * 32 + 8 * fq;
        const float* b = bd + (size_t)u.e * 1024 + col0;
        f32x4 bv[2][2];
#pragma unroll
        for (int bj = 0; bj < 2; ++bj)
#pragma unroll
            for (int n = 0; n < 2; ++n) bv[bj][n] = *(const f32x4*)(b + bj * HALF + 4 * n);
#pragma unroll
        for (int ai = 0; ai < 2; ++ai)
#pragma unroll
            for (int m = 0; m < 4; ++m) { const int row = row0 + ai * HALF + m * 16; const float gt = rowgate[row];
#pragma unroll
                for (int bj = 0; bj < 2; ++bj) { const f32x4 v0 = (acc[ai][bj][m][0] + bv[bj][0]) * gt, v1 = (acc[ai][bj][m][1] + bv[bj][1]) * gt;
                    *(u32x4*)(Y + (size_t)row * 1024 + col0 + bj * HALF) = pack8(v0, v1); } }
    }
};
struct EpiStore {
    static constexpr bool PERM = true, AFTER_DRAIN = false;
    bf16_t* O;
    __device__ __forceinline__ void operator()(const f32x4 (&acc)[2][2][4][2], const Unit& u, int wr, int wc, int fr, int fq) const {
        const int row0 = u.pm * BM + wr * 64 + fr, col0 = u.pn * BM + wc * 32 + 8 * fq;
#pragma unroll
        for (int ai = 0; ai < 2; ++ai)
#pragma unroll
            for (int m = 0; m < 4; ++m)
#pragma unroll
                for (int bj = 0; bj < 2; ++bj) *(u32x4*)(O + (size_t)(row0 + ai * HALF + m * 16) * 1024 + col0 + bj * HALF) = pack8(acc[ai][bj][m][0], acc[ai][bj][m][1]);
    }
};
struct EpiPle {
    static constexpr bool PERM = true, AFTER_DRAIN = false;
    const float* ssin; const float* bgate; const bf16_t* PJ; const bf16_t* Xi; bf16_t* Xo; float* ss;
    __device__ __forceinline__ void operator()(const f32x4 (&acc)[2][2][4][2], const Unit& u, int wr, int wc, int fr, int fq) const {
        const int row0 = u.pm * BM + wr * 64 + fr, col0 = u.pn * BM + wc * 32 + 8 * fq;
        f32x4 bv[2][2];
#pragma unroll
        for (int bj = 0; bj < 2; ++bj)
#pragma unroll
            for (int n = 0; n < 2; ++n) bv[bj][n] = *(const f32x4*)(bgate + col0 + bj * HALF + 4 * n);
        float sq[2][4];
#pragma unroll
        for (int ai = 0; ai < 2; ++ai)
#pragma unroll
            for (int mh = 0; mh < 4; mh += 2) { u32x4 pwv[2][2], xwv[2][2]; float rsv[2];
#pragma unroll
            for (int m2 = 0; m2 < 2; ++m2) { const int row = row0 + ai * HALF + (mh + m2) * 16; rsv[m2] = rstd_row(ssin, row, fq); const size_t ro = (size_t)row * 1024 + col0;
#pragma unroll
                for (int bj = 0; bj < 2; ++bj) { pwv[m2][bj] = *(const u32x4*)(PJ + ro + bj * HALF); xwv[m2][bj] = *(const u32x4*)(Xi + ro + bj * HALF); } }
#pragma unroll
            for (int m2 = 0; m2 < 2; ++m2) { const int m = mh + m2; const int row = row0 + ai * HALF + m * 16; const float rs = rsv[m2]; const size_t ro = (size_t)row * 1024 + col0; float s = 0.f;
#pragma unroll
                for (int bj = 0; bj < 2; ++bj) { f32x4 p0, p1, x0, x1; unpack8(pwv[m2][bj], p0, p1); unpack8(xwv[m2][bj], x0, x1);
                    f32x4 z0 = acc[ai][bj][m][0] * rs + bv[bj][0], z1 = acc[ai][bj][m][1] * rs + bv[bj][1];
#pragma unroll
                    for (int j = 0; j < 4; ++j) { z0[j] = __builtin_amdgcn_rcpf(1.0f + __builtin_amdgcn_exp2f(z0[j] * -1.4426950408889634f)); z1[j] = __builtin_amdgcn_rcpf(1.0f + __builtin_amdgcn_exp2f(z1[j] * -1.4426950408889634f)); }
                    const f32x4 v0 = x0 + z0 * p0, v1 = x1 + z1 * p1;
                    s += dot4(v0) + dot4(v1); *(u32x4*)(Xo + ro + bj * HALF) = pack8(v0, v1); }
                sq[ai][m] = s; }
            asm volatile("" ::: "memory"); }
        ss_store(ss, row0, sq, fq, u.pn * 4 + wc);
    }
};
struct EpiQkv {
    static constexpr bool PERM = true, AFTER_DRAIN = false;
    const float* ssin; bf16_t* Q; const float* bfg; float* LF; float qscale;
    __device__ __forceinline__ void operator()(const f32x4 (&acc)[2][2][4][2], const Unit& u, int wr, int wc, int fr, int fq) const {
        const int row0 = u.pm * BM + wr * 64 + fr;
        float rsr[2][4];
#pragma unroll
        for (int ai = 0; ai < 2; ++ai)
#pragma unroll
            for (int m = 0; m < 4; ++m) rsr[ai][m] = rstd_row(ssin, row0 + ai * HALF + m * 16, fq);
        if (u.pn < 12) {
            const int t = u.pn >> 2; bf16_t* base = Q + (size_t)t * (65536 * 1024); const float sc = t == 0 ? qscale : 1.0f;
            const int col0 = (u.pn & 3) * BM + wc * 32 + 8 * fq;
#pragma unroll
            for (int ai = 0; ai < 2; ++ai)
#pragma unroll
                for (int m = 0; m < 4; ++m) { const int row = row0 + ai * HALF + m * 16; const float rs = rsr[ai][m] * sc;
#pragma unroll
                    for (int bj = 0; bj < 2; ++bj) *(u32x4*)(base + (size_t)row * 1024 + col0 + bj * HALF) = pack8(acc[ai][bj][m][0] * rs, acc[ai][bj][m][1] * rs); }
        } else if (wc == 0 && fq < 2) {
            const f32x4 b0 = *(const f32x4*)(bfg + 8 * fq), b1 = *(const f32x4*)(bfg + 8 * fq + 4);
#pragma unroll
            for (int ai = 0; ai < 2; ++ai)
#pragma unroll
                for (int m = 0; m < 4; ++m) { const int row = row0 + ai * HALF + m * 16; const float rs = rsr[ai][m];
                    f32x4 z0 = acc[ai][0][m][0] * rs + b0, z1 = acc[ai][0][m][1] * rs + b1;
#pragma unroll
                    for (int j = 0; j < 4; ++j) { z0[j] = fminf(z0[j], 0.f) - 0.6931471805599453f * __builtin_amdgcn_logf(1.0f + __builtin_amdgcn_exp2f(-1.4426950408889634f * fabsf(z0[j]))); z1[j] = fminf(z1[j], 0.f) - 0.6931471805599453f * __builtin_amdgcn_logf(1.0f + __builtin_amdgcn_exp2f(-1.4426950408889634f * fabsf(z1[j]))); }
                    *(f32x4*)(LF + (size_t)row * 16 + 8 * fq) = z0; *(f32x4*)(LF + (size_t)row * 16 + 8 * fq + 4) = z1; }
        }
    }
};
struct EpiWo {
    static constexpr bool PERM = true, AFTER_DRAIN = false;
    bf16_t* X; float* ss;
    __device__ __forceinline__ void operator()(const f32x4 (&acc)[2][2][4][2], const Unit& u, int wr, int wc, int fr, int fq) const {
        const int row0 = u.pm * BM + wr * 64 + fr, col0 = u.pn * BM + wc * 32 + 8 * fq;
        float sq[2][4];
#pragma unroll
        for (int ai = 0; ai < 2; ++ai) { u32x4 xwv[4][2];
#pragma unroll
            for (int m = 0; m < 4; ++m) { const size_t ro = (size_t)(row0 + ai * HALF + m * 16) * 1024 + col0;
#pragma unroll
                for (int bj = 0; bj < 2; ++bj) xwv[m][bj] = *(const u32x4*)(X + ro + bj * HALF); }
#pragma unroll
            for (int m = 0; m < 4; ++m) { const size_t ro = (size_t)(row0 + ai * HALF + m * 16) * 1024 + col0; float s = 0.f;
#pragma unroll
                for (int bj = 0; bj < 2; ++bj) { f32x4 x0, x1; unpack8(xwv[m][bj], x0, x1);
                    const f32x4 v0 = x0 + acc[ai][bj][m][0], v1 = x1 + acc[ai][bj][m][1];
                    s += dot4(v0) + dot4(v1); *(u32x4*)(X + ro + bj * HALF) = pack8(v0, v1); }
                sq[ai][m] = s; }
            asm volatile("" ::: "memory"); }
        ss_store(ss, row0, sq, fq, u.pn * 4 + wc);
    }
};

template <class Epi, class Sched>
__device__ __forceinline__ void gemm_phase(PG8_LAS unsigned char* lds, const Gemm g, const Sched& S, const Epi& E) {
    int tid = threadIdx.x; asm volatile("" : "+v"(tid));
    const int wid = __builtin_amdgcn_readfirstlane(tid >> 6), lane = tid & 63, wr = wid >> 2, wc = wid & 3, fr = lane & 15, fq = lane >> 4;
    constexpr bool ALIGN_EPI = true, SP2 = true; const int K = g.K, nt = K / BK, lda = g.lda, ldb = g.ldb;
    unsigned voffA[2], voffB[2];
#pragma unroll
    for (int i = 0; i < 2; ++i) { int R, C; stage_rc(tid * 16 + i * 8192, R, C); const int Rb = Epi::PERM ? ((R & ~31) + perm32(R & 31)) : R;
        voffA[i] = (unsigned)(R * lda + C) * 2u; voffB[i] = (unsigned)(Rb * ldb + C) * 2u; }
    const size_t kstep = (size_t)(BK * 2);
    const size_t hstepA = (size_t)HALF * lda * 2, hstepB = (size_t)HALF * ldb * 2;
    const unsigned ldsw = (unsigned)wid * 1024u;
    const int aoff = lds_byte(wr * 64 + fr, fq * 8), boff = lds_byte(wc * 32 + fr, fq * 8);
#define PG8_SA(b, h) (((b) * 2 + (h)) * HTB)
#define PG8_SB(b, h) ((4 + (b) * 2 + (h)) * HTB)
#define PG8_STAGE(bufoff, gbase, voff) do { _Pragma("unroll") for (int _i = 0; _i < 2; ++_i) \
        __builtin_amdgcn_global_load_lds((const unsigned*)((const char*)(gbase) + (voff)[_i]), (PG8_LAS unsigned*)(lds + (bufoff) + ldsw + _i * 8192), 16, 0, 0); } while (0)
#define PG8_LDA(dst, b, h) do { _Pragma("unroll") for (int m = 0; m < 4; ++m) _Pragma("unroll") for (int k = 0; k < 2; ++k) dst[m][k] = *(const PG8_LAS bf16x8*)(lds + PG8_SA(b, h) + aoff + m * 2048 + k * 1024); } while (0)
#define PG8_LDB(dst, b, h) do { _Pragma("unroll") for (int n = 0; n < 2; ++n) _Pragma("unroll") for (int k = 0; k < 2; ++k) dst[n][k] = *(const PG8_LAS bf16x8*)(lds + PG8_SB(b, h) + boff + n * 2048 + k * 1024); } while (0)
#define PG8_MMA(ai, bj, At, Bt) do { __builtin_amdgcn_s_setprio(1); _Pragma("unroll") for (int m = 0; m < 4; ++m) _Pragma("unroll") for (int n = 0; n < 2; ++n) _Pragma("unroll") for (int k = 0; k < 2; ++k) \
        acc[ai][bj][m][n] = __builtin_amdgcn_mfma_f32_16x16x32_bf16(Bt[n][k], At[m][k], acc[ai][bj][m][n], 0, 0, 0); __builtin_amdgcn_s_setprio(0); } while (0)
#define PG8_WAIT_V(n) asm volatile("s_waitcnt vmcnt(" #n ")" ::: "memory")
#define PG8_WAIT_L(n) asm volatile("s_waitcnt lgkmcnt(" #n ")" ::: "memory")
#define PG8_BAR __builtin_amdgcn_s_barrier()
#define PG8_SCHED __builtin_amdgcn_sched_barrier(0)
    Unit cur, nxt; int ui = 0;
    if (!S.next(0, cur)) return;
    f32x4 acc[2][2][4][2];
#pragma unroll
    for (int a = 0; a < 2; ++a)
#pragma unroll
        for (int b = 0; b < 2; ++b)
#pragma unroll
            for (int m = 0; m < 4; ++m)
#pragma unroll
                for (int n = 0; n < 2; ++n) acc[a][b][m][n] = (f32x4){0.f, 0.f, 0.f, 0.f};
    bf16x8 At[4][2], B0[2][2], B1[2][2];
    const char* cA = (const char*)g.A + S.a_off(cur); const char* cB = (const char*)g.Bt + S.b_off(cur);
    S.a_ready(cur);
    if constexpr (SP2) {
        PG8_STAGE(PG8_SB(0, 0), cB, voffB); PG8_STAGE(PG8_SB(0, 1), cB + hstepB, voffB); PG8_STAGE(PG8_SA(0, 0), cA, voffA); PG8_STAGE(PG8_SA(0, 1), cA + hstepA, voffA);
        if (wr == 1) PG8_BAR;
        PG8_WAIT_V(2); PG8_BAR;
        PG8_STAGE(PG8_SB(1, 0), cB + kstep, voffB); PG8_STAGE(PG8_SA(1, 0), cA + kstep, voffA); PG8_STAGE(PG8_SB(1, 1), cB + hstepB + kstep, voffB);
        PG8_WAIT_V(6); PG8_BAR;
    } else {
        PG8_STAGE(PG8_SB(0, 0), cB, voffB); PG8_STAGE(PG8_SA(0, 0), cA, voffA); PG8_STAGE(PG8_SB(0, 1), cB + hstepB, voffB); PG8_STAGE(PG8_SA(0, 1), cA + hstepA, voffA);
        if (wr == 1) PG8_BAR;
        PG8_WAIT_V(4); PG8_BAR;
        PG8_STAGE(PG8_SB(1, 0), cB + kstep, voffB); PG8_STAGE(PG8_SA(1, 0), cA + kstep, voffA); PG8_STAGE(PG8_SB(1, 1), cB + hstepB + kstep, voffB);
        PG8_WAIT_V(6); PG8_BAR;
    }
    for (;;) {
        const bool has_next = S.next(ui + 1, nxt);
        const char* nA = has_next ? (const char*)g.A + S.a_off(nxt) : cA; const char* nB = has_next ? (const char*)g.Bt + S.b_off(nxt) : cB;
        for (int t = 0; t < nt; t += 2) {
            const bool last = (t == nt - 2);
            const char* a1 = cA + (size_t)(t + 1) * kstep;
            const char* a2 = last ? nA : cA + (size_t)(t + 2) * kstep; const char* b2 = last ? nB : cB + (size_t)(t + 2) * kstep;
            const char* a3 = a2 + kstep; const char* b3 = b2 + kstep;
            if (last && has_next) S.a_ready(nxt);
            if constexpr (SP2) {
            PG8_LDB(B0, 0, 0); PG8_LDB(B1, 0, 1); PG8_SCHED; PG8_LDA(At, 0, 0); PG8_STAGE(PG8_SA(1, 1), a1 + hstepA, voffA);
            PG8_WAIT_V(8); PG8_WAIT_L(0); PG8_BAR; PG8_MMA(0, 0, At, B0); PG8_MMA(0, 1, At, B1); PG8_BAR; PG8_SCHED;
            PG8_LDA(At, 0, 1); PG8_STAGE(PG8_SB(0, 0), b2, voffB); PG8_STAGE(PG8_SB(0, 1), b2 + hstepB, voffB); PG8_STAGE(PG8_SA(0, 0), a2, voffA);
            PG8_WAIT_V(8); PG8_WAIT_L(0); PG8_BAR; PG8_MMA(1, 0, At, B0); PG8_MMA(1, 1, At, B1); PG8_BAR; PG8_SCHED;
            PG8_LDB(B0, 1, 0); PG8_LDB(B1, 1, 1); PG8_SCHED; PG8_LDA(At, 1, 0); PG8_STAGE(PG8_SA(0, 1), a2 + hstepA, voffA);
            PG8_WAIT_V(8); PG8_WAIT_L(0); PG8_BAR; PG8_MMA(0, 0, At, B0); PG8_MMA(0, 1, At, B1); PG8_BAR; PG8_SCHED;
            PG8_LDA(At, 1, 1); PG8_STAGE(PG8_SB(1, 0), b3, voffB); PG8_STAGE(PG8_SB(1, 1), b3 + hstepB, voffB); PG8_STAGE(PG8_SA(1, 0), a3, voffA);
            PG8_WAIT_V(8); PG8_WAIT_L(0); PG8_BAR; PG8_MMA(1, 0, At, B0); PG8_MMA(1, 1, At, B1); PG8_BAR; PG8_SCHED;
            } else {
            PG8_LDB(B0, 0, 0); PG8_SCHED; PG8_LDA(At, 0, 0); PG8_STAGE(PG8_SA(1, 1), a1 + hstepA, voffA);
            PG8_WAIT_L(8); PG8_BAR; PG8_WAIT_L(0); PG8_MMA(0, 0, At, B0); PG8_BAR; PG8_SCHED;
            PG8_LDB(B1, 0, 1); PG8_STAGE(PG8_SB(0, 0), b2, voffB);
            PG8_BAR; PG8_WAIT_L(0); PG8_MMA(0, 1, At, B1); PG8_BAR;
            PG8_LDA(At, 0, 1); PG8_STAGE(PG8_SA(0, 0), a2, voffA);
            PG8_BAR; PG8_WAIT_L(0); PG8_MMA(1, 0, At, B0); PG8_BAR; PG8_SCHED;
            PG8_STAGE(PG8_SB(0, 1), b2 + hstepB, voffB);
            PG8_WAIT_V(6); PG8_BAR; PG8_MMA(1, 1, At, B1); PG8_BAR;
            PG8_LDB(B0, 1, 0); PG8_SCHED; PG8_LDA(At, 1, 0); PG8_STAGE(PG8_SA(0, 1), a2 + hstepA, voffA);
            PG8_WAIT_L(8); PG8_BAR; PG8_WAIT_L(0); PG8_MMA(0, 0, At, B0); PG8_BAR; PG8_SCHED;
            PG8_LDB(B1, 1, 1); PG8_STAGE(PG8_SB(1, 0), b3, voffB);
            PG8_BAR; PG8_WAIT_L(0); PG8_MMA(0, 1, At, B1); PG8_BAR;
            PG8_LDA(At, 1, 1); PG8_STAGE(PG8_SA(1, 0), a3, voffA);
            PG8_BAR; PG8_WAIT_L(0); PG8_MMA(1, 0, At, B0); PG8_BAR; PG8_SCHED;
            PG8_STAGE(PG8_SB(1, 1), b3 + hstepB, voffB);
            PG8_WAIT_V(6); PG8_BAR; PG8_MMA(1, 1, At, B1); PG8_BAR;
            }
        }
        if constexpr (ALIGN_EPI) { if (wr == 0) PG8_BAR; }
        { int t2 = threadIdx.x; asm volatile("" : "+v"(t2));
          const int w2 = __builtin_amdgcn_readfirstlane(t2 >> 6), l2 = t2 & 63; E(acc, cur, w2 >> 2, w2 & 3, l2 & 15, l2 >> 4); S.done(cur); }
        if (!has_next) break;
#pragma unroll
        for (int a = 0; a < 2; ++a)
#pragma unroll
            for (int b = 0; b < 2; ++b)
#pragma unroll
                for (int m = 0; m < 4; ++m)
#pragma unroll
                    for (int n = 0; n < 2; ++n) acc[a][b][m][n] = (f32x4){0.f, 0.f, 0.f, 0.f};
        cur = nxt; cA = nA; cB = nB; ++ui;
        if constexpr (ALIGN_EPI) { if (wr == 1) PG8_BAR; }
    }
    PG8_WAIT_V(0);
    if constexpr (!ALIGN_EPI) { if (wr == 0) PG8_BAR; }
    PG8_BAR;
#undef PG8_SA
#undef PG8_SB
#undef PG8_STAGE
#undef PG8_LDA
#undef PG8_LDB
#undef PG8_MMA
#undef PG8_WAIT_V
#undef PG8_WAIT_L
#undef PG8_BAR
#undef PG8_SCHED
}
}
#include <hip/hip_bf16.h>
#include <cmath>
namespace attn_body {
using bf16=__hip_bfloat16;
using bf16x8=__attribute__((ext_vector_type(8)))short;
using s16x4=__attribute__((ext_vector_type(4)))short;
using f32x16=__attribute__((ext_vector_type(16)))float;
using u32x4=__attribute__((ext_vector_type(4)))unsigned;
using f32x4_t=__attribute__((ext_vector_type(4)))float;
constexpr int BATCH=8,NHEAD=16,SEQ=8192,D=64,DM=NHEAD*D;
constexpr int NW=8,QBLK=32,QB=QBLK*NW,KVBLK=64,NQB=SEQ/QB;
constexpr int ATTN_PITCH=DM, ATTN_UNIT_ROWS=QB;
__device__ __forceinline__ int crow(int r,int hi){return (r&3)+8*(r>>2)+4*hi;}
#define SBAR() __builtin_amdgcn_sched_barrier(0)
__device__ __forceinline__ void cmask(f32x16&p0,f32x16&p1,int jb,int qrel,int hi){
  const float NEG=-INFINITY; int kb=64*jb+4*hi;
  #pragma unroll
  for(int r=0;r<16;++r){int kv=kb+(r&3)+8*(r>>2); if(kv>qrel)p0[r]=NEG; if(kv+32>qrel)p1[r]=NEG;}
}

constexpr int NSLOT=3, SLOTB=8192;
constexpr int LDS_K=0, LDS_V=NSLOT*SLOTB, LDS_WS=2*NSLOT*SLOTB, LDS_OST=LDS_WS+NW*64*4, LDS_BIAS=LDS_OST+NW*4096, LDS_BYTES=LDS_BIAS+SEQ*4;
constexpr float C2=0.125f*1.4426950408889634f;
__device__ __forceinline__ void glds16(const void*gsrc,unsigned lds_dst){unsigned keep;
  asm volatile("s_mov_b32 %0, m0\n\ts_mov_b32 m0, %2\n\ts_nop 0\n\tglobal_load_lds_dwordx4 %1, off\n\ts_mov_b32 m0, %0":"=&s"(keep):"v"(gsrc),"s"(lds_dst):"memory");}
__device__ __forceinline__ float max3f(float a,float b,float c){float r;asm("v_max3_f32 %0, %1, %2, %3":"=v"(r):"v"(a),"v"(b),"v"(c));return r;}
__device__ __forceinline__ float max2f(float a,float b){float r;asm("v_max_f32_e32 %0, %1, %2":"=v"(r):"v"(a),"v"(b));return r;}
__device__ __forceinline__ float fadd_s(float a,float b){float r;asm("v_add_f32_e32 %0, %1, %2":"=v"(r):"v"(a),"v"(b));return r;}
__device__ __forceinline__ float fsub_s(float a,float b){float r;asm("v_sub_f32_e32 %0, %1, %2":"=v"(r):"v"(a),"v"(b));return r;}
typedef float f32x2_t __attribute__((ext_vector_type(2))); typedef __bf16 bf16x2_t __attribute__((ext_vector_type(2)));
__device__ __forceinline__ unsigned cvtpk_s(float lo,float hi){f32x2_t v={lo,hi};bf16x2_t b=__builtin_convertvector(v,bf16x2_t);return __builtin_bit_cast(unsigned,b);}
#define WAIT_BAR(N) asm volatile("s_waitcnt vmcnt(" #N ") lgkmcnt(0)\n\ts_barrier":::"memory")

__device__ __forceinline__ void qkt(f32x16&p0,f32x16&p1,const char*Kslot,const bf16x8*qr,const f32x16&c0,const f32x16&c1,int r32,int hi){
  const char*kb=Kslot+hi*1024+r32*16;
  #pragma unroll
  for(int d0=0;d0<4;++d0){
    const bf16x8 b0=*reinterpret_cast<const bf16x8*>(kb+d0*2048);
    const bf16x8 b1=*reinterpret_cast<const bf16x8*>(kb+d0*2048+512);
    if(d0==0){p0=__builtin_amdgcn_mfma_f32_32x32x16_bf16(b0,qr[0],c0,0,0,0);p1=__builtin_amdgcn_mfma_f32_32x32x16_bf16(b1,qr[0],c1,0,0,0);}
    else{p0=__builtin_amdgcn_mfma_f32_32x32x16_bf16(b0,qr[d0],p0,0,0,0);p1=__builtin_amdgcn_mfma_f32_32x32x16_bf16(b1,qr[d0],p1,0,0,0);}}
}
typedef __attribute__((address_space(3))) const char* lds_cptr;
typedef short v4i16_t __attribute__((ext_vector_type(4)));
__device__ __forceinline__ void kload8(bf16x8*kf,lds_cptr kp){
  kf[0]=*(const __attribute__((address_space(3))) bf16x8*)(kp);      kf[1]=*(const __attribute__((address_space(3))) bf16x8*)(kp+512);
  kf[2]=*(const __attribute__((address_space(3))) bf16x8*)(kp+2048); kf[3]=*(const __attribute__((address_space(3))) bf16x8*)(kp+2560);
  kf[4]=*(const __attribute__((address_space(3))) bf16x8*)(kp+4096); kf[5]=*(const __attribute__((address_space(3))) bf16x8*)(kp+4608);
  kf[6]=*(const __attribute__((address_space(3))) bf16x8*)(kp+6144); kf[7]=*(const __attribute__((address_space(3))) bf16x8*)(kp+6656);
}
__device__ __forceinline__ void kload2(bf16x8*kf,lds_cptr kp,int j){ kf[2*j]=*(const __attribute__((address_space(3))) bf16x8*)(kp+j*2048); kf[2*j+1]=*(const __attribute__((address_space(3))) bf16x8*)(kp+j*2048+512); }
__device__ __forceinline__ s16x4 vtr(lds_cptr p){ return __builtin_bit_cast(s16x4,__builtin_amdgcn_ds_read_tr16_b64_v4i16((__attribute__((address_space(3))) v4i16_t*)p)); }
__device__ __forceinline__ float rowmax(const f32x16&p0,const f32x16&p1){
  float a=max3f(p0[0],p0[1],p1[0]),b=max3f(p0[2],p0[3],p1[1]);a=max3f(a,p1[2],p1[3]);
  #pragma unroll
  for(int r=4;r<16;r+=4){a=max3f(a,p0[r],p0[r+1]);b=max3f(b,p0[r+2],p0[r+3]);a=max3f(a,p1[r],p1[r+1]);b=max3f(b,p1[r+2],p1[r+3]);}
  const float m=max2f(a,b);
  auto rr=__builtin_amdgcn_permlane32_swap(__float_as_uint(m),__float_as_uint(m),false,false);
  return max2f(__uint_as_float(rr[0]),__uint_as_float(rr[1]));
}
__device__ __forceinline__ void pv(f32x16*o,int vb,bf16x8 pa0,bf16x8 pa1,bf16x8 pa2,bf16x8 pa3){
  #pragma unroll
  for(int d0=0;d0<2;++d0){s16x4 lo[4],hi[4];
    #pragma unroll
    for(int ks=0;ks<4;++ks){
      asm volatile("ds_read_b64_tr_b16 %0,%1 offset:%c2":"=&v"(lo[ks]):"v"(vb),"i"(d0*4096+ks*1024):"memory");
      asm volatile("ds_read_b64_tr_b16 %0,%1 offset:%c2":"=&v"(hi[ks]):"v"(vb),"i"(d0*4096+ks*1024+512):"memory");}
    asm volatile("s_waitcnt lgkmcnt(0)":::"memory");SBAR();
    #define PK(k) (bf16x8){lo[k][0],lo[k][1],lo[k][2],lo[k][3],hi[k][0],hi[k][1],hi[k][2],hi[k][3]}
    o[d0]=__builtin_amdgcn_mfma_f32_32x32x16_bf16(pa0,PK(0),o[d0],0,0,0);
    o[d0]=__builtin_amdgcn_mfma_f32_32x32x16_bf16(pa1,PK(1),o[d0],0,0,0);
    o[d0]=__builtin_amdgcn_mfma_f32_32x32x16_bf16(pa2,PK(2),o[d0],0,0,0);
    o[d0]=__builtin_amdgcn_mfma_f32_32x32x16_bf16(pa3,PK(3),o[d0],0,0,0);
    #undef PK
  }
}

#ifndef ATTN_STORE16
#define ATTN_STORE16(p,v) (*(u32x4*)(p)=(v))
#endif
template<int THRL> __device__ __forceinline__ void attn_unit(int b,int h,int qb,const bf16*Q,const bf16*__restrict__ K,const bf16*__restrict__ V,bf16*O,const float*biasg,char*shm){
  int tid=threadIdx.x; asm volatile("":"+v"(tid)); const int lane=tid&63,r32=lane&31,hi=lane>>5; const int wid=__builtin_amdgcn_readfirstlane(tid>>6);
  const long rowbase=(long)b*SEQ; const int q0=qb*QB;
  const bf16*Qw=Q+(rowbase+q0+wid*QBLK)*DM+h*D;
  const bf16*Kh=K+rowbase*DM+h*D,*Vh=V+rowbase*DM+h*D;
  const unsigned lds0=(unsigned)(uintptr_t)shm;
  float*wsf=(float*)(shm+LDS_WS)+wid*64;
  const bf16*ksrc=Kh+(long)lane*DM+wid*8;
  const bf16*vsrc=Vh+(long)(16*(wid&3)+(lane>>2))*DM+(wid>>2)*32+(lane&3)*8;
  const unsigned kdst=lds0+LDS_K+wid*1024, vdst=lds0+LDS_V+wid*1024;
  #define DMA_K(t,slot) glds16(ksrc+(long)(t)*KVBLK*DM,(unsigned)__builtin_amdgcn_readfirstlane(kdst+(slot)))
  #define DMA_V(t,slot) glds16(vsrc+(long)(t)*KVBLK*DM,(unsigned)__builtin_amdgcn_readfirstlane(vdst+(slot)))
  const int vb0=(int)(lds0+LDS_V)+((lane>>4)&1)*32+(lane&3)*8+(4*hi+((lane&15)>>2))*64;
  const char*Kbase=shm+LDS_K; bf16x8 kf[8];
  const lds_cptr shm3=(lds_cptr)shm; const lds_cptr kp0=shm3+LDS_K+hi*1024+r32*16; const lds_cptr vp0=shm3+LDS_V+((lane>>4)&1)*32+(lane&3)*8+(4*hi+((lane&15)>>2))*64;
  const int NT=(q0+QB)/KVBLK;
  { const float*bg=biasg+(long)(b*NHEAD+h)*SEQ; const int nb=NT*KVBLK;
    for(int i=tid*4;i<nb;i+=NW*64*4){ const f32x4_t v=*reinterpret_cast<const f32x4_t*>(bg+i); *(__attribute__((address_space(3))) f32x4_t*)((__attribute__((address_space(3))) char*)(shm3+LDS_BIAS)+i*4)=v; } }
  const lds_cptr bp0=shm3+LDS_BIAS+hi*16;
  DMA_K(0,0);DMA_V(0,0);DMA_K(1,SLOTB);
  bf16x8 qr[4];
  #pragma unroll
  for(int d0=0;d0<4;++d0)qr[d0]=*reinterpret_cast<const bf16x8*>(&Qw[(long)r32*DM+d0*16+hi*8]);
  float mhat=0.f,l_reg=0.f;f32x16 o[2];o[0]=f32x16{};o[1]=f32x16{};f32x16 cb0,cb1;
  #define LOADCB(t) do{ const lds_cptr bp_=bp0+(t)*256; _Pragma("unroll") for(int j_=0;j_<4;++j_){ \
      const f32x4_t u0_=*(const __attribute__((address_space(3))) f32x4_t*)(bp_+j_*32); const f32x4_t u1_=*(const __attribute__((address_space(3))) f32x4_t*)(bp_+128+j_*32); \
      _Pragma("unroll") for(int i_=0;i_<4;++i_){ cb0[4*j_+i_]=u0_[i_]-mhat; cb1[4*j_+i_]=u1_[i_]-mhat; } } }while(0)
  const int qrel=wid*QBLK+r32;
  #define CMASK(P0,P1,t) do{int jb_=(t)-(NT-4); if(jb_>=0)cmask(P0,P1,jb_,qrel,hi);}while(0)
  bool resc=false;
  #define START(P0,P1) do{ const float rm=rowmax(P0,P1); resc=false; \
    { const float dl=rm; mhat=fadd_s(mhat,dl); \
      _Pragma("unroll") for(int r=0;r<16;++r){P0[r]=fsub_s(P0[r],dl);P1[r]=fsub_s(P1[r],dl);} \
      } \
    _Pragma("unroll") for(int r=0;r<16;++r)P0[r]=__builtin_amdgcn_exp2f(P0[r]); }while(0)
  #define RESC() do{ if(resc){ asm volatile("s_waitcnt lgkmcnt(0)":::"memory"); \
      _Pragma("unroll") for(int d_=0;d_<2;++d_) _Pragma("unroll") for(int r=0;r<16;++r)o[d_][r]*=wsf[crow(r,hi)]; } }while(0)
  f32x16 pA0,pA1,pB0,pB1;
  int sl_prev=0,sl_cur=0,sl_next=SLOTB;
  #define ROT() do{sl_prev=sl_cur;sl_cur=sl_next;sl_next=(sl_next==(NSLOT-1)*SLOTB)?0:sl_next+SLOTB;}while(0)
  DMA_K(2,2*SLOTB);
  WAIT_BAR(3);
  LOADCB(0); qkt(pA0,pA1,Kbase,qr,cb0,cb1,r32,hi);asm volatile("s_nop 15\n\ts_nop 7":"+v"(pA0),"+v"(pA1));CMASK(pA0,pA1,0);
  START(pA0,pA1);
  _Pragma("unroll") for(int r=0;r<16;++r)pA1[r]=__builtin_amdgcn_exp2f(pA1[r]);
  WAIT_BAR(0);
  DMA_K(3,0);DMA_V(1,SLOTB);
  ROT();
  kload8(kf,kp0+sl_cur);
  WAIT_BAR(2);
  s16x4 vlo[8],vhi[8]; u32x4 pw0,pw1,pw2,pw3;
  #define PKW(P,B) cvtpk_s(P[B],P[B+1])
  #define PAF(k) __builtin_bit_cast(bf16x8,pw##k)
  #define VFR(i) (bf16x8){vlo[i][0],vlo[i][1],vlo[i][2],vlo[i][3],vhi[i][0],vhi[i][1],vhi[i][2],vhi[i][3]}
  #define PIN(x) asm volatile("":"+v"(x))
  #define MX3(a,b,c) __builtin_fmaxf(__builtin_fmaxf((a),(b)),(c))
  #define GAPA(MF,A0,A1,A2,A3,W0,W1,PW) do{ MF; sacc+=A0; sacc+=A1; sacc+=A2; sacc+=A3; PIN(sacc); W0; W1; PIN(PW); SBAR(); }while(0)
  #define EX(v) __builtin_amdgcn_exp2f(v)
  #define GAPB(MF,X,B) do{ MF; X[B]=EX(X[B]); X[B+1]=EX(X[B+1]); X[B+2]=EX(X[B+2]); X[B+3]=EX(X[B+3]); PIN(X); SBAR(); }while(0)
  #define VRD(i) do{ vlo[i]=vtr(vp_+(((i)>>2)*4096+((i)&3)*1024)); vhi[i]=vtr(vp_+(((i)>>2)*4096+((i)&3)*1024+512)); }while(0)
  #define KRD(G,j) do{ if(G){ kload2(kf,kp0+sl_next,j); SBAR(); } }while(0)
  #define STEP(C0,C1,P0,P1,t,GK,GV,GL) do{ SBAR(); \
    LOADCB(t); SBAR(); \
    const lds_cptr vp_=vp0+sl_prev; \
    VRD(0); SBAR(); float sacc=(P0[0]+P0[1]); \
    GAPA(C0=__builtin_amdgcn_mfma_f32_32x32x16_bf16(kf[0],qr[0],cb0,0,0,0), P0[2],P0[3],P0[4],P0[5],     pw0[0]=PKW(P0,0), pw0[1]=PKW(P0,2), pw0); \
    VRD(4); SBAR(); GAPA(C1=__builtin_amdgcn_mfma_f32_32x32x16_bf16(kf[1],qr[0],cb1,0,0,0), P0[6],P0[7],P0[8],P0[9],     pw0[2]=PKW(P0,4), pw0[3]=PKW(P0,6), pw0); \
    VRD(1); SBAR(); GAPA(C0=__builtin_amdgcn_mfma_f32_32x32x16_bf16(kf[2],qr[1],C0,0,0,0),   P0[10],P0[11],P0[12],P0[13], pw1[0]=PKW(P0,8), pw1[1]=PKW(P0,10), pw1); \
    VRD(5); SBAR(); GAPA(C1=__builtin_amdgcn_mfma_f32_32x32x16_bf16(kf[3],qr[1],C1,0,0,0),   P0[14],P0[15],P1[0],P1[1],   pw1[2]=PKW(P0,12),pw1[3]=PKW(P0,14), pw1); \
    VRD(2); SBAR(); GAPA(C0=__builtin_amdgcn_mfma_f32_32x32x16_bf16(kf[4],qr[2],C0,0,0,0),   P1[2],P1[3],P1[4],P1[5],     pw2[0]=PKW(P1,0), pw2[1]=PKW(P1,2), pw2); \
    VRD(6); SBAR(); GAPA(C1=__builtin_amdgcn_mfma_f32_32x32x16_bf16(kf[5],qr[2],C1,0,0,0),   P1[6],P1[7],P1[8],P1[9],     pw2[2]=PKW(P1,4), pw2[3]=PKW(P1,6), pw2); \
    VRD(3); SBAR(); GAPA(C0=__builtin_amdgcn_mfma_f32_32x32x16_bf16(kf[6],qr[3],C0,0,0,0),   P1[10],P1[11],P1[12],P1[13], pw3[0]=PKW(P1,8), pw3[1]=PKW(P1,10), pw3); \
    VRD(7); SBAR(); GAPA(C1=__builtin_amdgcn_mfma_f32_32x32x16_bf16(kf[7],qr[3],C1,0,0,0),   P1[14],P1[15],0.f,0.f,       pw3[2]=PKW(P1,12),pw3[3]=PKW(P1,14), pw3); \
    l_reg+=sacc; \
    if(GK){DMA_K((t)+3,sl_cur);} if(GV){DMA_V((t)+1,sl_next);} \
    CMASK(C0,C1,t); \
    { float a=MX3(C0[0],C0[1],C1[0]),b=MX3(C0[2],C0[3],C1[1]); a=MX3(a,C1[2],C1[3]); \
      _Pragma("unroll") for(int r=4;r<16;r+=4){a=MX3(a,C0[r],C0[r+1]);b=MX3(b,C0[r+2],C0[r+3]);a=MX3(a,C1[r],C1[r+1]);b=MX3(b,C1[r+2],C1[r+3]);} \
      float rm=__builtin_fmaxf(a,b); { auto rr=__builtin_amdgcn_permlane32_swap(__float_as_uint(rm),__float_as_uint(rm),false,false); rm=__builtin_fmaxf(__uint_as_float(rr[0]),__uint_as_float(rr[1])); } \
      resc=false; \
      if(__builtin_expect(__any(rm>(float)THRL),0)){ const float dl=__builtin_fmaxf(rm,0.f); mhat+=dl; \
        _Pragma("unroll") for(int r=0;r<16;++r){C0[r]-=dl;C1[r]-=dl;} \
        const float f=__builtin_amdgcn_exp2f(-dl); l_reg*=f; if(hi==0)wsf[r32]=f; resc=true; } } \
    SBAR(); \
    GAPB(o[0]=__builtin_amdgcn_mfma_f32_32x32x16_bf16(PAF(0),VFR(0),o[0],0,0,0), C0,0); \
    GAPB(o[1]=__builtin_amdgcn_mfma_f32_32x32x16_bf16(PAF(0),VFR(4),o[1],0,0,0), C0,4); \
    KRD(GL,0); GAPB(o[0]=__builtin_amdgcn_mfma_f32_32x32x16_bf16(PAF(1),VFR(1),o[0],0,0,0), C0,8); \
    KRD(GL,1); GAPB(o[1]=__builtin_amdgcn_mfma_f32_32x32x16_bf16(PAF(1),VFR(5),o[1],0,0,0), C0,12); \
    KRD(GL,2); GAPB(o[0]=__builtin_amdgcn_mfma_f32_32x32x16_bf16(PAF(2),VFR(2),o[0],0,0,0), C1,0); \
    KRD(GL,3); GAPB(o[1]=__builtin_amdgcn_mfma_f32_32x32x16_bf16(PAF(2),VFR(6),o[1],0,0,0), C1,4); \
    GAPB(o[0]=__builtin_amdgcn_mfma_f32_32x32x16_bf16(PAF(3),VFR(3),o[0],0,0,0), C1,8); \
    GAPB(o[1]=__builtin_amdgcn_mfma_f32_32x32x16_bf16(PAF(3),VFR(7),o[1],0,0,0), C1,12); \
    }while(0)
  int t=1;
  #undef CMASK
  #define CMASK(P0,P1,t) do{}while(0)
  for(;t+5<NT;t+=2){
    STEP(pB0,pB1,pA0,pA1,t,true,true,true);     WAIT_BAR(2); RESC(); ROT();
    STEP(pA0,pA1,pB0,pB1,t+1,true,true,true);   WAIT_BAR(2); RESC(); ROT();
  }
  #undef CMASK
  #define CMASK(P0,P1,t) do{int jb_=(t)-(NT-4); if(jb_>=0)cmask(P0,P1,jb_,qrel,hi);}while(0)
  #define ENDW(tt) do{ if((tt)+3<NT){WAIT_BAR(2);} else if((tt)+2<NT){WAIT_BAR(1);} else {WAIT_BAR(0);} }while(0)
  for(;t+1<NT;t+=2){
    STEP(pB0,pB1,pA0,pA1,t,(t+3<NT),(t+1<NT),(t+1<NT));       ENDW(t);   RESC(); ROT();
    STEP(pA0,pA1,pB0,pB1,t+1,(t+4<NT),(t+2<NT),(t+2<NT));     ENDW(t+1); RESC(); ROT();
  }
  STEP(pB0,pB1,pA0,pA1,NT-1,false,false,false); RESC();
  { float sacc=pB0[0]+pB0[1]; _Pragma("unroll") for(int r=2;r<16;++r)sacc+=pB0[r]; _Pragma("unroll") for(int r=0;r<16;++r)sacc+=pB1[r]; l_reg+=sacc;
    pw0=(u32x4){PKW(pB0,0),PKW(pB0,2),PKW(pB0,4),PKW(pB0,6)};pw1=(u32x4){PKW(pB0,8),PKW(pB0,10),PKW(pB0,12),PKW(pB0,14)};pw2=(u32x4){PKW(pB1,0),PKW(pB1,2),PKW(pB1,4),PKW(pB1,6)};pw3=(u32x4){PKW(pB1,8),PKW(pB1,10),PKW(pB1,12),PKW(pB1,14)};
    SBAR(); pv(o,vb0+sl_cur,PAF(0),PAF(1),PAF(2),PAF(3)); }
  #undef PKW
  #undef PAF
  #undef VFR
  #undef PIN
  #undef MX3
  #undef GAPA
  #undef GAPB
  #undef EX
  #undef VRD
  #undef KRD
  #undef STEP
  #undef ENDW
  {auto rr=__builtin_amdgcn_permlane32_swap(__float_as_uint(l_reg),__float_as_uint(l_reg),false,false);l_reg=__uint_as_float(rr[0])+__uint_as_float(rr[1]);}
  if(hi==0)wsf[32+r32]=l_reg;asm volatile("s_waitcnt lgkmcnt(0)":::"memory");
  float rli[16];
  #pragma unroll
  for(int r=0;r<16;++r)rli[r]=__builtin_amdgcn_rcpf(wsf[32+crow(r,hi)]);
  bf16*Ow=O+(rowbase+q0+wid*QBLK)*DM+h*D;
  { bf16*stg=(bf16*)(shm+LDS_OST)+wid*2048;
    #pragma unroll
    for(int r=0;r<16;++r){const int orow=crow(r,hi);
      #pragma unroll
      for(int d0=0;d0<2;++d0)stg[orow*64+d0*32+r32]=__float2bfloat16(o[d0][r]*rli[r]);}
    asm volatile("s_waitcnt lgkmcnt(0)":::"memory");
    #pragma unroll
    for(int i=0;i<4;++i){const int row=i*8+(lane>>3),ch=lane&7; const u32x4 v=*(const u32x4*)(stg+row*64+ch*8); ATTN_STORE16(Ow+(long)row*DM+ch*8,v);} }
  asm volatile("s_waitcnt lgkmcnt(0)\n\ts_barrier":::"memory");
  #undef DMA_K
  #undef DMA_V
  #undef CMASK
  #undef START
  #undef RESC
  #undef ROT
  #undef LOADCB
}
constexpr int ATTN_LDS_BYTES=LDS_BYTES;
struct AttnTensors { const bf16* Q; const bf16* K; const bf16* V; bf16* O; const float* bias; };
struct AttnUnit { int bh; int qb; };
struct StaticOrder {
  int vcu;
  __device__ __forceinline__ explicit StaticOrder(int grid,int block):vcu((block%8)*(grid/8)+block/8){}
  __device__ __forceinline__ bool next(int i,AttnUnit&u)const{ if(i>=16)return false; const int s=vcu&7,j=i&3; u.bh=(vcu>>3)+32*(i>>2); u.qb=(j==0)?s:(j==1)?15-s:(j==2)?16+s:31-s; return true; }
  __device__ __forceinline__ void a_ready(const AttnUnit&)const{}
  __device__ __forceinline__ void done(const AttnUnit&)const{}
};
template<class Sched,int THRL=8> __device__ __forceinline__ void attn_phase(char*lds,const AttnTensors&T,const Sched&S){
  AttnUnit u;
  for(int i=0;S.next(i,u);++i){ S.a_ready(u); attn_unit<THRL>(u.bh/NHEAD,u.bh%NHEAD,u.qb,T.Q,T.K,T.V,T.O,T.bias,lds); S.done(u); }
}
#undef SBAR
#undef WAIT_BAR
}
#define GAS __attribute__((address_space(1)))
#define LAS __attribute__((address_space(3)))
typedef unsigned short bf16;
typedef unsigned v4u __attribute__((ext_vector_type(4)));
typedef float f32x4 __attribute__((ext_vector_type(4)));
typedef short bf16x8 __attribute__((ext_vector_type(8)));
typedef GAS unsigned gu32;
typedef GAS unsigned long long gu64;
#define RLX_AGENT __ATOMIC_RELAXED, __HIP_MEMORY_SCOPE_AGENT
#define LDS_WAIT() asm volatile("s_waitcnt lgkmcnt(0)" ::: "memory")
#define VM_WAIT() asm volatile("s_waitcnt vmcnt(0)" ::: "memory")
__device__ __forceinline__ unsigned long long rt() { return __builtin_amdgcn_s_memrealtime(); }
__device__ __forceinline__ unsigned f2bf(float f) { unsigned u = __builtin_bit_cast(unsigned, f); return (u + 0x7fffu + ((u >> 16) & 1u)) >> 16; }
__device__ __forceinline__ unsigned pk2(float lo, float hi) { return f2bf(lo) | (f2bf(hi) << 16); }

#define XB_TMO      128
#define XB_XCNT(j)  (256  + 64 * (j))
#define XB_XSUB(j)  (1280 + 64 * (j))
#define XB_XGEN(j)  (2304 + 64 * (j))
#define XB_TOP      3328
#define XB_TOPGEN   3392
#define XCD_BAR_WORDS 3456
#define XB_SPIN_CAP (1u << 18)

__device__ __forceinline__ unsigned xb_ld(unsigned* p)              { return __hip_atomic_load(p, __ATOMIC_RELAXED, __HIP_MEMORY_SCOPE_AGENT); }
__device__ __forceinline__ unsigned xb_add(unsigned* p, unsigned v) { return __hip_atomic_fetch_add(p, v, __ATOMIC_RELAXED, __HIP_MEMORY_SCOPE_AGENT); }
__device__ __forceinline__ unsigned xb_xcc_id() { return (unsigned)__builtin_amdgcn_s_getreg((3 << 11) | 20) & 0xFu; }
#define XB_SPIN(cond, bar) do { unsigned _sp = 0; while (cond) { __builtin_amdgcn_s_sleep(1); \
    if ((++_sp & 255u) == 0u) { if (xb_ld(&(bar)[XB_TMO])) break; if (_sp > XB_SPIN_CAP) { atomicAdd(&(bar)[XB_TMO], 1u); break; } } } } while (0)

struct XcdBarrier {
    unsigned* bar; unsigned x;
    volatile LAS unsigned* st;
};

__device__ __forceinline__ XcdBarrier xcd_barrier_post(unsigned* bar, volatile LAS unsigned* st) {
    XcdBarrier b; b.bar = bar; b.x = xb_xcc_id(); b.st = st;
    if (threadIdx.x == 0) (void)xb_add(&bar[XB_XCNT(b.x)], 1u);
    return b;
}
__device__ __forceinline__ void xcd_barrier_complete(unsigned* bar, unsigned x, unsigned& nloc, unsigned& nx) {
    const unsigned G = gridDim.x * gridDim.y * gridDim.z;
    unsigned sum, cnt, mine, sp = 0u;
    for (;;) {
        sum = 0u; cnt = 0u; mine = 0u;
#pragma unroll
        for (unsigned j = 0; j < 16; ++j) { const unsigned c = xb_ld(&bar[XB_XCNT(j)]); sum += c; cnt += (c > 0u) ? 1u : 0u; mine = (j == x) ? c : mine; }
        if (sum == G) break;
        __builtin_amdgcn_s_sleep(1);
        if ((++sp & 255u) == 0u) { if (xb_ld(&bar[XB_TMO])) break; if (sp > XB_SPIN_CAP) { atomicAdd(&bar[XB_TMO], 1u); break; } }
    }
    nloc = mine > 0u ? mine : 1u; nx = cnt > 0u ? cnt : 1u;
}

__device__ __forceinline__ void xcd_barrier(const XcdBarrier& b) {
    asm volatile("s_waitcnt vmcnt(0)" ::: "memory");
    __syncthreads();
    if (threadIdx.x == 0) {
        unsigned* bar = b.bar;
        __builtin_amdgcn_s_waitcnt(0);
        unsigned nloc = b.st[0], nx = b.st[1];
        if (nloc == 0u) { xcd_barrier_complete(bar, b.x, nloc, nx); b.st[0] = nloc; b.st[1] = nx; }
        const unsigned old = xb_add(&bar[XB_XSUB(b.x)], 1u);
        const unsigned gen = old / nloc;
        if (old + 1u == (gen + 1u) * nloc) {
            __builtin_amdgcn_fence(__ATOMIC_RELEASE, "agent");
            asm volatile("s_waitcnt vmcnt(0)" ::: "memory");
            const unsigned og = xb_add(&bar[XB_TOP], 1u);
            const unsigned tg = og / nx;
            if (og + 1u == (tg + 1u) * nx) xb_add(&bar[XB_TOPGEN], 1u);
            else XB_SPIN(xb_ld(&bar[XB_TOPGEN]) == tg, bar);
            __builtin_amdgcn_fence(__ATOMIC_ACQUIRE, "agent");
            xb_add(&bar[XB_XGEN(b.x)], 1u);
            asm volatile("s_waitcnt vmcnt(0)" ::: "memory");
        } else {
            XB_SPIN(xb_ld(&bar[XB_XGEN(b.x)]) == gen, bar);
            __builtin_amdgcn_fence(__ATOMIC_ACQUIRE, "agent");
            asm volatile("s_waitcnt vmcnt(0)" ::: "memory");
        }
    }
    __syncthreads();
}

constexpr int NWAVES = 8;
constexpr int NB = 8, SEQ = 8192, D = 1024, NTOK = NB * SEQ, NE = 32, PLE = 256, NH = 16;
constexpr int MAXT = 1056;
constexpr int NCHUNK = NTOK / 256;
constexpr float LOG2E = 1.4426950408889634f;
#ifndef MK_PER_PHASE
#define MK_PER_PHASE 1
#endif
constexpr int N_PHASES = 21;

constexpr size_t MiB = 1u << 20;
constexpr size_t WS_CTL = 0, CTL_ZERO_BYTES = 1 * MiB;
constexpr size_t WS_META = 4 * MiB;
constexpr size_t WS_LOGITS = 5 * MiB;
constexpr size_t WS_TOKE = 13 * MiB;
constexpr size_t WS_TOKG = 14 * MiB;
constexpr size_t WS_TOKPOS = 15 * MiB;
constexpr size_t WS_SLOTG = 16 * MiB;
constexpr size_t WS_SLOTR = 18 * MiB;
constexpr size_t WS_LF = 20 * MiB;
constexpr size_t WS_BIAS = 24 * MiB;
constexpr size_t WS_WPOOL = 28 * MiB, WS_WROUTER = 29 * MiB, WS_WO = 30 * MiB, WS_WQKV = 32 * MiB, WS_WPG = 39 * MiB, WS_WPP = 43 * MiB, WS_WD = 44 * MiB, WS_WGU = 172 * MiB;
constexpr size_t WS_PB = 428 * MiB;
constexpr size_t WS_XA = 492 * MiB, WS_XB = 620 * MiB;
constexpr size_t WS_HS = 748 * MiB;
constexpr size_t WS_ACT = 1276 * MiB;
constexpr size_t WS_SS = 1804 * MiB;
constexpr size_t WS_END = 1828 * MiB;
constexpr size_t SSA = (size_t)NTOK * 16;
static_assert(WS_HS + (size_t)MAXT * 256 * D * 2 <= WS_ACT && WS_ACT + (size_t)MAXT * 256 * D * 2 <= WS_SS && WS_SS + 6 * SSA * 4 <= WS_END, "d_ws map");
static_assert(WS_WGU + (size_t)2 * 32 * 2048 * 1024 * 2 <= WS_PB && WS_WD + (size_t)2 * 32 * 1024 * 1024 * 2 <= WS_WGU && WS_WQKV + (size_t)3328 * 1024 * 2 <= WS_WPG, "d_ws map (weights)");
constexpr int CW_TMO = 0, CW_BAR = 4096;

constexpr int RING_OFF = 0, RING_BYTES = 131072;
constexpr int LDSCTL_OFF = RING_BYTES, MISC_OFF = LDSCTL_OFF + 320, TP_OFF = LDSCTL_OFF + 1024;
constexpr int LDS_BYTES = 147456;
static_assert(attn_body::ATTN_LDS_BYTES <= RING_BYTES, "attention LDS");

__device__ __forceinline__ float wave_sum(float v) {
#pragma unroll
    for (int o = 1; o < 64; o <<= 1) v += __shfl_xor(v, o);
    return v;
}
__device__ __forceinline__ float dot4f(const f32x4& a) { return (a[0] * a[0] + a[1] * a[1]) + (a[2] * a[2] + a[3] * a[3]); }
__device__ __forceinline__ float rstd_tok(const float* ssp, size_t t) { const f32x4 a = *(const f32x4*)(ssp + t * 16), b = *(const f32x4*)(ssp + t * 16 + 4), c = *(const f32x4*)(ssp + t * 16 + 8), d = *(const f32x4*)(ssp + t * 16 + 12);
    const float qa = (a[0] + a[1]) + (a[2] + a[3]), qb = (b[0] + b[1]) + (b[2] + b[3]), qc = (c[0] + c[1]) + (c[2] + c[3]), qd = (d[0] + d[1]) + (d[2] + d[3]); return pg8::rstd_of((qa + qb) + (qc + qd)); }
__device__ __forceinline__ float bflo(unsigned w) { return __builtin_bit_cast(float, w << 16); }
__device__ __forceinline__ float bfhi(unsigned w) { return __builtin_bit_cast(float, w & 0xffff0000u); }

__device__ __forceinline__ void conv_item(const float* W, int ldw, int k0, int n0, int nvalid, bf16* WT, int ldk, int drow0, const float* gain, LAS float* scr, int lane) {
    const bool ok = (lane & 31) < nvalid;
#pragma unroll 8
    for (int i = 0; i < 32; ++i) { const int kk = 2 * i + (lane >> 5); scr[kk * 33 + (lane & 31)] = ok ? W[(size_t)(k0 + kk) * ldw + n0 + (lane & 31)] : 0.f; }
    LDS_WAIT(); asm volatile("" ::: "memory");
    const int c = lane & 7;
    float gv[8];
#pragma unroll
    for (int i = 0; i < 8; ++i) gv[i] = gain ? gain[k0 + 8 * c + i] : 1.f;
#pragma unroll
    for (int j = 0; j < 4; ++j) { const int n = (lane >> 3) + 8 * j; const LAS float* s = scr + (8 * c) * 33 + n;
        v4u o; o.x = pk2(s[0 * 33] * gv[0], s[1 * 33] * gv[1]); o.y = pk2(s[2 * 33] * gv[2], s[3 * 33] * gv[3]); o.z = pk2(s[4 * 33] * gv[4], s[5 * 33] * gv[5]); o.w = pk2(s[6 * 33] * gv[6], s[7 * 33] * gv[7]);
        *(GAS v4u*)(WT + (size_t)(drow0 + n) * ldk + k0 + 8 * c) = o; }
    LDS_WAIT(); asm volatile("" ::: "memory");
}

template <int W> __device__ __forceinline__ void pool_run(const float* x, int t0, int c4, bool has_prev, int pos0, const LAS float* rs, f32x4 g, bf16* diff) {
    f32x4 hh[16];
#pragma unroll
    for (int i = 0; i < 16; ++i) hh[i] = (f32x4){0.f, 0.f, 0.f, 0.f};
    f32x4 S = (f32x4){0.f, 0.f, 0.f, 0.f};
    if (has_prev) {
#pragma unroll
        for (int i = 16 - W; i < 16; ++i) { const f32x4 v = *(const f32x4*)(x + (size_t)(t0 - 16 + i) * D + c4); hh[i] = v * rs[i] * g; S += hh[i]; }
    }
#pragma unroll 1
    for (int cb = 0; cb < 8; ++cb) {
        f32x4 xs[8], hn[8];
#pragma unroll
        for (int j = 0; j < 8; ++j) xs[j] = *(const f32x4*)(x + (size_t)(t0 + cb * 8 + j) * D + c4);
#pragma unroll
        for (int j = 0; j < 8; ++j) {
            hn[j] = xs[j] * rs[16 + cb * 8 + j] * g;
            const f32x4 old = (j - W >= 0) ? hn[(j - W >= 0) ? j - W : 0] : hh[(16 + j - W) & 15];
            S = S + hn[j] - old;
            const int pos = pos0 + cb * 8 + j; const int cnt = (pos + 1 < W) ? pos + 1 : W; const float inv = 1.0f / (float)cnt;
            const f32x4 dv = S * inv - hn[j];
            unsigned long long o = (unsigned long long)pk2(dv[0], dv[1]) | ((unsigned long long)pk2(dv[2], dv[3]) << 32);
            *(GAS unsigned long long*)(diff + (size_t)(t0 + cb * 8 + j) * D + c4) = o;
        }
#pragma unroll
        for (int i = 0; i < 8; ++i) hh[i] = hh[i + 8];
#pragma unroll
        for (int i = 0; i < 8; ++i) hh[8 + i] = hn[i];
    }
}

struct Args { const float* in[24]; float* out; unsigned char* ws; int ph_lo, ph_hi; };
enum { I_X = 0, I_P, I_NMIX, I_NFFN, I_NPLE, I_NFIN, I_POOLW, I_POOLS, I_KVN, I_WK, I_WV, I_WF, I_BF, I_WQ, I_WO, I_RW, I_RB, I_WGU, I_BGU, I_WD, I_BD, I_PWG, I_PBG, I_PWP };
#define WSP(T, off) ((T*)(args.ws + (off)))
#ifdef ONLY
#define PHON(n) ((n) == ONLY)
#else
#define PHON(n) true
#endif
#define IN(k) (lo <= (k) && (k) < hi)
#define SEAM(k) do { if (IN(k) && IN((k) + 1)) xcd_barrier(bar); } while (0)
#define FRESH_IDS() int tid = threadIdx.x; asm volatile("" : "+v"(tid)); const int lane = tid & 63, wave = __builtin_amdgcn_readfirstlane(tid >> 6); (void)lane; (void)wave; \
    const int G = gridDim.x, bx = blockIdx.x; const int vcu = (G % 8 == 0) ? (bx % 8) * (G / 8) + bx / 8 : bx; const int gw = vcu * NWAVES + wave, NGW = G * NWAVES; (void)gw; (void)NGW; (void)vcu

__device__ __forceinline__ void phase_prologue(const Args& args, LAS unsigned char* lds) {
    FRESH_IDS();
    const float* norm_ffn = args.in[I_NFFN];
    bf16* Wqkv = WSP(bf16, WS_WQKV); bf16* Wrouter = WSP(bf16, WS_WROUTER);
    LAS float* scr = (LAS float*)(lds + RING_OFF + wave * 16384);
    constexpr int I_GU = 2 * 32 * 1024, I_D = 2 * 32 * 512, I_PG = 2 * 512, I_PP = 2 * 128, I_SQ = 512, I_F = 16, I_POOL = 128, I_R = 32;
    constexpr int NITEMS = I_GU + I_D + I_PG + I_PP + 4 * I_SQ + I_F + I_POOL + I_R;
    for (int it = gw; it < NITEMS; it += NGW) {
        int r = it;
        if (r < I_GU) { const int le = r >> 10, q = r & 1023, kb = q >> 6, nb = q & 63, n0 = nb * 32;
            const int drow0 = 256 * ((n0 & 1023) >> 7) + 128 * (n0 >> 10) + (n0 & 127);
            conv_item(args.in[I_WGU] + (size_t)le * 1024 * 2048, 2048, kb * 64, n0, 32, WSP(bf16, WS_WGU) + (size_t)le * 2048 * 1024, 1024, drow0, norm_ffn + (le >> 5) * 1024, scr, lane); continue; } r -= I_GU;
        if (r < I_D) { const int le = r >> 9, q = r & 511, kb = q >> 5, nb = q & 31;
            conv_item(args.in[I_WD] + (size_t)le * 1024 * 1024, 1024, kb * 64, nb * 32, 32, WSP(bf16, WS_WD) + (size_t)le * 1024 * 1024, 1024, nb * 32, nullptr, scr, lane); continue; } r -= I_D;
        if (r < I_PG) { const int l = r >> 9, q = r & 511, kb = q >> 5, nb = q & 31;
            conv_item(args.in[I_PWG] + (size_t)l * 1024 * 1024, 1024, kb * 64, nb * 32, 32, WSP(bf16, WS_WPG) + (size_t)l * 1024 * 1024, 1024, nb * 32, args.in[I_NPLE] + l * 1024, scr, lane); continue; } r -= I_PG;
        if (r < I_PP) { const int l = r >> 7, q = r & 127, kb = q >> 5, nb = q & 31;
            conv_item(args.in[I_PWP] + (size_t)l * 256 * 1024, 1024, kb * 64, nb * 32, 32, WSP(bf16, WS_WPP) + (size_t)l * 1024 * 256, 256, nb * 32, nullptr, scr, lane); continue; } r -= I_PP;
        if (r < 4 * I_SQ) { const int w = r >> 9, q = r & 511, kb = q >> 5, nb = q & 31;
            const float* src = args.in[w == 0 ? I_WQ : (w == 1 ? I_WK : (w == 2 ? I_WV : I_WO))]; const float* gn = w == 0 ? args.in[I_NMIX] + 1024 : args.in[I_KVN];
            bf16* dst = w == 3 ? WSP(bf16, WS_WO) : Wqkv + (size_t)w * 1024 * 1024;
            conv_item(src, 1024, kb * 64, nb * 32, 32, dst, 1024, nb * 32, w == 3 ? nullptr : gn, scr, lane); continue; } r -= 4 * I_SQ;
        if (r < I_F) { conv_item(args.in[I_WF], 16, r * 64, 0, 16, Wqkv + (size_t)3072 * 1024, 1024, 0, args.in[I_KVN], scr, lane); continue; } r -= I_F;
        if (r < I_POOL) { const int g = r >> 5, q = r & 31, kb = q >> 3, nb = q & 7;
            conv_item(args.in[I_POOLW] + (size_t)g * 256 * 256, 256, kb * 64, nb * 32, 32, WSP(bf16, WS_WPOOL) + (size_t)g * 256 * 256, 256, nb * 32, nullptr, scr, lane); continue; } r -= I_POOL;
        { const int l = r >> 4, kb = r & 15;
            conv_item(args.in[I_RW] + (size_t)l * 1024 * 32, 32, kb * 64, 0, 32, Wrouter + (size_t)l * 256 * 1024, 1024, 0, norm_ffn + l * 1024, scr, lane); }
    }
    {
        const int gt = vcu * NWAVES * 64 + tid, NGT = G * NWAVES * 64; const v4u z = (v4u){0u, 0u, 0u, 0u};
        for (int i = gt; i < 2 * 224 * 128; i += NGT) { const int l = i / (224 * 128), q = i % (224 * 128); *(GAS v4u*)(Wrouter + (size_t)l * 256 * 1024 + (size_t)32 * 1024 + (size_t)q * 8) = z; }
        for (int i = gt; i < 224 * 128; i += NGT) *(GAS v4u*)(Wqkv + (size_t)3104 * 1024 + (size_t)i * 8) = z;
        const float* p_in = args.in[I_P]; bf16* PB = WSP(bf16, WS_PB);
        for (size_t i = gt; i < (size_t)2 * NTOK * PLE / 8; i += NGT) { const f32x4 a = *(const f32x4*)(p_in + i * 8), b = *(const f32x4*)(p_in + i * 8 + 4);
            v4u o; o.x = pk2(a[0], a[1]); o.y = pk2(a[2], a[3]); o.z = pk2(b[0], b[1]); o.w = pk2(b[2], b[3]); *(GAS v4u*)(PB + i * 8) = o; }
    }
    __syncthreads();
    {
        const float* x_in = args.in[I_X]; bf16* DIFF = WSP(bf16, WS_ACT);
        LAS float* rsl = (LAS float*)(lds + RING_OFF);
        const int half = tid >> 8, ht = tid & 255, hw = wave & 3, c4 = ht * 4;
        const f32x4 g = *(const f32x4*)(args.in[I_NMIX] + c4);
        for (int it = bx; it < NTOK / 128; it += G) {
            const int t0 = (it * 2 + half) * 64, pos0 = t0 & (SEQ - 1); const bool has_prev = pos0 != 0;
            for (int i = hw; i < 80; i += 4) { float r = 0.f;
                if (i >= 16 || has_prev) { const float* xr = x_in + (size_t)(t0 - 16 + i) * D; float s = 0.f;
#pragma unroll
                    for (int j = 0; j < 4; ++j) { const f32x4 v = *(const f32x4*)(xr + j * 256 + lane * 4); s += dot4f(v); }
                    r = pg8::rstd_of(wave_sum(s)); }
                if (lane == 0) rsl[half * 80 + i] = r; }
            __syncthreads();
            const LAS float* rs = rsl + half * 80;
            const int grp = __builtin_amdgcn_readfirstlane(ht >> 6);
            if (grp == 0) pool_run<2>(x_in, t0, c4, has_prev, pos0, rs, g, DIFF);
            else if (grp == 1) pool_run<4>(x_in, t0, c4, has_prev, pos0, rs, g, DIFF);
            else if (grp == 2) pool_run<8>(x_in, t0, c4, has_prev, pos0, rs, g, DIFF);
            else pool_run<16>(x_in, t0, c4, has_prev, pos0, rs, g, DIFF);
            __syncthreads();
        }
    }
}

template <int LAYER> __device__ __forceinline__ void moe_ple_block(const Args& args, LAS unsigned char* lds, const XcdBarrier& bar, const int lo, const int hi) {
    constexpr int PBASE = LAYER == 0 ? 2 : 13, SSM = LAYER == 0 ? 0 : 3;
    constexpr size_t XC_OFF = LAYER == 0 ? WS_XA : WS_XB, XN_OFF = LAYER == 0 ? WS_XB : WS_XA;
    if (IN(PBASE) && PHON(2)) {
        FRESH_IDS();
        pg8::Gemm g{WSP(bf16, XC_OFF), WSP(bf16, WS_WROUTER) + (size_t)LAYER * 256 * 1024, D, D, D}; pg8::DenseOrder S; S.init(NTOK / 256, 1, G, bx, D, D, 0);
        pg8::EpiRouter E{WSP(float, WS_SS) + (size_t)SSM * SSA, args.in[I_RB] + LAYER * 32, WSP(float, WS_LOGITS)};
        pg8::gemm_phase<pg8::EpiRouter, pg8::DenseOrder>(lds + RING_OFF, g, S, E);
    }
    SEAM(PBASE);
    if (IN(PBASE + 1) && PHON(3)) {
        FRESH_IDS();
        const float* LOGITS = WSP(float, WS_LOGITS); unsigned* TOKE = WSP(unsigned, WS_TOKE); float* TOKG = WSP(float, WS_TOKG); int* CH = WSP(int, WS_META);
        LAS int* hist = (LAS int*)(lds + RING_OFF);
        for (int ch = bx; ch < NCHUNK; ch += G) {
            if (tid < 32) hist[tid] = 0;
            __syncthreads();
            if (tid < 256) {
                const int t = ch * 256 + tid; float v[32];
#pragma unroll
                for (int j = 0; j < 8; ++j) { const f32x4 q = *(const f32x4*)(LOGITS + (size_t)t * 32 + 4 * j); v[4 * j] = q[0]; v[4 * j + 1] = q[1]; v[4 * j + 2] = q[2]; v[4 * j + 3] = q[3]; }
                float sv[4]; int si[4]; float pv = INFINITY; int pi = -1;
#pragma unroll
                for (int k = 0; k < 4; ++k) { float bv = -INFINITY; int bi = 0;
#pragma unroll
                    for (int i = 0; i < 32; ++i) { const bool after = (v[i] < pv) || (v[i] == pv && i > pi); if (after && v[i] > bv) { bv = v[i]; bi = i; } }
                    sv[k] = bv; si[k] = bi; pv = bv; pi = bi; }
                const float e1 = __expf(sv[1] - sv[0]), e2 = __expf(sv[2] - sv[0]), e3 = __expf(sv[3] - sv[0]); const float inv = 1.0f / (1.0f + e1 + e2 + e3);
                TOKE[t] = (unsigned)si[0] | ((unsigned)si[1] << 8) | ((unsigned)si[2] << 16) | ((unsigned)si[3] << 24);
                *(f32x4*)(TOKG + (size_t)t * 4) = (f32x4){inv, e1 * inv, e2 * inv, e3 * inv};
#pragma unroll
                for (int k = 0; k < 4; ++k) atomicAdd((int*)(hist + si[k]), 1);
            }
            __syncthreads();
            if (tid < 32) CH[ch * 32 + tid] = hist[tid];
            __syncthreads();
        }
    }
    SEAM(PBASE + 1);
    if (IN(PBASE + 2) && PHON(4)) {
        FRESH_IDS();
        const int* CH = WSP(int, WS_META); int* TPg = WSP(int, WS_META + 65536); const unsigned* TOKE = WSP(unsigned, WS_TOKE); const float* TOKG = WSP(float, WS_TOKG); int* TOKPOS = WSP(int, WS_TOKPOS);
        float* SLOTG = WSP(float, WS_SLOTG); float* SLOTR = WSP(float, WS_SLOTR); const float* ss_mix = WSP(float, WS_SS) + (size_t)SSM * SSA; const bf16* Xc = WSP(bf16, XC_OFF); bf16* HS = WSP(bf16, WS_HS);
        LAS int* ptot = (LAS int*)(lds + RING_OFF); LAS int* pbef = ptot + 256; LAS int* ntile = pbef + 256; LAS int* befl = ntile + 32; LAS int* tpl = befl + 32; LAS int* lcur = tpl + 64; LAS int* lpos = lcur + 32;
        for (int ch = bx; ch < NCHUNK; ch += G) {
            if (tid < 256) { const int e = tid & 31, part = tid >> 5; int tot = 0, bef = 0;
                for (int c2 = part * 32; c2 < part * 32 + 32; ++c2) { const int v = CH[c2 * 32 + e]; tot += v; bef += (c2 < ch) ? v : 0; }
                ptot[part * 32 + e] = tot; pbef[part * 32 + e] = bef; }
            __syncthreads();
            if (tid < 32) { int tot = 0, bef = 0;
#pragma unroll
                for (int q = 0; q < 8; ++q) { tot += ptot[q * 32 + tid]; bef += pbef[q * 32 + tid]; }
                ntile[tid] = (tot + 255) >> 8; befl[tid] = bef; }
            __syncthreads();
            if (tid == 0) { int a = 0; for (int e = 0; e < 32; ++e) { tpl[e] = a; a += ntile[e]; } tpl[32] = a; }
            __syncthreads();
            if (tid < 32) lcur[tid] = tpl[tid] * 256 + befl[tid];
            if (ch == 0 && tid < 33) TPg[tid] = tpl[tid];
            __syncthreads();
            LAS int* wcnt = lpos + 1024;
            unsigned ev = 0u; int rk[4] = {0, 0, 0, 0};
            if (tid < 256) { ev = TOKE[ch * 256 + tid];
                const int e0 = ev & 255, e1 = (ev >> 8) & 255, e2 = (ev >> 16) & 255, e3 = (ev >> 24) & 255;
                const unsigned mask = (1u << e0) | (1u << e1) | (1u << e2) | (1u << e3);
                const unsigned long long below = (1ull << lane) - 1ull;
#pragma unroll 1
                for (int e = 0; e < 32; ++e) { const unsigned long long bal = __ballot((mask >> e) & 1u); const int r = __popcll(bal & below);
                    if (e0 == e) rk[0] = r; if (e1 == e) rk[1] = r; if (e2 == e) rk[2] = r; if (e3 == e) rk[3] = r;
                    if (lane == 0) wcnt[wave * 32 + e] = __popcll(bal); } }
            __syncthreads();
            if (tid < 256) { const int t = ch * 256 + tid; const f32x4 gv = *(const f32x4*)(TOKG + (size_t)t * 4); const float rs = rstd_tok(ss_mix, (size_t)t);
                int ps[4];
#pragma unroll
                for (int k = 0; k < 4; ++k) { const int e = (ev >> (8 * k)) & 255; int pos = lcur[e] + rk[k];
                    for (int w = 0; w < wave; ++w) pos += wcnt[w * 32 + e];
                    ps[k] = pos; lpos[tid * 4 + k] = pos; SLOTG[pos] = gv[k]; SLOTR[pos] = rs; }
                *(GAS v4u*)(TOKPOS + (size_t)t * 4) = (v4u){(unsigned)ps[0], (unsigned)ps[1], (unsigned)ps[2], (unsigned)ps[3]}; }
            __syncthreads();
            for (int i = 0; i < 32; ++i) { const int tl = wave + 8 * i; const bf16* src = Xc + (size_t)(ch * 256 + tl) * D;
                const v4u a = *(const GAS v4u*)(src + lane * 8), b = *(const GAS v4u*)(src + 512 + lane * 8);
#pragma unroll
                for (int k = 0; k < 4; ++k) { bf16* dst = HS + (size_t)lpos[tl * 4 + k] * D; *(GAS v4u*)(dst + lane * 8) = a; *(GAS v4u*)(dst + 512 + lane * 8) = b; } }
            __syncthreads();
        }
    }
    SEAM(PBASE + 2);
    if (IN(PBASE + 3) && PHON(5)) {
        FRESH_IDS();
        LAS int* tpl = (LAS int*)(lds + TP_OFF);
        if (tid < 33) tpl[tid] = (int)__hip_atomic_load(WSP(gu32, WS_META + 65536) + tid, RLX_AGENT);
        __syncthreads();
        pg8::Gemm g{WSP(bf16, WS_HS), WSP(bf16, WS_WGU) + (size_t)LAYER * 32 * 2048 * 1024, D, D, D}; pg8::GroupedOrder S; S.init(tpl, 8, G, bx, D, D, 2048);
        pg8::EpiSwiGLU E{WSP(float, WS_SLOTR), args.in[I_BGU] + (size_t)LAYER * 32 * 2048, WSP(bf16, WS_ACT)};
        pg8::gemm_phase<pg8::EpiSwiGLU, pg8::GroupedOrder>(lds + RING_OFF, g, S, E);
    }
    SEAM(PBASE + 3);
    if (IN(PBASE + 4) && PHON(6)) {
        FRESH_IDS();
        LAS int* tpl = (LAS int*)(lds + TP_OFF);
        if (tid < 33) tpl[tid] = (int)__hip_atomic_load(WSP(gu32, WS_META + 65536) + tid, RLX_AGENT);
        __syncthreads();
        pg8::Gemm g{WSP(bf16, WS_ACT), WSP(bf16, WS_WD) + (size_t)LAYER * 32 * 1024 * 1024, D, D, D}; pg8::GroupedOrder S; S.init(tpl, 4, G, bx, D, D, 1024);
        pg8::EpiDown E{WSP(float, WS_SLOTG), args.in[I_BD] + (size_t)LAYER * 32 * 1024, WSP(bf16, WS_HS)};
        pg8::gemm_phase<pg8::EpiDown, pg8::GroupedOrder>(lds + RING_OFF, g, S, E);
    }
    SEAM(PBASE + 4);
    if (IN(PBASE + 5) && PHON(7)) {
        FRESH_IDS();
        const int* TOKPOS = WSP(int, WS_TOKPOS); bf16* Xc = WSP(bf16, XC_OFF); const bf16* HS = WSP(bf16, WS_HS); float* ss_moe = WSP(float, WS_SS) + (size_t)(SSM + 1) * SSA;
        for (int t = gw; t < NTOK; t += NGW) {
            const v4u ps = *(const GAS v4u*)(TOKPOS + (size_t)t * 4);
            bf16* xr = Xc + (size_t)t * D; float sq = 0.f;
#pragma unroll
            for (int hf = 0; hf < 2; ++hf) {
                const v4u xw = *(const GAS v4u*)(xr + hf * 512 + lane * 8);
                float a[8] = {bflo(xw.x), bfhi(xw.x), bflo(xw.y), bfhi(xw.y), bflo(xw.z), bfhi(xw.z), bflo(xw.w), bfhi(xw.w)};
#pragma unroll
                for (int k = 0; k < 4; ++k) { const unsigned pos = k == 0 ? ps.x : (k == 1 ? ps.y : (k == 2 ? ps.z : ps.w));
                    const v4u yw = *(const GAS v4u*)(HS + (size_t)pos * D + hf * 512 + lane * 8);
                    a[0] += bflo(yw.x); a[1] += bfhi(yw.x); a[2] += bflo(yw.y); a[3] += bfhi(yw.y); a[4] += bflo(yw.z); a[5] += bfhi(yw.z); a[6] += bflo(yw.w); a[7] += bfhi(yw.w); }
#pragma unroll
                for (int j = 0; j < 8; ++j) sq += a[j] * a[j];
                v4u o; o.x = pk2(a[0], a[1]); o.y = pk2(a[2], a[3]); o.z = pk2(a[4], a[5]); o.w = pk2(a[6], a[7]);
                *(GAS v4u*)(xr + hf * 512 + lane * 8) = o; }
            sq = wave_sum(sq);
            if (lane < 16) ss_moe[(size_t)t * 16 + lane] = lane == 0 ? sq : 0.f;
        }
    }
    SEAM(PBASE + 5);
    if (IN(PBASE + 6) && PHON(8)) {
        { FRESH_IDS();
          pg8::Gemm g{WSP(bf16, WS_PB) + (size_t)LAYER * NTOK * PLE, WSP(bf16, WS_WPP) + (size_t)LAYER * 1024 * 256, PLE, PLE, PLE}; pg8::DenseOrder S; S.init(NTOK / 256, 4, G, bx, PLE, PLE, 0);
          pg8::EpiStore E{WSP(bf16, WS_ACT)};
          pg8::gemm_phase<pg8::EpiStore, pg8::DenseOrder>(lds + RING_OFF, g, S, E); }
        VM_WAIT(); __syncthreads();
        { FRESH_IDS();
          pg8::Gemm g{WSP(bf16, XC_OFF), WSP(bf16, WS_WPG) + (size_t)LAYER * 1024 * 1024, D, D, D}; pg8::DenseOrder S; S.init(NTOK / 256, 4, G, bx, D, D, 0);
          pg8::EpiPle E{WSP(float, WS_SS) + (size_t)(SSM + 1) * SSA, args.in[I_PBG] + LAYER * 1024, WSP(bf16, WS_ACT), WSP(bf16, XC_OFF), WSP(bf16, XN_OFF), WSP(float, WS_SS) + (size_t)(SSM + 2) * SSA};
          pg8::gemm_phase<pg8::EpiPle, pg8::DenseOrder>(lds + RING_OFF, g, S, E); }
    }
    SEAM(PBASE + 6);
}

__global__ void __launch_bounds__(NWAVES * 64, 2) yoco_fwd(Args args) {
    extern __shared__ __attribute__((aligned(16))) unsigned char lds_raw[];
    LAS unsigned char* lds = (LAS unsigned char*)lds_raw;
    volatile LAS unsigned* MISC = (volatile LAS unsigned*)(lds + MISC_OFF);
    for (int u = threadIdx.x; u < (LDS_BYTES - LDSCTL_OFF) / 4; u += NWAVES * 64) ((LAS unsigned*)(lds + LDSCTL_OFF))[u] = 0u;
    __syncthreads();
    XcdBarrier bar; bar.bar = (unsigned*)(WSP(gu32, WS_CTL) + CW_BAR); bar.x = 0; bar.st = nullptr;
    if (!MK_PER_PHASE) bar = xcd_barrier_post((unsigned*)(WSP(gu32, WS_CTL) + CW_BAR), MISC + 8);
    const int lo = args.ph_lo, hi = args.ph_hi;

    if (IN(0) && PHON(0)) phase_prologue(args, lds);
    SEAM(0);
    if (IN(1) && PHON(1)) {
        FRESH_IDS();
        pg8::Gemm g{WSP(bf16, WS_ACT), WSP(bf16, WS_WPOOL), D, 256, 256}; pg8::DenseOrder S; S.init(NTOK / 256, 4, G, bx, D, 256, 256);
        pg8::EpiPool E{args.in[I_X], args.in[I_POOLS], WSP(bf16, WS_XA), WSP(float, WS_SS)};
        pg8::gemm_phase<pg8::EpiPool, pg8::DenseOrder>(lds + RING_OFF, g, S, E);
    }
    SEAM(1);
    moe_ple_block<0>(args, lds, bar, lo, hi);
    if (IN(9) && PHON(9)) {
        FRESH_IDS();
        pg8::Gemm g{WSP(bf16, WS_XB), WSP(bf16, WS_WQKV), D, D, D}; pg8::DenseOrder S; S.init(NTOK / 256, 13, G, bx, D, D, 0);
        pg8::EpiQkv E{WSP(float, WS_SS) + (size_t)2 * SSA, WSP(bf16, WS_HS), args.in[I_BF], WSP(float, WS_LF), attn_body::C2};
        pg8::gemm_phase<pg8::EpiQkv, pg8::DenseOrder>(lds + RING_OFF, g, S, E);
    }
    SEAM(9);
    if (IN(10) && PHON(10)) {
        FRESH_IDS();
        const float* LF = WSP(float, WS_LF); float* BIAS = WSP(float, WS_BIAS);
        LAS float* wtot = (LAS float*)(lds + RING_OFF);
        for (int item = bx; item < NB * NH; item += G) {
            const int b = item >> 4, h = item & 15; const int s0 = tid * 16; float v[16]; float run = 0.f;
#pragma unroll
            for (int j = 0; j < 16; ++j) { run += LF[(size_t)(b * SEQ + s0 + j) * 16 + h]; v[j] = run; }
            float incl = run;
#pragma unroll
            for (int o = 1; o < 64; o <<= 1) { const float n = __shfl_up(incl, o); if (lane >= o) incl += n; }
            if (lane == 63) wtot[wave] = incl;
            __syncthreads();
            float base = incl - run;
            for (int w = 0; w < wave; ++w) base += wtot[w];
            float* o = BIAS + (size_t)item * SEQ + s0;
#pragma unroll
            for (int j = 0; j < 16; j += 4) *(f32x4*)(o + j) = (f32x4){-(base + v[j]) * LOG2E, -(base + v[j + 1]) * LOG2E, -(base + v[j + 2]) * LOG2E, -(base + v[j + 3]) * LOG2E};
            __syncthreads();
        }
    }
    SEAM(10);
    if (IN(11) && PHON(11)) {
        const attn_body::AttnTensors AT{WSP(const attn_body::bf16, WS_HS), WSP(const attn_body::bf16, WS_HS) + (size_t)NTOK * D, WSP(const attn_body::bf16, WS_HS) + (size_t)2 * NTOK * D, WSP(attn_body::bf16, WS_HS), WSP(const float, WS_BIAS)};
        const attn_body::StaticOrder S((int)gridDim.x, (int)blockIdx.x);
#ifndef SKIP_ATTN
        attn_body::attn_phase<attn_body::StaticOrder>((char*)lds_raw + RING_OFF, AT, S);
#endif
    }
    SEAM(11);
    if (IN(12) && PHON(12)) {
        FRESH_IDS();
        pg8::Gemm g{WSP(bf16, WS_HS), WSP(bf16, WS_WO), D, D, D}; pg8::DenseOrder S; S.init(NTOK / 256, 4, G, bx, D, D, 0);
        pg8::EpiWo E{WSP(bf16, WS_XB), WSP(float, WS_SS) + (size_t)3 * SSA};
        pg8::gemm_phase<pg8::EpiWo, pg8::DenseOrder>(lds + RING_OFF, g, S, E);
    }
    SEAM(12);
    moe_ple_block<1>(args, lds, bar, lo, hi);
    if (IN(20) && PHON(20)) {
        FRESH_IDS();
        const float* ssf = WSP(float, WS_SS) + (size_t)5 * SSA; const bf16* XA = WSP(bf16, WS_XA); const float* norm_final = args.in[I_NFIN];
        for (int t = gw; t < NTOK; t += NGW) {
            const float rs = rstd_tok(ssf, (size_t)t); const bf16* xr = XA + (size_t)t * D; float* orow = args.out + (size_t)t * D;
#pragma unroll
            for (int hf = 0; hf < 2; ++hf) { const int c0 = hf * 512 + lane * 8; const v4u xw = *(const GAS v4u*)(xr + c0);
                const f32x4 g0 = *(const f32x4*)(norm_final + c0), g1 = *(const f32x4*)(norm_final + c0 + 4);
                *(f32x4*)(orow + c0) = (f32x4){bflo(xw.x) * rs * g0[0], bfhi(xw.x) * rs * g0[1], bflo(xw.y) * rs * g0[2], bfhi(xw.y) * rs * g0[3]};
                *(f32x4*)(orow + c0 + 4) = (f32x4){bflo(xw.z) * rs * g1[0], bfhi(xw.z) * rs * g1[1], bflo(xw.w) * rs * g1[2], bfhi(xw.w) * rs * g1[3]}; }
        }
    }
}
#undef IN
#undef SEAM

extern "C" void kernel_launch(void* const* d_in, const int* in_sizes, int n_in, void* d_out, int out_size, void* d_ws, size_t ws_size, hipStream_t stream) {
    static int grid = 0;
    if (grid == 0) {
        if (n_in != 24 || in_sizes[0] != NTOK * D || out_size != NTOK * D || ws_size < WS_END) { fprintf(stderr, "kernel_launch: unexpected shapes (n_in %d, in0 %d, out %d, ws %zu); nothing launched\n", n_in, n_in > 0 ? in_sizes[0] : -1, out_size, ws_size); grid = -1; return; }
        int dev = 0, cus = 0, per_cu = 0;
        if (hipGetDevice(&dev) != hipSuccess || hipDeviceGetAttribute(&cus, hipDeviceAttributeMultiprocessorCount, dev) != hipSuccess) { grid = -1; return; }
        if (hipFuncSetAttribute((const void*)yoco_fwd, hipFuncAttributeMaxDynamicSharedMemorySize, LDS_BYTES) != hipSuccess) { fprintf(stderr, "kernel_launch: hipFuncSetAttribute failed\n"); grid = -1; return; }
        if (hipOccupancyMaxActiveBlocksPerMultiprocessor(&per_cu, (const void*)yoco_fwd, NWAVES * 64, LDS_BYTES) != hipSuccess || per_cu < 1) { fprintf(stderr, "kernel_launch: occupancy query says %d blocks per CU\n", per_cu); }
        (void)hipGetLastError();
        grid = cus > 0 ? cus : 256;
    }
    if (grid < 0) return;
    if (hipMemsetAsync((char*)d_ws + WS_CTL, 0, CTL_ZERO_BYTES, stream) != hipSuccess) return;
    Args a{};
    for (int i = 0; i < 24; ++i) a.in[i] = (const float*)d_in[i];
    a.out = (float*)d_out; a.ws = (unsigned char*)d_ws;
#if MK_PER_PHASE
    for (int ph = 0; ph < N_PHASES; ++ph) { a.ph_lo = ph; a.ph_hi = ph + 1; hipLaunchKernelGGL(yoco_fwd, dim3(grid), dim3(NWAVES * 64), LDS_BYTES, stream, a); }
#else
    a.ph_lo = 0; a.ph_hi = N_PHASES; hipLaunchKernelGGL(yoco_fwd, dim3(grid), dim3(NWAVES * 64), LDS_BYTES, stream, a);
#endif
}
```

```cpp
#include <hip/hip_runtime.h>
#ifndef PROBE_MASK
#define PROBE_MASK 0
#endif
#include <cstdio>
#include <cstdint>
namespace pg8 {
#define PG8_LAS __attribute__((address_space(3)))
typedef unsigned short bf16_t;
typedef short bf16x8 __attribute__((ext_vector_type(8)));
typedef float f32x4 __attribute__((ext_vector_type(4)));
typedef unsigned u32x4 __attribute__((ext_vector_type(4)));
constexpr int BM = 256, BK = 64, HALF = 128, HTB = HALF * BK * 2  , STAGE_BYTES = 8 * HTB, NXCD = 8, WGM = 8;

__host__ __device__ __forceinline__ int lds_byte(int r, int c) { const int st = (r >> 4) * 2 + (c >> 5), rr = r & 15, cc = c & 31, ob = rr * 64 + cc * 2; return st * 1024 + (ob ^ (((ob >> 9) & 1) << 5)); }
__host__ __device__ __forceinline__ void stage_rc(int b, int& R, int& C) { const int st = b / 1024, sb = b % 1024, swz = sb ^ (((sb >> 9) & 1) << 5); R = (st >> 1) * 16 + swz / 64; C = (st & 1) * 32 + (swz % 64) / 2; }
__host__ __device__ __forceinline__ int perm32(int rho) { const int n = rho >> 4, i = rho & 15; return 8 * (i >> 2) + 4 * n + (i & 3); }

struct Unit { int pm, pn, e; };
struct Gemm { const bf16_t* A; const bf16_t* Bt; int lda, ldb, K, stag; const int* rowmap; void* dummy; };

struct DenseOrder {
    int nM, nN, nwg, G, c; size_t a_row, a_col, b_tile;
    __device__ __forceinline__ void init(int nM_, int nN_, int G_, int c_, int lda, int ldb, int a_col_elems, int esz = 2) { nM = nM_; nN = nN_; nwg = nM * nN; G = G_; c = c_; a_row = (size_t)BM * lda * esz; a_col = (size_t)a_col_elems * esz; b_tile = (size_t)BM * ldb * esz; }
    __device__ __forceinline__ bool next(int i, Unit& u) const {
        const long L = (long)i * G + c; if (L >= nwg) return false;
        int wgid = (int)L; { const int q = nwg / NXCD, r = nwg % NXCD, xcd = wgid % NXCD, off = wgid / NXCD; wgid = (xcd < r ? xcd * (q + 1) : r * (q + 1) + (xcd - r) * q) + off; }
        const int nig = WGM * nN, gid = wgid / nig, fm = gid * WGM, gsz = (nM - fm) < WGM ? (nM - fm) : WGM;
        u.pm = fm + ((wgid % nig) % gsz); u.pn = (wgid % nig) / gsz; u.e = 0; return true;
    }
    __device__ __forceinline__ size_t a_off(const Unit& u) const { return (size_t)u.pm * a_row + (size_t)u.pn * a_col; }
    __device__ __forceinline__ size_t b_off(const Unit& u) const { return (size_t)u.pn * b_tile; }
    __device__ __forceinline__ void a_ready(const Unit&) const {}
    __device__ __forceinline__ void done(const Unit&) const {}
};
struct GroupedOrder {
    int nM, nN, nwg, G, c; const PG8_LAS int* tp; const PG8_LAS unsigned char* te; size_t a_row, b_exp, b_tile;
    __device__ __forceinline__ void init(const PG8_LAS int* tp_, int nN_, int G_, int c_, int lda, int ldb, int n_w_rows, int esz) { tp = tp_; te = (const PG8_LAS unsigned char*)(tp_ + 64); nM = __builtin_amdgcn_readfirstlane(tp_[32]); nN = nN_; nwg = nM * nN; G = G_; c = c_; a_row = (size_t)BM * lda * esz; b_exp = (size_t)n_w_rows * ldb * esz; b_tile = (size_t)BM * ldb * esz; }
    __device__ __forceinline__ bool next(int i, Unit& u) const {
        const long L = (long)i * G + c; if (L >= nwg) return false;
        int wgid = (int)L; { const int q = nwg / NXCD, r = nwg % NXCD, xcd = wgid % NXCD, off = wgid / NXCD; wgid = (xcd < r ? xcd * (q + 1) : r * (q + 1) + (xcd - r) * q) + off; }
        const int nig = WGM * nN, gid = wgid / nig, fm = gid * WGM, gsz = (nM - fm) < WGM ? (nM - fm) : WGM;
        u.pm = fm + ((wgid % nig) % gsz); u.pn = (wgid % nig) / gsz;
        u.e = __builtin_amdgcn_readfirstlane((int)te[u.pm]); u.pm = __builtin_amdgcn_readfirstlane(u.pm); u.pn = __builtin_amdgcn_readfirstlane(u.pn); return true;
    }
    __device__ __forceinline__ size_t a_off(const Unit& u) const { return (size_t)u.pm * a_row; }
    __device__ __forceinline__ size_t b_off(const Unit& u) const { return (size_t)u.e * b_exp + (size_t)u.pn * b_tile; }
    __device__ __forceinline__ void a_ready(const Unit&) const {}
    __device__ __forceinline__ void done(const Unit&) const {}
};

__device__ __forceinline__ unsigned cvt_pk_bf16(float lo, float hi) { unsigned r; asm volatile("v_cvt_pk_bf16_f32 %0, %1, %2" : "=v"(r) : "v"(lo), "v"(hi)); return r; }
__device__ __forceinline__ float bf_lo(unsigned w) { return __builtin_bit_cast(float, w << 16); }
__device__ __forceinline__ float bf_hi(unsigned w) { return __builtin_bit_cast(float, w & 0xffff0000u); }
__device__ __forceinline__ float rstd_of(float ss) { return __builtin_amdgcn_rsqf(ss * (1.f / 1024.f) + 1e-6f); }
__device__ __forceinline__ u32x4 pack8(const f32x4& a, const f32x4& b) { u32x4 w; w.x = cvt_pk_bf16(a[0], a[1]); w.y = cvt_pk_bf16(a[2], a[3]); w.z = cvt_pk_bf16(b[0], b[1]); w.w = cvt_pk_bf16(b[2], b[3]); return w; }
__device__ __forceinline__ void unpack8(const u32x4& w, f32x4& a, f32x4& b) { a = (f32x4){bf_lo(w.x), bf_hi(w.x), bf_lo(w.y), bf_hi(w.y)}; b = (f32x4){bf_lo(w.z), bf_hi(w.z), bf_lo(w.w), bf_hi(w.w)}; }
__device__ __forceinline__ float dot4(const f32x4& a) { return (a[0] * a[0] + a[1] * a[1]) + (a[2] * a[2] + a[3] * a[3]); }
constexpr float W8INV = 1.0f / 16.0f;
typedef float f32x2 __attribute__((ext_vector_type(2)));
struct EpiCtx { PG8_LAS unsigned char* stg; int wr, wc, fr, fq, lane; };
constexpr int EPW = 2816, EP_RSL = 2304, EP_PITCH = 144, NTOKC = 65536;
typedef PG8_LAS u32x4* lds_u4p;
struct RawTile { u32x4 a, b; };
template <int MODE> __device__ __forceinline__ int piece_off(int fq, int k) { return MODE == 0 ? 64 * k + 16 * fq : 32 * fq + 16 * k; }
__device__ __forceinline__ RawTile tile_fetch(const EpiCtx& c, const char* gbase, size_t pitch) {
    const int r = c.lane >> 3, ch = c.lane & 7; RawTile t; t.a = *(const u32x4*)(gbase + (size_t)r * pitch + ch * 16); t.b = *(const u32x4*)(gbase + (size_t)(r + 8) * pitch + ch * 16); return t;
}
template <int MODE> __device__ __forceinline__ void tile_unstage(const EpiCtx& c, const RawTile& t, u32x4& v0, u32x4& v1) {
    const int r = c.lane >> 3, ch = c.lane & 7;
    *(lds_u4p)(c.stg + r * EP_PITCH + ch * 16) = t.a; *(lds_u4p)(c.stg + (r + 8) * EP_PITCH + ch * 16) = t.b;
    v0 = *(lds_u4p)(c.stg + c.fr * EP_PITCH + piece_off<MODE>(c.fq, 0)); v1 = *(lds_u4p)(c.stg + c.fr * EP_PITCH + piece_off<MODE>(c.fq, 1));
}
template <int MODE> __device__ __forceinline__ void tile_store(const EpiCtx& c, char* gbase, size_t pitch, const u32x4& v0, const u32x4& v1) {
    *(lds_u4p)(c.stg + c.fr * EP_PITCH + piece_off<MODE>(c.fq, 0)) = v0; *(lds_u4p)(c.stg + c.fr * EP_PITCH + piece_off<MODE>(c.fq, 1)) = v1;
    const int r = c.lane >> 3, ch = c.lane & 7;
    const u32x4 a = *(lds_u4p)(c.stg + r * EP_PITCH + ch * 16), b = *(lds_u4p)(c.stg + (r + 8) * EP_PITCH + ch * 16);
    *(u32x4*)(gbase + (size_t)r * pitch + ch * 16) = a; *(u32x4*)(gbase + (size_t)(r + 8) * pitch + ch * 16) = b;
}
__device__ __forceinline__ void tile_store_half(const EpiCtx& c, char* gbase, size_t pitch, const u32x4& v) {
    *(lds_u4p)(c.stg + c.fr * 80 + c.fq * 16) = v;
    const int r = c.lane >> 2, ch = c.lane & 3;
    const u32x4 a = *(lds_u4p)(c.stg + r * 80 + ch * 16);
    *(u32x4*)(gbase + (size_t)r * pitch + ch * 16) = a;
}
__device__ __forceinline__ float sum16(const float (&s)[16]) { return (((s[0] + s[1]) + (s[2] + s[3])) + ((s[4] + s[5]) + (s[6] + s[7]))) + (((s[8] + s[9]) + (s[10] + s[11])) + ((s[12] + s[13]) + (s[14] + s[15]))); }
__device__ __forceinline__ void ss_put(const EpiCtx& c, float* ssp, int unit_row0, const float (&sq)[2][4], int slot) {
    PG8_LAS float* t = (PG8_LAS float*)c.stg;
#pragma unroll
    for (int ai = 0; ai < 2; ++ai)
#pragma unroll
        for (int m = 0; m < 4; ++m) t[(ai * 64 + m * 16 + c.fr) * 4 + c.fq] = sq[ai][m];
#pragma unroll
    for (int hb = 0; hb < 2; ++hb) { const f32x4 v = *(PG8_LAS f32x4*)(t + (hb * 64 + c.lane) * 4); ssp[(size_t)slot * NTOKC + unit_row0 + hb * HALF + c.wr * 64 + c.lane] = (v[0] + v[1]) + (v[2] + v[3]); }
}
__device__ __forceinline__ void rstd_stage(const EpiCtx& c, const float* ssp, int unit_row0) {
    PG8_LAS float* rsl = (PG8_LAS float*)(c.stg + EP_RSL);
#pragma unroll
    for (int hb = 0; hb < 2; ++hb) { const int row = unit_row0 + hb * HALF + c.wr * 64 + c.lane; float s[16];
#pragma unroll
        for (int k = 0; k < 16; ++k) s[k] = ssp[(size_t)k * NTOKC + row];
        rsl[hb * 64 + c.lane] = rstd_of(sum16(s)); asm volatile("" ::: "memory"); }
}
__device__ __forceinline__ float rstd_get(const EpiCtx& c, int ai, int m) { return ((PG8_LAS float*)(c.stg + EP_RSL))[ai * 64 + m * 16 + c.fr]; }
#define EPI_ROW(g_) (u.pm * BM + ((g_) >> 2) * HALF + c.wr * 64 + ((g_) & 3) * 16)

__device__ __forceinline__ unsigned long long fp8x8_sat(f32x4 v0, f32x4 v1) {
#pragma unroll
    for (int j = 0; j < 4; ++j) { v0[j] = __builtin_amdgcn_fmed3f(v0[j], -448.0f, 448.0f); v1[j] = __builtin_amdgcn_fmed3f(v1[j], -448.0f, 448.0f); }
    unsigned w0 = 0u, w1 = 0u; w0 = __builtin_amdgcn_cvt_pk_fp8_f32(v0[0], v0[1], w0, false); w0 = __builtin_amdgcn_cvt_pk_fp8_f32(v0[2], v0[3], w0, true);
    w1 = __builtin_amdgcn_cvt_pk_fp8_f32(v1[0], v1[1], w1, false); w1 = __builtin_amdgcn_cvt_pk_fp8_f32(v1[2], v1[3], w1, true); return (unsigned long long)w0 | ((unsigned long long)w1 << 32); }
__device__ __forceinline__ void fp8_rows_store(const EpiCtx& c, unsigned char* dst  , unsigned long long q0, unsigned long long q1) {
    *(PG8_LAS unsigned long long*)(c.stg + c.fr * 80 + c.fq * 8) = q0; *(PG8_LAS unsigned long long*)(c.stg + c.fr * 80 + 32 + c.fq * 8) = q1;
    const int r = c.lane >> 2, ch = c.lane & 3; const u32x4 t8 = *(lds_u4p)(c.stg + r * 80 + ch * 16);
    *(u32x4*)(dst + (size_t)r * 1024 + ch * 16) = t8; }
struct EpiPool {
    struct Pre {}; __device__ __forceinline__ Pre fetch(const Unit&, const EpiCtx&) const { return Pre{}; }
    static constexpr int NST = 0;     static constexpr bool PERM = true, AFTER_DRAIN = false, TWICE = false;
    const float* xin; const float* scale; bf16_t* Xo; float* ss; unsigned char* X8;
    __device__ __forceinline__ void operator()(const f32x4 (&acc)[2][2][4][2], const Unit& u, const EpiCtx& c, const Pre& pre) const {
        const int colw = u.pn * BM + c.wc * 64;
        float sq[2][4]; RawTile rt[1][2];
#define EP_FETCH(g_) do { _Pragma("unroll") for (int bj = 0; bj < 2; ++bj) rt[0][bj] = tile_fetch(c, (const char*)(xin + (size_t)EPI_ROW(g_) * 1024 + colw + 32 * bj), 4096); } while (0)
#pragma unroll
        for (int g = 0; g < 8; ++g) { const int ai = g >> 2, m = g & 3; float s = 0.f; u32x4 o[2]; unsigned long long q8[2];
            EP_FETCH(g);
            f32x4 sc[2][2];
#pragma unroll
            for (int bj = 0; bj < 2; ++bj)
#pragma unroll
                for (int n = 0; n < 2; ++n) sc[bj][n] = *(const f32x4*)(scale + colw + 32 * bj + 8 * c.fq + 4 * n);
#pragma unroll
            for (int bj = 0; bj < 2; ++bj) { u32x4 r0, r1; tile_unstage<1>(c, rt[0][bj], r0, r1);
                const f32x4 v0 = __builtin_bit_cast(f32x4, r0) + sc[bj][0] * acc[ai][bj][m][0], v1 = __builtin_bit_cast(f32x4, r1) + sc[bj][1] * acc[ai][bj][m][1];
                s += dot4(v0) + dot4(v1); o[bj] = pack8(v0, v1); q8[bj] = fp8x8_sat(v0, v1); }
            tile_store<0>(c, (char*)(Xo + (size_t)EPI_ROW(g) * 1024 + colw), 2048, o[0], o[1]);
            fp8_rows_store(c, X8 + (size_t)EPI_ROW(g) * 1024 + colw, q8[0], q8[1]);
            sq[ai][m] = s; asm volatile("" ::: "memory"); }
#undef EP_FETCH
        ss_put(c, ss, u.pm * BM, sq, u.pn * 4 + c.wc);
    }
};
struct EpiRouter {
    struct Pre {}; __device__ __forceinline__ Pre fetch(const Unit&, const EpiCtx&) const { return Pre{}; }
    static constexpr int NST = 0;     static constexpr bool PERM = true, AFTER_DRAIN = false, TWICE = false;
    const float* ssin; const float* rb; float* logits;
    __device__ __forceinline__ void operator()(const f32x4 (&acc)[2][2][4][2], const Unit& u, const EpiCtx& c, const Pre& pre) const {
        if (c.wc != 0) return;
        rstd_stage(c, ssin, u.pm * BM);
        const f32x4 b0 = *(const f32x4*)(rb + 8 * c.fq), b1 = *(const f32x4*)(rb + 8 * c.fq + 4);
#pragma unroll
        for (int g = 0; g < 8; ++g) { const int ai = g >> 2, m = g & 3; const float rs = rstd_get(c, ai, m);
            const f32x4 v0 = acc[ai][0][m][0] * rs + b0, v1 = acc[ai][0][m][1] * rs + b1;
            tile_store<1>(c, (char*)(logits + (size_t)EPI_ROW(g) * 32), 128, __builtin_bit_cast(u32x4, v0), __builtin_bit_cast(u32x4, v1)); }
    }
};
constexpr float SW_A2 = 1.702f * 1.4426950408889634f;
struct EpiSwiGLU {
    struct Pre { u32x4 bg, bu; float rs[8]; };
    __device__ __forceinline__ Pre fetch(const Unit& u, const EpiCtx& c) const { const bf16_t* p = bgu16 + (size_t)u.e * 2048 + u.pn * HALF + c.wc * 32 + 8 * c.fq; Pre r; r.bg = *(const u32x4*)p; r.bu = *(const u32x4*)(p + 1024);
#pragma unroll
        for (int g = 0; g < 8; ++g) r.rs[g] = rowrstd[EPI_ROW(g) + c.fr];
        return r; }
    static constexpr int NST = 8;     static constexpr bool PERM = true, AFTER_DRAIN = false, TWICE = ((PROBE_MASK >> 16) & 1) != 0;
    const bf16_t* bgu16; unsigned char* act; const float* rowrstd;
    __device__ __forceinline__ void operator()(const f32x4 (&acc)[2][2][4][2], const Unit& u, const EpiCtx& c, const Pre& pre) const {
        const int cw = u.pn * HALF + c.wc * 32;
        f32x4 bgt[2], bup[2]; unpack8(pre.bg, bgt[0], bgt[1]); unpack8(pre.bu, bup[0], bup[1]);
#pragma unroll
        for (int g = 0; g < 8; ++g) { const int ai = g >> 2, m = g & 3; f32x4 y[2]; const float rs = W8INV * pre.rs[g];
#pragma unroll
            for (int n = 0; n < 2; ++n) { const f32x4 gt = acc[ai][0][m][n] * rs + bgt[n], up = acc[ai][1][m][n] * rs + bup[n];
#pragma unroll
                for (int hp = 0; hp < 2; ++hp) {
                    f32x2 gc, uc; gc.x = fminf(gt[2 * hp], 7.0f * SW_A2); gc.y = fminf(gt[2 * hp + 1], 7.0f * SW_A2); uc.x = fminf(fmaxf(up[2 * hp], -6.0f), 8.0f); uc.y = fminf(fmaxf(up[2 * hp + 1], -6.0f), 8.0f);
                    f32x2 e; e.x = __builtin_amdgcn_exp2f(-gc.x); e.y = __builtin_amdgcn_exp2f(-gc.y);
                    const f32x2 d = e + 1.0f; f32x2 sg; sg.x = __builtin_amdgcn_rcpf(d.x); sg.y = __builtin_amdgcn_rcpf(d.y);
                    const f32x2 yy = uc * (gc * sg); y[n][2 * hp] = yy.x; y[n][2 * hp + 1] = yy.y; } }
            unsigned w0 = 0u, w1 = 0u;
            w0 = __builtin_amdgcn_cvt_pk_fp8_f32(y[0][0], y[0][1], w0, false); w0 = __builtin_amdgcn_cvt_pk_fp8_f32(y[0][2], y[0][3], w0, true);
            w1 = __builtin_amdgcn_cvt_pk_fp8_f32(y[1][0], y[1][1], w1, false); w1 = __builtin_amdgcn_cvt_pk_fp8_f32(y[1][2], y[1][3], w1, true);
            *(PG8_LAS unsigned long long*)(c.stg + c.fr * 40 + c.fq * 8) = (unsigned long long)w0 | ((unsigned long long)w1 << 32);
            const int r = c.lane >> 2, ch = c.lane & 3; const unsigned long long q = *(PG8_LAS unsigned long long*)(c.stg + r * 40 + ch * 8);
            *(unsigned long long*)(act + (size_t)(EPI_ROW(g) + r) * 1024 + cw + ch * 8) = q; }
    }
};
constexpr float YSCALE = 8.0f, YSINV = 0.125f;
struct EpiDown {
    struct Pre { float gt[8]; u32x4 b0, b1; };
    __device__ __forceinline__ Pre fetch(const Unit& u, const EpiCtx& c) const { Pre r;
#pragma unroll
        for (int g = 0; g < 8; ++g) r.gt[g] = rowgate[EPI_ROW(g) + c.fr];
        const bf16_t* p = bd16 + (size_t)u.e * 1024 + u.pn * BM + c.wc * 64 + 8 * c.fq; r.b0 = *(const u32x4*)p; r.b1 = *(const u32x4*)(p + 32); return r; }
    static constexpr int NST = 8;     static constexpr bool PERM = true, AFTER_DRAIN = false, TWICE = ((PROBE_MASK >> 15) & 1) != 0;
    const float* rowgate; const bf16_t* bd16; unsigned char* Y;
    __device__ __forceinline__ void operator()(const f32x4 (&acc)[2][2][4][2], const Unit& u, const EpiCtx& c, const Pre& pre) const {
        const int colw = u.pn * BM + c.wc * 64;
        f32x4 bv[2][2]; unpack8(pre.b0, bv[0][0], bv[0][1]); unpack8(pre.b1, bv[1][0], bv[1][1]);
        const float osc = W8INV / SW_A2;
#pragma unroll
        for (int g = 0; g < 8; ++g) { const int ai = g >> 2, m = g & 3; const float gt = pre.gt[g] * YSCALE; unsigned long long q8[2];
#pragma unroll
            for (int bj = 0; bj < 2; ++bj) { f32x4 v0 = (acc[ai][bj][m][0] * osc + bv[bj][0]) * gt, v1 = (acc[ai][bj][m][1] * osc + bv[bj][1]) * gt;
#pragma unroll
                for (int j = 0; j < 4; ++j) { v0[j] = __builtin_amdgcn_fmed3f(v0[j], -448.0f, 448.0f); v1[j] = __builtin_amdgcn_fmed3f(v1[j], -448.0f, 448.0f); }
                unsigned w0 = 0u, w1 = 0u; w0 = __builtin_amdgcn_cvt_pk_fp8_f32(v0[0], v0[1], w0, false); w0 = __builtin_amdgcn_cvt_pk_fp8_f32(v0[2], v0[3], w0, true);
                w1 = __builtin_amdgcn_cvt_pk_fp8_f32(v1[0], v1[1], w1, false); w1 = __builtin_amdgcn_cvt_pk_fp8_f32(v1[2], v1[3], w1, true); q8[bj] = (unsigned long long)w0 | ((unsigned long long)w1 << 32); }
            *(PG8_LAS unsigned long long*)(c.stg + c.fr * 80 + c.fq * 8) = q8[0]; *(PG8_LAS unsigned long long*)(c.stg + c.fr * 80 + 32 + c.fq * 8) = q8[1];
            const int r = c.lane >> 2, ch = c.lane & 3; const u32x4 t8 = *(lds_u4p)(c.stg + r * 80 + ch * 16);
            *(u32x4*)(Y + (size_t)(EPI_ROW(g) + r) * 1024 + colw + ch * 16) = t8; asm volatile("" ::: "memory"); }
    }
};
constexpr float PJSCALE = 8.0f, PJSINV = 0.125f;
struct EpiStore {
    struct Pre {}; __device__ __forceinline__ Pre fetch(const Unit&, const EpiCtx&) const { return Pre{}; }
    static constexpr int NST = 0;     static constexpr bool PERM = true, AFTER_DRAIN = false, TWICE = false;
    unsigned char* O;
    __device__ __forceinline__ void operator()(const f32x4 (&acc)[2][2][4][2], const Unit& u, const EpiCtx& c, const Pre& pre) const {
        unsigned char* ob = O + ((size_t)(u.pm * 4 + u.pn) * 8 + (c.wr * 4 + c.wc)) * 8192 + c.lane * 16;
#pragma unroll
        for (int g = 0; g < 8; ++g) { const int ai = g >> 2, m = g & 3; u32x4 w;
#pragma unroll
            for (int bj = 0; bj < 2; ++bj)
#pragma unroll
                for (int n = 0; n < 2; ++n) { f32x4 v = acc[ai][bj][m][n] * PJSCALE;
#pragma unroll
                    for (int j = 0; j < 4; ++j) v[j] = __builtin_amdgcn_fmed3f(v[j], -448.0f, 448.0f);
                    unsigned w0 = 0u; w0 = __builtin_amdgcn_cvt_pk_fp8_f32(v[0], v[1], w0, false); w0 = __builtin_amdgcn_cvt_pk_fp8_f32(v[2], v[3], w0, true); w[2 * bj + n] = w0; }
            *(u32x4*)(ob + g * 1024) = w; }
    }
};
struct EpiPle {
    struct Pre {}; __device__ __forceinline__ Pre fetch(const Unit&, const EpiCtx&) const { return Pre{}; }
    static constexpr int NST = 18;     static constexpr bool PERM = true, AFTER_DRAIN = false, TWICE = false;
    const float* bgate; const unsigned char* PJ; const bf16_t* Xi; bf16_t* Xo; float* ss; unsigned char* X8;
    __device__ __forceinline__ void operator()(const f32x4 (&acc)[2][2][4][2], const Unit& u, const EpiCtx& c, const Pre& pre) const {
        const int colw = u.pn * BM + c.wc * 64;
        float sq[2][4]; RawTile rx[1]; u32x4 pj;
        const unsigned char* pjb = PJ + ((size_t)(u.pm * 4 + u.pn) * 8 + (c.wr * 4 + c.wc)) * 8192 + c.lane * 16;
#define EP_FETCH(g_) do { const size_t ro_ = (size_t)EPI_ROW(g_) * 1024 + colw; pj = *(const u32x4*)(pjb + (g_) * 1024); rx[0] = tile_fetch(c, (const char*)(Xi + ro_), 2048); } while (0)
#pragma unroll
        for (int g = 0; g < 8; ++g) { const int ai = g >> 2, m = g & 3; const float rs = W8INV; float s = 0.f; u32x4 o[2], xw[2]; unsigned long long q8[2];
            EP_FETCH(g);
            f32x4 bv[2][2];
#pragma unroll
            for (int bj = 0; bj < 2; ++bj)
#pragma unroll
                for (int n = 0; n < 2; ++n) bv[bj][n] = *(const f32x4*)(bgate + colw + 32 * bj + 8 * c.fq + 4 * n);
            tile_unstage<0>(c, rx[0], xw[0], xw[1]);
#pragma unroll
            for (int bj = 0; bj < 2; ++bj) { f32x4 p0, p1, x0, x1; unpack8(xw[bj], x0, x1);
                { const f32x2 a0 = __builtin_amdgcn_cvt_pk_f32_fp8((int)pj[2 * bj], false), a1 = __builtin_amdgcn_cvt_pk_f32_fp8((int)pj[2 * bj], true), b0 = __builtin_amdgcn_cvt_pk_f32_fp8((int)pj[2 * bj + 1], false), b1 = __builtin_amdgcn_cvt_pk_f32_fp8((int)pj[2 * bj + 1], true);
                  p0 = (f32x4){a0.x, a0.y, a1.x, a1.y} * PJSINV; p1 = (f32x4){b0.x, b0.y, b1.x, b1.y} * PJSINV; }
                f32x4 z0 = acc[ai][bj][m][0] * rs + bv[bj][0], z1 = acc[ai][bj][m][1] * rs + bv[bj][1];
#pragma unroll
                for (int hp = 0; hp < 2; ++hp) {
                    f32x2 a0 = {z0[2 * hp], z0[2 * hp + 1]}, a1 = {z1[2 * hp], z1[2 * hp + 1]}; a0 = a0 * -1.4426950408889634f; a1 = a1 * -1.4426950408889634f;
                    f32x2 e0, e1; e0.x = __builtin_amdgcn_exp2f(a0.x); e0.y = __builtin_amdgcn_exp2f(a0.y); e1.x = __builtin_amdgcn_exp2f(a1.x); e1.y = __builtin_amdgcn_exp2f(a1.y); e0 = e0 + 1.0f; e1 = e1 + 1.0f;
                    z0[2 * hp] = __builtin_amdgcn_rcpf(e0.x); z0[2 * hp + 1] = __builtin_amdgcn_rcpf(e0.y); z1[2 * hp] = __builtin_amdgcn_rcpf(e1.x); z1[2 * hp + 1] = __builtin_amdgcn_rcpf(e1.y); }
                const f32x4 v0 = x0 + z0 * p0, v1 = x1 + z1 * p1;
                s += dot4(v0) + dot4(v1); o[bj] = pack8(v0, v1);
                { unsigned w0 = 0u, w1 = 0u; w0 = __builtin_amdgcn_cvt_pk_fp8_f32(v0[0], v0[1], w0, false); w0 = __builtin_amdgcn_cvt_pk_fp8_f32(v0[2], v0[3], w0, true);
                  w1 = __builtin_amdgcn_cvt_pk_fp8_f32(v1[0], v1[1], w1, false); w1 = __builtin_amdgcn_cvt_pk_fp8_f32(v1[2], v1[3], w1, true); q8[bj] = (unsigned long long)w0 | ((unsigned long long)w1 << 32); } }
            tile_store<0>(c, (char*)(Xo + (size_t)EPI_ROW(g) * 1024 + colw), 2048, o[0], o[1]);
            if (X8) {
              *(PG8_LAS unsigned long long*)(c.stg + c.fr * 80 + c.fq * 8) = q8[0]; *(PG8_LAS unsigned long long*)(c.stg + c.fr * 80 + 32 + c.fq * 8) = q8[1];
              const int r = c.lane >> 2, ch = c.lane & 3; const u32x4 t8 = *(lds_u4p)(c.stg + r * 80 + ch * 16);
              *(u32x4*)(X8 + (size_t)(EPI_ROW(g) + r) * 1024 + colw + ch * 16) = t8; }
            sq[ai][m] = s; asm volatile("" ::: "memory"); }
#undef EP_FETCH
        ss_put(c, ss, u.pm * BM, sq, u.pn * 4 + c.wc);
    }
};
struct EpiQkv {
    struct Pre {}; __device__ __forceinline__ Pre fetch(const Unit&, const EpiCtx&) const { return Pre{}; }
    static constexpr int NST = 0;     static constexpr bool PERM = true, AFTER_DRAIN = false, TWICE = false;
    const float* ssin; bf16_t* Q; const float* bfg; float* LF; float qscale; float* nrm;
    __device__ __forceinline__ void operator()(const f32x4 (&acc)[2][2][4][2], const Unit& u, const EpiCtx& c, const Pre& pre) const {
        rstd_stage(c, ssin, u.pm * BM);
        if (u.pn < 12) {
            const int t = u.pn >> 2; bf16_t* base = Q + (size_t)t * (65536 * 1024); const float sc = t == 0 ? qscale : 1.0f;
            const int colw = (u.pn & 3) * BM + c.wc * 64; float mx = 0.f;
#pragma unroll
            for (int g = 0; g < 8; ++g) { const int ai = g >> 2, m = g & 3; const float rs = rstd_get(c, ai, m) * sc * W8INV; u32x4 o[2]; float q = 0.f;
#pragma unroll
                for (int bj = 0; bj < 2; ++bj) { const f32x4 a = acc[ai][bj][m][0] * rs, b = acc[ai][bj][m][1] * rs; q += dot4(a) + dot4(b); o[bj] = pack8(a, b); }
                tile_store<0>(c, (char*)(base + (size_t)EPI_ROW(g) * 1024 + colw), 2048, o[0], o[1]);
                if (t < 2) { q += __shfl_xor(q, 16); q += __shfl_xor(q, 32); mx = fmaxf(mx, q); } }
            if (t < 2) {
                mx = fmaxf(mx, __shfl_xor(mx, 1)); mx = fmaxf(mx, __shfl_xor(mx, 2)); mx = fmaxf(mx, __shfl_xor(mx, 4)); mx = fmaxf(mx, __shfl_xor(mx, 8));
                if (c.lane == 0) nrm[(((size_t)u.pm * 16 + 4 * (u.pn & 3) + c.wc) * 2 + t) * 2 + c.wr] = mx; }
        } else if (c.wc == 0) {
            const f32x4 b0 = *(const f32x4*)(bfg + 8 * (c.fq & 1)), b1 = *(const f32x4*)(bfg + 8 * (c.fq & 1) + 4);
#pragma unroll
            for (int g = 0; g < 8; ++g) { const int ai = g >> 2, m = g & 3; const float rs = rstd_get(c, ai, m) * W8INV;
                f32x4 z0 = acc[ai][0][m][0] * rs + b0, z1 = acc[ai][0][m][1] * rs + b1;
#pragma unroll
                for (int j = 0; j < 4; ++j) { z0[j] = fminf(z0[j], 0.f) - 0.6931471805599453f * __builtin_amdgcn_logf(1.0f + __builtin_amdgcn_exp2f(-1.4426950408889634f * fabsf(z0[j]))); z1[j] = fminf(z1[j], 0.f) - 0.6931471805599453f * __builtin_amdgcn_logf(1.0f + __builtin_amdgcn_exp2f(-1.4426950408889634f * fabsf(z1[j]))); }
                if (c.fq < 2) { float* o = LF + (size_t)(EPI_ROW(g) + c.fr) * 16 + 8 * c.fq; *(f32x4*)o = z0; *(f32x4*)(o + 4) = z1; } }
        }
    }
};
struct EpiWo {
    struct Pre {}; __device__ __forceinline__ Pre fetch(const Unit&, const EpiCtx&) const { return Pre{}; }
    static constexpr int NST = 18;     static constexpr bool PERM = true, AFTER_DRAIN = false, TWICE = ((PROBE_MASK >> 14) & 1) != 0;
    const bf16_t* Xi; bf16_t* Xo; float* ss; unsigned char* X8;
    __device__ __forceinline__ void operator()(const f32x4 (&acc)[2][2][4][2], const Unit& u, const EpiCtx& c, const Pre& pre) const {
        const int colw = u.pn * BM + c.wc * 64;
        float sq[2][4]; RawTile rx[2];
#define EP_FETCH(g_) do { rx[(g_) & 1] = tile_fetch(c, (const char*)(Xi + (size_t)EPI_ROW(g_) * 1024 + colw), 2048); } while (0)
        EP_FETCH(0);
#pragma unroll
        for (int g = 0; g < 8; ++g) { const int ai = g >> 2, m = g & 3; float s = 0.f; u32x4 o[2], xw[2]; unsigned long long q8[2];
            if (g + 1 < 8) EP_FETCH(g + 1);
            tile_unstage<0>(c, rx[g & 1], xw[0], xw[1]);
#pragma unroll
            for (int bj = 0; bj < 2; ++bj) { f32x4 x0, x1; unpack8(xw[bj], x0, x1);
                const f32x4 v0 = x0 + acc[ai][bj][m][0] * W8INV, v1 = x1 + acc[ai][bj][m][1] * W8INV;
                s += dot4(v0) + dot4(v1); o[bj] = pack8(v0, v1); q8[bj] = fp8x8_sat(v0, v1); }
            tile_store<0>(c, (char*)(Xo + (size_t)EPI_ROW(g) * 1024 + colw), 2048, o[0], o[1]);
            fp8_rows_store(c, X8 + (size_t)EPI_ROW(g) * 1024 + colw, q8[0], q8[1]);
            sq[ai][m] = s; asm volatile("" ::: "memory"); }
#undef EP_FETCH
        ss_put(c, ss, u.pm * BM, sq, u.pn * 4 + c.wc);
    }
};

typedef int v8i_t __attribute__((ext_vector_type(8))); typedef int v4i_t __attribute__((ext_vector_type(4)));
struct Frag2 { bf16x8 k0, k1; };
struct Frag1 { v8i_t v; };
template <int ESZ> struct FragSel { typedef Frag2 type; };
template <> struct FragSel<1> { typedef Frag1 type; };
__device__ __forceinline__ void ld_frag(Frag2& f, const PG8_LAS unsigned char* p) { f.k0 = *(const PG8_LAS bf16x8*)p; f.k1 = *(const PG8_LAS bf16x8*)(p + 1024); }
__device__ __forceinline__ void ld_frag(Frag1& f, const PG8_LAS unsigned char* p) { const v4i_t lo = *(const PG8_LAS v4i_t*)p, hi = *(const PG8_LAS v4i_t*)(p + 1024); f.v = __builtin_shufflevector(lo, hi, 0, 1, 2, 3, 4, 5, 6, 7); }
__device__ __forceinline__ void mma_frag(f32x4& acc, const Frag2& b, const Frag2& a) { acc = __builtin_amdgcn_mfma_f32_16x16x32_bf16(b.k0, a.k0, acc, 0, 0, 0); acc = __builtin_amdgcn_mfma_f32_16x16x32_bf16(b.k1, a.k1, acc, 0, 0, 0); }
__device__ __forceinline__ void mma_frag(f32x4& acc, const Frag1& b, const Frag1& a) {
#if defined(__HIP_DEVICE_COMPILE__)
    asm volatile("v_mfma_f32_16x16x128_f8f6f4 %0, %1, %2, %0" : "+v"(acc) : "v"(b.v), "v"(a.v));
#endif
}
#define PG8_KITER(SKIP11, WX, MMA0) do { \
            unsigned w2[2][2]; \
            if constexpr (GATHER) { if (last) { _Pragma("unroll") for (int h_ = 0; h_ < 2; ++h_) _Pragma("unroll") for (int i_ = 0; i_ < 2; ++i_) w2[h_][i_] = vgN[h_][i_]; } else { _Pragma("unroll") for (int h_ = 0; h_ < 2; ++h_) _Pragma("unroll") for (int i_ = 0; i_ < 2; ++i_) w2[h_][i_] = vgC[h_][i_]; } } \
            PG8_LDB(B0, 0, 0); PG8_LDB(B1, 0, 1); PG8_SCHED; PG8_LDA(At, 0, 0); if (!(SKIP11)) { if constexpr (GATHER) PG8_STAGE(PG8_SA(1, 1), a1, vgC[1]); else PG8_STAGE(PG8_SA(1, 1), a1 + hstepA, voffA); } \
            PG8_WAIT_V(WX); PG8_WAIT_L(0); PG8_BAR; MMA0(0, 0, At, B0); MMA0(0, 1, At, B1); PG8_BAR; PG8_SCHED; \
            PG8_LDA(At, 0, 1); PG8_STAGE(PG8_SB(0, 0), b2, voffB); PG8_STAGE(PG8_SB(0, 1), b2 + hstepB, voffB); if constexpr (GATHER) PG8_STAGE(PG8_SA(0, 0), a2, w2[0]); else PG8_STAGE(PG8_SA(0, 0), a2, voffA); \
            PG8_WAIT_V(WX); PG8_WAIT_L(0); PG8_BAR; MMA0(1, 0, At, B0); MMA0(1, 1, At, B1); PG8_BAR; PG8_SCHED; \
            PG8_LDB(B0, 1, 0); PG8_LDB(B1, 1, 1); PG8_SCHED; PG8_LDA(At, 1, 0); if constexpr (GATHER) PG8_STAGE(PG8_SA(0, 1), a2, w2[1]); else PG8_STAGE(PG8_SA(0, 1), a2 + hstepA, voffA); \
            PG8_WAIT_V(WX); PG8_WAIT_L(0); PG8_BAR; PG8_MMA(0, 0, At, B0); PG8_MMA(0, 1, At, B1); PG8_BAR; PG8_SCHED; \
            PG8_LDA(At, 1, 1); PG8_STAGE(PG8_SB(1, 0), b3, voffB); PG8_STAGE(PG8_SB(1, 1), b3 + hstepB, voffB); if constexpr (GATHER) PG8_STAGE(PG8_SA(1, 0), a3, w2[0]); else PG8_STAGE(PG8_SA(1, 0), a3, voffA); \
            PG8_WAIT_V(8); PG8_WAIT_L(0); PG8_BAR; PG8_MMA(1, 0, At, B0); PG8_MMA(1, 1, At, B1); PG8_BAR; PG8_SCHED; \
            } while (0)
__device__ __forceinline__ void mma_frag_z(f32x4& acc, const Frag1& b, const Frag1& a) {
#if defined(__HIP_DEVICE_COMPILE__)
    asm volatile("v_mfma_f32_16x16x128_f8f6f4 %0, %1, %2, 0" : "=&v"(acc) : "v"(b.v), "v"(a.v));
#endif
}
__device__ __forceinline__ void mma_frag_z(f32x4& acc, const Frag2& b, const Frag2& a) { acc = (f32x4){0.f, 0.f, 0.f, 0.f}; mma_frag(acc, b, a); }
template <class Epi, class Sched, bool GATHER = false, int ESZ = 2>
__device__ __forceinline__ void gemm_phase(PG8_LAS unsigned char* lds, PG8_LAS unsigned char* epi, const Gemm g, const Sched& S, const Epi& E) {
    int tid = threadIdx.x; asm volatile("" : "+v"(tid));
    const int wid = __builtin_amdgcn_readfirstlane(tid >> 6), lane = tid & 63, wr = wid >> 2, wc = wid & 3, fr = lane & 15, fq = lane >> 4;
    constexpr bool ALIGN_EPI = true, SP2 = true, RELAX = (ESZ == 1)  ; const int K = g.K, nt = (K * ESZ) / (BK * 2), lda = g.lda, ldb = g.ldb;
    unsigned voffA[2], voffB[2];
#pragma unroll
    for (int i = 0; i < 2; ++i) { int R, C; stage_rc(tid * 16 + i * 8192, R, C); const int Rb = 64 * (R >> 5) + 8 * ((R & 15) >> 2) + 4 * ((R >> 4) & 1) + (R & 3);
        voffA[i] = GATHER ? (unsigned)(R | (C << 16)) : (unsigned)(R * lda * ESZ + C * 2); voffB[i] = (unsigned)(Rb * ldb * ESZ + C * 2); }
    unsigned vgC[2][2], vgN[2][2];
#define PG8_ROWMAP(dst, pm_) do { _Pragma("unroll") for (int h_ = 0; h_ < 2; ++h_) _Pragma("unroll") for (int i_ = 0; i_ < 2; ++i_) { \
        const unsigned tok_ = (unsigned)g.rowmap[(size_t)(pm_) * BM + h_ * HALF + (voffA[i_] & 0xFFFFu)] & 0xFFFFu; dst[h_][i_] = tok_ * (unsigned)(lda * ESZ) + (voffA[i_] >> 16) * 2u; } } while (0)
    const size_t kstep = (size_t)(BK * 2);
    const size_t hstepA = (size_t)HALF * lda * ESZ, hstepB = (size_t)32 * ldb * ESZ;
    const unsigned ldsw = (unsigned)wid * 1024u;
    const int aoff = lds_byte(wr * 64 + fr, fq * 8), boff = lds_byte(wc * 32 + fr, fq * 8);
#define PG8_SA(b, h) (((b) * 2 + (h)) * HTB)
#define PG8_SB(b, h) ((4 + (b) * 2 + (h)) * HTB)
#define PG8_STAGE(bufoff, gbase, voff) do { _Pragma("unroll") for (int _i = 0; _i < 2; ++_i) \
        __builtin_amdgcn_global_load_lds((const unsigned*)((const char*)(gbase) + (voff)[_i]), (PG8_LAS unsigned*)(lds + (bufoff) + ldsw + _i * 8192), 16, 0, 0); } while (0)
#define PG8_LDA(dst, b, h) do { _Pragma("unroll") for (int m = 0; m < 4; ++m) ld_frag(dst[m], lds + PG8_SA(b, h) + aoff + m * 2048); } while (0)
#define PG8_LDB(dst, b, h) do { _Pragma("unroll") for (int n = 0; n < 2; ++n) ld_frag(dst[n], lds + PG8_SB(b, h) + boff + n * 2048); } while (0)
#define PG8_MMA(ai, bj, At, Bt) do { __builtin_amdgcn_s_setprio(1); _Pragma("unroll") for (int m = 0; m < 4; ++m) _Pragma("unroll") for (int n = 0; n < 2; ++n) mma_frag(acc[ai][bj][m][n], Bt[n], At[m]); __builtin_amdgcn_s_setprio(0); } while (0)
#define PG8_MMAZ(ai, bj, At, Bt) do { __builtin_amdgcn_s_setprio(1); _Pragma("unroll") for (int m = 0; m < 4; ++m) _Pragma("unroll") for (int n = 0; n < 2; ++n) mma_frag_z(acc[ai][bj][m][n], Bt[n], At[m]); __builtin_amdgcn_s_setprio(0); } while (0)
#define PG8_WAIT_V(n) asm volatile("s_waitcnt vmcnt(%0)" :: "n"(n) : "memory")
#define PG8_WAIT_L(n) asm volatile("s_waitcnt lgkmcnt(" #n ")" ::: "memory")
#define PG8_BAR __builtin_amdgcn_s_barrier()
#define PG8_SCHED __builtin_amdgcn_sched_barrier(0)
    Unit cur, nxt; int ui = 0;
    if (!S.next(0, cur)) return;
    if (g.stag > 0) { const unsigned long long t0 = __builtin_amdgcn_s_memrealtime(), d = (unsigned long long)((blockIdx.x & 15u) * (unsigned)g.stag); while (__builtin_amdgcn_s_memrealtime() - t0 < d) __builtin_amdgcn_s_sleep(8); }
    f32x4 acc[2][2][4][2];
#pragma unroll
    for (int a = 0; a < 2; ++a)
#pragma unroll
        for (int b = 0; b < 2; ++b)
#pragma unroll
            for (int m = 0; m < 4; ++m)
#pragma unroll
                for (int n = 0; n < 2; ++n) { if constexpr (!RELAX) { acc[a][b][m][n] = (f32x4){0.f, 0.f, 0.f, 0.f}; if constexpr (ESZ == 1) asm volatile("" : "+v"(acc[a][b][m][n])); } }
    typename FragSel<ESZ>::type At[4], B0[2], B1[2];
    const char* cA = GATHER ? (const char*)g.A : (const char*)g.A + S.a_off(cur); const char* cB = (const char*)g.Bt + S.b_off(cur);
    if constexpr (GATHER) { PG8_ROWMAP(vgC, cur.pm); _Pragma("unroll") for (int h_ = 0; h_ < 2; ++h_) _Pragma("unroll") for (int i_ = 0; i_ < 2; ++i_) vgN[h_][i_] = vgC[h_][i_]; }
    typename Epi::Pre pre;
#define PG8_FETCH() do { int t3 = threadIdx.x; asm volatile("" : "+v"(t3)); const int w3 = __builtin_amdgcn_readfirstlane(t3 >> 6), l3 = t3 & 63; const EpiCtx ec3{epi + w3 * EPW, w3 >> 2, w3 & 3, l3 & 15, l3 >> 4, l3}; pre = E.fetch(cur, ec3); } while (0)
    PG8_FETCH();
    S.a_ready(cur);
    {
        PG8_STAGE(PG8_SB(0, 0), cB, voffB); PG8_STAGE(PG8_SB(0, 1), cB + hstepB, voffB);
        if constexpr (GATHER) { PG8_STAGE(PG8_SA(0, 0), cA, vgC[0]); PG8_STAGE(PG8_SA(0, 1), cA, vgC[1]); } else { PG8_STAGE(PG8_SA(0, 0), cA, voffA); PG8_STAGE(PG8_SA(0, 1), cA + hstepA, voffA); }
        if (wr == 1) PG8_BAR;
        PG8_WAIT_V(2); PG8_BAR;
        PG8_STAGE(PG8_SB(1, 0), cB + kstep, voffB); if constexpr (GATHER) PG8_STAGE(PG8_SA(1, 0), cA + kstep, vgC[0]); else PG8_STAGE(PG8_SA(1, 0), cA + kstep, voffA); PG8_STAGE(PG8_SB(1, 1), cB + hstepB + kstep, voffB);
        if constexpr (RELAX) {
            if constexpr (GATHER) PG8_STAGE(PG8_SA(1, 1), cA + kstep, vgC[1]); else PG8_STAGE(PG8_SA(1, 1), cA + kstep + hstepA, voffA);
            volatile __attribute__((address_space(1))) u32x4* dm = (volatile __attribute__((address_space(1))) u32x4*)g.dummy + ((size_t)blockIdx.x * 512 + (size_t)tid);
#pragma unroll
            for (int k_ = 0; k_ < Epi::NST; ++k_) *dm = (u32x4){0u, 0u, 0u, 0u};
            PG8_WAIT_V(8 + Epi::NST); PG8_BAR;
        } else { PG8_WAIT_V(6); PG8_BAR; }
    }
    for (;;) {
        const bool has_next = S.next(ui + 1, nxt);
        const char* nA = (has_next && !GATHER) ? (const char*)g.A + S.a_off(nxt) : cA; const char* nB = has_next ? (const char*)g.Bt + S.b_off(nxt) : cB;
        if constexpr (GATHER) { if (has_next) PG8_ROWMAP(vgN, nxt.pm); }
#define PG8_KPTRS const bool last = (t == nt - 2); const char* a1 = cA + (size_t)(t + 1) * kstep; \
            const char* a2 = last ? nA : cA + (size_t)(t + 2) * kstep; const char* b2 = last ? nB : cB + (size_t)(t + 2) * kstep; const char* a3 = a2 + kstep; const char* b3 = b2 + kstep; (void)a1
        if constexpr (RELAX) {
            { const int t = 0; PG8_KPTRS; PG8_KITER(true, 8 + Epi::NST, PG8_MMAZ); }
            for (int t = 2; t < nt; t += 2) { PG8_KPTRS; PG8_KITER(false, 8, PG8_MMA); }
            if (has_next) { if constexpr (GATHER) PG8_STAGE(PG8_SA(1, 1), nA + kstep, vgN[1]); else PG8_STAGE(PG8_SA(1, 1), nA + kstep + hstepA, voffA); }
        } else {
            for (int t = 0; t < nt; t += 2) { PG8_KPTRS; PG8_KITER(false, 8, PG8_MMA); }
        }
#undef PG8_KPTRS
        if constexpr (ESZ == 1) asm volatile("s_nop 15\n\ts_nop 15" ::: "memory");
        if constexpr (ALIGN_EPI) { if (wr == 0) PG8_BAR; }
        { int t2 = threadIdx.x; asm volatile("" : "+v"(t2));
          const int w2 = __builtin_amdgcn_readfirstlane(t2 >> 6), l2 = t2 & 63; const EpiCtx ec{epi + w2 * EPW, w2 >> 2, w2 & 3, l2 & 15, l2 >> 4, l2}; E(acc, cur, ec, pre); if (Epi::TWICE) { asm volatile("" ::: "memory"); E(acc, cur, ec, pre); } S.done(cur); }
        if (!has_next) break;
#pragma unroll
        for (int a = 0; a < 2; ++a)
#pragma unroll
            for (int b = 0; b < 2; ++b)
#pragma unroll
                for (int m = 0; m < 4; ++m)
#pragma unroll
                    for (int n = 0; n < 2; ++n) { if constexpr (!RELAX) { acc[a][b][m][n] = (f32x4){0.f, 0.f, 0.f, 0.f}; if constexpr (ESZ == 1) asm volatile("" : "+v"(acc[a][b][m][n])); } }
        cur = nxt; cA = nA; cB = nB; ++ui;
        PG8_FETCH();
        if constexpr (GATHER) { _Pragma("unroll") for (int h_ = 0; h_ < 2; ++h_) _Pragma("unroll") for (int i_ = 0; i_ < 2; ++i_) vgC[h_][i_] = vgN[h_][i_]; }
        if constexpr (ALIGN_EPI) { if (wr == 1) PG8_BAR; }
    }
    PG8_WAIT_V(0);
    if constexpr (!ALIGN_EPI) { if (wr == 0) PG8_BAR; }
    PG8_BAR;
#undef PG8_SA
#undef PG8_FETCH
#undef PG8_ROWMAP
#undef PG8_SB
#undef PG8_STAGE
#undef PG8_LDA
#undef PG8_LDB
#undef PG8_MMA
#undef PG8_MMAZ
#undef PG8_WAIT_V
#undef PG8_WAIT_L
#undef PG8_BAR
#undef PG8_SCHED
}
}
#include <hip/hip_bf16.h>
#include <cmath>
namespace attn_body {
using bf16=__hip_bfloat16;
using bf16x8=__attribute__((ext_vector_type(8)))short;
using s16x4=__attribute__((ext_vector_type(4)))short;
using f32x16=__attribute__((ext_vector_type(16)))float;
using u32x4=__attribute__((ext_vector_type(4)))unsigned;
using f32x4_t=__attribute__((ext_vector_type(4)))float;
constexpr int BATCH=8,NHEAD=16,SEQ=8192,D=64,DM=NHEAD*D;
constexpr int NW=8,QBLK=32,QB=QBLK*NW,KVBLK=64,NQB=SEQ/QB;
constexpr int ATTN_PITCH=DM, ATTN_UNIT_ROWS=QB;
__device__ __forceinline__ int crow(int r,int hi){return (r&3)+8*(r>>2)+4*hi;}
#define SBAR() __builtin_amdgcn_sched_barrier(0)
__device__ __forceinline__ void cmask(f32x16&p0,f32x16&p1,int jb,int qrel,int hi){
  const float NEG=-INFINITY; int kb=64*jb+4*hi;
  #pragma unroll
  for(int r=0;r<16;++r){int kv=kb+(r&3)+8*(r>>2); if(kv>qrel)p0[r]=NEG; if(kv+32>qrel)p1[r]=NEG;}
}

constexpr int NSLOT=3, SLOTB=8192;
constexpr int LDS_K=0, LDS_V=NSLOT*SLOTB, LDS_WS=2*NSLOT*SLOTB, LDS_OST=LDS_WS+NW*64*4, LDS_BIAS=LDS_OST+NW*4096, LDS_BYTES=LDS_BIAS+SEQ*4;
constexpr float C2=0.125f*1.4426950408889634f;
__device__ __forceinline__ void glds16(const void*gsrc,unsigned lds_dst){unsigned keep;
  asm volatile("s_mov_b32 %0, m0\n\ts_mov_b32 m0, %2\n\ts_nop 0\n\tglobal_load_lds_dwordx4 %1, off\n\ts_mov_b32 m0, %0":"=&s"(keep):"v"(gsrc),"s"(lds_dst):"memory");}
__device__ __forceinline__ float max3f(float a,float b,float c){float r;asm("v_max3_f32 %0, %1, %2, %3":"=v"(r):"v"(a),"v"(b),"v"(c));return r;}
__device__ __forceinline__ float max2f(float a,float b){float r;asm("v_max_f32_e32 %0, %1, %2":"=v"(r):"v"(a),"v"(b));return r;}
__device__ __forceinline__ float fadd_s(float a,float b){float r;asm("v_add_f32_e32 %0, %1, %2":"=v"(r):"v"(a),"v"(b));return r;}
__device__ __forceinline__ float fsub_s(float a,float b){float r;asm("v_sub_f32_e32 %0, %1, %2":"=v"(r):"v"(a),"v"(b));return r;}
typedef float f32x2_t __attribute__((ext_vector_type(2))); typedef __bf16 bf16x2_t __attribute__((ext_vector_type(2)));
__device__ __forceinline__ unsigned cvtpk_s(float lo,float hi){f32x2_t v={lo,hi};bf16x2_t b=__builtin_convertvector(v,bf16x2_t);return __builtin_bit_cast(unsigned,b);}
#define WAIT_BAR(N) asm volatile("s_waitcnt vmcnt(" #N ") lgkmcnt(0)\n\ts_barrier":::"memory")

__device__ __forceinline__ void qkt(f32x16&p0,f32x16&p1,const char*Kslot,const bf16x8*qr,const f32x16&c0,const f32x16&c1,int r32,int hi){
  const char*kb=Kslot+hi*1024+r32*16;
  #pragma unroll
  for(int d0=0;d0<4;++d0){
    const bf16x8 b0=*reinterpret_cast<const bf16x8*>(kb+d0*2048);
    const bf16x8 b1=*reinterpret_cast<const bf16x8*>(kb+d0*2048+512);
    if(d0==0){p0=__builtin_amdgcn_mfma_f32_32x32x16_bf16(b0,qr[0],c0,0,0,0);p1=__builtin_amdgcn_mfma_f32_32x32x16_bf16(b1,qr[0],c1,0,0,0);}
    else{p0=__builtin_amdgcn_mfma_f32_32x32x16_bf16(b0,qr[d0],p0,0,0,0);p1=__builtin_amdgcn_mfma_f32_32x32x16_bf16(b1,qr[d0],p1,0,0,0);}}
}
typedef __attribute__((address_space(3))) const char* lds_cptr;
typedef short v4i16_t __attribute__((ext_vector_type(4)));
__device__ __forceinline__ void kload8(bf16x8*kf,lds_cptr kp){
  kf[0]=*(const __attribute__((address_space(3))) bf16x8*)(kp);      kf[1]=*(const __attribute__((address_space(3))) bf16x8*)(kp+512);
  kf[2]=*(const __attribute__((address_space(3))) bf16x8*)(kp+2048); kf[3]=*(const __attribute__((address_space(3))) bf16x8*)(kp+2560);
  kf[4]=*(const __attribute__((address_space(3))) bf16x8*)(kp+4096); kf[5]=*(const __attribute__((address_space(3))) bf16x8*)(kp+4608);
  kf[6]=*(const __attribute__((address_space(3))) bf16x8*)(kp+6144); kf[7]=*(const __attribute__((address_space(3))) bf16x8*)(kp+6656);
}
__device__ __forceinline__ void kload2(bf16x8*kf,lds_cptr kp,int j){ kf[2*j]=*(const __attribute__((address_space(3))) bf16x8*)(kp+j*2048); kf[2*j+1]=*(const __attribute__((address_space(3))) bf16x8*)(kp+j*2048+512); }
__device__ __forceinline__ s16x4 vtr(lds_cptr p){ return __builtin_bit_cast(s16x4,__builtin_amdgcn_ds_read_tr16_b64_v4i16((__attribute__((address_space(3))) v4i16_t*)p)); }
__device__ __forceinline__ float rowmax(const f32x16&p0,const f32x16&p1){
  float a=max3f(p0[0],p0[1],p1[0]),b=max3f(p0[2],p0[3],p1[1]);a=max3f(a,p1[2],p1[3]);
  #pragma unroll
  for(int r=4;r<16;r+=4){a=max3f(a,p0[r],p0[r+1]);b=max3f(b,p0[r+2],p0[r+3]);a=max3f(a,p1[r],p1[r+1]);b=max3f(b,p1[r+2],p1[r+3]);}
  const float m=max2f(a,b);
  auto rr=__builtin_amdgcn_permlane32_swap(__float_as_uint(m),__float_as_uint(m),false,false);
  return max2f(__uint_as_float(rr[0]),__uint_as_float(rr[1]));
}
__device__ __forceinline__ void pv(f32x16*o,int vb,bf16x8 pa0,bf16x8 pa1,bf16x8 pa2,bf16x8 pa3){
  #pragma unroll
  for(int d0=0;d0<2;++d0){s16x4 lo[4],hi[4];
    #pragma unroll
    for(int ks=0;ks<4;++ks){
      asm volatile("ds_read_b64_tr_b16 %0,%1 offset:%c2":"=&v"(lo[ks]):"v"(vb),"i"(d0*4096+ks*1024):"memory");
      asm volatile("ds_read_b64_tr_b16 %0,%1 offset:%c2":"=&v"(hi[ks]):"v"(vb),"i"(d0*4096+ks*1024+512):"memory");}
    asm volatile("s_waitcnt lgkmcnt(0)":::"memory");SBAR();
    #define PK(k) (bf16x8){lo[k][0],lo[k][1],lo[k][2],lo[k][3],hi[k][0],hi[k][1],hi[k][2],hi[k][3]}
    o[d0]=__builtin_amdgcn_mfma_f32_32x32x16_bf16(pa0,PK(0),o[d0],0,0,0);
    o[d0]=__builtin_amdgcn_mfma_f32_32x32x16_bf16(pa1,PK(1),o[d0],0,0,0);
    o[d0]=__builtin_amdgcn_mfma_f32_32x32x16_bf16(pa2,PK(2),o[d0],0,0,0);
    o[d0]=__builtin_amdgcn_mfma_f32_32x32x16_bf16(pa3,PK(3),o[d0],0,0,0);
    #undef PK
  }
}

#ifndef ATTN_STORE16
#define ATTN_STORE16(p,v) (*(u32x4*)(p)=(v))
#endif
template<int THRL,bool STATIC> __device__ __forceinline__ void attn_unit(int b,int h,int qb,int ts,const bf16*Q,const bf16*__restrict__ K,const bf16*__restrict__ V,bf16*O,const float*biasg,char*shm){
  int tid=threadIdx.x; asm volatile("":"+v"(tid)); const int lane=tid&63,r32=lane&31,hi=lane>>5; const int wid=__builtin_amdgcn_readfirstlane(tid>>6);
  const long rowbase=(long)b*SEQ; const int q0=qb*QB;
  const bf16*Qw=Q+(rowbase+q0+wid*QBLK)*DM+h*D;
  const bf16*Kh=K+(rowbase+(long)ts*KVBLK)*DM+h*D,*Vh=V+(rowbase+(long)ts*KVBLK)*DM+h*D;
  const unsigned lds0=(unsigned)(uintptr_t)shm;
  float*wsf=(float*)(shm+LDS_WS)+wid*64;
  const bf16*ksrc=Kh+(long)lane*DM+wid*8;
  const bf16*vsrc=Vh+(long)(16*(wid&3)+(lane>>2))*DM+(wid>>2)*32+(lane&3)*8;
  const unsigned kdst=lds0+LDS_K+wid*1024, vdst=lds0+LDS_V+wid*1024;
  #define DMA_K(t,slot) glds16(ksrc+(long)(t)*KVBLK*DM,(unsigned)__builtin_amdgcn_readfirstlane(kdst+(slot)))
  #define DMA_V(t,slot) glds16(vsrc+(long)(t)*KVBLK*DM,(unsigned)__builtin_amdgcn_readfirstlane(vdst+(slot)))
  const int vb0=(int)(lds0+LDS_V)+((lane>>4)&1)*32+(lane&3)*8+(4*hi+((lane&15)>>2))*64;
  const char*Kbase=shm+LDS_K; bf16x8 kf[8];
  const lds_cptr shm3=(lds_cptr)shm; const lds_cptr kp0=shm3+LDS_K+hi*1024+r32*16; const lds_cptr vp0=shm3+LDS_V+((lane>>4)&1)*32+(lane&3)*8+(4*hi+((lane&15)>>2))*64;
  const int NT=(q0+QB)/KVBLK-ts;
  if(!STATIC){ const float*bg=biasg+(long)(b*NHEAD+h)*SEQ+ts*KVBLK; const int nb=NT*KVBLK;
    for(int f0=wid*256;f0<nb;f0+=NW*256) glds16(bg+f0+lane*4,(unsigned)__builtin_amdgcn_readfirstlane(lds0+LDS_BIAS+f0*4)); }
  const lds_cptr bp0=shm3+LDS_BIAS+hi*16;
  DMA_K(0,0);DMA_V(0,0);DMA_K(1,SLOTB);
  bf16x8 qr[4];
  #pragma unroll
  for(int d0=0;d0<4;++d0)qr[d0]=*reinterpret_cast<const bf16x8*>(&Qw[(long)r32*DM+d0*16+hi*8]);
  float mhat=0.f,l_reg=0.f;f32x16 o[2];o[0]=f32x16{};o[1]=f32x16{};f32x16 cb0,cb1;
  #define LOADCB(t) do{ const lds_cptr bp_=bp0+(t)*256; _Pragma("unroll") for(int j_=0;j_<4;++j_){ \
      const f32x4_t u0_=*(const __attribute__((address_space(3))) f32x4_t*)(bp_+j_*32); const f32x4_t u1_=*(const __attribute__((address_space(3))) f32x4_t*)(bp_+128+j_*32); \
      _Pragma("unroll") for(int i_=0;i_<4;++i_){ if(STATIC){ cb0[4*j_+i_]=u0_[i_]; cb1[4*j_+i_]=u1_[i_]; } else { cb0[4*j_+i_]=u0_[i_]-mhat; cb1[4*j_+i_]=u1_[i_]-mhat; } } } }while(0)
  const int qrel=wid*QBLK+r32;
  #define CMASK(P0,P1,t) do{int jb_=(t)-(NT-4); if(jb_>=0)cmask(P0,P1,jb_,qrel,hi);}while(0)
  bool resc=false;
  #define START(P0,P1) do{ resc=false; \
    if(!STATIC){ const float rm=rowmax(P0,P1); const float dl=rm; mhat=fadd_s(mhat,dl); \
      _Pragma("unroll") for(int r=0;r<16;++r){P0[r]=fsub_s(P0[r],dl);P1[r]=fsub_s(P1[r],dl);} \
      } \
    _Pragma("unroll") for(int r=0;r<16;++r)P0[r]=__builtin_amdgcn_exp2f(P0[r]); }while(0)
  #define RESC() do{ if(resc){ asm volatile("s_waitcnt lgkmcnt(0)":::"memory"); \
      _Pragma("unroll") for(int d_=0;d_<2;++d_) _Pragma("unroll") for(int r=0;r<16;++r)o[d_][r]*=wsf[crow(r,hi)]; } }while(0)
  f32x16 pA0,pA1,pB0,pB1;
  int sl_prev=0,sl_cur=0,sl_next=SLOTB;
  #define ROT() do{sl_prev=sl_cur;sl_cur=sl_next;sl_next=(sl_next==(NSLOT-1)*SLOTB)?0:sl_next+SLOTB;}while(0)
  DMA_K(2,2*SLOTB);
  if(STATIC){ const float*bg=biasg+(long)(b*NHEAD+h)*SEQ; const float ref=bg[q0+QB-1]; const int nb=NT*KVBLK;
    for(int f0=tid*4;f0<nb;f0+=NW*256){ f32x4_t v=*(const f32x4_t*)(bg+ts*KVBLK+f0); v[0]-=ref; v[1]-=ref; v[2]-=ref; v[3]-=ref; *(__attribute__((address_space(3))) f32x4_t*)(shm3+LDS_BIAS+f0*4)=v; } }
  WAIT_BAR(3);
  LOADCB(0); qkt(pA0,pA1,Kbase,qr,cb0,cb1,r32,hi);asm volatile("s_nop 15\n\ts_nop 7":"+v"(pA0),"+v"(pA1));CMASK(pA0,pA1,0);
  START(pA0,pA1);
  _Pragma("unroll") for(int r=0;r<16;++r)pA1[r]=__builtin_amdgcn_exp2f(pA1[r]);
  WAIT_BAR(0);
  DMA_K(3,0);DMA_V(1,SLOTB);
  ROT();
  kload8(kf,kp0+sl_cur);
  WAIT_BAR(2);
  s16x4 vlo[8],vhi[8]; u32x4 pw0,pw1,pw2,pw3;
  #define PKW(P,B) cvtpk_s(P[B],P[B+1])
  #define PAF(k) __builtin_bit_cast(bf16x8,pw##k)
  #define VFR(i) (bf16x8){vlo[i][0],vlo[i][1],vlo[i][2],vlo[i][3],vhi[i][0],vhi[i][1],vhi[i][2],vhi[i][3]}
  #define PIN(x) asm volatile("":"+v"(x))
  #define MX3(a,b,c) __builtin_fmaxf(__builtin_fmaxf((a),(b)),(c))
  #define GAPA(MF,A0,A1,A2,A3,W0,W1,PW) do{ MF; sacc+=A0; sacc+=A1; sacc+=A2; sacc+=A3; PIN(sacc); W0; W1; PIN(PW); SBAR(); }while(0)
  #define EX(v) __builtin_amdgcn_exp2f(v)
  #define GAPB(MF,X,B) do{ MF; X[B]=EX(X[B]); X[B+1]=EX(X[B+1]); X[B+2]=EX(X[B+2]); X[B+3]=EX(X[B+3]); PIN(X); SBAR(); }while(0)
  #define VRD(i) do{ vlo[i]=vtr(vp_+(((i)>>2)*4096+((i)&3)*1024)); vhi[i]=vtr(vp_+(((i)>>2)*4096+((i)&3)*1024+512)); }while(0)
  #define KRD(G,j) do{ if(G){ kload2(kf,kp0+sl_next,j); SBAR(); } }while(0)
  #define STEP(C0,C1,P0,P1,t,GK,GV,GL) do{ SBAR(); \
    LOADCB(t); SBAR(); \
    const lds_cptr vp_=vp0+sl_prev; \
    VRD(0); SBAR(); float sacc=(P0[0]+P0[1]); \
    GAPA(C0=__builtin_amdgcn_mfma_f32_32x32x16_bf16(kf[0],qr[0],cb0,0,0,0), P0[2],P0[3],P0[4],P0[5],     pw0[0]=PKW(P0,0), pw0[1]=PKW(P0,2), pw0); \
    VRD(4); SBAR(); GAPA(C1=__builtin_amdgcn_mfma_f32_32x32x16_bf16(kf[1],qr[0],cb1,0,0,0), P0[6],P0[7],P0[8],P0[9],     pw0[2]=PKW(P0,4), pw0[3]=PKW(P0,6), pw0); \
    VRD(1); SBAR(); GAPA(C0=__builtin_amdgcn_mfma_f32_32x32x16_bf16(kf[2],qr[1],C0,0,0,0),   P0[10],P0[11],P0[12],P0[13], pw1[0]=PKW(P0,8), pw1[1]=PKW(P0,10), pw1); \
    VRD(5); SBAR(); GAPA(C1=__builtin_amdgcn_mfma_f32_32x32x16_bf16(kf[3],qr[1],C1,0,0,0),   P0[14],P0[15],P1[0],P1[1],   pw1[2]=PKW(P0,12),pw1[3]=PKW(P0,14), pw1); \
    VRD(2); SBAR(); GAPA(C0=__builtin_amdgcn_mfma_f32_32x32x16_bf16(kf[4],qr[2],C0,0,0,0),   P1[2],P1[3],P1[4],P1[5],     pw2[0]=PKW(P1,0), pw2[1]=PKW(P1,2), pw2); \
    VRD(6); SBAR(); GAPA(C1=__builtin_amdgcn_mfma_f32_32x32x16_bf16(kf[5],qr[2],C1,0,0,0),   P1[6],P1[7],P1[8],P1[9],     pw2[2]=PKW(P1,4), pw2[3]=PKW(P1,6), pw2); \
    VRD(3); SBAR(); GAPA(C0=__builtin_amdgcn_mfma_f32_32x32x16_bf16(kf[6],qr[3],C0,0,0,0),   P1[10],P1[11],P1[12],P1[13], pw3[0]=PKW(P1,8), pw3[1]=PKW(P1,10), pw3); \
    VRD(7); SBAR(); GAPA(C1=__builtin_amdgcn_mfma_f32_32x32x16_bf16(kf[7],qr[3],C1,0,0,0),   P1[14],P1[15],0.f,0.f,       pw3[2]=PKW(P1,12),pw3[3]=PKW(P1,14), pw3); \
    l_reg+=sacc; \
    if(GK){DMA_K((t)+3,sl_cur);} if(GV){DMA_V((t)+1,sl_next);} \
    CMASK(C0,C1,t); \
    if(!STATIC){ float a=MX3(C0[0],C0[1],C1[0]),b=MX3(C0[2],C0[3],C1[1]); a=MX3(a,C1[2],C1[3]); \
      _Pragma("unroll") for(int r=4;r<16;r+=4){a=MX3(a,C0[r],C0[r+1]);b=MX3(b,C0[r+2],C0[r+3]);a=MX3(a,C1[r],C1[r+1]);b=MX3(b,C1[r+2],C1[r+3]);} \
      float rm=__builtin_fmaxf(a,b); { auto rr=__builtin_amdgcn_permlane32_swap(__float_as_uint(rm),__float_as_uint(rm),false,false); rm=__builtin_fmaxf(__uint_as_float(rr[0]),__uint_as_float(rr[1])); } \
      resc=false; \
      if(__builtin_expect(__any(rm>(float)THRL),0)){ const float dl=__builtin_fmaxf(rm,0.f); mhat+=dl; \
        _Pragma("unroll") for(int r=0;r<16;++r){C0[r]-=dl;C1[r]-=dl;} \
        const float f=__builtin_amdgcn_exp2f(-dl); l_reg*=f; if(hi==0)wsf[r32]=f; resc=true; } } \
    SBAR(); \
    GAPB(o[0]=__builtin_amdgcn_mfma_f32_32x32x16_bf16(PAF(0),VFR(0),o[0],0,0,0), C0,0); \
    GAPB(o[1]=__builtin_amdgcn_mfma_f32_32x32x16_bf16(PAF(0),VFR(4),o[1],0,0,0), C0,4); \
    KRD(GL,0); GAPB(o[0]=__builtin_amdgcn_mfma_f32_32x32x16_bf16(PAF(1),VFR(1),o[0],0,0,0), C0,8); \
    KRD(GL,1); GAPB(o[1]=__builtin_amdgcn_mfma_f32_32x32x16_bf16(PAF(1),VFR(5),o[1],0,0,0), C0,12); \
    KRD(GL,2); GAPB(o[0]=__builtin_amdgcn_mfma_f32_32x32x16_bf16(PAF(2),VFR(2),o[0],0,0,0), C1,0); \
    KRD(GL,3); GAPB(o[1]=__builtin_amdgcn_mfma_f32_32x32x16_bf16(PAF(2),VFR(6),o[1],0,0,0), C1,4); \
    GAPB(o[0]=__builtin_amdgcn_mfma_f32_32x32x16_bf16(PAF(3),VFR(3),o[0],0,0,0), C1,8); \
    GAPB(o[1]=__builtin_amdgcn_mfma_f32_32x32x16_bf16(PAF(3),VFR(7),o[1],0,0,0), C1,12); \
    }while(0)
  int t=1;
  #undef CMASK
  #define CMASK(P0,P1,t) do{}while(0)
  for(;t+5<NT;t+=2){
    STEP(pB0,pB1,pA0,pA1,t,true,true,true);     WAIT_BAR(2); RESC(); ROT();
    STEP(pA0,pA1,pB0,pB1,t+1,true,true,true);   WAIT_BAR(2); RESC(); ROT();
  }
  #undef CMASK
  #define CMASK(P0,P1,t) do{int jb_=(t)-(NT-4); if(jb_>=0)cmask(P0,P1,jb_,qrel,hi);}while(0)
  #define ENDW(tt) do{ if((tt)+3<NT){WAIT_BAR(2);} else if((tt)+2<NT){WAIT_BAR(1);} else {WAIT_BAR(0);} }while(0)
  for(;t+1<NT;t+=2){
    STEP(pB0,pB1,pA0,pA1,t,(t+3<NT),(t+1<NT),(t+1<NT));       ENDW(t);   RESC(); ROT();
    STEP(pA0,pA1,pB0,pB1,t+1,(t+4<NT),(t+2<NT),(t+2<NT));     ENDW(t+1); RESC(); ROT();
  }
  STEP(pB0,pB1,pA0,pA1,NT-1,false,false,false); RESC();
  { float sacc=pB0[0]+pB0[1]; _Pragma("unroll") for(int r=2;r<16;++r)sacc+=pB0[r]; _Pragma("unroll") for(int r=0;r<16;++r)sacc+=pB1[r]; l_reg+=sacc;
    pw0=(u32x4){PKW(pB0,0),PKW(pB0,2),PKW(pB0,4),PKW(pB0,6)};pw1=(u32x4){PKW(pB0,8),PKW(pB0,10),PKW(pB0,12),PKW(pB0,14)};pw2=(u32x4){PKW(pB1,0),PKW(pB1,2),PKW(pB1,4),PKW(pB1,6)};pw3=(u32x4){PKW(pB1,8),PKW(pB1,10),PKW(pB1,12),PKW(pB1,14)};
    SBAR(); pv(o,vb0+sl_cur,PAF(0),PAF(1),PAF(2),PAF(3)); }
  #undef PKW
  #undef PAF
  #undef VFR
  #undef PIN
  #undef MX3
  #undef GAPA
  #undef GAPB
  #undef EX
  #undef VRD
  #undef KRD
  #undef STEP
  #undef ENDW
  {auto rr=__builtin_amdgcn_permlane32_swap(__float_as_uint(l_reg),__float_as_uint(l_reg),false,false);l_reg=__uint_as_float(rr[0])+__uint_as_float(rr[1]);}
  if(hi==0)wsf[32+r32]=l_reg;asm volatile("s_waitcnt lgkmcnt(0)":::"memory");
  float rli[16];
  #pragma unroll
  for(int r=0;r<16;++r)rli[r]=__builtin_amdgcn_rcpf(wsf[32+crow(r,hi)]);
  unsigned char*Ow=(unsigned char*)O+(rowbase+q0+wid*QBLK)*DM+h*D;
  { __attribute__((address_space(3))) unsigned char*stg=(__attribute__((address_space(3))) unsigned char*)(shm3+LDS_OST)+wid*2048;
    #pragma unroll
    for(int r=0;r<16;++r){const int orow=crow(r,hi);
      #pragma unroll
      for(int d0=0;d0<2;++d0){const float v=o[d0][r]*rli[r]; stg[orow*64+d0*32+r32]=(unsigned char)(__builtin_amdgcn_cvt_pk_fp8_f32(v,v,0u,false)&0xffu);}}
    asm volatile("s_waitcnt lgkmcnt(0)":::"memory");
    #pragma unroll
    for(int i=0;i<2;++i){const int row=i*16+(lane>>2),ch=lane&3; const u32x4 v=*(const __attribute__((address_space(3))) u32x4*)(stg+row*64+ch*16); ATTN_STORE16(Ow+(long)row*DM+ch*16,v);} }
  asm volatile("s_waitcnt lgkmcnt(0)\n\ts_barrier":::"memory");
  #undef DMA_K
  #undef DMA_V
  #undef CMASK
  #undef START
  #undef RESC
  #undef ROT
  #undef LOADCB
}
constexpr int ATTN_LDS_BYTES=LDS_BYTES;
struct AttnTensors { const bf16* Q; const bf16* K; const bf16* V; bf16* O; const float* bias; const int* ts; };
struct AttnUnit { int bh; int qb; };
struct StaticOrder {
  int vcu;
  __device__ __forceinline__ explicit StaticOrder(int grid,int block):vcu((block%8)*(grid/8)+block/8){}
  __device__ __forceinline__ bool next(int i,AttnUnit&u)const{ if(i>=16)return false; const int grp=i>>2,j=i&3,r=((vcu&7)+2*grp)&7; u.bh=(vcu>>3)+32*grp;
    u.qb=(r<5)?((j==0)?r:(4+3*r+j)):(20+4*(r-5)+j); return true; }
  __device__ __forceinline__ void a_ready(const AttnUnit&)const{}
  __device__ __forceinline__ void done(const AttnUnit&)const{}
};
template<class Sched,int THRL=60> __device__ __forceinline__ void attn_phase(char*lds,const AttnTensors&T,const Sched&S){
  AttnUnit u;
  for(int i=0;S.next(i,u);++i){ S.a_ready(u); const int ts_=__builtin_amdgcn_readfirstlane(T.ts[u.bh*NQB+u.qb]);
    if(ts_&0x10000) attn_unit<THRL,true>(u.bh/NHEAD,u.bh%NHEAD,u.qb,ts_&0xffff,T.Q,T.K,T.V,T.O,T.bias,lds); else attn_unit<THRL,false>(u.bh/NHEAD,u.bh%NHEAD,u.qb,ts_,T.Q,T.K,T.V,T.O,T.bias,lds);
    S.done(u); }
}
#undef SBAR
#undef WAIT_BAR
}
#define GAS __attribute__((address_space(1)))
#define LAS __attribute__((address_space(3)))
typedef unsigned short bf16;
typedef unsigned v4u __attribute__((ext_vector_type(4)));
typedef float f32x4 __attribute__((ext_vector_type(4)));
typedef short bf16x8 __attribute__((ext_vector_type(8)));
typedef GAS unsigned gu32;
typedef GAS unsigned long long gu64;
#define RLX_AGENT __ATOMIC_RELAXED, __HIP_MEMORY_SCOPE_AGENT
#define LDS_WAIT() asm volatile("s_waitcnt lgkmcnt(0)" ::: "memory")
#define VM_WAIT() asm volatile("s_waitcnt vmcnt(0)" ::: "memory")
__device__ __forceinline__ unsigned long long rt() { return __builtin_amdgcn_s_memrealtime(); }
__device__ __forceinline__ unsigned f2bf(float f) { unsigned u = __builtin_bit_cast(unsigned, f); return (u + 0x7fffu + ((u >> 16) & 1u)) >> 16; }
__device__ __forceinline__ unsigned pk2(float lo, float hi) { return f2bf(lo) | (f2bf(hi) << 16); }

#define XB_TMO      128
#define XB_XCNT(j)  (256  + 64 * (j))
#define XB_XSUB(j)  (1280 + 64 * (j))
#define XB_XGEN(j)  (2304 + 64 * (j))
#define XB_TOP      3328
#define XB_TOPGEN   3392
#define XCD_BAR_WORDS 3456
#define XB_SPIN_CAP (1u << 18)

__device__ __forceinline__ unsigned xb_ld(unsigned* p)              { return __hip_atomic_load(p, __ATOMIC_RELAXED, __HIP_MEMORY_SCOPE_AGENT); }
__device__ __forceinline__ unsigned xb_add(unsigned* p, unsigned v) { return __hip_atomic_fetch_add(p, v, __ATOMIC_RELAXED, __HIP_MEMORY_SCOPE_AGENT); }
__device__ __forceinline__ unsigned xb_xcc_id() { return (unsigned)__builtin_amdgcn_s_getreg((3 << 11) | 20) & 0xFu; }
#define XB_SPIN(cond, bar) do { unsigned _sp = 0; while (cond) { __builtin_amdgcn_s_sleep(1); \
    if ((++_sp & 255u) == 0u) { if (xb_ld(&(bar)[XB_TMO])) break; if (_sp > XB_SPIN_CAP) { atomicAdd(&(bar)[XB_TMO], 1u); break; } } } } while (0)

struct XcdBarrier {
    unsigned* bar; unsigned x;
    volatile LAS unsigned* st;
};

__device__ __forceinline__ XcdBarrier xcd_barrier_post(unsigned* bar, volatile LAS unsigned* st) {
    XcdBarrier b; b.bar = bar; b.x = xb_xcc_id(); b.st = st;
    if (threadIdx.x == 0) (void)xb_add(&bar[XB_XCNT(b.x)], 1u);
    return b;
}
__device__ __forceinline__ void xcd_barrier_complete(unsigned* bar, unsigned x, unsigned& nloc, unsigned& nx) {
    const unsigned G = gridDim.x * gridDim.y * gridDim.z;
    unsigned sum, cnt, mine, sp = 0u;
    for (;;) {
        sum = 0u; cnt = 0u; mine = 0u;
#pragma unroll
        for (unsigned j = 0; j < 16; ++j) { const unsigned c = xb_ld(&bar[XB_XCNT(j)]); sum += c; cnt += (c > 0u) ? 1u : 0u; mine = (j == x) ? c : mine; }
        if (sum == G) break;
        __builtin_amdgcn_s_sleep(1);
        if ((++sp & 255u) == 0u) { if (xb_ld(&bar[XB_TMO])) break; if (sp > XB_SPIN_CAP) { atomicAdd(&bar[XB_TMO], 1u); break; } }
    }
    nloc = mine > 0u ? mine : 1u; nx = cnt > 0u ? cnt : 1u;
}

__device__ __forceinline__ void xcd_barrier(const XcdBarrier& b) {
    asm volatile("s_waitcnt vmcnt(0)" ::: "memory");
    __syncthreads();
    if (threadIdx.x == 0) {
        unsigned* bar = b.bar;
        __builtin_amdgcn_s_waitcnt(0);
        unsigned nloc = b.st[0], nx = b.st[1];
        if (nloc == 0u) { xcd_barrier_complete(bar, b.x, nloc, nx); b.st[0] = nloc; b.st[1] = nx; }
        const unsigned old = xb_add(&bar[XB_XSUB(b.x)], 1u);
        const unsigned gen = old / nloc;
        if (old + 1u == (gen + 1u) * nloc) {
            __builtin_amdgcn_fence(__ATOMIC_RELEASE, "agent");
            asm volatile("s_waitcnt vmcnt(0)" ::: "memory");
            const unsigned og = xb_add(&bar[XB_TOP], 1u);
            const unsigned tg = og / nx;
            if (og + 1u == (tg + 1u) * nx) xb_add(&bar[XB_TOPGEN], 1u);
            else XB_SPIN(xb_ld(&bar[XB_TOPGEN]) == tg, bar);
            __builtin_amdgcn_fence(__ATOMIC_ACQUIRE, "agent");
            xb_add(&bar[XB_XGEN(b.x)], 1u);
            asm volatile("s_waitcnt vmcnt(0)" ::: "memory");
        } else {
            XB_SPIN(xb_ld(&bar[XB_XGEN(b.x)]) == gen, bar);
            __builtin_amdgcn_fence(__ATOMIC_ACQUIRE, "agent");
            asm volatile("s_waitcnt vmcnt(0)" ::: "memory");
        }
    }
    __syncthreads();
}

constexpr int NWAVES = 8;
constexpr int NB = 8, SEQ = 8192, D = 1024, NTOK = NB * SEQ, NE = 32, PLE = 256, NH = 16;
constexpr int MAXT = 1056;
constexpr int NCHUNK = NTOK / 256;
constexpr float LOG2E = 1.4426950408889634f;
constexpr float WSCALE8 = 1.0f / pg8::W8INV;
#ifndef MK_PER_PHASE
#define MK_PER_PHASE 0
#endif
constexpr int N_PHASES = 21;
#ifndef STAG_GU
#define STAG_GU 0
#endif
#ifndef STAG_DOWN
#define STAG_DOWN 0
#endif
#ifndef STAG_QKV
#define STAG_QKV 0
#endif
#ifndef STAG_PLE
#define STAG_PLE 0
#endif
#ifndef STAG_PJ
#define STAG_PJ 0
#endif
#ifndef STAG_WO
#define STAG_WO 0
#endif
#ifndef STAG_POOL
#define STAG_POOL 0
#endif

constexpr size_t MiB = 1u << 20;
constexpr size_t WS_CTL = 0, CTL_ZERO_BYTES = 1 * MiB;
constexpr size_t WS_META = 4 * MiB;
constexpr size_t WS_LOGITS = 5 * MiB;
constexpr size_t WS_TOKE = 13 * MiB;
constexpr size_t WS_TOKG = 14 * MiB;
constexpr size_t WS_TOKPOS = 15 * MiB;
constexpr size_t WS_SLOTG = 16 * MiB;
constexpr size_t WS_SLOTR = 18 * MiB;
constexpr size_t WS_LF = 20 * MiB;
constexpr size_t WS_BIAS = 24 * MiB;
constexpr size_t WS_TS = WS_META + 128 * 1024;
constexpr size_t WS_BGU16 = WS_META + 512 * 1024, WS_BD16 = WS_META + 768 * 1024;
constexpr size_t WS_NRM = WS_META + 256 * 1024;
constexpr size_t WS_WPOOL = 28 * MiB, WS_WROUTER = 29 * MiB, WS_WO = 30 * MiB, WS_WQKV = 32 * MiB, WS_WPG = 39 * MiB, WS_WPP = 43 * MiB, WS_WD = 44 * MiB, WS_WGU = 172 * MiB;
constexpr size_t WS_PB = 428 * MiB;
constexpr size_t WS_XA = 492 * MiB, WS_XB = 620 * MiB;
constexpr size_t WS_XA8 = 1276 * MiB + 384 * MiB;
constexpr size_t WS_XB8 = 1276 * MiB + 128 * MiB;
constexpr size_t WS_XT8 = 1276 * MiB + 448 * MiB;
constexpr size_t WS_XT = 1276 * MiB + 256 * MiB;
constexpr size_t WS_HS = 748 * MiB;
constexpr size_t WS_ACT = 1276 * MiB;
constexpr size_t WS_SS = 1804 * MiB;
constexpr size_t WS_SLOTT = 1828 * MiB;
constexpr size_t WS_DUMMY = 1830 * MiB;
constexpr size_t WS_END = 1832 * MiB;
constexpr size_t SSA = (size_t)NTOK * 16;
static_assert(WS_HS + (size_t)MAXT * 256 * D * 2 <= WS_ACT && WS_ACT + (size_t)MAXT * 256 * D * 2 <= WS_SS && WS_SS + 6 * SSA * 4 <= WS_SLOTT && WS_SLOTT + (size_t)MAXT * 256 * 4 <= WS_DUMMY, "d_ws map");
static_assert(WS_WGU + (size_t)2 * 32 * 2048 * 1024 * 2 <= WS_PB && WS_WD + (size_t)2 * 32 * 1024 * 1024 * 2 <= WS_WGU && WS_WQKV + (size_t)3328 * 1024 * 2 <= WS_WPG, "d_ws map (weights)");
constexpr int CW_TMO = 0, CW_BAR = 4096, CW_NRM = 8192;

constexpr int RING_OFF = 0, RING_BYTES = 131072;
constexpr int EPI_OFF = RING_BYTES, LDSCTL_OFF = EPI_OFF + 8 * pg8::EPW, MISC_OFF = LDSCTL_OFF + 320, TP_OFF = LDSCTL_OFF + 1024;
constexpr int LDS_BYTES = LDSCTL_OFF + 4096;
static_assert(attn_body::ATTN_LDS_BYTES <= RING_BYTES, "attention LDS");

__device__ __forceinline__ float wave_sum(float v) {
#pragma unroll
    for (int o = 1; o < 64; o <<= 1) v += __shfl_xor(v, o);
    return v;
}
__device__ __forceinline__ float dot4f(const f32x4& a) { return (a[0] * a[0] + a[1] * a[1]) + (a[2] * a[2] + a[3] * a[3]); }
__device__ __forceinline__ float rstd_tok(const float* ssp, size_t t) { float v[16];
#pragma unroll
    for (int k = 0; k < 16; ++k) v[k] = ssp[(size_t)k * NTOK + t];
    return pg8::rstd_of(pg8::sum16(v)); }
__device__ __forceinline__ float bflo(unsigned w) { return __builtin_bit_cast(float, w << 16); }
__device__ __forceinline__ float bfhi(unsigned w) { return __builtin_bit_cast(float, w & 0xffff0000u); }

__device__ __forceinline__ void conv_item(const float* W, int ldw, int k0, int n0, int nvalid, bf16* WT, int ldk, int drow0, const float* gain, LAS float* scr, int lane) {
    const bool ok = (lane & 31) < nvalid;
#pragma unroll 8
    for (int i = 0; i < 32; ++i) { const int kk = 2 * i + (lane >> 5); scr[kk * 33 + (lane & 31)] = ok ? W[(size_t)(k0 + kk) * ldw + n0 + (lane & 31)] : 0.f; }
    LDS_WAIT(); asm volatile("" ::: "memory");
    const int c = lane & 7;
    float gv[8];
#pragma unroll
    for (int i = 0; i < 8; ++i) gv[i] = gain ? gain[k0 + 8 * c + i] : 1.f;
#pragma unroll
    for (int j = 0; j < 4; ++j) { const int n = (lane >> 3) + 8 * j; const LAS float* s = scr + (8 * c) * 33 + n;
        v4u o; o.x = pk2(s[0 * 33] * gv[0], s[1 * 33] * gv[1]); o.y = pk2(s[2 * 33] * gv[2], s[3 * 33] * gv[3]); o.z = pk2(s[4 * 33] * gv[4], s[5 * 33] * gv[5]); o.w = pk2(s[6 * 33] * gv[6], s[7 * 33] * gv[7]);
        *(GAS v4u*)(WT + (size_t)(drow0 + n) * ldk + k0 + 8 * c) = o; }
    LDS_WAIT(); asm volatile("" ::: "memory");
}

__device__ __forceinline__ void conv_item8(const float* W, int ldw, int k0, int n0, unsigned char* WT, int ldk, int drow0, const float* gain, float wscale, LAS float* scr, int lane, int nvalid = 32) {
    const bool ok = (lane & 31) < nvalid;
#pragma unroll 8
    for (int i = 0; i < 32; ++i) { const int kk = 2 * i + (lane >> 5); scr[kk * 33 + (lane & 31)] = ok ? W[(size_t)(k0 + kk) * ldw + n0 + (lane & 31)] : 0.f; }
    LDS_WAIT(); asm volatile("" ::: "memory");
    const int c = lane & 7;
    float gv[8];
#pragma unroll
    for (int i = 0; i < 8; ++i) gv[i] = (gain ? gain[k0 + 8 * c + i] : 1.f) * wscale;
#pragma unroll
    for (int j = 0; j < 4; ++j) { const int n = (lane >> 3) + 8 * j; const LAS float* s = scr + (8 * c) * 33 + n;
        unsigned w0 = 0u, w1 = 0u;
        w0 = __builtin_amdgcn_cvt_pk_fp8_f32(s[0 * 33] * gv[0], s[1 * 33] * gv[1], w0, false); w0 = __builtin_amdgcn_cvt_pk_fp8_f32(s[2 * 33] * gv[2], s[3 * 33] * gv[3], w0, true);
        w1 = __builtin_amdgcn_cvt_pk_fp8_f32(s[4 * 33] * gv[4], s[5 * 33] * gv[5], w1, false); w1 = __builtin_amdgcn_cvt_pk_fp8_f32(s[6 * 33] * gv[6], s[7 * 33] * gv[7], w1, true);
        *(GAS unsigned long long*)(WT + (size_t)(drow0 + n) * ldk + k0 + 8 * c) = (unsigned long long)w0 | ((unsigned long long)w1 << 32); }
    LDS_WAIT(); asm volatile("" ::: "memory");
}

__device__ __forceinline__ void rstd8(const f32x4 (&xs)[8], LAS float* part  , int hw, int lane, float (&rs)[8]) {
    float p[8];
#pragma unroll
    for (int j = 0; j < 8; ++j) p[j] = wave_sum(dot4f(xs[j]));
    if (lane == 0) {
#pragma unroll
        for (int j = 0; j < 8; ++j) part[j * 4 + hw] = p[j]; }
    __syncthreads();
#pragma unroll
    for (int j = 0; j < 8; ++j) { const f32x4 q = *(const LAS f32x4*)(part + j * 4); rs[j] = pg8::rstd_of((q[0] + q[1]) + (q[2] + q[3])); }
}
template <int W> __device__ __forceinline__ void pool_run(const float* x, int t0, int c4, bool has_prev, int pos0, f32x4 g, bf16* diff, LAS float* part2  , int& buf, int hw, int lane) {
    f32x4 hh[16]; f32x4 xs[8], xn[8]; float rs[8];
#pragma unroll
    for (int hc = 0; hc < 2; ++hc) {
#pragma unroll
        for (int j = 0; j < 8; ++j) xs[j] = has_prev ? *(const f32x4*)(x + (size_t)(t0 - 16 + hc * 8 + j) * D + c4) : (f32x4){0.f, 0.f, 0.f, 0.f};
        rstd8(xs, part2 + buf * 32, hw, lane, rs); buf ^= 1;
#pragma unroll
        for (int j = 0; j < 8; ++j) hh[hc * 8 + j] = xs[j] * rs[j] * g;
    }
    f32x4 S = (f32x4){0.f, 0.f, 0.f, 0.f};
#pragma unroll
    for (int i = 16 - W; i < 16; ++i) S += hh[i];
#pragma unroll
    for (int j = 0; j < 8; ++j) xn[j] = *(const f32x4*)(x + (size_t)(t0 + j) * D + c4);
#pragma unroll 1
    for (int cb = 0; cb < 8; ++cb) {
        f32x4 hn[8];
#pragma unroll
        for (int j = 0; j < 8; ++j) xs[j] = xn[j];
        if (cb < 7) {
#pragma unroll
            for (int j = 0; j < 8; ++j) xn[j] = *(const f32x4*)(x + (size_t)(t0 + (cb + 1) * 8 + j) * D + c4); }
        rstd8(xs, part2 + buf * 32, hw, lane, rs); buf ^= 1;
#pragma unroll
        for (int j = 0; j < 8; ++j) {
            hn[j] = xs[j] * rs[j] * g;
            const f32x4 old = (j - W >= 0) ? hn[(j - W >= 0) ? j - W : 0] : hh[(16 + j - W) & 15];
            S = S + hn[j] - old;
            const int pos = pos0 + cb * 8 + j; const int cnt = (pos + 1 < W) ? pos + 1 : W; const float inv = 1.0f / (float)cnt;
            const f32x4 dv = S * inv - hn[j];
            unsigned long long o = (unsigned long long)pk2(dv[0], dv[1]) | ((unsigned long long)pk2(dv[2], dv[3]) << 32);
            *(GAS unsigned long long*)(diff + (size_t)(t0 + cb * 8 + j) * D + c4) = o;
        }
#pragma unroll
        for (int i = 0; i < 8; ++i) hh[i] = hh[i + 8];
#pragma unroll
        for (int i = 0; i < 8; ++i) hh[8 + i] = hn[i];
    }
}

struct Args { const float* in[24]; float* out; unsigned char* ws; int ph_lo, ph_hi; };
enum { I_X = 0, I_P, I_NMIX, I_NFFN, I_NPLE, I_NFIN, I_POOLW, I_POOLS, I_KVN, I_WK, I_WV, I_WF, I_BF, I_WQ, I_WO, I_RW, I_RB, I_WGU, I_BGU, I_WD, I_BD, I_PWG, I_PBG, I_PWP };
#define WSP(T, off) ((T*)(args.ws + (off)))
#ifdef ONLY
#define PHON(n) ((n) == ONLY)
#else
#define PHON(n) true
#endif
#define IN(k) (lo <= (k) && (k) < hi)
#define NREP(bit) ((((PROBE_MASK) >> (bit)) & 1) ? 2 : 1)
#define SEAM(k) do { if (IN(k) && IN((k) + 1)) xcd_barrier(bar); } while (0)
#define FRESH_IDS() int tid = threadIdx.x; asm volatile("" : "+v"(tid)); const int lane = tid & 63, wave = __builtin_amdgcn_readfirstlane(tid >> 6); (void)lane; (void)wave; \
    const int G = gridDim.x, bx = blockIdx.x; const int vcu = (G % 8 == 0) ? (bx % 8) * (G / 8) + bx / 8 : bx; const int gw = vcu * NWAVES + wave, NGW = G * NWAVES; (void)gw; (void)NGW; (void)vcu

__device__ __forceinline__ void phase_prologue(const Args& args, LAS unsigned char* lds) {
    FRESH_IDS();
    const float* norm_ffn = args.in[I_NFFN];
    unsigned char* Wqkv8 = WSP(unsigned char, WS_WQKV); bf16* Wrouter = WSP(bf16, WS_WROUTER);
    LAS float* scr = (LAS float*)(lds + RING_OFF + wave * 16384);
    constexpr int I_GU = 2 * 32 * 1024, I_D = 2 * 32 * 512, I_PG = 2 * 512, I_PP = 2 * 128, I_SQ = 512, I_F = 16, I_POOL = 128, I_R = 32;
    constexpr int NITEMS = I_GU + I_D + I_PG + I_PP + 4 * I_SQ + I_F + I_POOL + I_R;
    for (int it = gw; it < NITEMS; it += NGW) {
        int r = it;
        if (r < I_GU) { const int le = r >> 10, q = r & 1023, kb = q >> 6, nb = q & 63, n0 = nb * 32;
            const int drow0 = 256 * ((n0 & 1023) >> 7) + 64 * ((n0 & 127) >> 5) + 32 * (n0 >> 10);
            conv_item8(args.in[I_WGU] + (size_t)le * 1024 * 2048, 2048, kb * 64, n0, WSP(unsigned char, WS_WGU) + (size_t)le * 2048 * 1024, 1024, drow0, norm_ffn + (le >> 5) * 1024, (n0 < 1024) ? WSCALE8 * pg8::SW_A2 : WSCALE8, scr, lane); continue; } r -= I_GU;
        if (r < I_D) { const int le = r >> 9, q = r & 511, kb = q >> 5, nb = q & 31;
            conv_item8(args.in[I_WD] + (size_t)le * 1024 * 1024, 1024, kb * 64, nb * 32, WSP(unsigned char, WS_WD) + (size_t)le * 1024 * 1024, 1024, nb * 32, nullptr, WSCALE8, scr, lane); continue; } r -= I_D;
        if (r < I_PG) { const int l = r >> 9, q = r & 511, kb = q >> 5, nb = q & 31;
            conv_item8(args.in[I_PWG] + (size_t)l * 1024 * 1024, 1024, kb * 64, nb * 32, WSP(unsigned char, WS_WPG) + (size_t)l * 1024 * 1024, 1024, nb * 32, args.in[I_NPLE] + l * 1024, WSCALE8, scr, lane); continue; } r -= I_PG;
        if (r < I_PP) { const int l = r >> 7, q = r & 127, kb = q >> 5, nb = q & 31;
            conv_item(args.in[I_PWP] + (size_t)l * 256 * 1024, 1024, kb * 64, nb * 32, 32, WSP(bf16, WS_WPP) + (size_t)l * 1024 * 256, 256, nb * 32, nullptr, scr, lane); continue; } r -= I_PP;
        if (r < 4 * I_SQ) { const int w = r >> 9, q = r & 511, kb = q >> 5, nb = q & 31;
            const float* src = args.in[w == 0 ? I_WQ : (w == 1 ? I_WK : (w == 2 ? I_WV : I_WO))]; const float* gn = w == 0 ? args.in[I_NMIX] + 1024 : args.in[I_KVN];
            if (w == 3) conv_item8(src, 1024, kb * 64, nb * 32, WSP(unsigned char, WS_WO), 1024, nb * 32, nullptr, WSCALE8, scr, lane);
            else conv_item8(src, 1024, kb * 64, nb * 32, Wqkv8 + (size_t)w * 1024 * 1024, 1024, nb * 32, gn, WSCALE8, scr, lane);
            continue; } r -= 4 * I_SQ;
        if (r < I_F) { conv_item8(args.in[I_WF], 16, r * 64, 0, Wqkv8 + (size_t)3072 * 1024, 1024, 0, args.in[I_KVN], WSCALE8, scr, lane, 16); continue; } r -= I_F;
        if (r < I_POOL) { const int g = r >> 5, q = r & 31, kb = q >> 3, nb = q & 7;
            conv_item(args.in[I_POOLW] + (size_t)g * 256 * 256, 256, kb * 64, nb * 32, 32, WSP(bf16, WS_WPOOL) + (size_t)g * 256 * 256, 256, nb * 32, nullptr, scr, lane); continue; } r -= I_POOL;
        { const int l = r >> 4, kb = r & 15;
            conv_item(args.in[I_RW] + (size_t)l * 1024 * 32, 32, kb * 64, 0, 32, Wrouter + (size_t)l * 256 * 1024, 1024, 0, norm_ffn + l * 1024, scr, lane); }
    }
    {
        const int gt = vcu * NWAVES * 64 + tid, NGT = G * NWAVES * 64; const v4u z = (v4u){0u, 0u, 0u, 0u};
        for (int i = gt; i < 2 * 224 * 128; i += NGT) { const int l = i / (224 * 128), q = i % (224 * 128); *(GAS v4u*)(Wrouter + (size_t)l * 256 * 1024 + (size_t)32 * 1024 + (size_t)q * 8) = z; }
        for (int i = gt; i < 224 * 64; i += NGT) *(GAS v4u*)(Wqkv8 + (size_t)3104 * 1024 + (size_t)i * 16) = z;
        { const float* bgu = args.in[I_BGU]; const float* bd = args.in[I_BD]; bf16* o1 = WSP(bf16, WS_BGU16); bf16* o2 = WSP(bf16, WS_BD16);
          for (int i = gt; i < 2 * 32 * 2048 / 2; i += NGT) { const bool gate = ((2 * i) & 2047) < 1024; ((GAS unsigned*)o1)[i] = gate ? pk2(bgu[2 * i] * pg8::SW_A2, bgu[2 * i + 1] * pg8::SW_A2) : pk2(bgu[2 * i] + 1.0f, bgu[2 * i + 1] + 1.0f); }
          for (int i = gt; i < 2 * 32 * 1024 / 2; i += NGT) ((GAS unsigned*)o2)[i] = pk2(bd[2 * i], bd[2 * i + 1]); }
        const float* p_in = args.in[I_P]; bf16* PB = WSP(bf16, WS_PB);
        for (size_t i = gt; i < (size_t)2 * NTOK * PLE / 8; i += NGT) { const f32x4 a = *(const f32x4*)(p_in + i * 8), b = *(const f32x4*)(p_in + i * 8 + 4);
            v4u o; o.x = pk2(a[0], a[1]); o.y = pk2(a[2], a[3]); o.z = pk2(b[0], b[1]); o.w = pk2(b[2], b[3]); *(GAS v4u*)(PB + i * 8) = o; }
    }
    __syncthreads();
    {
        const float* x_in = args.in[I_X]; bf16* DIFF = WSP(bf16, WS_ACT);
        const int half = tid >> 8, ht = tid & 255, hw = wave & 3, c4 = ht * 4;
        LAS float* part2 = (LAS float*)(lds + RING_OFF) + half * 64;
        const f32x4 g = *(const f32x4*)(args.in[I_NMIX] + c4);
        const int grp = __builtin_amdgcn_readfirstlane(ht >> 6);
        int buf = 0;
        for (int it = bx; it < NTOK / 128; it += G) {
            const int t0 = (it * 2 + half) * 64, pos0 = t0 & (SEQ - 1); const bool has_prev = pos0 != 0;
            if (grp == 0) pool_run<2>(x_in, t0, c4, has_prev, pos0, g, DIFF, part2, buf, hw, lane);
            else if (grp == 1) pool_run<4>(x_in, t0, c4, has_prev, pos0, g, DIFF, part2, buf, hw, lane);
            else if (grp == 2) pool_run<8>(x_in, t0, c4, has_prev, pos0, g, DIFF, part2, buf, hw, lane);
            else pool_run<16>(x_in, t0, c4, has_prev, pos0, g, DIFF, part2, buf, hw, lane);
        }
        __syncthreads();
    }
}

template <int LAYER> __device__ __forceinline__ void ple_phase(const Args& args, LAS unsigned char* lds) {
    constexpr int SSM = LAYER == 0 ? 0 : 3; constexpr size_t XT_OFF = WS_XT, XN_OFF = WS_XB;
        { FRESH_IDS();
          pg8::Gemm g{WSP(bf16, WS_PB) + (size_t)LAYER * NTOK * PLE, WSP(bf16, WS_WPP) + (size_t)LAYER * 1024 * 256, PLE, PLE, PLE, STAG_PJ}; pg8::DenseOrder S; S.init(NTOK / 256, 4, G, bx, PLE, PLE, 0);
          pg8::EpiStore E{WSP(unsigned char, WS_ACT)};
          pg8::gemm_phase<pg8::EpiStore, pg8::DenseOrder>(lds + RING_OFF, lds + EPI_OFF, g, S, E); }
        VM_WAIT(); __syncthreads();
        { FRESH_IDS();
          pg8::Gemm g{(const pg8::bf16_t*)WSP(unsigned char, WS_XT8), (const pg8::bf16_t*)(WSP(unsigned char, WS_WPG) + (size_t)LAYER * 1024 * 1024), D, D, D, STAG_PLE, nullptr, WSP(unsigned char, WS_DUMMY)}; pg8::DenseOrder S; S.init(NTOK / 256, 4, G, bx, D, D, 0, 1);
          pg8::EpiPle E{args.in[I_PBG] + LAYER * 1024, WSP(unsigned char, WS_ACT), WSP(bf16, XT_OFF), WSP(bf16, XN_OFF), WSP(float, WS_SS) + (size_t)(SSM + 2) * SSA, LAYER == 0 ? WSP(unsigned char, WS_XB8) : (unsigned char*)nullptr};
          pg8::gemm_phase<pg8::EpiPle, pg8::DenseOrder, false, 1>(lds + RING_OFF, lds + EPI_OFF, g, S, E); }
}

template <int LAYER> __device__ __forceinline__ void moe_ple_block(const Args& args, LAS unsigned char* lds, const XcdBarrier& bar, const int lo, const int hi) {
    constexpr int PBASE = LAYER == 0 ? 2 : 13, SSM = LAYER == 0 ? 0 : 3;
    constexpr size_t XC_OFF = WS_XA, XT_OFF = WS_XT, XN_OFF = WS_XB;
    if (IN(PBASE) && PHON(2)) for (int rep_ = 0; rep_ < NREP(2); ++rep_) {
        FRESH_IDS();
        pg8::Gemm g{WSP(bf16, XC_OFF), WSP(bf16, WS_WROUTER) + (size_t)LAYER * 256 * 1024, D, D, D, 0}; pg8::DenseOrder S; S.init(NTOK / 256, 1, G, bx, D, D, 0);
        pg8::EpiRouter E{WSP(float, WS_SS) + (size_t)SSM * SSA, args.in[I_RB] + LAYER * 32, WSP(float, WS_LOGITS)};
        pg8::gemm_phase<pg8::EpiRouter, pg8::DenseOrder>(lds + RING_OFF, lds + EPI_OFF, g, S, E);
        VM_WAIT(); __syncthreads(); __builtin_amdgcn_fence(__ATOMIC_ACQUIRE, "agent"); VM_WAIT(); __syncthreads();
        const float* LOGITS = WSP(float, WS_LOGITS); unsigned* TOKE = WSP(unsigned, WS_TOKE); float* TOKG = WSP(float, WS_TOKG); int* CH = WSP(int, WS_META);
        LAS int* hist = (LAS int*)(lds + RING_OFF);
        pg8::Unit uu;
        for (int ui = 0; S.next(ui, uu); ++ui) { const int ch = uu.pm;
            if (tid < 32) hist[tid] = 0;
            __syncthreads();
            if (tid < 256) {
                const int t = ch * 256 + tid; float v[32];
#pragma unroll
                for (int j = 0; j < 8; ++j) { const f32x4 q = *(const f32x4*)(LOGITS + (size_t)t * 32 + 4 * j); v[4 * j] = q[0]; v[4 * j + 1] = q[1]; v[4 * j + 2] = q[2]; v[4 * j + 3] = q[3]; }
                float sv[4]; int si[4]; float pv = INFINITY; int pi = -1;
#pragma unroll
                for (int k = 0; k < 4; ++k) { float bv = -INFINITY; int bi = 0;
#pragma unroll
                    for (int i = 0; i < 32; ++i) { const bool after = (v[i] < pv) || (v[i] == pv && i > pi); if (after && v[i] > bv) { bv = v[i]; bi = i; } }
                    sv[k] = bv; si[k] = bi; pv = bv; pi = bi; }
                const float e1 = __expf(sv[1] - sv[0]), e2 = __expf(sv[2] - sv[0]), e3 = __expf(sv[3] - sv[0]); const float inv = 1.0f / (1.0f + e1 + e2 + e3);
                TOKE[t] = (unsigned)si[0] | ((unsigned)si[1] << 8) | ((unsigned)si[2] << 16) | ((unsigned)si[3] << 24);
                *(f32x4*)(TOKG + (size_t)t * 4) = (f32x4){inv, e1 * inv, e2 * inv, e3 * inv};
#pragma unroll
                for (int k = 0; k < 4; ++k) atomicAdd((int*)(hist + si[k]), 1);
            }
            __syncthreads();
            if (tid < 32) CH[ch * 32 + tid] = hist[tid];
            __syncthreads();
        }
    }
    if (IN(PBASE) && IN(PBASE + 2)) xcd_barrier(bar);
    if (IN(PBASE + 2) && PHON(4)) for (int rep_ = 0; rep_ < NREP(4); ++rep_) {
        FRESH_IDS();
        const int* CH = WSP(int, WS_META); int* TPg = WSP(int, WS_META + 65536); const unsigned* TOKE = WSP(unsigned, WS_TOKE); const float* TOKG = WSP(float, WS_TOKG); int* TOKPOS = WSP(int, WS_TOKPOS);
        float* SLOTG = WSP(float, WS_SLOTG); const float* ss_mix = WSP(float, WS_SS) + (size_t)SSM * SSA; int* SLOTT = WSP(int, WS_SLOTT); float* SLOTR = WSP(float, WS_SLOTR);
        LAS int* ptot = (LAS int*)(lds + RING_OFF); LAS int* pbef = ptot + 256; LAS int* ntile = pbef + 256; LAS int* befl = ntile + 32; LAS int* tpl = befl + 32; LAS int* lcur = tpl + 64; LAS int* lpos = lcur + 32;
        for (int ch = bx; ch < NCHUNK; ch += G) {
            if (tid < 256) { const int e = tid & 31, part = tid >> 5; int tot = 0, bef = 0;
                for (int c2 = part * 32; c2 < part * 32 + 32; ++c2) { const int v = CH[c2 * 32 + e]; tot += v; bef += (c2 < ch) ? v : 0; }
                ptot[part * 32 + e] = tot; pbef[part * 32 + e] = bef; }
            __syncthreads();
            if (tid < 32) { int tot = 0, bef = 0;
#pragma unroll
                for (int q = 0; q < 8; ++q) { tot += ptot[q * 32 + tid]; bef += pbef[q * 32 + tid]; }
                ntile[tid] = (tot + 255) >> 8; befl[tid] = bef; }
            __syncthreads();
            if (tid == 0) { int a = 0; for (int e = 0; e < 32; ++e) { tpl[e] = a; a += ntile[e]; } tpl[32] = a; }
            __syncthreads();
            if (tid < 32) lcur[tid] = tpl[tid] * 256 + befl[tid];
            if (ch == 0 && tid < 33) TPg[tid] = tpl[tid];
            __syncthreads();
            LAS int* wcnt = lpos + 1024;
            unsigned ev = 0u; int rk[4] = {0, 0, 0, 0};
            if (tid < 256) { ev = TOKE[ch * 256 + tid];
                const int e0 = ev & 255, e1 = (ev >> 8) & 255, e2 = (ev >> 16) & 255, e3 = (ev >> 24) & 255;
                const unsigned mask = (1u << e0) | (1u << e1) | (1u << e2) | (1u << e3);
                const unsigned long long below = (1ull << lane) - 1ull;
#pragma unroll 1
                for (int e = 0; e < 32; ++e) { const unsigned long long bal = __ballot((mask >> e) & 1u); const int r = __popcll(bal & below);
                    if (e0 == e) rk[0] = r; if (e1 == e) rk[1] = r; if (e2 == e) rk[2] = r; if (e3 == e) rk[3] = r;
                    if (lane == 0) wcnt[wave * 32 + e] = __popcll(bal); } }
            __syncthreads();
            if (tid < 256) { const int t = ch * 256 + tid; const f32x4 gv = *(const f32x4*)(TOKG + (size_t)t * 4); const float rst = rstd_tok(ss_mix, (size_t)t);
                int ps[4];
#pragma unroll
                for (int k = 0; k < 4; ++k) { const int e = (ev >> (8 * k)) & 255; int pos = lcur[e] + rk[k];
                    for (int w = 0; w < wave; ++w) pos += wcnt[w * 32 + e];
                    ps[k] = pos; SLOTG[pos] = gv[k]; SLOTT[pos] = t; SLOTR[pos] = rst; }
                *(GAS v4u*)(TOKPOS + (size_t)t * 4) = (v4u){(unsigned)ps[0], (unsigned)ps[1], (unsigned)ps[2], (unsigned)ps[3]}; }
            __syncthreads();
        }
    }
    SEAM(PBASE + 2);
    if (IN(PBASE + 3) && PHON(5)) for (int rep_ = 0; rep_ < NREP(5); ++rep_) {
        FRESH_IDS();
        LAS int* tpl = (LAS int*)(lds + TP_OFF);
        if (tid < 33) tpl[tid] = (int)__hip_atomic_load(WSP(gu32, WS_META + 65536) + tid, RLX_AGENT);
        __syncthreads();
        { LAS unsigned char* te = (LAS unsigned char*)(tpl + 64); const int nT = tpl[32];
          for (int j = tid; j < nT; j += NWAVES * 64) { int e = 0; for (int k = 1; k < 32; ++k) e += (tpl[k] <= j) ? 1 : 0; te[j] = (unsigned char)e; } }
        __syncthreads();
        pg8::Gemm g{(const pg8::bf16_t*)WSP(unsigned char, WS_XA8), (const pg8::bf16_t*)(WSP(unsigned char, WS_WGU) + (size_t)LAYER * 32 * 2048 * 1024), D, D, D, STAG_GU, WSP(int, WS_SLOTT), WSP(unsigned char, WS_DUMMY)}; pg8::GroupedOrder S; S.init(tpl, 8, G, bx, D, D, 2048, 1);
        pg8::EpiSwiGLU E{WSP(bf16, WS_BGU16) + (size_t)LAYER * 32 * 2048, WSP(unsigned char, WS_ACT), WSP(float, WS_SLOTR)};
        pg8::gemm_phase<pg8::EpiSwiGLU, pg8::GroupedOrder, true, 1>(lds + RING_OFF, lds + EPI_OFF, g, S, E);
    }
    SEAM(PBASE + 3);
    if (IN(PBASE + 4) && PHON(6)) for (int rep_ = 0; rep_ < NREP(6); ++rep_) {
        FRESH_IDS();
        LAS int* tpl = (LAS int*)(lds + TP_OFF);
        if (tid < 33) tpl[tid] = (int)__hip_atomic_load(WSP(gu32, WS_META + 65536) + tid, RLX_AGENT);
        __syncthreads();
        { LAS unsigned char* te = (LAS unsigned char*)(tpl + 64); const int nT = tpl[32];
          for (int j = tid; j < nT; j += NWAVES * 64) { int e = 0; for (int k = 1; k < 32; ++k) e += (tpl[k] <= j) ? 1 : 0; te[j] = (unsigned char)e; } }
        __syncthreads();
        pg8::Gemm g{(const pg8::bf16_t*)WSP(unsigned char, WS_ACT), (const pg8::bf16_t*)(WSP(unsigned char, WS_WD) + (size_t)LAYER * 32 * 1024 * 1024), D, D, D, STAG_DOWN, nullptr, WSP(unsigned char, WS_DUMMY)}; pg8::GroupedOrder S; S.init(tpl, 4, G, bx, D, D, 1024, 1);
        pg8::EpiDown E{WSP(float, WS_SLOTG), WSP(bf16, WS_BD16) + (size_t)LAYER * 32 * 1024, WSP(unsigned char, WS_HS)};
        pg8::gemm_phase<pg8::EpiDown, pg8::GroupedOrder, false, 1>(lds + RING_OFF, lds + EPI_OFF, g, S, E);
    }
    SEAM(PBASE + 4);
    if (IN(PBASE + 5) && PHON(7)) for (int rep_ = 0; rep_ < NREP(7); ++rep_) {
        FRESH_IDS();
        const int* TOKPOS = WSP(int, WS_TOKPOS); const bf16* Xc = WSP(bf16, XC_OFF); bf16* Xt = WSP(bf16, XT_OFF); const unsigned char* Y8 = WSP(unsigned char, WS_HS); unsigned char* Xt8 = WSP(unsigned char, WS_XT8); float* ss_moe = WSP(float, WS_SS) + (size_t)(SSM + 1) * SSA;
        for (int t = gw; t < NTOK; t += NGW) {
            const v4u ps = *(const GAS v4u*)(TOKPOS + (size_t)t * 4);
            const bf16* xr = Xc + (size_t)t * D + lane * 16; bf16* xo = Xt + (size_t)t * D + lane * 16; float sq = 0.f;
            const v4u xw0 = *(const GAS v4u*)(xr), xw1 = *(const GAS v4u*)(xr + 8);
            v4u yw[4];
#pragma unroll
            for (int k = 0; k < 4; ++k) { const unsigned pos = k == 0 ? ps.x : (k == 1 ? ps.y : (k == 2 ? ps.z : ps.w)); yw[k] = *(const GAS v4u*)(Y8 + (size_t)pos * D + lane * 16); }
            float a[16] = {bflo(xw0.x), bfhi(xw0.x), bflo(xw0.y), bfhi(xw0.y), bflo(xw0.z), bfhi(xw0.z), bflo(xw0.w), bfhi(xw0.w), bflo(xw1.x), bfhi(xw1.x), bflo(xw1.y), bfhi(xw1.y), bflo(xw1.z), bfhi(xw1.z), bflo(xw1.w), bfhi(xw1.w)};
#pragma unroll
            for (int k = 0; k < 4; ++k) {
#pragma unroll
                for (int w = 0; w < 4; ++w) { const unsigned wd = w == 0 ? yw[k].x : (w == 1 ? yw[k].y : (w == 2 ? yw[k].z : yw[k].w));
                    const pg8::f32x2 lo = __builtin_amdgcn_cvt_pk_f32_fp8((int)wd, false), hi = __builtin_amdgcn_cvt_pk_f32_fp8((int)wd, true);
                    a[4 * w] += lo.x * pg8::YSINV; a[4 * w + 1] += lo.y * pg8::YSINV; a[4 * w + 2] += hi.x * pg8::YSINV; a[4 * w + 3] += hi.y * pg8::YSINV; } }
#pragma unroll
            for (int j = 0; j < 16; ++j) sq += a[j] * a[j];
            { v4u o; o.x = pk2(a[0], a[1]); o.y = pk2(a[2], a[3]); o.z = pk2(a[4], a[5]); o.w = pk2(a[6], a[7]); *(GAS v4u*)(xo) = o;
              o.x = pk2(a[8], a[9]); o.y = pk2(a[10], a[11]); o.z = pk2(a[12], a[13]); o.w = pk2(a[14], a[15]); *(GAS v4u*)(xo + 8) = o; }
            sq = wave_sum(sq);
            { const float rs = pg8::rstd_of(sq);
              v4u o8;
#pragma unroll
              for (int w = 0; w < 4; ++w) { unsigned w0 = 0u; w0 = __builtin_amdgcn_cvt_pk_fp8_f32(a[4 * w] * rs, a[4 * w + 1] * rs, w0, false); w0 = __builtin_amdgcn_cvt_pk_fp8_f32(a[4 * w + 2] * rs, a[4 * w + 3] * rs, w0, true);
                if (w == 0) o8.x = w0; else if (w == 1) o8.y = w0; else if (w == 2) o8.z = w0; else o8.w = w0; }
              *(GAS v4u*)(Xt8 + (size_t)t * D + lane * 16) = o8; }
            (void)ss_moe;
        }
    }
    SEAM(PBASE + 5);
    if (IN(PBASE + 6) && PHON(8)) { if (NREP(8) == 2) ple_phase<LAYER>(args, lds); ple_phase<LAYER>(args, lds); }
    SEAM(PBASE + 6);
}

__global__ void __launch_bounds__(NWAVES * 64, 2) yoco_fwd(Args args) {
    extern __shared__ __attribute__((aligned(16))) unsigned char lds_raw[];
    LAS unsigned char* lds = (LAS unsigned char*)lds_raw;
    volatile LAS unsigned* MISC = (volatile LAS unsigned*)(lds + MISC_OFF);
    for (int u = threadIdx.x; u < (LDS_BYTES - LDSCTL_OFF) / 4; u += NWAVES * 64) ((LAS unsigned*)(lds + LDSCTL_OFF))[u] = 0u;
    __syncthreads();
    XcdBarrier bar; bar.bar = (unsigned*)(WSP(gu32, WS_CTL) + CW_BAR); bar.x = 0; bar.st = nullptr;
    if (!MK_PER_PHASE) bar = xcd_barrier_post((unsigned*)(WSP(gu32, WS_CTL) + CW_BAR), MISC + 8);
#if MK_PER_PHASE
    const int lo = args.ph_lo, hi = args.ph_hi;
#else
    constexpr int lo = 0, hi = N_PHASES;
#endif

    if (IN(0) && PHON(0)) for (int rep_ = 0; rep_ < NREP(0); ++rep_) phase_prologue(args, lds);
    SEAM(0);
    if (IN(1) && PHON(1)) for (int rep_ = 0; rep_ < NREP(1); ++rep_) {
        FRESH_IDS();
        pg8::Gemm g{WSP(bf16, WS_ACT), WSP(bf16, WS_WPOOL), D, 256, 256, STAG_POOL}; pg8::DenseOrder S; S.init(NTOK / 256, 4, G, bx, D, 256, 256);
        pg8::EpiPool E{args.in[I_X], args.in[I_POOLS], WSP(bf16, WS_XA), WSP(float, WS_SS), WSP(unsigned char, WS_XA8)};
        pg8::gemm_phase<pg8::EpiPool, pg8::DenseOrder>(lds + RING_OFF, lds + EPI_OFF, g, S, E);
    }
    SEAM(1);
    moe_ple_block<0>(args, lds, bar, lo, hi);
    if (IN(9) && PHON(9)) for (int rep_ = 0; rep_ < NREP(9); ++rep_) {
        FRESH_IDS();
        pg8::Gemm g{(const pg8::bf16_t*)WSP(unsigned char, WS_XB8), (const pg8::bf16_t*)WSP(unsigned char, WS_WQKV), D, D, D, STAG_QKV, nullptr, WSP(unsigned char, WS_DUMMY)}; pg8::DenseOrder S; S.init(NTOK / 256, 13, G, bx, D, D, 0, 1);
        pg8::EpiQkv E{WSP(float, WS_SS) + (size_t)2 * SSA, WSP(bf16, WS_HS), args.in[I_BF], WSP(float, WS_LF), attn_body::C2, WSP(float, WS_NRM)};
        pg8::gemm_phase<pg8::EpiQkv, pg8::DenseOrder, false, 1>(lds + RING_OFF, lds + EPI_OFF, g, S, E);
    }
    SEAM(9);
    if (IN(10) && PHON(10)) for (int rep_ = 0; rep_ < NREP(10); ++rep_) {
        FRESH_IDS();
        const float* LF = WSP(float, WS_LF); float* BIAS = WSP(float, WS_BIAS);
        LAS float* wtot = (LAS float*)(lds + RING_OFF);
        for (int item = bx; item < NB * NH; item += G) {
            const int b = item >> 4, h = item & 15; const int s0 = tid * 16; float v[16]; float run = 0.f;
#pragma unroll
            for (int j = 0; j < 16; ++j) { run += LF[(size_t)(b * SEQ + s0 + j) * 16 + h]; v[j] = run; }
            float incl = run;
#pragma unroll
            for (int o = 1; o < 64; o <<= 1) { const float n = __shfl_up(incl, o); if (lane >= o) incl += n; }
            if (lane == 63) wtot[wave] = incl;
            __syncthreads();
            float base = incl - run;
            for (int w = 0; w < wave; ++w) base += wtot[w];
            float* o = BIAS + (size_t)item * SEQ + s0; LAS float* lb = wtot + 64;
#pragma unroll
            for (int j = 0; j < 16; j += 4) { const f32x4 bv4 = (f32x4){-(base + v[j]) * LOG2E, -(base + v[j + 1]) * LOG2E, -(base + v[j + 2]) * LOG2E, -(base + v[j + 3]) * LOG2E}; *(f32x4*)(o + j) = bv4; *(LAS f32x4*)(lb + s0 + j) = bv4; }
            LAS float* LE = lb + SEQ; LAS float* wm = wtot + 16; LAS float* wsum = wtot + 32;
            float pm_ = -(base + v[15]) * LOG2E, ps_ = 0.f;
#pragma unroll
            for (int j = 0; j < 16; ++j) ps_ += exp2f(-(base + v[j]) * LOG2E - pm_);
#pragma unroll
            for (int o2 = 1; o2 < 64; o2 <<= 1) { const float m2 = __shfl_up(pm_, o2), s2 = __shfl_up(ps_, o2); if (lane >= o2) { const float M = fmaxf(pm_, m2); ps_ = ps_ * exp2f(pm_ - M) + s2 * exp2f(m2 - M); pm_ = M; } }
            if (lane == 63) { wm[wave] = pm_; wsum[wave] = ps_; }
            __syncthreads();
            for (int w = 0; w < wave; ++w) { const float m2 = wm[w], s2 = wsum[w]; const float M = fmaxf(pm_, m2); ps_ = ps_ * exp2f(pm_ - M) + s2 * exp2f(m2 - M); pm_ = M; }
            LE[tid] = pm_ + log2f(ps_);
            __syncthreads();
            if (tid < 32) {
                const float* nr = WSP(float, WS_NRM);
                const size_t e0 = (((size_t)(b * 32 + tid) * 16 + h) * 2) * 2;
                const float qn = sqrtf(fmaxf(nr[e0], nr[e0 + 1]) * 1.02f), kown = sqrtf(fmaxf(nr[e0 + 2], nr[e0 + 3]) * 1.02f);
                const int q0 = tid * 256, ntile = 4 * (tid + 1); const float bq = lb[q0]; int ts = 0; float kn2 = 0.f;
                for (int j = 0; j + 4 < ntile; ++j) {
                    if ((j & 3) == 0) { const size_t ek = (((size_t)(b * 32 + (j >> 2)) * 16 + h) * 2 + 1) * 2; kn2 = fmaxf(kn2, fmaxf(nr[ek], nr[ek + 1]) * 1.02f); }
                    const float bqk = qn * (sqrtf(kn2) + kown);
                    if (LE[4 * j + 3] + bqk - bq < -25.0f) ts = j + 1; else break; }
                float kall = 0.f;
                for (int j = 0; j <= tid; ++j) { const size_t ek = (((size_t)(b * 32 + j) * 16 + h) * 2 + 1) * 2; kall = fmaxf(kall, fmaxf(nr[ek], nr[ek + 1]) * 1.02f); }
                const float bqs = qn * sqrtf(kall), dlt = lb[q0 + 255] - bq;
                const bool sok = (bqs <= 90.0f) && (bqs + dlt <= 100.0f) && (dlt >= 0.0f);
                WSP(int, WS_TS)[item * 32 + tid] = (ts & ~1) | (sok ? 0x10000 : 0);
            }
            __syncthreads();
        }
    }
    SEAM(10);
    if (IN(11) && PHON(11)) for (int rep_ = 0; rep_ < NREP(11); ++rep_) {
        const attn_body::AttnTensors AT{WSP(const attn_body::bf16, WS_HS), WSP(const attn_body::bf16, WS_HS) + (size_t)NTOK * D, WSP(const attn_body::bf16, WS_HS) + (size_t)2 * NTOK * D, WSP(attn_body::bf16, WS_ACT), WSP(const float, WS_BIAS), WSP(const int, WS_TS)};
        const attn_body::StaticOrder S((int)gridDim.x, (int)blockIdx.x);
#ifndef SKIP_ATTN
        attn_body::attn_phase<attn_body::StaticOrder>((char*)lds_raw + RING_OFF, AT, S);
#endif
    }
    SEAM(11);
    if (IN(12) && PHON(12)) for (int rep_ = 0; rep_ < NREP(12); ++rep_) {
        FRESH_IDS();
        pg8::Gemm g{(const pg8::bf16_t*)WSP(unsigned char, WS_ACT), (const pg8::bf16_t*)WSP(unsigned char, WS_WO), D, D, D, STAG_WO, nullptr, WSP(unsigned char, WS_DUMMY)}; pg8::DenseOrder S; S.init(NTOK / 256, 4, G, bx, D, D, 0, 1);
        pg8::EpiWo E{WSP(bf16, WS_XB), WSP(bf16, WS_XA), WSP(float, WS_SS) + (size_t)3 * SSA, WSP(unsigned char, WS_XA8)};
        pg8::gemm_phase<pg8::EpiWo, pg8::DenseOrder, false, 1>(lds + RING_OFF, lds + EPI_OFF, g, S, E);
    }
    SEAM(12);
    moe_ple_block<1>(args, lds, bar, lo, hi);
    if (IN(20) && PHON(20)) for (int rep_ = 0; rep_ < NREP(13); ++rep_) {
        FRESH_IDS();
        const float* ssf = WSP(float, WS_SS) + (size_t)5 * SSA; const bf16* XA = WSP(bf16, WS_XB); const float* norm_final = args.in[I_NFIN];
        for (int t = gw; t < NTOK; t += NGW) {
            const float rs = rstd_tok(ssf, (size_t)t); const bf16* xr = XA + (size_t)t * D; float* orow = args.out + (size_t)t * D;
#pragma unroll
            for (int hf = 0; hf < 2; ++hf) { const int c0 = hf * 512 + lane * 8; const v4u xw = *(const GAS v4u*)(xr + c0);
                const f32x4 g0 = *(const f32x4*)(norm_final + c0), g1 = *(const f32x4*)(norm_final + c0 + 4);
                *(f32x4*)(orow + c0) = (f32x4){bflo(xw.x) * rs * g0[0], bfhi(xw.x) * rs * g0[1], bflo(xw.y) * rs * g0[2], bfhi(xw.y) * rs * g0[3]};
                *(f32x4*)(orow + c0 + 4) = (f32x4){bflo(xw.z) * rs * g1[0], bfhi(xw.z) * rs * g1[1], bflo(xw.w) * rs * g1[2], bfhi(xw.w) * rs * g1[3]}; }
        }
    }
}
#undef IN
#undef SEAM

extern "C" void kernel_launch(void* const* d_in, const int* in_sizes, int n_in, void* d_out, int out_size, void* d_ws, size_t ws_size, hipStream_t stream) {
    static int grid = 0;
    if (grid == 0) {
        if (n_in != 24 || in_sizes[0] != NTOK * D || out_size != NTOK * D || ws_size < WS_END) { fprintf(stderr, "kernel_launch: unexpected shapes (n_in %d, in0 %d, out %d, ws %zu); nothing launched\n", n_in, n_in > 0 ? in_sizes[0] : -1, out_size, ws_size); grid = -1; return; }
        int dev = 0, cus = 0, per_cu = 0;
        if (hipGetDevice(&dev) != hipSuccess || hipDeviceGetAttribute(&cus, hipDeviceAttributeMultiprocessorCount, dev) != hipSuccess) { grid = -1; return; }
        if (hipFuncSetAttribute((const void*)yoco_fwd, hipFuncAttributeMaxDynamicSharedMemorySize, LDS_BYTES) != hipSuccess) { fprintf(stderr, "kernel_launch: hipFuncSetAttribute failed\n"); grid = -1; return; }
        if (hipOccupancyMaxActiveBlocksPerMultiprocessor(&per_cu, (const void*)yoco_fwd, NWAVES * 64, LDS_BYTES) != hipSuccess || per_cu < 1) { fprintf(stderr, "kernel_launch: occupancy query says %d blocks per CU\n", per_cu); }
        (void)hipGetLastError();
        grid = cus > 0 ? cus : 256;
    }
    if (grid < 0) return;
    if (hipMemsetAsync((char*)d_ws + WS_CTL, 0, CTL_ZERO_BYTES, stream) != hipSuccess) return;
    Args a{};
    for (int i = 0; i < 24; ++i) a.in[i] = (const float*)d_in[i];
    a.out = (float*)d_out; a.ws = (unsigned char*)d_ws;
#if MK_PER_PHASE
    for (int ph = 0; ph < N_PHASES; ++ph) { a.ph_lo = ph; a.ph_hi = ph + 1; hipLaunchKernelGGL(yoco_fwd, dim3(grid), dim3(NWAVES * 64), LDS_BYTES, stream, a); }
#else
    a.ph_lo = 0; a.ph_hi = N_PHASES; hipLaunchKernelGGL(yoco_fwd, dim3(grid), dim3(NWAVES * 64), LDS_BYTES, stream, a);
#endif
}
```

```cpp
#include <hip/hip_runtime.h>
#ifndef PROBE_MASK
#define PROBE_MASK 0
#endif
#include <cstdio>
#include <cstdint>
namespace pg8 {
#define PG8_LAS __attribute__((address_space(3)))
typedef unsigned short bf16_t;
typedef short bf16x8 __attribute__((ext_vector_type(8)));
typedef float f32x4 __attribute__((ext_vector_type(4)));
typedef unsigned u32x4 __attribute__((ext_vector_type(4)));
constexpr int BM = 256, BK = 64, HALF = 128, HTB = HALF * BK * 2  , STAGE_BYTES = 8 * HTB, NXCD = 8, WGM = 8;

__host__ __device__ __forceinline__ int lds_byte(int r, int c) { const int st = (r >> 4) * 2 + (c >> 5), rr = r & 15, cc = c & 31, ob = rr * 64 + cc * 2; return st * 1024 + (ob ^ (((ob >> 9) & 1) << 5)); }
__host__ __device__ __forceinline__ void stage_rc(int b, int& R, int& C) { const int st = b / 1024, sb = b % 1024, swz = sb ^ (((sb >> 9) & 1) << 5); R = (st >> 1) * 16 + swz / 64; C = (st & 1) * 32 + (swz % 64) / 2; }
__host__ __device__ __forceinline__ int perm32(int rho) { const int n = rho >> 4, i = rho & 15; return 8 * (i >> 2) + 4 * n + (i & 3); }

struct Unit { int pm, pn, e; };
struct Gemm { const bf16_t* A; const bf16_t* Bt; int lda, ldb, K, stag; const int* rowmap; void* dummy; };

struct DenseOrder {
    int nM, nN, nwg, G, c; size_t a_row, a_col, b_tile;
    __device__ __forceinline__ void init(int nM_, int nN_, int G_, int c_, int lda, int ldb, int a_col_elems, int esz = 2) { nM = nM_; nN = nN_; nwg = nM * nN; G = G_; c = c_; a_row = (size_t)BM * lda * esz; a_col = (size_t)a_col_elems * esz; b_tile = (size_t)BM * ldb * esz; }
    __device__ __forceinline__ bool next(int i, Unit& u) const {
        const long L = (long)i * G + c; if (L >= nwg) return false;
        int wgid = (int)L; { const int q = nwg / NXCD, r = nwg % NXCD, xcd = wgid % NXCD, off = wgid / NXCD; wgid = (xcd < r ? xcd * (q + 1) : r * (q + 1) + (xcd - r) * q) + off; }
        const int nig = WGM * nN, gid = wgid / nig, fm = gid * WGM, gsz = (nM - fm) < WGM ? (nM - fm) : WGM;
        u.pm = fm + ((wgid % nig) % gsz); u.pn = (wgid % nig) / gsz; u.e = 0; return true;
    }
    __device__ __forceinline__ size_t a_off(const Unit& u) const { return (size_t)u.pm * a_row + (size_t)u.pn * a_col; }
    __device__ __forceinline__ size_t b_off(const Unit& u) const { return (size_t)u.pn * b_tile; }
    __device__ __forceinline__ void a_ready(const Unit&) const {}
    __device__ __forceinline__ void done(const Unit&) const {}
};
struct GroupedOrder {
    int nM, nN, nwg, G, c; const PG8_LAS int* tp; const PG8_LAS unsigned char* te; size_t a_row, b_exp, b_tile;
    __device__ __forceinline__ void init(const PG8_LAS int* tp_, int nN_, int G_, int c_, int lda, int ldb, int n_w_rows, int esz) { tp = tp_; te = (const PG8_LAS unsigned char*)(tp_ + 64); nM = __builtin_amdgcn_readfirstlane(tp_[32]); nN = nN_; nwg = nM * nN; G = G_; c = c_; a_row = (size_t)BM * lda * esz; b_exp = (size_t)n_w_rows * ldb * esz; b_tile = (size_t)BM * ldb * esz; }
    __device__ __forceinline__ bool next(int i, Unit& u) const {
        const long L = (long)i * G + c; if (L >= nwg) return false;
        int wgid = (int)L; { const int q = nwg / NXCD, r = nwg % NXCD, xcd = wgid % NXCD, off = wgid / NXCD; wgid = (xcd < r ? xcd * (q + 1) : r * (q + 1) + (xcd - r) * q) + off; }
        const int nig = WGM * nN, gid = wgid / nig, fm = gid * WGM, gsz = (nM - fm) < WGM ? (nM - fm) : WGM;
        u.pm = fm + ((wgid % nig) % gsz); u.pn = (wgid % nig) / gsz;
        u.e = __builtin_amdgcn_readfirstlane((int)te[u.pm]); u.pm = __builtin_amdgcn_readfirstlane(u.pm); u.pn = __builtin_amdgcn_readfirstlane(u.pn); return true;
    }
    __device__ __forceinline__ size_t a_off(const Unit& u) const { return (size_t)u.pm * a_row; }
    __device__ __forceinline__ size_t b_off(const Unit& u) const { return (size_t)u.e * b_exp + (size_t)u.pn * b_tile; }
    __device__ __forceinline__ void a_ready(const Unit&) const {}
    __device__ __forceinline__ void done(const Unit&) const {}
};

__device__ __forceinline__ unsigned cvt_pk_bf16(float lo, float hi) { unsigned r; asm volatile("v_cvt_pk_bf16_f32 %0, %1, %2" : "=v"(r) : "v"(lo), "v"(hi)); return r; }
__device__ __forceinline__ float bf_lo(unsigned w) { return __builtin_bit_cast(float, w << 16); }
__device__ __forceinline__ float bf_hi(unsigned w) { return __builtin_bit_cast(float, w & 0xffff0000u); }
__device__ __forceinline__ float rstd_of(float ss) { return __builtin_amdgcn_rsqf(ss * (1.f / 1024.f) + 1e-6f); }
__device__ __forceinline__ u32x4 pack8(const f32x4& a, const f32x4& b) { u32x4 w; w.x = cvt_pk_bf16(a[0], a[1]); w.y = cvt_pk_bf16(a[2], a[3]); w.z = cvt_pk_bf16(b[0], b[1]); w.w = cvt_pk_bf16(b[2], b[3]); return w; }
__device__ __forceinline__ void unpack8(const u32x4& w, f32x4& a, f32x4& b) { a = (f32x4){bf_lo(w.x), bf_hi(w.x), bf_lo(w.y), bf_hi(w.y)}; b = (f32x4){bf_lo(w.z), bf_hi(w.z), bf_lo(w.w), bf_hi(w.w)}; }
__device__ __forceinline__ float dot4(const f32x4& a) { return (a[0] * a[0] + a[1] * a[1]) + (a[2] * a[2] + a[3] * a[3]); }
constexpr float W8INV = 1.0f / 16.0f;
typedef float f32x2 __attribute__((ext_vector_type(2)));
struct EpiCtx { PG8_LAS unsigned char* stg; int wr, wc, fr, fq, lane; };
constexpr int EPW = 2816, EP_RSL = 2304, EP_PITCH = 144, NTOKC = 65536;
typedef PG8_LAS u32x4* lds_u4p;
struct RawTile { u32x4 a, b; };
template <int MODE> __device__ __forceinline__ int piece_off(int fq, int k) { return MODE == 0 ? 64 * k + 16 * fq : 32 * fq + 16 * k; }
__device__ __forceinline__ RawTile tile_fetch(const EpiCtx& c, const char* gbase, size_t pitch) {
    const int r = c.lane >> 3, ch = c.lane & 7; RawTile t; t.a = *(const u32x4*)(gbase + (size_t)r * pitch + ch * 16); t.b = *(const u32x4*)(gbase + (size_t)(r + 8) * pitch + ch * 16); return t;
}
template <int MODE> __device__ __forceinline__ void tile_unstage(const EpiCtx& c, const RawTile& t, u32x4& v0, u32x4& v1) {
    const int r = c.lane >> 3, ch = c.lane & 7;
    *(lds_u4p)(c.stg + r * EP_PITCH + ch * 16) = t.a; *(lds_u4p)(c.stg + (r + 8) * EP_PITCH + ch * 16) = t.b;
    v0 = *(lds_u4p)(c.stg + c.fr * EP_PITCH + piece_off<MODE>(c.fq, 0)); v1 = *(lds_u4p)(c.stg + c.fr * EP_PITCH + piece_off<MODE>(c.fq, 1));
}
template <int MODE> __device__ __forceinline__ void tile_store(const EpiCtx& c, char* gbase, size_t pitch, const u32x4& v0, const u32x4& v1) {
    *(lds_u4p)(c.stg + c.fr * EP_PITCH + piece_off<MODE>(c.fq, 0)) = v0; *(lds_u4p)(c.stg + c.fr * EP_PITCH + piece_off<MODE>(c.fq, 1)) = v1;
    const int r = c.lane >> 3, ch = c.lane & 7;
    const u32x4 a = *(lds_u4p)(c.stg + r * EP_PITCH + ch * 16), b = *(lds_u4p)(c.stg + (r + 8) * EP_PITCH + ch * 16);
    *(u32x4*)(gbase + (size_t)r * pitch + ch * 16) = a; *(u32x4*)(gbase + (size_t)(r + 8) * pitch + ch * 16) = b;
}
__device__ __forceinline__ void tile_store_half(const EpiCtx& c, char* gbase, size_t pitch, const u32x4& v) {
    *(lds_u4p)(c.stg + c.fr * 80 + c.fq * 16) = v;
    const int r = c.lane >> 2, ch = c.lane & 3;
    const u32x4 a = *(lds_u4p)(c.stg + r * 80 + ch * 16);
    *(u32x4*)(gbase + (size_t)r * pitch + ch * 16) = a;
}
__device__ __forceinline__ float sum16(const float (&s)[16]) { return (((s[0] + s[1]) + (s[2] + s[3])) + ((s[4] + s[5]) + (s[6] + s[7]))) + (((s[8] + s[9]) + (s[10] + s[11])) + ((s[12] + s[13]) + (s[14] + s[15]))); }
__device__ __forceinline__ void ss_put(const EpiCtx& c, float* ssp, int unit_row0, const float (&sq)[2][4], int slot) {
    PG8_LAS float* t = (PG8_LAS float*)c.stg;
#pragma unroll
    for (int ai = 0; ai < 2; ++ai)
#pragma unroll
        for (int m = 0; m < 4; ++m) t[(ai * 64 + m * 16 + c.fr) * 4 + c.fq] = sq[ai][m];
#pragma unroll
    for (int hb = 0; hb < 2; ++hb) { const f32x4 v = *(PG8_LAS f32x4*)(t + (hb * 64 + c.lane) * 4); ssp[(size_t)slot * NTOKC + unit_row0 + hb * HALF + c.wr * 64 + c.lane] = (v[0] + v[1]) + (v[2] + v[3]); }
}
__device__ __forceinline__ void rstd_stage(const EpiCtx& c, const float* ssp, int unit_row0) {
    PG8_LAS float* rsl = (PG8_LAS float*)(c.stg + EP_RSL);
#pragma unroll
    for (int hb = 0; hb < 2; ++hb) { const int row = unit_row0 + hb * HALF + c.wr * 64 + c.lane; float s[16];
#pragma unroll
        for (int k = 0; k < 16; ++k) s[k] = ssp[(size_t)k * NTOKC + row];
        rsl[hb * 64 + c.lane] = rstd_of(sum16(s)); asm volatile("" ::: "memory"); }
}
__device__ __forceinline__ float rstd_get(const EpiCtx& c, int ai, int m) { return ((PG8_LAS float*)(c.stg + EP_RSL))[ai * 64 + m * 16 + c.fr]; }
#define EPI_ROW(g_) (u.pm * BM + ((g_) >> 2) * HALF + c.wr * 64 + ((g_) & 3) * 16)

__device__ __forceinline__ unsigned long long fp8x8_sat(f32x4 v0, f32x4 v1) {
#pragma unroll
    for (int j = 0; j < 4; ++j) { v0[j] = __builtin_amdgcn_fmed3f(v0[j], -448.0f, 448.0f); v1[j] = __builtin_amdgcn_fmed3f(v1[j], -448.0f, 448.0f); }
    unsigned w0 = 0u, w1 = 0u; w0 = __builtin_amdgcn_cvt_pk_fp8_f32(v0[0], v0[1], w0, false); w0 = __builtin_amdgcn_cvt_pk_fp8_f32(v0[2], v0[3], w0, true);
    w1 = __builtin_amdgcn_cvt_pk_fp8_f32(v1[0], v1[1], w1, false); w1 = __builtin_amdgcn_cvt_pk_fp8_f32(v1[2], v1[3], w1, true); return (unsigned long long)w0 | ((unsigned long long)w1 << 32); }
__device__ __forceinline__ void fp8_rows_store(const EpiCtx& c, unsigned char* dst  , unsigned long long q0, unsigned long long q1) {
    *(PG8_LAS unsigned long long*)(c.stg + c.fr * 80 + c.fq * 8) = q0; *(PG8_LAS unsigned long long*)(c.stg + c.fr * 80 + 32 + c.fq * 8) = q1;
    const int r = c.lane >> 2, ch = c.lane & 3; const u32x4 t8 = *(lds_u4p)(c.stg + r * 80 + ch * 16);
    *(u32x4*)(dst + (size_t)r * 1024 + ch * 16) = t8; }
struct EpiPool {
    struct Pre {}; __device__ __forceinline__ Pre fetch(const Unit&, const EpiCtx&) const { return Pre{}; }
    static constexpr int NST = 0;     static constexpr bool PERM = true, AFTER_DRAIN = false, TWICE = false;
    const float* xin; const float* scale; bf16_t* Xo; float* ss; unsigned char* X8;
    __device__ __forceinline__ void operator()(const f32x4 (&acc)[2][2][4][2], const Unit& u, const EpiCtx& c, const Pre& pre) const {
        const int colw = u.pn * BM + c.wc * 64;
        float sq[2][4]; RawTile rt[1][2];
#define EP_FETCH(g_) do { _Pragma("unroll") for (int bj = 0; bj < 2; ++bj) rt[0][bj] = tile_fetch(c, (const char*)(xin + (size_t)EPI_ROW(g_) * 1024 + colw + 32 * bj), 4096); } while (0)
#pragma unroll
        for (int g = 0; g < 8; ++g) { const int ai = g >> 2, m = g & 3; float s = 0.f; u32x4 o[2]; unsigned long long q8[2];
            EP_FETCH(g);
            f32x4 sc[2][2];
#pragma unroll
            for (int bj = 0; bj < 2; ++bj)
#pragma unroll
                for (int n = 0; n < 2; ++n) sc[bj][n] = *(const f32x4*)(scale + colw + 32 * bj + 8 * c.fq + 4 * n);
#pragma unroll
            for (int bj = 0; bj < 2; ++bj) { u32x4 r0, r1; tile_unstage<1>(c, rt[0][bj], r0, r1);
                const f32x4 v0 = __builtin_bit_cast(f32x4, r0) + sc[bj][0] * acc[ai][bj][m][0], v1 = __builtin_bit_cast(f32x4, r1) + sc[bj][1] * acc[ai][bj][m][1];
                s += dot4(v0) + dot4(v1); o[bj] = pack8(v0, v1); q8[bj] = fp8x8_sat(v0, v1); }
            tile_store<0>(c, (char*)(Xo + (size_t)EPI_ROW(g) * 1024 + colw), 2048, o[0], o[1]);
            fp8_rows_store(c, X8 + (size_t)EPI_ROW(g) * 1024 + colw, q8[0], q8[1]);
            sq[ai][m] = s; asm volatile("" ::: "memory"); }
#undef EP_FETCH
        ss_put(c, ss, u.pm * BM, sq, u.pn * 4 + c.wc);
    }
};
struct EpiRouter {
    struct Pre {}; __device__ __forceinline__ Pre fetch(const Unit&, const EpiCtx&) const { return Pre{}; }
    static constexpr int NST = 0;     static constexpr bool PERM = true, AFTER_DRAIN = false, TWICE = false;
    const float* ssin; const float* rb; float* logits;
    __device__ __forceinline__ void operator()(const f32x4 (&acc)[2][2][4][2], const Unit& u, const EpiCtx& c, const Pre& pre) const {
        if (c.wc != 0) return;
        rstd_stage(c, ssin, u.pm * BM);
        const f32x4 b0 = *(const f32x4*)(rb + 8 * c.fq), b1 = *(const f32x4*)(rb + 8 * c.fq + 4);
#pragma unroll
        for (int g = 0; g < 8; ++g) { const int ai = g >> 2, m = g & 3; const float rs = rstd_get(c, ai, m);
            const f32x4 v0 = acc[ai][0][m][0] * rs + b0, v1 = acc[ai][0][m][1] * rs + b1;
            tile_store<1>(c, (char*)(logits + (size_t)EPI_ROW(g) * 32), 128, __builtin_bit_cast(u32x4, v0), __builtin_bit_cast(u32x4, v1)); }
    }
};
constexpr float SW_A2 = 1.702f * 1.4426950408889634f;
struct EpiSwiGLU {
    struct Pre { u32x4 bg, bu; float rs[8]; };
    __device__ __forceinline__ Pre fetch(const Unit& u, const EpiCtx& c) const { const bf16_t* p = bgu16 + (size_t)u.e * 2048 + u.pn * HALF + c.wc * 32 + 8 * c.fq; Pre r; r.bg = *(const u32x4*)p; r.bu = *(const u32x4*)(p + 1024);
#pragma unroll
        for (int g = 0; g < 8; ++g) r.rs[g] = rowrstd[EPI_ROW(g) + c.fr];
        return r; }
    static constexpr int NST = 8;     static constexpr bool PERM = true, AFTER_DRAIN = false, TWICE = ((PROBE_MASK >> 16) & 1) != 0;
    const bf16_t* bgu16; unsigned char* act; const float* rowrstd;
    __device__ __forceinline__ void operator()(const f32x4 (&acc)[2][2][4][2], const Unit& u, const EpiCtx& c, const Pre& pre) const {
        const int cw = u.pn * HALF + c.wc * 32;
        f32x4 bgt[2], bup[2]; unpack8(pre.bg, bgt[0], bgt[1]); unpack8(pre.bu, bup[0], bup[1]);
#pragma unroll
        for (int g = 0; g < 8; ++g) { const int ai = g >> 2, m = g & 3; f32x4 y[2]; const float rs = W8INV * pre.rs[g];
#pragma unroll
            for (int n = 0; n < 2; ++n) { const f32x4 gt = acc[ai][0][m][n] * rs + bgt[n], up = acc[ai][1][m][n] * rs + bup[n];
#pragma unroll
                for (int hp = 0; hp < 2; ++hp) {
                    f32x2 gc, uc; gc.x = fminf(gt[2 * hp], 7.0f * SW_A2); gc.y = fminf(gt[2 * hp + 1], 7.0f * SW_A2); uc.x = fminf(fmaxf(up[2 * hp], -6.0f), 8.0f); uc.y = fminf(fmaxf(up[2 * hp + 1], -6.0f), 8.0f);
                    f32x2 e; e.x = __builtin_amdgcn_exp2f(-gc.x); e.y = __builtin_amdgcn_exp2f(-gc.y);
                    const f32x2 d = e + 1.0f; f32x2 sg; sg.x = __builtin_amdgcn_rcpf(d.x); sg.y = __builtin_amdgcn_rcpf(d.y);
                    const f32x2 yy = uc * (gc * sg); y[n][2 * hp] = yy.x; y[n][2 * hp + 1] = yy.y; } }
            unsigned w0 = 0u, w1 = 0u;
            w0 = __builtin_amdgcn_cvt_pk_fp8_f32(y[0][0], y[0][1], w0, false); w0 = __builtin_amdgcn_cvt_pk_fp8_f32(y[0][2], y[0][3], w0, true);
            w1 = __builtin_amdgcn_cvt_pk_fp8_f32(y[1][0], y[1][1], w1, false); w1 = __builtin_amdgcn_cvt_pk_fp8_f32(y[1][2], y[1][3], w1, true);
            *(PG8_LAS unsigned long long*)(c.stg + c.fr * 40 + c.fq * 8) = (unsigned long long)w0 | ((unsigned long long)w1 << 32);
            const int r = c.lane >> 2, ch = c.lane & 3; const unsigned long long q = *(PG8_LAS unsigned long long*)(c.stg + r * 40 + ch * 8);
            *(unsigned long long*)(act + (size_t)(EPI_ROW(g) + r) * 1024 + cw + ch * 8) = q; }
    }
};
constexpr float YSCALE = 8.0f, YSINV = 0.125f;
struct EpiDown {
    struct Pre { float gt[8]; u32x4 b0, b1; };
    __device__ __forceinline__ Pre fetch(const Unit& u, const EpiCtx& c) const { Pre r;
#pragma unroll
        for (int g = 0; g < 8; ++g) r.gt[g] = rowgate[EPI_ROW(g) + c.fr];
        const bf16_t* p = bd16 + (size_t)u.e * 1024 + u.pn * BM + c.wc * 64 + 8 * c.fq; r.b0 = *(const u32x4*)p; r.b1 = *(const u32x4*)(p + 32); return r; }
    static constexpr int NST = 8;     static constexpr bool PERM = true, AFTER_DRAIN = false, TWICE = ((PROBE_MASK >> 15) & 1) != 0;
    const float* rowgate; const bf16_t* bd16; unsigned char* Y;
    __device__ __forceinline__ void operator()(const f32x4 (&acc)[2][2][4][2], const Unit& u, const EpiCtx& c, const Pre& pre) const {
        const int colw = u.pn * BM + c.wc * 64;
        f32x4 bv[2][2]; unpack8(pre.b0, bv[0][0], bv[0][1]); unpack8(pre.b1, bv[1][0], bv[1][1]);
        const float osc = W8INV / SW_A2;
#pragma unroll
        for (int g = 0; g < 8; ++g) { const int ai = g >> 2, m = g & 3; const float gt = pre.gt[g] * YSCALE; unsigned long long q8[2];
#pragma unroll
            for (int bj = 0; bj < 2; ++bj) { f32x4 v0 = (acc[ai][bj][m][0] * osc + bv[bj][0]) * gt, v1 = (acc[ai][bj][m][1] * osc + bv[bj][1]) * gt;
#pragma unroll
                for (int j = 0; j < 4; ++j) { v0[j] = __builtin_amdgcn_fmed3f(v0[j], -448.0f, 448.0f); v1[j] = __builtin_amdgcn_fmed3f(v1[j], -448.0f, 448.0f); }
                unsigned w0 = 0u, w1 = 0u; w0 = __builtin_amdgcn_cvt_pk_fp8_f32(v0[0], v0[1], w0, false); w0 = __builtin_amdgcn_cvt_pk_fp8_f32(v0[2], v0[3], w0, true);
                w1 = __builtin_amdgcn_cvt_pk_fp8_f32(v1[0], v1[1], w1, false); w1 = __builtin_amdgcn_cvt_pk_fp8_f32(v1[2], v1[3], w1, true); q8[bj] = (unsigned long long)w0 | ((unsigned long long)w1 << 32); }
            *(PG8_LAS unsigned long long*)(c.stg + c.fr * 80 + c.fq * 8) = q8[0]; *(PG8_LAS unsigned long long*)(c.stg + c.fr * 80 + 32 + c.fq * 8) = q8[1];
            const int r = c.lane >> 2, ch = c.lane & 3; const u32x4 t8 = *(lds_u4p)(c.stg + r * 80 + ch * 16);
            *(u32x4*)(Y + (size_t)(EPI_ROW(g) + r) * 1024 + colw + ch * 16) = t8; asm volatile("" ::: "memory"); }
    }
};
constexpr float PJSCALE = 8.0f, PJSINV = 0.125f;
struct EpiStore {
    struct Pre {}; __device__ __forceinline__ Pre fetch(const Unit&, const EpiCtx&) const { return Pre{}; }
    static constexpr int NST = 0;     static constexpr bool PERM = true, AFTER_DRAIN = false, TWICE = false;
    unsigned char* O;
    __device__ __forceinline__ void operator()(const f32x4 (&acc)[2][2][4][2], const Unit& u, const EpiCtx& c, const Pre& pre) const {
        unsigned char* ob = O + ((size_t)(u.pm * 4 + u.pn) * 8 + (c.wr * 4 + c.wc)) * 8192 + c.lane * 16;
#pragma unroll
        for (int g = 0; g < 8; ++g) { const int ai = g >> 2, m = g & 3; u32x4 w;
#pragma unroll
            for (int bj = 0; bj < 2; ++bj)
#pragma unroll
                for (int n = 0; n < 2; ++n) { f32x4 v = acc[ai][bj][m][n] * PJSCALE;
#pragma unroll
                    for (int j = 0; j < 4; ++j) v[j] = __builtin_amdgcn_fmed3f(v[j], -448.0f, 448.0f);
                    unsigned w0 = 0u; w0 = __builtin_amdgcn_cvt_pk_fp8_f32(v[0], v[1], w0, false); w0 = __builtin_amdgcn_cvt_pk_fp8_f32(v[2], v[3], w0, true); w[2 * bj + n] = w0; }
            *(u32x4*)(ob + g * 1024) = w; }
    }
};
struct EpiPle {
    struct Pre {}; __device__ __forceinline__ Pre fetch(const Unit&, const EpiCtx&) const { return Pre{}; }
    static constexpr int NST = 18;     static constexpr bool PERM = true, AFTER_DRAIN = false, TWICE = false;
    const float* bgate; const unsigned char* PJ; const bf16_t* Xi; bf16_t* Xo; float* ss; unsigned char* X8;
    __device__ __forceinline__ void operator()(const f32x4 (&acc)[2][2][4][2], const Unit& u, const EpiCtx& c, const Pre& pre) const {
        const int colw = u.pn * BM + c.wc * 64;
        float sq[2][4]; RawTile rx[1]; u32x4 pj;
        const unsigned char* pjb = PJ + ((size_t)(u.pm * 4 + u.pn) * 8 + (c.wr * 4 + c.wc)) * 8192 + c.lane * 16;
#define EP_FETCH(g_) do { const size_t ro_ = (size_t)EPI_ROW(g_) * 1024 + colw; pj = *(const u32x4*)(pjb + (g_) * 1024); rx[0] = tile_fetch(c, (const char*)(Xi + ro_), 2048); } while (0)
#pragma unroll
        for (int g = 0; g < 8; ++g) { const int ai = g >> 2, m = g & 3; const float rs = W8INV; float s = 0.f; u32x4 o[2], xw[2]; unsigned long long q8[2];
            EP_FETCH(g);
            f32x4 bv[2][2];
#pragma unroll
            for (int bj = 0; bj < 2; ++bj)
#pragma unroll
                for (int n = 0; n < 2; ++n) bv[bj][n] = *(const f32x4*)(bgate + colw + 32 * bj + 8 * c.fq + 4 * n);
            tile_unstage<0>(c, rx[0], xw[0], xw[1]);
#pragma unroll
            for (int bj = 0; bj < 2; ++bj) { f32x4 p0, p1, x0, x1; unpack8(xw[bj], x0, x1);
                { const f32x2 a0 = __builtin_amdgcn_cvt_pk_f32_fp8((int)pj[2 * bj], false), a1 = __builtin_amdgcn_cvt_pk_f32_fp8((int)pj[2 * bj], true), b0 = __builtin_amdgcn_cvt_pk_f32_fp8((int)pj[2 * bj + 1], false), b1 = __builtin_amdgcn_cvt_pk_f32_fp8((int)pj[2 * bj + 1], true);
                  p0 = (f32x4){a0.x, a0.y, a1.x, a1.y} * PJSINV; p1 = (f32x4){b0.x, b0.y, b1.x, b1.y} * PJSINV; }
                f32x4 z0 = acc[ai][bj][m][0] * rs + bv[bj][0], z1 = acc[ai][bj][m][1] * rs + bv[bj][1];
#pragma unroll
                for (int hp = 0; hp < 2; ++hp) {
                    f32x2 a0 = {z0[2 * hp], z0[2 * hp + 1]}, a1 = {z1[2 * hp], z1[2 * hp + 1]}; a0 = a0 * -1.4426950408889634f; a1 = a1 * -1.4426950408889634f;
                    f32x2 e0, e1; e0.x = __builtin_amdgcn_exp2f(a0.x); e0.y = __builtin_amdgcn_exp2f(a0.y); e1.x = __builtin_amdgcn_exp2f(a1.x); e1.y = __builtin_amdgcn_exp2f(a1.y); e0 = e0 + 1.0f; e1 = e1 + 1.0f;
                    z0[2 * hp] = __builtin_amdgcn_rcpf(e0.x); z0[2 * hp + 1] = __builtin_amdgcn_rcpf(e0.y); z1[2 * hp] = __builtin_amdgcn_rcpf(e1.x); z1[2 * hp + 1] = __builtin_amdgcn_rcpf(e1.y); }
                const f32x4 v0 = x0 + z0 * p0, v1 = x1 + z1 * p1;
                s += dot4(v0) + dot4(v1); o[bj] = pack8(v0, v1);
                { unsigned w0 = 0u, w1 = 0u; w0 = __builtin_amdgcn_cvt_pk_fp8_f32(v0[0], v0[1], w0, false); w0 = __builtin_amdgcn_cvt_pk_fp8_f32(v0[2], v0[3], w0, true);
                  w1 = __builtin_amdgcn_cvt_pk_fp8_f32(v1[0], v1[1], w1, false); w1 = __builtin_amdgcn_cvt_pk_fp8_f32(v1[2], v1[3], w1, true); q8[bj] = (unsigned long long)w0 | ((unsigned long long)w1 << 32); } }
            tile_store<0>(c, (char*)(Xo + (size_t)EPI_ROW(g) * 1024 + colw), 2048, o[0], o[1]);
            if (X8) {
              *(PG8_LAS unsigned long long*)(c.stg + c.fr * 80 + c.fq * 8) = q8[0]; *(PG8_LAS unsigned long long*)(c.stg + c.fr * 80 + 32 + c.fq * 8) = q8[1];
              const int r = c.lane >> 2, ch = c.lane & 3; const u32x4 t8 = *(lds_u4p)(c.stg + r * 80 + ch * 16);
              *(u32x4*)(X8 + (size_t)(EPI_ROW(g) + r) * 1024 + colw + ch * 16) = t8; }
            sq[ai][m] = s; asm volatile("" ::: "memory"); }
#undef EP_FETCH
        ss_put(c, ss, u.pm * BM, sq, u.pn * 4 + c.wc);
    }
};
struct EpiQkv {
    struct Pre {}; __device__ __forceinline__ Pre fetch(const Unit&, const EpiCtx&) const { return Pre{}; }
    static constexpr int NST = 0;     static constexpr bool PERM = true, AFTER_DRAIN = false, TWICE = false;
    const float* ssin; bf16_t* Q; const float* bfg; float* LF; float qscale; float* nrm;
    __device__ __forceinline__ void operator()(const f32x4 (&acc)[2][2][4][2], const Unit& u, const EpiCtx& c, const Pre& pre) const {
        rstd_stage(c, ssin, u.pm * BM);
        if (u.pn < 12) {
            const int t = u.pn >> 2; bf16_t* base = Q + (size_t)t * (65536 * 1024); const float sc = t == 0 ? qscale : 1.0f;
            const int colw = (u.pn & 3) * BM + c.wc * 64; float mx = 0.f;
#pragma unroll
            for (int g = 0; g < 8; ++g) { const int ai = g >> 2, m = g & 3; const float rs = rstd_get(c, ai, m) * sc * W8INV; u32x4 o[2]; float q = 0.f;
#pragma unroll
                for (int bj = 0; bj < 2; ++bj) { const f32x4 a = acc[ai][bj][m][0] * rs, b = acc[ai][bj][m][1] * rs; q += dot4(a) + dot4(b); o[bj] = pack8(a, b); }
                tile_store<0>(c, (char*)(base + (size_t)EPI_ROW(g) * 1024 + colw), 2048, o[0], o[1]);
                if (t < 2) { q += __shfl_xor(q, 16); q += __shfl_xor(q, 32); mx = fmaxf(mx, q); } }
            if (t < 2) {
                mx = fmaxf(mx, __shfl_xor(mx, 1)); mx = fmaxf(mx, __shfl_xor(mx, 2)); mx = fmaxf(mx, __shfl_xor(mx, 4)); mx = fmaxf(mx, __shfl_xor(mx, 8));
                if (c.lane == 0) nrm[(((size_t)u.pm * 16 + 4 * (u.pn & 3) + c.wc) * 2 + t) * 2 + c.wr] = mx; }
        } else if (c.wc == 0) {
            const f32x4 b0 = *(const f32x4*)(bfg + 8 * (c.fq & 1)), b1 = *(const f32x4*)(bfg + 8 * (c.fq & 1) + 4);
#pragma unroll
            for (int g = 0; g < 8; ++g) { const int ai = g >> 2, m = g & 3; const float rs = rstd_get(c, ai, m) * W8INV;
                f32x4 z0 = acc[ai][0][m][0] * rs + b0, z1 = acc[ai][0][m][1] * rs + b1;
#pragma unroll
                for (int j = 0; j < 4; ++j) { z0[j] = fminf(z0[j], 0.f) - 0.6931471805599453f * __builtin_amdgcn_logf(1.0f + __builtin_amdgcn_exp2f(-1.4426950408889634f * fabsf(z0[j]))); z1[j] = fminf(z1[j], 0.f) - 0.6931471805599453f * __builtin_amdgcn_logf(1.0f + __builtin_amdgcn_exp2f(-1.4426950408889634f * fabsf(z1[j]))); }
                if (c.fq < 2) { float* o = LF + (size_t)(EPI_ROW(g) + c.fr) * 16 + 8 * c.fq; *(f32x4*)o = z0; *(f32x4*)(o + 4) = z1; } }
        }
    }
};
struct EpiWo {
    struct Pre {}; __device__ __forceinline__ Pre fetch(const Unit&, const EpiCtx&) const { return Pre{}; }
    static constexpr int NST = 18;     static constexpr bool PERM = true, AFTER_DRAIN = false, TWICE = ((PROBE_MASK >> 14) & 1) != 0;
    const bf16_t* Xi; bf16_t* Xo; float* ss; unsigned char* X8;
    __device__ __forceinline__ void operator()(const f32x4 (&acc)[2][2][4][2], const Unit& u, const EpiCtx& c, const Pre& pre) const {
        const int colw = u.pn * BM + c.wc * 64;
        float sq[2][4]; RawTile rx[2];
#define EP_FETCH(g_) do { rx[(g_) & 1] = tile_fetch(c, (const char*)(Xi + (size_t)EPI_ROW(g_) * 1024 + colw), 2048); } while (0)
        EP_FETCH(0);
#pragma unroll
        for (int g = 0; g < 8; ++g) { const int ai = g >> 2, m = g & 3; float s = 0.f; u32x4 o[2], xw[2]; unsigned long long q8[2];
            if (g + 1 < 8) EP_FETCH(g + 1);
            tile_unstage<0>(c, rx[g & 1], xw[0], xw[1]);
#pragma unroll
            for (int bj = 0; bj < 2; ++bj) { f32x4 x0, x1; unpack8(xw[bj], x0, x1);
                const f32x4 v0 = x0 + acc[ai][bj][m][0] * W8INV, v1 = x1 + acc[ai][bj][m][1] * W8INV;
                s += dot4(v0) + dot4(v1); o[bj] = pack8(v0, v1); q8[bj] = fp8x8_sat(v0, v1); }
            tile_store<0>(c, (char*)(Xo + (size_t)EPI_ROW(g) * 1024 + colw), 2048, o[0], o[1]);
            fp8_rows_store(c, X8 + (size_t)EPI_ROW(g) * 1024 + colw, q8[0], q8[1]);
            sq[ai][m] = s; asm volatile("" ::: "memory"); }
#undef EP_FETCH
        ss_put(c, ss, u.pm * BM, sq, u.pn * 4 + c.wc);
    }
};

typedef int v8i_t __attribute__((ext_vector_type(8))); typedef int v4i_t __attribute__((ext_vector_type(4)));
struct Frag2 { bf16x8 k0, k1; };
struct Frag1 { v8i_t v; };
template <int ESZ> struct FragSel { typedef Frag2 type; };
template <> struct FragSel<1> { typedef Frag1 type; };
__device__ __forceinline__ void ld_frag(Frag2& f, const PG8_LAS unsigned char* p) { f.k0 = *(const PG8_LAS bf16x8*)p; f.k1 = *(const PG8_LAS bf16x8*)(p + 1024); }
__device__ __forceinline__ void ld_frag(Frag1& f, const PG8_LAS unsigned char* p) { const v4i_t lo = *(const PG8_LAS v4i_t*)p, hi = *(const PG8_LAS v4i_t*)(p + 1024); f.v = __builtin_shufflevector(lo, hi, 0, 1, 2, 3, 4, 5, 6, 7); }
__device__ __forceinline__ void mma_frag(f32x4& acc, const Frag2& b, const Frag2& a) { acc = __builtin_amdgcn_mfma_f32_16x16x32_bf16(b.k0, a.k0, acc, 0, 0, 0); acc = __builtin_amdgcn_mfma_f32_16x16x32_bf16(b.k1, a.k1, acc, 0, 0, 0); }
__device__ __forceinline__ void mma_frag(f32x4& acc, const Frag1& b, const Frag1& a) {
#if defined(__HIP_DEVICE_COMPILE__)
    asm volatile("v_mfma_f32_16x16x128_f8f6f4 %0, %1, %2, %0" : "+v"(acc) : "v"(b.v), "v"(a.v));
#endif
}
#define PG8_KITER(SKIP11, WX, MMA0) do { \
            unsigned w2[2][2]; \
            if constexpr (GATHER) { if (last) { _Pragma("unroll") for (int h_ = 0; h_ < 2; ++h_) _Pragma("unroll") for (int i_ = 0; i_ < 2; ++i_) w2[h_][i_] = vgN[h_][i_]; } else { _Pragma("unroll") for (int h_ = 0; h_ < 2; ++h_) _Pragma("unroll") for (int i_ = 0; i_ < 2; ++i_) w2[h_][i_] = vgC[h_][i_]; } } \
            PG8_LDB(B0, 0, 0); PG8_LDB(B1, 0, 1); PG8_SCHED; PG8_LDA(At, 0, 0); if (!(SKIP11)) { if constexpr (GATHER) PG8_STAGE(PG8_SA(1, 1), a1, vgC[1]); else PG8_STAGE(PG8_SA(1, 1), a1 + hstepA, voffA); } \
            PG8_WAIT_V(WX); PG8_WAIT_L(0); PG8_BAR; MMA0(0, 0, At, B0); MMA0(0, 1, At, B1); PG8_BAR; PG8_SCHED; \
            PG8_LDA(At, 0, 1); PG8_STAGE(PG8_SB(0, 0), b2, voffB); PG8_STAGE(PG8_SB(0, 1), b2 + hstepB, voffB); if constexpr (GATHER) PG8_STAGE(PG8_SA(0, 0), a2, w2[0]); else PG8_STAGE(PG8_SA(0, 0), a2, voffA); \
            PG8_WAIT_V(WX); PG8_WAIT_L(0); PG8_BAR; MMA0(1, 0, At, B0); MMA0(1, 1, At, B1); PG8_BAR; PG8_SCHED; \
            PG8_LDB(B0, 1, 0); PG8_LDB(B1, 1, 1); PG8_SCHED; PG8_LDA(At, 1, 0); if constexpr (GATHER) PG8_STAGE(PG8_SA(0, 1), a2, w2[1]); else PG8_STAGE(PG8_SA(0, 1), a2 + hstepA, voffA); \
            PG8_WAIT_V(WX); PG8_WAIT_L(0); PG8_BAR; PG8_MMA(0, 0, At, B0); PG8_MMA(0, 1, At, B1); PG8_BAR; PG8_SCHED; \
            PG8_LDA(At, 1, 1); PG8_STAGE(PG8_SB(1, 0), b3, voffB); PG8_STAGE(PG8_SB(1, 1), b3 + hstepB, voffB); if constexpr (GATHER) PG8_STAGE(PG8_SA(1, 0), a3, w2[0]); else PG8_STAGE(PG8_SA(1, 0), a3, voffA); \
            PG8_WAIT_V(8); PG8_WAIT_L(0); PG8_BAR; PG8_MMA(1, 0, At, B0); PG8_MMA(1, 1, At, B1); PG8_BAR; PG8_SCHED; \
            } while (0)
__device__ __forceinline__ void mma_frag_z(f32x4& acc, const Frag1& b, const Frag1& a) {
#if defined(__HIP_DEVICE_COMPILE__)
    asm volatile("v_mfma_f32_16x16x128_f8f6f4 %0, %1, %2, 0" : "=&v"(acc) : "v"(b.v), "v"(a.v));
#endif
}
__device__ __forceinline__ void mma_frag_z(f32x4& acc, const Frag2& b, const Frag2& a) { acc = (f32x4){0.f, 0.f, 0.f, 0.f}; mma_frag(acc, b, a); }
template <class Epi, class Sched, bool GATHER = false, int ESZ = 2>
__device__ __forceinline__ void gemm_phase(PG8_LAS unsigned char* lds, PG8_LAS unsigned char* epi, const Gemm g, const Sched& S, const Epi& E) {
    int tid = threadIdx.x; asm volatile("" : "+v"(tid));
    const int wid = __builtin_amdgcn_readfirstlane(tid >> 6), lane = tid & 63, wr = wid >> 2, wc = wid & 3, fr = lane & 15, fq = lane >> 4;
    constexpr bool ALIGN_EPI = true, SP2 = true, RELAX = (ESZ == 1)  ; const int K = g.K, nt = (K * ESZ) / (BK * 2), lda = g.lda, ldb = g.ldb;
    unsigned voffA[2], voffB[2];
#pragma unroll
    for (int i = 0; i < 2; ++i) { int R, C; stage_rc(tid * 16 + i * 8192, R, C); const int Rb = 64 * (R >> 5) + 8 * ((R & 15) >> 2) + 4 * ((R >> 4) & 1) + (R & 3);
        voffA[i] = GATHER ? (unsigned)(R | (C << 16)) : (unsigned)(R * lda * ESZ + C * 2); voffB[i] = (unsigned)(Rb * ldb * ESZ + C * 2); }
    unsigned vgC[2][2], vgN[2][2];
#define PG8_ROWMAP(dst, pm_) do { _Pragma("unroll") for (int h_ = 0; h_ < 2; ++h_) _Pragma("unroll") for (int i_ = 0; i_ < 2; ++i_) { \
        const unsigned tok_ = (unsigned)g.rowmap[(size_t)(pm_) * BM + h_ * HALF + (voffA[i_] & 0xFFFFu)] & 0xFFFFu; dst[h_][i_] = tok_ * (unsigned)(lda * ESZ) + (voffA[i_] >> 16) * 2u; } } while (0)
    const size_t kstep = (size_t)(BK * 2);
    const size_t hstepA = (size_t)HALF * lda * ESZ, hstepB = (size_t)32 * ldb * ESZ;
    const unsigned ldsw = (unsigned)wid * 1024u;
    const int aoff = lds_byte(wr * 64 + fr, fq * 8), boff = lds_byte(wc * 32 + fr, fq * 8);
#define PG8_SA(b, h) (((b) * 2 + (h)) * HTB)
#define PG8_SB(b, h) ((4 + (b) * 2 + (h)) * HTB)
#define PG8_STAGE(bufoff, gbase, voff) do { _Pragma("unroll") for (int _i = 0; _i < 2; ++_i) \
        __builtin_amdgcn_global_load_lds((const unsigned*)((const char*)(gbase) + (voff)[_i]), (PG8_LAS unsigned*)(lds + (bufoff) + ldsw + _i * 8192), 16, 0, 0); } while (0)
#define PG8_LDA(dst, b, h) do { _Pragma("unroll") for (int m = 0; m < 4; ++m) ld_frag(dst[m], lds + PG8_SA(b, h) + aoff + m * 2048); } while (0)
#define PG8_LDB(dst, b, h) do { _Pragma("unroll") for (int n = 0; n < 2; ++n) ld_frag(dst[n], lds + PG8_SB(b, h) + boff + n * 2048); } while (0)
#define PG8_MMA(ai, bj, At, Bt) do { __builtin_amdgcn_s_setprio(1); _Pragma("unroll") for (int m = 0; m < 4; ++m) _Pragma("unroll") for (int n = 0; n < 2; ++n) mma_frag(acc[ai][bj][m][n], Bt[n], At[m]); __builtin_amdgcn_s_setprio(0); } while (0)
#define PG8_MMAZ(ai, bj, At, Bt) do { __builtin_amdgcn_s_setprio(1); _Pragma("unroll") for (int m = 0; m < 4; ++m) _Pragma("unroll") for (int n = 0; n < 2; ++n) mma_frag_z(acc[ai][bj][m][n], Bt[n], At[m]); __builtin_amdgcn_s_setprio(0); } while (0)
#define PG8_WAIT_V(n) asm volatile("s_waitcnt vmcnt(%0)" :: "n"(n) : "memory")
#define PG8_WAIT_L(n) asm volatile("s_waitcnt lgkmcnt(" #n ")" ::: "memory")
#define PG8_BAR __builtin_amdgcn_s_barrier()
#define PG8_SCHED __builtin_amdgcn_sched_barrier(0)
    Unit cur, nxt; int ui = 0;
    if (!S.next(0, cur)) return;
    if (g.stag > 0) { const unsigned long long t0 = __builtin_amdgcn_s_memrealtime(), d = (unsigned long long)((blockIdx.x & 15u) * (unsigned)g.stag); while (__builtin_amdgcn_s_memrealtime() - t0 < d) __builtin_amdgcn_s_sleep(8); }
    f32x4 acc[2][2][4][2];
#pragma unroll
    for (int a = 0; a < 2; ++a)
#pragma unroll
        for (int b = 0; b < 2; ++b)
#pragma unroll
            for (int m = 0; m < 4; ++m)
#pragma unroll
                for (int n = 0; n < 2; ++n) { if constexpr (!RELAX) { acc[a][b][m][n] = (f32x4){0.f, 0.f, 0.f, 0.f}; if constexpr (ESZ == 1) asm volatile("" : "+v"(acc[a][b][m][n])); } }
    typename FragSel<ESZ>::type At[4], B0[2], B1[2];
    const char* cA = GATHER ? (const char*)g.A : (const char*)g.A + S.a_off(cur); const char* cB = (const char*)g.Bt + S.b_off(cur);
    if constexpr (GATHER) { PG8_ROWMAP(vgC, cur.pm); _Pragma("unroll") for (int h_ = 0; h_ < 2; ++h_) _Pragma("unroll") for (int i_ = 0; i_ < 2; ++i_) vgN[h_][i_] = vgC[h_][i_]; }
    typename Epi::Pre pre;
#define PG8_FETCH() do { int t3 = threadIdx.x; asm volatile("" : "+v"(t3)); const int w3 = __builtin_amdgcn_readfirstlane(t3 >> 6), l3 = t3 & 63; const EpiCtx ec3{epi + w3 * EPW, w3 >> 2, w3 & 3, l3 & 15, l3 >> 4, l3}; pre = E.fetch(cur, ec3); } while (0)
    PG8_FETCH();
    S.a_ready(cur);
    {
        PG8_STAGE(PG8_SB(0, 0), cB, voffB); PG8_STAGE(PG8_SB(0, 1), cB + hstepB, voffB);
        if constexpr (GATHER) { PG8_STAGE(PG8_SA(0, 0), cA, vgC[0]); PG8_STAGE(PG8_SA(0, 1), cA, vgC[1]); } else { PG8_STAGE(PG8_SA(0, 0), cA, voffA); PG8_STAGE(PG8_SA(0, 1), cA + hstepA, voffA); }
        if (wr == 1) PG8_BAR;
        PG8_WAIT_V(2); PG8_BAR;
        PG8_STAGE(PG8_SB(1, 0), cB + kstep, voffB); if constexpr (GATHER) PG8_STAGE(PG8_SA(1, 0), cA + kstep, vgC[0]); else PG8_STAGE(PG8_SA(1, 0), cA + kstep, voffA); PG8_STAGE(PG8_SB(1, 1), cB + hstepB + kstep, voffB);
        if constexpr (RELAX) {
            if constexpr (GATHER) PG8_STAGE(PG8_SA(1, 1), cA + kstep, vgC[1]); else PG8_STAGE(PG8_SA(1, 1), cA + kstep + hstepA, voffA);
            volatile __attribute__((address_space(1))) u32x4* dm = (volatile __attribute__((address_space(1))) u32x4*)g.dummy + ((size_t)blockIdx.x * 512 + (size_t)tid);
#pragma unroll
            for (int k_ = 0; k_ < Epi::NST; ++k_) *dm = (u32x4){0u, 0u, 0u, 0u};
            PG8_WAIT_V(8 + Epi::NST); PG8_BAR;
        } else { PG8_WAIT_V(6); PG8_BAR; }
    }
    for (;;) {
        const bool has_next = S.next(ui + 1, nxt);
        const char* nA = (has_next && !GATHER) ? (const char*)g.A + S.a_off(nxt) : cA; const char* nB = has_next ? (const char*)g.Bt + S.b_off(nxt) : cB;
        if constexpr (GATHER) { if (has_next) PG8_ROWMAP(vgN, nxt.pm); }
#define PG8_KPTRS const bool last = (t == nt - 2); const char* a1 = cA + (size_t)(t + 1) * kstep; \
            const char* a2 = last ? nA : cA + (size_t)(t + 2) * kstep; const char* b2 = last ? nB : cB + (size_t)(t + 2) * kstep; const char* a3 = a2 + kstep; const char* b3 = b2 + kstep; (void)a1
        if constexpr (RELAX) {
            { const int t = 0; PG8_KPTRS; PG8_KITER(true, 8 + Epi::NST, PG8_MMAZ); }
            for (int t = 2; t < nt; t += 2) { PG8_KPTRS; PG8_KITER(false, 8, PG8_MMA); }
            if (has_next) { if constexpr (GATHER) PG8_STAGE(PG8_SA(1, 1), nA + kstep, vgN[1]); else PG8_STAGE(PG8_SA(1, 1), nA + kstep + hstepA, voffA); }
        } else {
            for (int t = 0; t < nt; t += 2) { PG8_KPTRS; PG8_KITER(false, 8, PG8_MMA); }
        }
#undef PG8_KPTRS
        if constexpr (ESZ == 1) asm volatile("s_nop 15\n\ts_nop 15" ::: "memory");
        if constexpr (ALIGN_EPI) { if (wr == 0) PG8_BAR; }
        { int t2 = threadIdx.x; asm volatile("" : "+v"(t2));
          const int w2 = __builtin_amdgcn_readfirstlane(t2 >> 6), l2 = t2 & 63; const EpiCtx ec{epi + w2 * EPW, w2 >> 2, w2 & 3, l2 & 15, l2 >> 4, l2}; E(acc, cur, ec, pre); if (Epi::TWICE) { asm volatile("" ::: "memory"); E(acc, cur, ec, pre); } S.done(cur); }
        if (!has_next) break;
#pragma unroll
        for (int a = 0; a < 2; ++a)
#pragma unroll
            for (int b = 0; b < 2; ++b)
#pragma unroll
                for (int m = 0; m < 4; ++m)
#pragma unroll
                    for (int n = 0; n < 2; ++n) { if constexpr (!RELAX) { acc[a][b][m][n] = (f32x4){0.f, 0.f, 0.f, 0.f}; if constexpr (ESZ == 1) asm volatile("" : "+v"(acc[a][b][m][n])); } }
        cur = nxt; cA = nA; cB = nB; ++ui;
        PG8_FETCH();
        if constexpr (GATHER) { _Pragma("unroll") for (int h_ = 0; h_ < 2; ++h_) _Pragma("unroll") for (int i_ = 0; i_ < 2; ++i_) vgC[h_][i_] = vgN[h_][i_]; }
        if constexpr (ALIGN_EPI) { if (wr == 1) PG8_BAR; }
    }
    PG8_WAIT_V(0);
    if constexpr (!ALIGN_EPI) { if (wr == 0) PG8_BAR; }
    PG8_BAR;
#undef PG8_SA
#undef PG8_FETCH
#undef PG8_ROWMAP
#undef PG8_SB
#undef PG8_STAGE
#undef PG8_LDA
#undef PG8_LDB
#undef PG8_MMA
#undef PG8_MMAZ
#undef PG8_WAIT_V
#undef PG8_WAIT_L
#undef PG8_BAR
#undef PG8_SCHED
}
}
#include <hip/hip_bf16.h>
#include <cmath>
namespace attn_body {
using bf16=__hip_bfloat16;
using bf16x8=__attribute__((ext_vector_type(8)))short;
using s16x4=__attribute__((ext_vector_type(4)))short;
using f32x16=__attribute__((ext_vector_type(16)))float;
using u32x4=__attribute__((ext_vector_type(4)))unsigned;
using f32x4_t=__attribute__((ext_vector_type(4)))float;
constexpr int BATCH=8,NHEAD=16,SEQ=8192,D=64,DM=NHEAD*D;
constexpr int NW=8,QBLK=32,QB=QBLK*NW,KVBLK=64,NQB=SEQ/QB;
constexpr int ATTN_PITCH=DM, ATTN_UNIT_ROWS=QB;
__device__ __forceinline__ int crow(int r,int hi){return (r&3)+8*(r>>2)+4*hi;}
#define SBAR() __builtin_amdgcn_sched_barrier(0)
__device__ __forceinline__ void cmask(f32x16&p0,f32x16&p1,int jb,int qrel,int hi){
  const float NEG=-INFINITY; int kb=64*jb+4*hi;
  #pragma unroll
  for(int r=0;r<16;++r){int kv=kb+(r&3)+8*(r>>2); if(kv>qrel)p0[r]=NEG; if(kv+32>qrel)p1[r]=NEG;}
}

constexpr int NSLOT=3, SLOTB=8192;
constexpr int LDS_K=0, LDS_V=NSLOT*SLOTB, LDS_WS=2*NSLOT*SLOTB, LDS_OST=LDS_WS+NW*64*4, LDS_BIAS=LDS_OST+NW*4096, LDS_BYTES=LDS_BIAS+SEQ*4;
constexpr float C2=0.125f*1.4426950408889634f;
__device__ __forceinline__ void glds16(const void*gsrc,unsigned lds_dst){unsigned keep;
  asm volatile("s_mov_b32 %0, m0\n\ts_mov_b32 m0, %2\n\ts_nop 0\n\tglobal_load_lds_dwordx4 %1, off\n\ts_mov_b32 m0, %0":"=&s"(keep):"v"(gsrc),"s"(lds_dst):"memory");}
__device__ __forceinline__ float max3f(float a,float b,float c){float r;asm("v_max3_f32 %0, %1, %2, %3":"=v"(r):"v"(a),"v"(b),"v"(c));return r;}
__device__ __forceinline__ float max2f(float a,float b){float r;asm("v_max_f32_e32 %0, %1, %2":"=v"(r):"v"(a),"v"(b));return r;}
__device__ __forceinline__ float fadd_s(float a,float b){float r;asm("v_add_f32_e32 %0, %1, %2":"=v"(r):"v"(a),"v"(b));return r;}
__device__ __forceinline__ float fsub_s(float a,float b){float r;asm("v_sub_f32_e32 %0, %1, %2":"=v"(r):"v"(a),"v"(b));return r;}
typedef float f32x2_t __attribute__((ext_vector_type(2))); typedef __bf16 bf16x2_t __attribute__((ext_vector_type(2)));
__device__ __forceinline__ unsigned cvtpk_s(float lo,float hi){f32x2_t v={lo,hi};bf16x2_t b=__builtin_convertvector(v,bf16x2_t);return __builtin_bit_cast(unsigned,b);}
#define WAIT_BAR(N) asm volatile("s_waitcnt vmcnt(" #N ") lgkmcnt(0)\n\ts_barrier":::"memory")

__device__ __forceinline__ void qkt(f32x16&p0,f32x16&p1,const char*Kslot,const bf16x8*qr,const f32x16&c0,const f32x16&c1,int r32,int hi){
  const char*kb=Kslot+hi*1024+r32*16;
  #pragma unroll
  for(int d0=0;d0<4;++d0){
    const bf16x8 b0=*reinterpret_cast<const bf16x8*>(kb+d0*2048);
    const bf16x8 b1=*reinterpret_cast<const bf16x8*>(kb+d0*2048+512);
    if(d0==0){p0=__builtin_amdgcn_mfma_f32_32x32x16_bf16(b0,qr[0],c0,0,0,0);p1=__builtin_amdgcn_mfma_f32_32x32x16_bf16(b1,qr[0],c1,0,0,0);}
    else{p0=__builtin_amdgcn_mfma_f32_32x32x16_bf16(b0,qr[d0],p0,0,0,0);p1=__builtin_amdgcn_mfma_f32_32x32x16_bf16(b1,qr[d0],p1,0,0,0);}}
}
typedef __attribute__((address_space(3))) const char* lds_cptr;
typedef short v4i16_t __attribute__((ext_vector_type(4)));
__device__ __forceinline__ void kload8(bf16x8*kf,lds_cptr kp){
  kf[0]=*(const __attribute__((address_space(3))) bf16x8*)(kp);      kf[1]=*(const __attribute__((address_space(3))) bf16x8*)(kp+512);
  kf[2]=*(const __attribute__((address_space(3))) bf16x8*)(kp+2048); kf[3]=*(const __attribute__((address_space(3))) bf16x8*)(kp+2560);
  kf[4]=*(const __attribute__((address_space(3))) bf16x8*)(kp+4096); kf[5]=*(const __attribute__((address_space(3))) bf16x8*)(kp+4608);
  kf[6]=*(const __attribute__((address_space(3))) bf16x8*)(kp+6144); kf[7]=*(const __attribute__((address_space(3))) bf16x8*)(kp+6656);
}
__device__ __forceinline__ void kload2(bf16x8*kf,lds_cptr kp,int j){ kf[2*j]=*(const __attribute__((address_space(3))) bf16x8*)(kp+j*2048); kf[2*j+1]=*(const __attribute__((address_space(3))) bf16x8*)(kp+j*2048+512); }
__device__ __forceinline__ s16x4 vtr(lds_cptr p){ return __builtin_bit_cast(s16x4,__builtin_amdgcn_ds_read_tr16_b64_v4i16((__attribute__((address_space(3))) v4i16_t*)p)); }
__device__ __forceinline__ float rowmax(const f32x16&p0,const f32x16&p1){
  float a=max3f(p0[0],p0[1],p1[0]),b=max3f(p0[2],p0[3],p1[1]);a=max3f(a,p1[2],p1[3]);
  #pragma unroll
  for(int r=4;r<16;r+=4){a=max3f(a,p0[r],p0[r+1]);b=max3f(b,p0[r+2],p0[r+3]);a=max3f(a,p1[r],p1[r+1]);b=max3f(b,p1[r+2],p1[r+3]);}
  const float m=max2f(a,b);
  auto rr=__builtin_amdgcn_permlane32_swap(__float_as_uint(m),__float_as_uint(m),false,false);
  return max2f(__uint_as_float(rr[0]),__uint_as_float(rr[1]));
}
__device__ __forceinline__ void pv(f32x16*o,int vb,bf16x8 pa0,bf16x8 pa1,bf16x8 pa2,bf16x8 pa3){
  #pragma unroll
  for(int d0=0;d0<2;++d0){s16x4 lo[4],hi[4];
    #pragma unroll
    for(int ks=0;ks<4;++ks){
      asm volatile("ds_read_b64_tr_b16 %0,%1 offset:%c2":"=&v"(lo[ks]):"v"(vb),"i"(d0*4096+ks*1024):"memory");
      asm volatile("ds_read_b64_tr_b16 %0,%1 offset:%c2":"=&v"(hi[ks]):"v"(vb),"i"(d0*4096+ks*1024+512):"memory");}
    asm volatile("s_waitcnt lgkmcnt(0)":::"memory");SBAR();
    #define PK(k) (bf16x8){lo[k][0],lo[k][1],lo[k][2],lo[k][3],hi[k][0],hi[k][1],hi[k][2],hi[k][3]}
    o[d0]=__builtin_amdgcn_mfma_f32_32x32x16_bf16(pa0,PK(0),o[d0],0,0,0);
    o[d0]=__builtin_amdgcn_mfma_f32_32x32x16_bf16(pa1,PK(1),o[d0],0,0,0);
    o[d0]=__builtin_amdgcn_mfma_f32_32x32x16_bf16(pa2,PK(2),o[d0],0,0,0);
    o[d0]=__builtin_amdgcn_mfma_f32_32x32x16_bf16(pa3,PK(3),o[d0],0,0,0);
    #undef PK
  }
}

#ifndef ATTN_STORE16
#define ATTN_STORE16(p,v) (*(u32x4*)(p)=(v))
#endif
template<int THRL,bool STATIC> __device__ __forceinline__ void attn_unit(int b,int h,int qb,int ts,const bf16*Q,const bf16*__restrict__ K,const bf16*__restrict__ V,bf16*O,const float*biasg,char*shm){
  int tid=threadIdx.x; asm volatile("":"+v"(tid)); const int lane=tid&63,r32=lane&31,hi=lane>>5; const int wid=__builtin_amdgcn_readfirstlane(tid>>6);
  const long rowbase=(long)b*SEQ; const int q0=qb*QB;
  const bf16*Qw=Q+(rowbase+q0+wid*QBLK)*DM+h*D;
  const bf16*Kh=K+(rowbase+(long)ts*KVBLK)*DM+h*D,*Vh=V+(rowbase+(long)ts*KVBLK)*DM+h*D;
  const unsigned lds0=(unsigned)(uintptr_t)shm;
  float*wsf=(float*)(shm+LDS_WS)+wid*64;
  const bf16*ksrc=Kh+(long)lane*DM+wid*8;
  const bf16*vsrc=Vh+(long)(16*(wid&3)+(lane>>2))*DM+(wid>>2)*32+(lane&3)*8;
  const unsigned kdst=lds0+LDS_K+wid*1024, vdst=lds0+LDS_V+wid*1024;
  #define DMA_K(t,slot) glds16(ksrc+(long)(t)*KVBLK*DM,(unsigned)__builtin_amdgcn_readfirstlane(kdst+(slot)))
  #define DMA_V(t,slot) glds16(vsrc+(long)(t)*KVBLK*DM,(unsigned)__builtin_amdgcn_readfirstlane(vdst+(slot)))
  const int vb0=(int)(lds0+LDS_V)+((lane>>4)&1)*32+(lane&3)*8+(4*hi+((lane&15)>>2))*64;
  const char*Kbase=shm+LDS_K; bf16x8 kf[8];
  const lds_cptr shm3=(lds_cptr)shm; const lds_cptr kp0=shm3+LDS_K+hi*1024+r32*16; const lds_cptr vp0=shm3+LDS_V+((lane>>4)&1)*32+(lane&3)*8+(4*hi+((lane&15)>>2))*64;
  const int NT=(q0+QB)/KVBLK-ts;
  if(!STATIC){ const float*bg=biasg+(long)(b*NHEAD+h)*SEQ+ts*KVBLK; const int nb=NT*KVBLK;
    for(int f0=wid*256;f0<nb;f0+=NW*256) glds16(bg+f0+lane*4,(unsigned)__builtin_amdgcn_readfirstlane(lds0+LDS_BIAS+f0*4)); }
  const lds_cptr bp0=shm3+LDS_BIAS+hi*16;
  DMA_K(0,0);DMA_V(0,0);DMA_K(1,SLOTB);
  bf16x8 qr[4];
  #pragma unroll
  for(int d0=0;d0<4;++d0)qr[d0]=*reinterpret_cast<const bf16x8*>(&Qw[(long)r32*DM+d0*16+hi*8]);
  float mhat=0.f,l_reg=0.f;f32x16 o[2];o[0]=f32x16{};o[1]=f32x16{};f32x16 cb0,cb1;
  #define LOADCB(t) do{ const lds_cptr bp_=bp0+(t)*256; _Pragma("unroll") for(int j_=0;j_<4;++j_){ \
      const f32x4_t u0_=*(const __attribute__((address_space(3))) f32x4_t*)(bp_+j_*32); const f32x4_t u1_=*(const __attribute__((address_space(3))) f32x4_t*)(bp_+128+j_*32); \
      _Pragma("unroll") for(int i_=0;i_<4;++i_){ if(STATIC){ cb0[4*j_+i_]=u0_[i_]; cb1[4*j_+i_]=u1_[i_]; } else { cb0[4*j_+i_]=u0_[i_]-mhat; cb1[4*j_+i_]=u1_[i_]-mhat; } } } }while(0)
  const int qrel=wid*QBLK+r32;
  #define CMASK(P0,P1,t) do{int jb_=(t)-(NT-4); if(jb_>=0)cmask(P0,P1,jb_,qrel,hi);}while(0)
  bool resc=false;
  #define START(P0,P1) do{ resc=false; \
    if(!STATIC){ const float rm=rowmax(P0,P1); const float dl=rm; mhat=fadd_s(mhat,dl); \
      _Pragma("unroll") for(int r=0;r<16;++r){P0[r]=fsub_s(P0[r],dl);P1[r]=fsub_s(P1[r],dl);} \
      } \
    _Pragma("unroll") for(int r=0;r<16;++r)P0[r]=__builtin_amdgcn_exp2f(P0[r]); }while(0)
  #define RESC() do{ if(resc){ asm volatile("s_waitcnt lgkmcnt(0)":::"memory"); \
      _Pragma("unroll") for(int d_=0;d_<2;++d_) _Pragma("unroll") for(int r=0;r<16;++r)o[d_][r]*=wsf[crow(r,hi)]; } }while(0)
  f32x16 pA0,pA1,pB0,pB1;
  int sl_prev=0,sl_cur=0,sl_next=SLOTB;
  #define ROT() do{sl_prev=sl_cur;sl_cur=sl_next;sl_next=(sl_next==(NSLOT-1)*SLOTB)?0:sl_next+SLOTB;}while(0)
  DMA_K(2,2*SLOTB);
  if(STATIC){ const float*bg=biasg+(long)(b*NHEAD+h)*SEQ; const float ref=bg[q0+QB-1]; const int nb=NT*KVBLK;
    for(int f0=tid*4;f0<nb;f0+=NW*256){ f32x4_t v=*(const f32x4_t*)(bg+ts*KVBLK+f0); v[0]-=ref; v[1]-=ref; v[2]-=ref; v[3]-=ref; *(__attribute__((address_space(3))) f32x4_t*)(shm3+LDS_BIAS+f0*4)=v; } }
  WAIT_BAR(3);
  LOADCB(0); qkt(pA0,pA1,Kbase,qr,cb0,cb1,r32,hi);asm volatile("s_nop 15\n\ts_nop 7":"+v"(pA0),"+v"(pA1));CMASK(pA0,pA1,0);
  START(pA0,pA1);
  _Pragma("unroll") for(int r=0;r<16;++r)pA1[r]=__builtin_amdgcn_exp2f(pA1[r]);
  WAIT_BAR(0);
  DMA_K(3,0);DMA_V(1,SLOTB);
  ROT();
  kload8(kf,kp0+sl_cur);
  WAIT_BAR(2);
  s16x4 vlo[8],vhi[8]; u32x4 pw0,pw1,pw2,pw3;
  #define PKW(P,B) cvtpk_s(P[B],P[B+1])
  #define PAF(k) __builtin_bit_cast(bf16x8,pw##k)
  #define VFR(i) (bf16x8){vlo[i][0],vlo[i][1],vlo[i][2],vlo[i][3],vhi[i][0],vhi[i][1],vhi[i][2],vhi[i][3]}
  #define PIN(x) asm volatile("":"+v"(x))
  #define MX3(a,b,c) __builtin_fmaxf(__builtin_fmaxf((a),(b)),(c))
  #define GAPA(MF,A0,A1,A2,A3,W0,W1,PW) do{ MF; sacc+=A0; sacc+=A1; sacc+=A2; sacc+=A3; PIN(sacc); W0; W1; PIN(PW); SBAR(); }while(0)
  #define EX(v) __builtin_amdgcn_exp2f(v)
  #define GAPB(MF,X,B) do{ MF; X[B]=EX(X[B]); X[B+1]=EX(X[B+1]); X[B+2]=EX(X[B+2]); X[B+3]=EX(X[B+3]); PIN(X); SBAR(); }while(0)
  #define VRD(i) do{ vlo[i]=vtr(vp_+(((i)>>2)*4096+((i)&3)*1024)); vhi[i]=vtr(vp_+(((i)>>2)*4096+((i)&3)*1024+512)); }while(0)
  #define KRD(G,j) do{ if(G){ kload2(kf,kp0+sl_next,j); SBAR(); } }while(0)
  #define STEP(C0,C1,P0,P1,t,GK,GV,GL) do{ SBAR(); \
    LOADCB(t); SBAR(); \
    const lds_cptr vp_=vp0+sl_prev; \
    VRD(0); SBAR(); float sacc=(P0[0]+P0[1]); \
    GAPA(C0=__builtin_amdgcn_mfma_f32_32x32x16_bf16(kf[0],qr[0],cb0,0,0,0), P0[2],P0[3],P0[4],P0[5],     pw0[0]=PKW(P0,0), pw0[1]=PKW(P0,2), pw0); \
    VRD(4); SBAR(); GAPA(C1=__builtin_amdgcn_mfma_f32_32x32x16_bf16(kf[1],qr[0],cb1,0,0,0), P0[6],P0[7],P0[8],P0[9],     pw0[2]=PKW(P0,4), pw0[3]=PKW(P0,6), pw0); \
    VRD(1); SBAR(); GAPA(C0=__builtin_amdgcn_mfma_f32_32x32x16_bf16(kf[2],qr[1],C0,0,0,0),   P0[10],P0[11],P0[12],P0[13], pw1[0]=PKW(P0,8), pw1[1]=PKW(P0,10), pw1); \
    VRD(5); SBAR(); GAPA(C1=__builtin_amdgcn_mfma_f32_32x32x16_bf16(kf[3],qr[1],C1,0,0,0),   P0[14],P0[15],P1[0],P1[1],   pw1[2]=PKW(P0,12),pw1[3]=PKW(P0,14), pw1); \
    VRD(2); SBAR(); GAPA(C0=__builtin_amdgcn_mfma_f32_32x32x16_bf16(kf[4],qr[2],C0,0,0,0),   P1[2],P1[3],P1[4],P1[5],     pw2[0]=PKW(P1,0), pw2[1]=PKW(P1,2), pw2); \
    VRD(6); SBAR(); GAPA(C1=__builtin_amdgcn_mfma_f32_32x32x16_bf16(kf[5],qr[2],C1,0,0,0),   P1[6],P1[7],P1[8],P1[9],     pw2[2]=PKW(P1,4), pw2[3]=PKW(P1,6), pw2); \
    VRD(3); SBAR(); GAPA(C0=__builtin_amdgcn_mfma_f32_32x32x16_bf16(kf[6],qr[3],C0,0,0,0),   P1[10],P1[11],P1[12],P1[13], pw3[0]=PKW(P1,8), pw3[1]=PKW(P1,10), pw3); \
    VRD(7); SBAR(); GAPA(C1=__builtin_amdgcn_mfma_f32_32x32x16_bf16(kf[7],qr[3],C1,0,0,0),   P1[14],P1[15],0.f,0.f,       pw3[2]=PKW(P1,12),pw3[3]=PKW(P1,14), pw3); \
    l_reg+=sacc; \
    if(GK){DMA_K((t)+3,sl_cur);} if(GV){DMA_V((t)+1,sl_next);} \
    CMASK(C0,C1,t); \
    if(!STATIC){ float a=MX3(C0[0],C0[1],C1[0]),b=MX3(C0[2],C0[3],C1[1]); a=MX3(a,C1[2],C1[3]); \
      _Pragma("unroll") for(int r=4;r<16;r+=4){a=MX3(a,C0[r],C0[r+1]);b=MX3(b,C0[r+2],C0[r+3]);a=MX3(a,C1[r],C1[r+1]);b=MX3(b,C1[r+2],C1[r+3]);} \
      float rm=__builtin_fmaxf(a,b); { auto rr=__builtin_amdgcn_permlane32_swap(__float_as_uint(rm),__float_as_uint(rm),false,false); rm=__builtin_fmaxf(__uint_as_float(rr[0]),__uint_as_float(rr[1])); } \
      resc=false; \
      if(__builtin_expect(__any(rm>(float)THRL),0)){ const float dl=__builtin_fmaxf(rm,0.f); mhat+=dl; \
        _Pragma("unroll") for(int r=0;r<16;++r){C0[r]-=dl;C1[r]-=dl;} \
        const float f=__builtin_amdgcn_exp2f(-dl); l_reg*=f; if(hi==0)wsf[r32]=f; resc=true; } } \
    SBAR(); \
    GAPB(o[0]=__builtin_amdgcn_mfma_f32_32x32x16_bf16(PAF(0),VFR(0),o[0],0,0,0), C0,0); \
    GAPB(o[1]=__builtin_amdgcn_mfma_f32_32x32x16_bf16(PAF(0),VFR(4),o[1],0,0,0), C0,4); \
    KRD(GL,0); GAPB(o[0]=__builtin_amdgcn_mfma_f32_32x32x16_bf16(PAF(1),VFR(1),o[0],0,0,0), C0,8); \
    KRD(GL,1); GAPB(o[1]=__builtin_amdgcn_mfma_f32_32x32x16_bf16(PAF(1),VFR(5),o[1],0,0,0), C0,12); \
    KRD(GL,2); GAPB(o[0]=__builtin_amdgcn_mfma_f32_32x32x16_bf16(PAF(2),VFR(2),o[0],0,0,0), C1,0); \
    KRD(GL,3); GAPB(o[1]=__builtin_amdgcn_mfma_f32_32x32x16_bf16(PAF(2),VFR(6),o[1],0,0,0), C1,4); \
    GAPB(o[0]=__builtin_amdgcn_mfma_f32_32x32x16_bf16(PAF(3),VFR(3),o[0],0,0,0), C1,8); \
    GAPB(o[1]=__builtin_amdgcn_mfma_f32_32x32x16_bf16(PAF(3),VFR(7),o[1],0,0,0), C1,12); \
    }while(0)
  int t=1;
  #undef CMASK
  #define CMASK(P0,P1,t) do{}while(0)
  for(;t+5<NT;t+=2){
    STEP(pB0,pB1,pA0,pA1,t,true,true,true);     WAIT_BAR(2); RESC(); ROT();
    STEP(pA0,pA1,pB0,pB1,t+1,true,true,true);   WAIT_BAR(2); RESC(); ROT();
  }
  #undef CMASK
  #define CMASK(P0,P1,t) do{int jb_=(t)-(NT-4); if(jb_>=0)cmask(P0,P1,jb_,qrel,hi);}while(0)
  #define ENDW(tt) do{ if((tt)+3<NT){WAIT_BAR(2);} else if((tt)+2<NT){WAIT_BAR(1);} else {WAIT_BAR(0);} }while(0)
  for(;t+1<NT;t+=2){
    STEP(pB0,pB1,pA0,pA1,t,(t+3<NT),(t+1<NT),(t+1<NT));       ENDW(t);   RESC(); ROT();
    STEP(pA0,pA1,pB0,pB1,t+1,(t+4<NT),(t+2<NT),(t+2<NT));     ENDW(t+1); RESC(); ROT();
  }
  STEP(pB0,pB1,pA0,pA1,NT-1,false,false,false); RESC();
  { float sacc=pB0[0]+pB0[1]; _Pragma("unroll") for(int r=2;r<16;++r)sacc+=pB0[r]; _Pragma("unroll") for(int r=0;r<16;++r)sacc+=pB1[r]; l_reg+=sacc;
    pw0=(u32x4){PKW(pB0,0),PKW(pB0,2),PKW(pB0,4),PKW(pB0,6)};pw1=(u32x4){PKW(pB0,8),PKW(pB0,10),PKW(pB0,12),PKW(pB0,14)};pw2=(u32x4){PKW(pB1,0),PKW(pB1,2),PKW(pB1,4),PKW(pB1,6)};pw3=(u32x4){PKW(pB1,8),PKW(pB1,10),PKW(pB1,12),PKW(pB1,14)};
    SBAR(); pv(o,vb0+sl_cur,PAF(0),PAF(1),PAF(2),PAF(3)); }
  #undef PKW
  #undef PAF
  #undef VFR
  #undef PIN
  #undef MX3
  #undef GAPA
  #undef GAPB
  #undef EX
  #undef VRD
  #undef KRD
  #undef STEP
  #undef ENDW
  {auto rr=__builtin_amdgcn_permlane32_swap(__float_as_uint(l_reg),__float_as_uint(l_reg),false,false);l_reg=__uint_as_float(rr[0])+__uint_as_float(rr[1]);}
  if(hi==0)wsf[32+r32]=l_reg;asm volatile("s_waitcnt lgkmcnt(0)":::"memory");
  float rli[16];
  #pragma unroll
  for(int r=0;r<16;++r)rli[r]=__builtin_amdgcn_rcpf(wsf[32+crow(r,hi)]);
  unsigned char*Ow=(unsigned char*)O+(rowbase+q0+wid*QBLK)*DM+h*D;
  { __attribute__((address_space(3))) unsigned char*stg=(__attribute__((address_space(3))) unsigned char*)(shm3+LDS_OST)+wid*2048;
    #pragma unroll
    for(int r=0;r<16;++r){const int orow=crow(r,hi);
      #pragma unroll
      for(int d0=0;d0<2;++d0){const float v=o[d0][r]*rli[r]; stg[orow*64+d0*32+r32]=(unsigned char)(__builtin_amdgcn_cvt_pk_fp8_f32(v,v,0u,false)&0xffu);}}
    asm volatile("s_waitcnt lgkmcnt(0)":::"memory");
    #pragma unroll
    for(int i=0;i<2;++i){const int row=i*16+(lane>>2),ch=lane&3; const u32x4 v=*(const __attribute__((address_space(3))) u32x4*)(stg+row*64+ch*16); ATTN_STORE16(Ow+(long)row*DM+ch*16,v);} }
  asm volatile("s_waitcnt lgkmcnt(0)\n\ts_barrier":::"memory");
  #undef DMA_K
  #undef DMA_V
  #undef CMASK
  #undef START
  #undef RESC
  #undef ROT
  #undef LOADCB
}
constexpr int ATTN_LDS_BYTES=LDS_BYTES;
struct AttnTensors { const bf16* Q; const bf16* K; const bf16* V; bf16* O; const float* bias; const int* ts; };
struct AttnUnit { int bh; int qb; };
struct StaticOrder {
  int vcu;
  __device__ __forceinline__ explicit StaticOrder(int grid,int block):vcu((block%8)*(grid/8)+block/8){}
  __device__ __forceinline__ bool next(int i,AttnUnit&u)const{ if(i>=16)return false; const int grp=i>>2,j=i&3,r=((vcu&7)+2*grp)&7; u.bh=(vcu>>3)+32*grp;
    u.qb=(r<5)?((j==0)?r:(4+3*r+j)):(20+4*(r-5)+j); return true; }
  __device__ __forceinline__ void a_ready(const AttnUnit&)const{}
  __device__ __forceinline__ void done(const AttnUnit&)const{}
};
template<class Sched,int THRL=60> __device__ __forceinline__ void attn_phase(char*lds,const AttnTensors&T,const Sched&S){
  AttnUnit u;
  for(int i=0;S.next(i,u);++i){ S.a_ready(u); const int ts_=__builtin_amdgcn_readfirstlane(T.ts[u.bh*NQB+u.qb]);
    if(ts_&0x10000) attn_unit<THRL,true>(u.bh/NHEAD,u.bh%NHEAD,u.qb,ts_&0xffff,T.Q,T.K,T.V,T.O,T.bias,lds); else attn_unit<THRL,false>(u.bh/NHEAD,u.bh%NHEAD,u.qb,ts_,T.Q,T.K,T.V,T.O,T.bias,lds);
    S.done(u); }
}
#undef SBAR
#undef WAIT_BAR
}
#define GAS __attribute__((address_space(1)))
#define LAS __attribute__((address_space(3)))
typedef unsigned short bf16;
typedef unsigned v4u __attribute__((ext_vector_type(4)));
typedef float f32x4 __attribute__((ext_vector_type(4)));
typedef short bf16x8 __attribute__((ext_vector_type(8)));
typedef GAS unsigned gu32;
typedef GAS unsigned long long gu64;
#define RLX_AGENT __ATOMIC_RELAXED, __HIP_MEMORY_SCOPE_AGENT
#define LDS_WAIT() asm volatile("s_waitcnt lgkmcnt(0)" ::: "memory")
#define VM_WAIT() asm volatile("s_waitcnt vmcnt(0)" ::: "memory")
__device__ __forceinline__ unsigned long long rt() { return __builtin_amdgcn_s_memrealtime(); }
__device__ __forceinline__ unsigned f2bf(float f) { unsigned u = __builtin_bit_cast(unsigned, f); return (u + 0x7fffu + ((u >> 16) & 1u)) >> 16; }
__device__ __forceinline__ unsigned pk2(float lo, float hi) { return f2bf(lo) | (f2bf(hi) << 16); }

#define XB_TMO      128
#define XB_XCNT(j)  (256  + 64 * (j))
#define XB_XSUB(j)  (1280 + 64 * (j))
#define XB_XGEN(j)  (2304 + 64 * (j))
#define XB_TOP      3328
#define XB_TOPGEN   3392
#define XCD_BAR_WORDS 3456
#define XB_SPIN_CAP (1u << 18)

__device__ __forceinline__ unsigned xb_ld(unsigned* p)              { return __hip_atomic_load(p, __ATOMIC_RELAXED, __HIP_MEMORY_SCOPE_AGENT); }
__device__ __forceinline__ unsigned xb_add(unsigned* p, unsigned v) { return __hip_atomic_fetch_add(p, v, __ATOMIC_RELAXED, __HIP_MEMORY_SCOPE_AGENT); }
__device__ __forceinline__ unsigned xb_xcc_id() { return (unsigned)__builtin_amdgcn_s_getreg((3 << 11) | 20) & 0xFu; }
#define XB_SPIN(cond, bar) do { unsigned _sp = 0; while (cond) { __builtin_amdgcn_s_sleep(1); \
    if ((++_sp & 255u) == 0u) { if (xb_ld(&(bar)[XB_TMO])) break; if (_sp > XB_SPIN_CAP) { atomicAdd(&(bar)[XB_TMO], 1u); break; } } } } while (0)

struct XcdBarrier {
    unsigned* bar; unsigned x;
    volatile LAS unsigned* st;
};

__device__ __forceinline__ XcdBarrier xcd_barrier_post(unsigned* bar, volatile LAS unsigned* st) {
    XcdBarrier b; b.bar = bar; b.x = xb_xcc_id(); b.st = st;
    if (threadIdx.x == 0) (void)xb_add(&bar[XB_XCNT(b.x)], 1u);
    return b;
}
__device__ __forceinline__ void xcd_barrier_complete(unsigned* bar, unsigned x, unsigned& nloc, unsigned& nx) {
    const unsigned G = gridDim.x * gridDim.y * gridDim.z;
    unsigned sum, cnt, mine, sp = 0u;
    for (;;) {
        sum = 0u; cnt = 0u; mine = 0u;
#pragma unroll
        for (unsigned j = 0; j < 16; ++j) { const unsigned c = xb_ld(&bar[XB_XCNT(j)]); sum += c; cnt += (c > 0u) ? 1u : 0u; mine = (j == x) ? c : mine; }
        if (sum == G) break;
        __builtin_amdgcn_s_sleep(1);
        if ((++sp & 255u) == 0u) { if (xb_ld(&bar[XB_TMO])) break; if (sp > XB_SPIN_CAP) { atomicAdd(&bar[XB_TMO], 1u); break; } }
    }
    nloc = mine > 0u ? mine : 1u; nx = cnt > 0u ? cnt : 1u;
}

__device__ __forceinline__ void xcd_barrier(const XcdBarrier& b) {
    asm volatile("s_waitcnt vmcnt(0)" ::: "memory");
    __syncthreads();
    if (threadIdx.x == 0) {
        unsigned* bar = b.bar;
        __builtin_amdgcn_s_waitcnt(0);
        unsigned nloc = b.st[0], nx = b.st[1];
        if (nloc == 0u) { xcd_barrier_complete(bar, b.x, nloc, nx); b.st[0] = nloc; b.st[1] = nx; }
        const unsigned old = xb_add(&bar[XB_XSUB(b.x)], 1u);
        const unsigned gen = old / nloc;
        if (old + 1u == (gen + 1u) * nloc) {
            __builtin_amdgcn_fence(__ATOMIC_RELEASE, "agent");
            asm volatile("s_waitcnt vmcnt(0)" ::: "memory");
            const unsigned og = xb_add(&bar[XB_TOP], 1u);
            const unsigned tg = og / nx;
            if (og + 1u == (tg + 1u) * nx) xb_add(&bar[XB_TOPGEN], 1u);
            else XB_SPIN(xb_ld(&bar[XB_TOPGEN]) == tg, bar);
            __builtin_amdgcn_fence(__ATOMIC_ACQUIRE, "agent");
            xb_add(&bar[XB_XGEN(b.x)], 1u);
            asm volatile("s_waitcnt vmcnt(0)" ::: "memory");
        } else {
            XB_SPIN(xb_ld(&bar[XB_XGEN(b.x)]) == gen, bar);
            __builtin_amdgcn_fence(__ATOMIC_ACQUIRE, "agent");
            asm volatile("s_waitcnt vmcnt(0)" ::: "memory");
        }
    }
    __syncthreads();
}

constexpr int NWAVES = 8;
constexpr int NB = 8, SEQ = 8192, D = 1024, NTOK = NB * SEQ, NE = 32, PLE = 256, NH = 16;
constexpr int MAXT = 1056;
constexpr int NCHUNK = NTOK / 256;
constexpr float LOG2E = 1.4426950408889634f;
constexpr float WSCALE8 = 1.0f / pg8::W8INV;
#ifndef MK_PER_PHASE
#define MK_PER_PHASE 0
#endif
constexpr int N_PHASES = 21;
#ifndef STAG_GU
#define STAG_GU 0
#endif
#ifndef STAG_DOWN
#define STAG_DOWN 0
#endif
#ifndef STAG_QKV
#define STAG_QKV 0
#endif
#ifndef STAG_PLE
#define STAG_PLE 0
#endif
#ifndef STAG_PJ
#define STAG_PJ 0
#endif
#ifndef STAG_WO
#define STAG_WO 0
#endif
#ifndef STAG_POOL
#define STAG_POOL 0
#endif

constexpr size_t MiB = 1u << 20;
constexpr size_t WS_CTL = 0, CTL_ZERO_BYTES = 1 * MiB;
constexpr size_t WS_META = 4 * MiB;
constexpr size_t WS_LOGITS = 5 * MiB;
constexpr size_t WS_TOKE = 13 * MiB;
constexpr size_t WS_TOKG = 14 * MiB;
constexpr size_t WS_TOKPOS = 15 * MiB;
constexpr size_t WS_SLOTG = 16 * MiB;
constexpr size_t WS_SLOTR = 18 * MiB;
constexpr size_t WS_LF = 20 * MiB;
constexpr size_t WS_BIAS = 24 * MiB;
constexpr size_t WS_TS = WS_META + 128 * 1024;
constexpr size_t WS_BGU16 = WS_META + 512 * 1024, WS_BD16 = WS_META + 768 * 1024;
constexpr size_t WS_NRM = WS_META + 256 * 1024;
constexpr size_t WS_WPOOL = 28 * MiB, WS_WROUTER = 29 * MiB, WS_WO = 30 * MiB, WS_WQKV = 32 * MiB, WS_WPG = 39 * MiB, WS_WPP = 43 * MiB, WS_WD = 44 * MiB, WS_WGU = 172 * MiB;
constexpr size_t WS_PB = 428 * MiB;
constexpr size_t WS_XA = 492 * MiB, WS_XB = 620 * MiB;
constexpr size_t WS_XA8 = 1276 * MiB + 384 * MiB;
constexpr size_t WS_XB8 = 1276 * MiB + 128 * MiB;
constexpr size_t WS_XT8 = 1276 * MiB + 448 * MiB;
constexpr size_t WS_XT = 1276 * MiB + 256 * MiB;
constexpr size_t WS_HS = 748 * MiB;
constexpr size_t WS_ACT = 1276 * MiB;
constexpr size_t WS_SS = 1804 * MiB;
constexpr size_t WS_SLOTT = 1828 * MiB;
constexpr size_t WS_DUMMY = 1830 * MiB;
constexpr size_t WS_END = 1832 * MiB;
constexpr size_t SSA = (size_t)NTOK * 16;
static_assert(WS_HS + (size_t)MAXT * 256 * D * 2 <= WS_ACT && WS_ACT + (size_t)MAXT * 256 * D * 2 <= WS_SS && WS_SS + 6 * SSA * 4 <= WS_SLOTT && WS_SLOTT + (size_t)MAXT * 256 * 4 <= WS_DUMMY, "d_ws map");
static_assert(WS_WGU + (size_t)2 * 32 * 2048 * 1024 * 2 <= WS_PB && WS_WD + (size_t)2 * 32 * 1024 * 1024 * 2 <= WS_WGU && WS_WQKV + (size_t)3328 * 1024 * 2 <= WS_WPG, "d_ws map (weights)");
constexpr int CW_TMO = 0, CW_BAR = 4096, CW_NRM = 8192;

constexpr int RING_OFF = 0, RING_BYTES = 131072;
constexpr int EPI_OFF = RING_BYTES, LDSCTL_OFF = EPI_OFF + 8 * pg8::EPW, MISC_OFF = LDSCTL_OFF + 320, TP_OFF = LDSCTL_OFF + 1024;
constexpr int LDS_BYTES = LDSCTL_OFF + 4096;
static_assert(attn_body::ATTN_LDS_BYTES <= RING_BYTES, "attention LDS");

__device__ __forceinline__ float wave_sum(float v) {
#pragma unroll
    for (int o = 1; o < 64; o <<= 1) v += __shfl_xor(v, o);
    return v;
}
__device__ __forceinline__ float dot4f(const f32x4& a) { return (a[0] * a[0] + a[1] * a[1]) + (a[2] * a[2] + a[3] * a[3]); }
__device__ __forceinline__ float rstd_tok(const float* ssp, size_t t) { float v[16];
#pragma unroll
    for (int k = 0; k < 16; ++k) v[k] = ssp[(size_t)k * NTOK + t];
    return pg8::rstd_of(pg8::sum16(v)); }
__device__ __forceinline__ float bflo(unsigned w) { return __builtin_bit_cast(float, w << 16); }
__device__ __forceinline__ float bfhi(unsigned w) { return __builtin_bit_cast(float, w & 0xffff0000u); }

__device__ __forceinline__ void conv_item(const float* W, int ldw, int k0, int n0, int nvalid, bf16* WT, int ldk, int drow0, const float* gain, LAS float* scr, int lane) {
    const bool ok = (lane & 31) < nvalid;
#pragma unroll 8
    for (int i = 0; i < 32; ++i) { const int kk = 2 * i + (lane >> 5); scr[kk * 33 + (lane & 31)] = ok ? W[(size_t)(k0 + kk) * ldw + n0 + (lane & 31)] : 0.f; }
    LDS_WAIT(); asm volatile("" ::: "memory");
    const int c = lane & 7;
    float gv[8];
#pragma unroll
    for (int i = 0; i < 8; ++i) gv[i] = gain ? gain[k0 + 8 * c + i] : 1.f;
#pragma unroll
    for (int j = 0; j < 4; ++j) { const int n = (lane >> 3) + 8 * j; const LAS float* s = scr + (8 * c) * 33 + n;
        v4u o; o.x = pk2(s[0 * 33] * gv[0], s[1 * 33] * gv[1]); o.y = pk2(s[2 * 33] * gv[2], s[3 * 33] * gv[3]); o.z = pk2(s[4 * 33] * gv[4], s[5 * 33] * gv[5]); o.w = pk2(s[6 * 33] * gv[6], s[7 * 33] * gv[7]);
        *(GAS v4u*)(WT + (size_t)(drow0 + n) * ldk + k0 + 8 * c) = o; }
    LDS_WAIT(); asm volatile("" ::: "memory");
}

__device__ __forceinline__ void conv_item8(const float* W, int ldw, int k0, int n0, unsigned char* WT, int ldk, int drow0, const float* gain, float wscale, LAS float* scr, int lane, int nvalid = 32) {
    { const int c8 = lane & 7, r8 = lane >> 3; const bool ok = 4 * c8 < nvalid; f32x4 wv[8];
      const float* wp = W + (size_t)(k0 + r8) * ldw + n0 + 4 * c8;
#pragma unroll
      for (int i = 0; i < 8; ++i) wv[i] = ok ? *(const f32x4*)(wp + (size_t)(8 * i) * ldw) : (f32x4){0.f, 0.f, 0.f, 0.f};
#pragma unroll
      for (int i = 0; i < 8; ++i)
#pragma unroll
          for (int j = 0; j < 4; ++j) scr[(r8 + 8 * i) * 33 + 4 * c8 + j] = wv[i][j]; }
    LDS_WAIT(); asm volatile("" ::: "memory");
    const int c = lane & 3, nn = lane >> 2;
    float gv[16];
#pragma unroll
    for (int i = 0; i < 16; ++i) gv[i] = (gain ? gain[k0 + 16 * c + i] : 1.f) * wscale;
#pragma unroll
    for (int j = 0; j < 2; ++j) { const int n = nn + 16 * j; const LAS float* s = scr + (16 * c) * 33 + n; pg8::u32x4 o;
#pragma unroll
        for (int q = 0; q < 4; ++q) { unsigned w0 = 0u;
            w0 = __builtin_amdgcn_cvt_pk_fp8_f32(s[(4 * q) * 33] * gv[4 * q], s[(4 * q + 1) * 33] * gv[4 * q + 1], w0, false); w0 = __builtin_amdgcn_cvt_pk_fp8_f32(s[(4 * q + 2) * 33] * gv[4 * q + 2], s[(4 * q + 3) * 33] * gv[4 * q + 3], w0, true); o[q] = w0; }
        *(pg8::u32x4*)(WT + (size_t)(drow0 + n) * ldk + k0 + 16 * c) = o; }
    LDS_WAIT(); asm volatile("" ::: "memory");
}

__device__ __forceinline__ void rstd8(const f32x4 (&xs)[8], LAS float* part  , int hw, int lane, float (&rs)[8]) {
    float p[8];
#pragma unroll
    for (int j = 0; j < 8; ++j) p[j] = wave_sum(dot4f(xs[j]));
    if (lane == 0) {
#pragma unroll
        for (int j = 0; j < 8; ++j) part[j * 4 + hw] = p[j]; }
    __syncthreads();
#pragma unroll
    for (int j = 0; j < 8; ++j) { const f32x4 q = *(const LAS f32x4*)(part + j * 4); rs[j] = pg8::rstd_of((q[0] + q[1]) + (q[2] + q[3])); }
}
template <int W> __device__ __forceinline__ void pool_run(const float* x, int t0, int c4, bool has_prev, int pos0, f32x4 g, bf16* diff, LAS float* part2  , int& buf, int hw, int lane) {
    f32x4 hh[16]; f32x4 xs[8], xn[8]; float rs[8];
#pragma unroll
    for (int hc = 0; hc < 2; ++hc) {
#pragma unroll
        for (int j = 0; j < 8; ++j) xs[j] = has_prev ? *(const f32x4*)(x + (size_t)(t0 - 16 + hc * 8 + j) * D + c4) : (f32x4){0.f, 0.f, 0.f, 0.f};
        rstd8(xs, part2 + buf * 32, hw, lane, rs); buf ^= 1;
#pragma unroll
        for (int j = 0; j < 8; ++j) hh[hc * 8 + j] = xs[j] * rs[j] * g;
    }
    f32x4 S = (f32x4){0.f, 0.f, 0.f, 0.f};
#pragma unroll
    for (int i = 16 - W; i < 16; ++i) S += hh[i];
#pragma unroll
    for (int j = 0; j < 8; ++j) xn[j] = *(const f32x4*)(x + (size_t)(t0 + j) * D + c4);
#pragma unroll 1
    for (int cb = 0; cb < 8; ++cb) {
        f32x4 hn[8];
#pragma unroll
        for (int j = 0; j < 8; ++j) xs[j] = xn[j];
        if (cb < 7) {
#pragma unroll
            for (int j = 0; j < 8; ++j) xn[j] = *(const f32x4*)(x + (size_t)(t0 + (cb + 1) * 8 + j) * D + c4); }
        rstd8(xs, part2 + buf * 32, hw, lane, rs); buf ^= 1;
#pragma unroll
        for (int j = 0; j < 8; ++j) {
            hn[j] = xs[j] * rs[j] * g;
            const f32x4 old = (j - W >= 0) ? hn[(j - W >= 0) ? j - W : 0] : hh[(16 + j - W) & 15];
            S = S + hn[j] - old;
            const int pos = pos0 + cb * 8 + j; const int cnt = (pos + 1 < W) ? pos + 1 : W; const float inv = 1.0f / (float)cnt;
            const f32x4 dv = S * inv - hn[j];
            unsigned long long o = (unsigned long long)pk2(dv[0], dv[1]) | ((unsigned long long)pk2(dv[2], dv[3]) << 32);
            *(GAS unsigned long long*)(diff + (size_t)(t0 + cb * 8 + j) * D + c4) = o;
        }
#pragma unroll
        for (int i = 0; i < 8; ++i) hh[i] = hh[i + 8];
#pragma unroll
        for (int i = 0; i < 8; ++i) hh[8 + i] = hn[i];
    }
}

struct Args { const float* in[24]; float* out; unsigned char* ws; int ph_lo, ph_hi; };
enum { I_X = 0, I_P, I_NMIX, I_NFFN, I_NPLE, I_NFIN, I_POOLW, I_POOLS, I_KVN, I_WK, I_WV, I_WF, I_BF, I_WQ, I_WO, I_RW, I_RB, I_WGU, I_BGU, I_WD, I_BD, I_PWG, I_PBG, I_PWP };
#define WSP(T, off) ((T*)(args.ws + (off)))
#ifdef ONLY
#define PHON(n) ((n) == ONLY)
#else
#define PHON(n) true
#endif
#define IN(k) (lo <= (k) && (k) < hi)
#define NREP(bit) ((((PROBE_MASK) >> (bit)) & 1) ? 2 : 1)
#define SEAM(k) do { if (IN(k) && IN((k) + 1)) xcd_barrier(bar); } while (0)
#define FRESH_IDS() int tid = threadIdx.x; asm volatile("" : "+v"(tid)); const int lane = tid & 63, wave = __builtin_amdgcn_readfirstlane(tid >> 6); (void)lane; (void)wave; \
    const int G = gridDim.x, bx = blockIdx.x; const int vcu = (G % 8 == 0) ? (bx % 8) * (G / 8) + bx / 8 : bx; const int gw = vcu * NWAVES + wave, NGW = G * NWAVES; (void)gw; (void)NGW; (void)vcu

__device__ __forceinline__ void phase_prologue(const Args& args, LAS unsigned char* lds) {
    FRESH_IDS();
    const float* norm_ffn = args.in[I_NFFN];
    unsigned char* Wqkv8 = WSP(unsigned char, WS_WQKV); bf16* Wrouter = WSP(bf16, WS_WROUTER);
    LAS float* scr = (LAS float*)(lds + RING_OFF + wave * 16384);
    constexpr int I_GU = 2 * 32 * 1024, I_D = 2 * 32 * 512, I_PG = 2 * 512, I_PP = 2 * 128, I_SQ = 512, I_F = 16, I_POOL = 128, I_R = 32;
    constexpr int NITEMS = I_GU + I_D + I_PG + I_PP + 4 * I_SQ + I_F + I_POOL + I_R;
    for (int it = gw; it < NITEMS; it += NGW) {
        int r = it;
        if (r < I_GU) { const int le = r >> 10, q = r & 1023, kb = q >> 6, nb = q & 63, n0 = nb * 32;
            const int drow0 = 256 * ((n0 & 1023) >> 7) + 64 * ((n0 & 127) >> 5) + 32 * (n0 >> 10);
            conv_item8(args.in[I_WGU] + (size_t)le * 1024 * 2048, 2048, kb * 64, n0, WSP(unsigned char, WS_WGU) + (size_t)le * 2048 * 1024, 1024, drow0, norm_ffn + (le >> 5) * 1024, (n0 < 1024) ? WSCALE8 * pg8::SW_A2 : WSCALE8, scr, lane); continue; } r -= I_GU;
        if (r < I_D) { const int le = r >> 9, q = r & 511, kb = q >> 5, nb = q & 31;
            conv_item8(args.in[I_WD] + (size_t)le * 1024 * 1024, 1024, kb * 64, nb * 32, WSP(unsigned char, WS_WD) + (size_t)le * 1024 * 1024, 1024, nb * 32, nullptr, WSCALE8, scr, lane); continue; } r -= I_D;
        if (r < I_PG) { const int l = r >> 9, q = r & 511, kb = q >> 5, nb = q & 31;
            conv_item8(args.in[I_PWG] + (size_t)l * 1024 * 1024, 1024, kb * 64, nb * 32, WSP(unsigned char, WS_WPG) + (size_t)l * 1024 * 1024, 1024, nb * 32, args.in[I_NPLE] + l * 1024, WSCALE8, scr, lane); continue; } r -= I_PG;
        if (r < I_PP) { const int l = r >> 7, q = r & 127, kb = q >> 5, nb = q & 31;
            conv_item(args.in[I_PWP] + (size_t)l * 256 * 1024, 1024, kb * 64, nb * 32, 32, WSP(bf16, WS_WPP) + (size_t)l * 1024 * 256, 256, nb * 32, nullptr, scr, lane); continue; } r -= I_PP;
        if (r < 4 * I_SQ) { const int w = r >> 9, q = r & 511, kb = q >> 5, nb = q & 31;
            const float* src = args.in[w == 0 ? I_WQ : (w == 1 ? I_WK : (w == 2 ? I_WV : I_WO))]; const float* gn = w == 0 ? args.in[I_NMIX] + 1024 : args.in[I_KVN];
            if (w == 3) conv_item8(src, 1024, kb * 64, nb * 32, WSP(unsigned char, WS_WO), 1024, nb * 32, nullptr, WSCALE8, scr, lane);
            else conv_item8(src, 1024, kb * 64, nb * 32, Wqkv8 + (size_t)w * 1024 * 1024, 1024, nb * 32, gn, WSCALE8, scr, lane);
            continue; } r -= 4 * I_SQ;
        if (r < I_F) { conv_item8(args.in[I_WF], 16, r * 64, 0, Wqkv8 + (size_t)3072 * 1024, 1024, 0, args.in[I_KVN], WSCALE8, scr, lane, 16); continue; } r -= I_F;
        if (r < I_POOL) { const int g = r >> 5, q = r & 31, kb = q >> 3, nb = q & 7;
            conv_item(args.in[I_POOLW] + (size_t)g * 256 * 256, 256, kb * 64, nb * 32, 32, WSP(bf16, WS_WPOOL) + (size_t)g * 256 * 256, 256, nb * 32, nullptr, scr, lane); continue; } r -= I_POOL;
        { const int l = r >> 4, kb = r & 15;
            conv_item(args.in[I_RW] + (size_t)l * 1024 * 32, 32, kb * 64, 0, 32, Wrouter + (size_t)l * 256 * 1024, 1024, 0, norm_ffn + l * 1024, scr, lane); }
    }
    {
        const int gt = vcu * NWAVES * 64 + tid, NGT = G * NWAVES * 64; const v4u z = (v4u){0u, 0u, 0u, 0u};
        for (int i = gt; i < 2 * 224 * 128; i += NGT) { const int l = i / (224 * 128), q = i % (224 * 128); *(GAS v4u*)(Wrouter + (size_t)l * 256 * 1024 + (size_t)32 * 1024 + (size_t)q * 8) = z; }
        for (int i = gt; i < 224 * 64; i += NGT) *(GAS v4u*)(Wqkv8 + (size_t)3104 * 1024 + (size_t)i * 16) = z;
        { const float* bgu = args.in[I_BGU]; const float* bd = args.in[I_BD]; bf16* o1 = WSP(bf16, WS_BGU16); bf16* o2 = WSP(bf16, WS_BD16);
          for (int i = gt; i < 2 * 32 * 2048 / 2; i += NGT) { const bool gate = ((2 * i) & 2047) < 1024; ((GAS unsigned*)o1)[i] = gate ? pk2(bgu[2 * i] * pg8::SW_A2, bgu[2 * i + 1] * pg8::SW_A2) : pk2(bgu[2 * i] + 1.0f, bgu[2 * i + 1] + 1.0f); }
          for (int i = gt; i < 2 * 32 * 1024 / 2; i += NGT) ((GAS unsigned*)o2)[i] = pk2(bd[2 * i], bd[2 * i + 1]); }
        const float* p_in = args.in[I_P]; bf16* PB = WSP(bf16, WS_PB);
        for (size_t i = gt; i < (size_t)2 * NTOK * PLE / 8; i += NGT) { const f32x4 a = *(const f32x4*)(p_in + i * 8), b = *(const f32x4*)(p_in + i * 8 + 4);
            v4u o; o.x = pk2(a[0], a[1]); o.y = pk2(a[2], a[3]); o.z = pk2(b[0], b[1]); o.w = pk2(b[2], b[3]); *(GAS v4u*)(PB + i * 8) = o; }
    }
    __syncthreads();
    {
        const float* x_in = args.in[I_X]; bf16* DIFF = WSP(bf16, WS_ACT);
        const int half = tid >> 8, ht = tid & 255, hw = wave & 3, c4 = ht * 4;
        LAS float* part2 = (LAS float*)(lds + RING_OFF) + half * 64;
        const f32x4 g = *(const f32x4*)(args.in[I_NMIX] + c4);
        const int grp = __builtin_amdgcn_readfirstlane(ht >> 6);
        int buf = 0;
        for (int it = bx; it < NTOK / 128; it += G) {
            const int t0 = (it * 2 + half) * 64, pos0 = t0 & (SEQ - 1); const bool has_prev = pos0 != 0;
            if (grp == 0) pool_run<2>(x_in, t0, c4, has_prev, pos0, g, DIFF, part2, buf, hw, lane);
            else if (grp == 1) pool_run<4>(x_in, t0, c4, has_prev, pos0, g, DIFF, part2, buf, hw, lane);
            else if (grp == 2) pool_run<8>(x_in, t0, c4, has_prev, pos0, g, DIFF, part2, buf, hw, lane);
            else pool_run<16>(x_in, t0, c4, has_prev, pos0, g, DIFF, part2, buf, hw, lane);
        }
        __syncthreads();
    }
}

template <int LAYER> __device__ __forceinline__ void ple_phase(const Args& args, LAS unsigned char* lds) {
    constexpr int SSM = LAYER == 0 ? 0 : 3; constexpr size_t XT_OFF = WS_XT, XN_OFF = WS_XB;
        { FRESH_IDS();
          pg8::Gemm g{WSP(bf16, WS_PB) + (size_t)LAYER * NTOK * PLE, WSP(bf16, WS_WPP) + (size_t)LAYER * 1024 * 256, PLE, PLE, PLE, STAG_PJ}; pg8::DenseOrder S; S.init(NTOK / 256, 4, G, bx, PLE, PLE, 0);
          pg8::EpiStore E{WSP(unsigned char, WS_ACT)};
          pg8::gemm_phase<pg8::EpiStore, pg8::DenseOrder>(lds + RING_OFF, lds + EPI_OFF, g, S, E); }
        VM_WAIT(); __syncthreads();
        { FRESH_IDS();
          pg8::Gemm g{(const pg8::bf16_t*)WSP(unsigned char, WS_XT8), (const pg8::bf16_t*)(WSP(unsigned char, WS_WPG) + (size_t)LAYER * 1024 * 1024), D, D, D, STAG_PLE, nullptr, WSP(unsigned char, WS_DUMMY)}; pg8::DenseOrder S; S.init(NTOK / 256, 4, G, bx, D, D, 0, 1);
          pg8::EpiPle E{args.in[I_PBG] + LAYER * 1024, WSP(unsigned char, WS_ACT), WSP(bf16, XT_OFF), WSP(bf16, XN_OFF), WSP(float, WS_SS) + (size_t)(SSM + 2) * SSA, LAYER == 0 ? WSP(unsigned char, WS_XB8) : (unsigned char*)nullptr};
          pg8::gemm_phase<pg8::EpiPle, pg8::DenseOrder, false, 1>(lds + RING_OFF, lds + EPI_OFF, g, S, E); }
}

template <int LAYER> __device__ __forceinline__ void moe_ple_block(const Args& args, LAS unsigned char* lds, const XcdBarrier& bar, const int lo, const int hi) {
    constexpr int PBASE = LAYER == 0 ? 2 : 13, SSM = LAYER == 0 ? 0 : 3;
    constexpr size_t XC_OFF = WS_XA, XT_OFF = WS_XT, XN_OFF = WS_XB;
    if (IN(PBASE) && PHON(2)) for (int rep_ = 0; rep_ < NREP(2); ++rep_) {
        FRESH_IDS();
        pg8::Gemm g{WSP(bf16, XC_OFF), WSP(bf16, WS_WROUTER) + (size_t)LAYER * 256 * 1024, D, D, D, 0}; pg8::DenseOrder S; S.init(NTOK / 256, 1, G, bx, D, D, 0);
        pg8::EpiRouter E{WSP(float, WS_SS) + (size_t)SSM * SSA, args.in[I_RB] + LAYER * 32, WSP(float, WS_LOGITS)};
        pg8::gemm_phase<pg8::EpiRouter, pg8::DenseOrder>(lds + RING_OFF, lds + EPI_OFF, g, S, E);
        VM_WAIT(); __syncthreads(); __builtin_amdgcn_fence(__ATOMIC_ACQUIRE, "agent"); VM_WAIT(); __syncthreads();
        const float* LOGITS = WSP(float, WS_LOGITS); unsigned* TOKE = WSP(unsigned, WS_TOKE); float* TOKG = WSP(float, WS_TOKG); int* CH = WSP(int, WS_META);
        LAS int* hist = (LAS int*)(lds + RING_OFF);
        pg8::Unit uu;
        for (int ui = 0; S.next(ui, uu); ++ui) { const int ch = uu.pm;
            if (tid < 32) hist[tid] = 0;
            __syncthreads();
            if (tid < 256) {
                const int t = ch * 256 + tid; float v[32];
#pragma unroll
                for (int j = 0; j < 8; ++j) { const f32x4 q = *(const f32x4*)(LOGITS + (size_t)t * 32 + 4 * j); v[4 * j] = q[0]; v[4 * j + 1] = q[1]; v[4 * j + 2] = q[2]; v[4 * j + 3] = q[3]; }
                float sv[4]; int si[4]; float pv = INFINITY; int pi = -1;
#pragma unroll
                for (int k = 0; k < 4; ++k) { float bv = -INFINITY; int bi = 0;
#pragma unroll
                    for (int i = 0; i < 32; ++i) { const bool after = (v[i] < pv) || (v[i] == pv && i > pi); if (after && v[i] > bv) { bv = v[i]; bi = i; } }
                    sv[k] = bv; si[k] = bi; pv = bv; pi = bi; }
                const float e1 = __expf(sv[1] - sv[0]), e2 = __expf(sv[2] - sv[0]), e3 = __expf(sv[3] - sv[0]); const float inv = 1.0f / (1.0f + e1 + e2 + e3);
                TOKE[t] = (unsigned)si[0] | ((unsigned)si[1] << 8) | ((unsigned)si[2] << 16) | ((unsigned)si[3] << 24);
                *(f32x4*)(TOKG + (size_t)t * 4) = (f32x4){inv, e1 * inv, e2 * inv, e3 * inv};
#pragma unroll
                for (int k = 0; k < 4; ++k) atomicAdd((int*)(hist + si[k]), 1);
            }
            __syncthreads();
            if (tid < 32) CH[ch * 32 + tid] = hist[tid];
            __syncthreads();
        }
    }
    if (IN(PBASE) && IN(PBASE + 2)) xcd_barrier(bar);
    if (IN(PBASE + 2) && PHON(4)) for (int rep_ = 0; rep_ < NREP(4); ++rep_) {
        FRESH_IDS();
        const int* CH = WSP(int, WS_META); int* TPg = WSP(int, WS_META + 65536); const unsigned* TOKE = WSP(unsigned, WS_TOKE); const float* TOKG = WSP(float, WS_TOKG); int* TOKPOS = WSP(int, WS_TOKPOS);
        float* SLOTG = WSP(float, WS_SLOTG); const float* ss_mix = WSP(float, WS_SS) + (size_t)SSM * SSA; int* SLOTT = WSP(int, WS_SLOTT); float* SLOTR = WSP(float, WS_SLOTR);
        LAS int* ptot = (LAS int*)(lds + RING_OFF); LAS int* pbef = ptot + 256; LAS int* ntile = pbef + 256; LAS int* befl = ntile + 32; LAS int* tpl = befl + 32; LAS int* lcur = tpl + 64; LAS int* lpos = lcur + 32;
        for (int ch = bx; ch < NCHUNK; ch += G) {
            if (tid < 256) { const int e = tid & 31, part = tid >> 5; int tot = 0, bef = 0;
                for (int c2 = part * 32; c2 < part * 32 + 32; ++c2) { const int v = CH[c2 * 32 + e]; tot += v; bef += (c2 < ch) ? v : 0; }
                ptot[part * 32 + e] = tot; pbef[part * 32 + e] = bef; }
            __syncthreads();
            if (tid < 32) { int tot = 0, bef = 0;
#pragma unroll
                for (int q = 0; q < 8; ++q) { tot += ptot[q * 32 + tid]; bef += pbef[q * 32 + tid]; }
                ntile[tid] = (tot + 255) >> 8; befl[tid] = bef; }
            __syncthreads();
            if (tid == 0) { int a = 0; for (int e = 0; e < 32; ++e) { tpl[e] = a; a += ntile[e]; } tpl[32] = a; }
            __syncthreads();
            if (tid < 32) lcur[tid] = tpl[tid] * 256 + befl[tid];
            if (ch == 0 && tid < 33) TPg[tid] = tpl[tid];
            __syncthreads();
            LAS int* wcnt = lpos + 1024;
            unsigned ev = 0u; int rk[4] = {0, 0, 0, 0};
            if (tid < 256) { ev = TOKE[ch * 256 + tid];
                const int e0 = ev & 255, e1 = (ev >> 8) & 255, e2 = (ev >> 16) & 255, e3 = (ev >> 24) & 255;
                const unsigned mask = (1u << e0) | (1u << e1) | (1u << e2) | (1u << e3);
                const unsigned long long below = (1ull << lane) - 1ull;
#pragma unroll 1
                for (int e = 0; e < 32; ++e) { const unsigned long long bal = __ballot((mask >> e) & 1u); const int r = __popcll(bal & below);
                    if (e0 == e) rk[0] = r; if (e1 == e) rk[1] = r; if (e2 == e) rk[2] = r; if (e3 == e) rk[3] = r;
                    if (lane == 0) wcnt[wave * 32 + e] = __popcll(bal); } }
            __syncthreads();
            if (tid < 256) { const int t = ch * 256 + tid; const f32x4 gv = *(const f32x4*)(TOKG + (size_t)t * 4); const float rst = rstd_tok(ss_mix, (size_t)t);
                int ps[4];
#pragma unroll
                for (int k = 0; k < 4; ++k) { const int e = (ev >> (8 * k)) & 255; int pos = lcur[e] + rk[k];
                    for (int w = 0; w < wave; ++w) pos += wcnt[w * 32 + e];
                    ps[k] = pos; SLOTG[pos] = gv[k]; SLOTT[pos] = t; SLOTR[pos] = rst; }
                *(GAS v4u*)(TOKPOS + (size_t)t * 4) = (v4u){(unsigned)ps[0], (unsigned)ps[1], (unsigned)ps[2], (unsigned)ps[3]}; }
            __syncthreads();
        }
    }
    SEAM(PBASE + 2);
    if (IN(PBASE + 3) && PHON(5)) for (int rep_ = 0; rep_ < NREP(5); ++rep_) {
        FRESH_IDS();
        LAS int* tpl = (LAS int*)(lds + TP_OFF);
        if (tid < 33) tpl[tid] = (int)__hip_atomic_load(WSP(gu32, WS_META + 65536) + tid, RLX_AGENT);
        __syncthreads();
        { LAS unsigned char* te = (LAS unsigned char*)(tpl + 64); const int nT = tpl[32];
          for (int j = tid; j < nT; j += NWAVES * 64) { int e = 0; for (int k = 1; k < 32; ++k) e += (tpl[k] <= j) ? 1 : 0; te[j] = (unsigned char)e; } }
        __syncthreads();
        pg8::Gemm g{(const pg8::bf16_t*)WSP(unsigned char, WS_XA8), (const pg8::bf16_t*)(WSP(unsigned char, WS_WGU) + (size_t)LAYER * 32 * 2048 * 1024), D, D, D, STAG_GU, WSP(int, WS_SLOTT), WSP(unsigned char, WS_DUMMY)}; pg8::GroupedOrder S; S.init(tpl, 8, G, bx, D, D, 2048, 1);
        pg8::EpiSwiGLU E{WSP(bf16, WS_BGU16) + (size_t)LAYER * 32 * 2048, WSP(unsigned char, WS_ACT), WSP(float, WS_SLOTR)};
        pg8::gemm_phase<pg8::EpiSwiGLU, pg8::GroupedOrder, true, 1>(lds + RING_OFF, lds + EPI_OFF, g, S, E);
    }
    SEAM(PBASE + 3);
    if (IN(PBASE + 4) && PHON(6)) for (int rep_ = 0; rep_ < NREP(6); ++rep_) {
        FRESH_IDS();
        LAS int* tpl = (LAS int*)(lds + TP_OFF);
        if (tid < 33) tpl[tid] = (int)__hip_atomic_load(WSP(gu32, WS_META + 65536) + tid, RLX_AGENT);
        __syncthreads();
        { LAS unsigned char* te = (LAS unsigned char*)(tpl + 64); const int nT = tpl[32];
          for (int j = tid; j < nT; j += NWAVES * 64) { int e = 0; for (int k = 1; k < 32; ++k) e += (tpl[k] <= j) ? 1 : 0; te[j] = (unsigned char)e; } }
        __syncthreads();
        pg8::Gemm g{(const pg8::bf16_t*)WSP(unsigned char, WS_ACT), (const pg8::bf16_t*)(WSP(unsigned char, WS_WD) + (size_t)LAYER * 32 * 1024 * 1024), D, D, D, STAG_DOWN, nullptr, WSP(unsigned char, WS_DUMMY)}; pg8::GroupedOrder S; S.init(tpl, 4, G, bx, D, D, 1024, 1);
        pg8::EpiDown E{WSP(float, WS_SLOTG), WSP(bf16, WS_BD16) + (size_t)LAYER * 32 * 1024, WSP(unsigned char, WS_HS)};
        pg8::gemm_phase<pg8::EpiDown, pg8::GroupedOrder, false, 1>(lds + RING_OFF, lds + EPI_OFF, g, S, E);
    }
    SEAM(PBASE + 4);
    if (IN(PBASE + 5) && PHON(7)) for (int rep_ = 0; rep_ < NREP(7); ++rep_) {
        FRESH_IDS();
        const int* TOKPOS = WSP(int, WS_TOKPOS); const bf16* Xc = WSP(bf16, XC_OFF); bf16* Xt = WSP(bf16, XT_OFF); const unsigned char* Y8 = WSP(unsigned char, WS_HS); unsigned char* Xt8 = WSP(unsigned char, WS_XT8); float* ss_moe = WSP(float, WS_SS) + (size_t)(SSM + 1) * SSA;
        for (int t = gw; t < NTOK; t += NGW) {
            const v4u ps = *(const GAS v4u*)(TOKPOS + (size_t)t * 4);
            const bf16* xr = Xc + (size_t)t * D + lane * 16; bf16* xo = Xt + (size_t)t * D + lane * 16; float sq = 0.f;
            const v4u xw0 = *(const GAS v4u*)(xr), xw1 = *(const GAS v4u*)(xr + 8);
            v4u yw[4];
#pragma unroll
            for (int k = 0; k < 4; ++k) { const unsigned pos = k == 0 ? ps.x : (k == 1 ? ps.y : (k == 2 ? ps.z : ps.w)); yw[k] = *(const GAS v4u*)(Y8 + (size_t)pos * D + lane * 16); }
            float a[16] = {bflo(xw0.x), bfhi(xw0.x), bflo(xw0.y), bfhi(xw0.y), bflo(xw0.z), bfhi(xw0.z), bflo(xw0.w), bfhi(xw0.w), bflo(xw1.x), bfhi(xw1.x), bflo(xw1.y), bfhi(xw1.y), bflo(xw1.z), bfhi(xw1.z), bflo(xw1.w), bfhi(xw1.w)};
#pragma unroll
            for (int k = 0; k < 4; ++k) {
#pragma unroll
                for (int w = 0; w < 4; ++w) { const unsigned wd = w == 0 ? yw[k].x : (w == 1 ? yw[k].y : (w == 2 ? yw[k].z : yw[k].w));
                    const pg8::f32x2 lo = __builtin_amdgcn_cvt_pk_f32_fp8((int)wd, false), hi = __builtin_amdgcn_cvt_pk_f32_fp8((int)wd, true);
                    a[4 * w] += lo.x * pg8::YSINV; a[4 * w + 1] += lo.y * pg8::YSINV; a[4 * w + 2] += hi.x * pg8::YSINV; a[4 * w + 3] += hi.y * pg8::YSINV; } }
#pragma unroll
            for (int j = 0; j < 16; ++j) sq += a[j] * a[j];
            { v4u o; o.x = pk2(a[0], a[1]); o.y = pk2(a[2], a[3]); o.z = pk2(a[4], a[5]); o.w = pk2(a[6], a[7]); *(GAS v4u*)(xo) = o;
              o.x = pk2(a[8], a[9]); o.y = pk2(a[10], a[11]); o.z = pk2(a[12], a[13]); o.w = pk2(a[14], a[15]); *(GAS v4u*)(xo + 8) = o; }
            sq = wave_sum(sq);
            { const float rs = pg8::rstd_of(sq);
              v4u o8;
#pragma unroll
              for (int w = 0; w < 4; ++w) { unsigned w0 = 0u; w0 = __builtin_amdgcn_cvt_pk_fp8_f32(a[4 * w] * rs, a[4 * w + 1] * rs, w0, false); w0 = __builtin_amdgcn_cvt_pk_fp8_f32(a[4 * w + 2] * rs, a[4 * w + 3] * rs, w0, true);
                if (w == 0) o8.x = w0; else if (w == 1) o8.y = w0; else if (w == 2) o8.z = w0; else o8.w = w0; }
              *(GAS v4u*)(Xt8 + (size_t)t * D + lane * 16) = o8; }
            (void)ss_moe;
        }
    }
    SEAM(PBASE + 5);
    if (IN(PBASE + 6) && PHON(8)) { if (NREP(8) == 2) ple_phase<LAYER>(args, lds); ple_phase<LAYER>(args, lds); }
    SEAM(PBASE + 6);
}

__global__ void __launch_bounds__(NWAVES * 64, 2) yoco_fwd(Args args) {
    extern __shared__ __attribute__((aligned(16))) unsigned char lds_raw[];
    LAS unsigned char* lds = (LAS unsigned char*)lds_raw;
    volatile LAS unsigned* MISC = (volatile LAS unsigned*)(lds + MISC_OFF);
    for (int u = threadIdx.x; u < (LDS_BYTES - LDSCTL_OFF) / 4; u += NWAVES * 64) ((LAS unsigned*)(lds + LDSCTL_OFF))[u] = 0u;
    __syncthreads();
    XcdBarrier bar; bar.bar = (unsigned*)(WSP(gu32, WS_CTL) + CW_BAR); bar.x = 0; bar.st = nullptr;
    if (!MK_PER_PHASE) bar = xcd_barrier_post((unsigned*)(WSP(gu32, WS_CTL) + CW_BAR), MISC + 8);
#if MK_PER_PHASE
    const int lo = args.ph_lo, hi = args.ph_hi;
#else
    constexpr int lo = 0, hi = N_PHASES;
#endif

    if (IN(0) && PHON(0)) for (int rep_ = 0; rep_ < NREP(0); ++rep_) phase_prologue(args, lds);
    SEAM(0);
    if (IN(1) && PHON(1)) for (int rep_ = 0; rep_ < NREP(1); ++rep_) {
        FRESH_IDS();
        pg8::Gemm g{WSP(bf16, WS_ACT), WSP(bf16, WS_WPOOL), D, 256, 256, STAG_POOL}; pg8::DenseOrder S; S.init(NTOK / 256, 4, G, bx, D, 256, 256);
        pg8::EpiPool E{args.in[I_X], args.in[I_POOLS], WSP(bf16, WS_XA), WSP(float, WS_SS), WSP(unsigned char, WS_XA8)};
        pg8::gemm_phase<pg8::EpiPool, pg8::DenseOrder>(lds + RING_OFF, lds + EPI_OFF, g, S, E);
    }
    SEAM(1);
    moe_ple_block<0>(args, lds, bar, lo, hi);
    if (IN(9) && PHON(9)) for (int rep_ = 0; rep_ < NREP(9); ++rep_) {
        FRESH_IDS();
        pg8::Gemm g{(const pg8::bf16_t*)WSP(unsigned char, WS_XB8), (const pg8::bf16_t*)WSP(unsigned char, WS_WQKV), D, D, D, STAG_QKV, nullptr, WSP(unsigned char, WS_DUMMY)}; pg8::DenseOrder S; S.init(NTOK / 256, 13, G, bx, D, D, 0, 1);
        pg8::EpiQkv E{WSP(float, WS_SS) + (size_t)2 * SSA, WSP(bf16, WS_HS), args.in[I_BF], WSP(float, WS_LF), attn_body::C2, WSP(float, WS_NRM)};
        pg8::gemm_phase<pg8::EpiQkv, pg8::DenseOrder, false, 1>(lds + RING_OFF, lds + EPI_OFF, g, S, E);
    }
    SEAM(9);
    if (IN(10) && PHON(10)) for (int rep_ = 0; rep_ < NREP(10); ++rep_) {
        FRESH_IDS();
        const float* LF = WSP(float, WS_LF); float* BIAS = WSP(float, WS_BIAS);
        LAS float* wtot = (LAS float*)(lds + RING_OFF);
        for (int item = bx; item < NB * NH; item += G) {
            const int b = item >> 4, h = item & 15; const int s0 = tid * 16; float v[16]; float run = 0.f;
#pragma unroll
            for (int j = 0; j < 16; ++j) { run += LF[(size_t)(b * SEQ + s0 + j) * 16 + h]; v[j] = run; }
            float incl = run;
#pragma unroll
            for (int o = 1; o < 64; o <<= 1) { const float n = __shfl_up(incl, o); if (lane >= o) incl += n; }
            if (lane == 63) wtot[wave] = incl;
            __syncthreads();
            float base = incl - run;
            for (int w = 0; w < wave; ++w) base += wtot[w];
            float* o = BIAS + (size_t)item * SEQ + s0; LAS float* lb = wtot + 64;
#pragma unroll
            for (int j = 0; j < 16; j += 4) { const f32x4 bv4 = (f32x4){-(base + v[j]) * LOG2E, -(base + v[j + 1]) * LOG2E, -(base + v[j + 2]) * LOG2E, -(base + v[j + 3]) * LOG2E}; *(f32x4*)(o + j) = bv4; *(LAS f32x4*)(lb + s0 + j) = bv4; }
            LAS float* LE = lb + SEQ; LAS float* wm = wtot + 16; LAS float* wsum = wtot + 32;
            float pm_ = -(base + v[15]) * LOG2E, ps_ = 0.f;
#pragma unroll
            for (int j = 0; j < 16; ++j) ps_ += exp2f(-(base + v[j]) * LOG2E - pm_);
#pragma unroll
            for (int o2 = 1; o2 < 64; o2 <<= 1) { const float m2 = __shfl_up(pm_, o2), s2 = __shfl_up(ps_, o2); if (lane >= o2) { const float M = fmaxf(pm_, m2); ps_ = ps_ * exp2f(pm_ - M) + s2 * exp2f(m2 - M); pm_ = M; } }
            if (lane == 63) { wm[wave] = pm_; wsum[wave] = ps_; }
            __syncthreads();
            for (int w = 0; w < wave; ++w) { const float m2 = wm[w], s2 = wsum[w]; const float M = fmaxf(pm_, m2); ps_ = ps_ * exp2f(pm_ - M) + s2 * exp2f(m2 - M); pm_ = M; }
            LE[tid] = pm_ + log2f(ps_);
            __syncthreads();
            if (tid < 32) {
                const float* nr = WSP(float, WS_NRM);
                const size_t e0 = (((size_t)(b * 32 + tid) * 16 + h) * 2) * 2;
                const float qn = sqrtf(fmaxf(nr[e0], nr[e0 + 1]) * 1.02f), kown = sqrtf(fmaxf(nr[e0 + 2], nr[e0 + 3]) * 1.02f);
                const int q0 = tid * 256, ntile = 4 * (tid + 1); const float bq = lb[q0]; int ts = 0; float kn2 = 0.f;
                float kp = fmaxf(nr[e0 + 2], nr[e0 + 3]) * 1.02f;
#pragma unroll
                for (int o = 1; o < 32; o <<= 1) { const float n = __shfl_up(kp, o); if (tid >= o) kp = fmaxf(kp, n); }
                LAS float* kpl = LE + 512; kpl[tid] = kp;
                for (int j = 0; j + 4 < ntile; ++j) {
                    if ((j & 3) == 0) kn2 = kpl[j >> 2];
                    const float bqk = qn * (sqrtf(kn2) + kown);
                    if (LE[4 * j + 3] + bqk - bq < -25.0f) ts = j + 1; else break; }
                const float kall = kp;
                const float bqs = qn * sqrtf(kall), dlt = lb[q0 + 255] - bq;
                const bool sok = (bqs <= 90.0f) && (bqs + dlt <= 100.0f) && (dlt >= 0.0f);
                WSP(int, WS_TS)[item * 32 + tid] = (ts & ~1) | (sok ? 0x10000 : 0);
            }
            __syncthreads();
        }
    }
    SEAM(10);
    if (IN(11) && PHON(11)) for (int rep_ = 0; rep_ < NREP(11); ++rep_) {
        const attn_body::AttnTensors AT{WSP(const attn_body::bf16, WS_HS), WSP(const attn_body::bf16, WS_HS) + (size_t)NTOK * D, WSP(const attn_body::bf16, WS_HS) + (size_t)2 * NTOK * D, WSP(attn_body::bf16, WS_ACT), WSP(const float, WS_BIAS), WSP(const int, WS_TS)};
        const attn_body::StaticOrder S((int)gridDim.x, (int)blockIdx.x);
#ifndef SKIP_ATTN
        attn_body::attn_phase<attn_body::StaticOrder>((char*)lds_raw + RING_OFF, AT, S);
#endif
    }
    SEAM(11);
    if (IN(12) && PHON(12)) for (int rep_ = 0; rep_ < NREP(12); ++rep_) {
        FRESH_IDS();
        pg8::Gemm g{(const pg8::bf16_t*)WSP(unsigned char, WS_ACT), (const pg8::bf16_t*)WSP(unsigned char, WS_WO), D, D, D, STAG_WO, nullptr, WSP(unsigned char, WS_DUMMY)}; pg8::DenseOrder S; S.init(NTOK / 256, 4, G, bx, D, D, 0, 1);
        pg8::EpiWo E{WSP(bf16, WS_XB), WSP(bf16, WS_XA), WSP(float, WS_SS) + (size_t)3 * SSA, WSP(unsigned char, WS_XA8)};
        pg8::gemm_phase<pg8::EpiWo, pg8::DenseOrder, false, 1>(lds + RING_OFF, lds + EPI_OFF, g, S, E);
    }
    SEAM(12);
    moe_ple_block<1>(args, lds, bar, lo, hi);
    if (IN(20) && PHON(20)) for (int rep_ = 0; rep_ < NREP(13); ++rep_) {
        FRESH_IDS();
        const float* ssf = WSP(float, WS_SS) + (size_t)5 * SSA; const bf16* XA = WSP(bf16, WS_XB); const float* norm_final = args.in[I_NFIN];
        for (int t = gw; t < NTOK; t += NGW) {
            const float rs = rstd_tok(ssf, (size_t)t); const bf16* xr = XA + (size_t)t * D; float* orow = args.out + (size_t)t * D;
#pragma unroll
            for (int hf = 0; hf < 2; ++hf) { const int c0 = hf * 512 + lane * 8; const v4u xw = *(const GAS v4u*)(xr + c0);
                const f32x4 g0 = *(const f32x4*)(norm_final + c0), g1 = *(const f32x4*)(norm_final + c0 + 4);
                *(f32x4*)(orow + c0) = (f32x4){bflo(xw.x) * rs * g0[0], bfhi(xw.x) * rs * g0[1], bflo(xw.y) * rs * g0[2], bfhi(xw.y) * rs * g0[3]};
                *(f32x4*)(orow + c0 + 4) = (f32x4){bflo(xw.z) * rs * g1[0], bfhi(xw.z) * rs * g1[1], bflo(xw.w) * rs * g1[2], bfhi(xw.w) * rs * g1[3]}; }
        }
    }
}
#undef IN
#undef SEAM

extern "C" void kernel_launch(void* const* d_in, const int* in_sizes, int n_in, void* d_out, int out_size, void* d_ws, size_t ws_size, hipStream_t stream) {
    static int grid = 0;
    if (grid == 0) {
        if (n_in != 24 || in_sizes[0] != NTOK * D || out_size != NTOK * D || ws_size < WS_END) { fprintf(stderr, "kernel_launch: unexpected shapes (n_in %d, in0 %d, out %d, ws %zu); nothing launched\n", n_in, n_in > 0 ? in_sizes[0] : -1, out_size, ws_size); grid = -1; return; }
        int dev = 0, cus = 0, per_cu = 0;
        if (hipGetDevice(&dev) != hipSuccess || hipDeviceGetAttribute(&cus, hipDeviceAttributeMultiprocessorCount, dev) != hipSuccess) { grid = -1; return; }
        if (hipFuncSetAttribute((const void*)yoco_fwd, hipFuncAttributeMaxDynamicSharedMemorySize, LDS_BYTES) != hipSuccess) { fprintf(stderr, "kernel_launch: hipFuncSetAttribute failed\n"); grid = -1; return; }
        if (hipOccupancyMaxActiveBlocksPerMultiprocessor(&per_cu, (const void*)yoco_fwd, NWAVES * 64, LDS_BYTES) != hipSuccess || per_cu < 1) { fprintf(stderr, "kernel_launch: occupancy query says %d blocks per CU\n", per_cu); }
        (void)hipGetLastError();
        grid = cus > 0 ? cus : 256;
    }
    if (grid < 0) return;
    if (hipMemsetAsync((char*)d_ws + WS_CTL, 0, CTL_ZERO_BYTES, stream) != hipSuccess) return;
    Args a{};
    for (int i = 0; i < 24; ++i) a.in[i] = (const float*)d_in[i];
    a.out = (float*)d_out; a.ws = (unsigned char*)d_ws;
#if MK_PER_PHASE
    for (int ph = 0; ph < N_PHASES; ++ph) { a.ph_lo = ph; a.ph_hi = ph + 1; hipLaunchKernelGGL(yoco_fwd, dim3(grid), dim3(NWAVES * 64), LDS_BYTES, stream, a); }
#else
    a.ph_lo = 0; a.ph_hi = N_PHASES; hipLaunchKernelGGL(yoco_fwd, dim3(grid), dim3(NWAVES * 64), LDS_BYTES, stream, a);
#endif
}
```

```cpp
#include <hip/hip_runtime.h>
#ifndef PROBE_MASK
#define PROBE_MASK 0
#endif
#include <cstdio>
#include <cstdint>
namespace pg8 {
#define PG8_LAS __attribute__((address_space(3)))
typedef unsigned short bf16_t;
typedef short bf16x8 __attribute__((ext_vector_type(8)));
typedef float f32x4 __attribute__((ext_vector_type(4)));
typedef unsigned u32x4 __attribute__((ext_vector_type(4)));
constexpr int BM = 256, BK = 64, HALF = 128, HTB = HALF * BK * 2  , STAGE_BYTES = 8 * HTB, NXCD = 8, WGM = 8;

__host__ __device__ __forceinline__ int lds_byte(int r, int c) { const int st = (r >> 4) * 2 + (c >> 5), rr = r & 15, cc = c & 31, ob = rr * 64 + cc * 2; return st * 1024 + (ob ^ (((ob >> 9) & 1) << 5)); }
__host__ __device__ __forceinline__ void stage_rc(int b, int& R, int& C) { const int st = b / 1024, sb = b % 1024, swz = sb ^ (((sb >> 9) & 1) << 5); R = (st >> 1) * 16 + swz / 64; C = (st & 1) * 32 + (swz % 64) / 2; }
__host__ __device__ __forceinline__ int perm32(int rho) { const int n = rho >> 4, i = rho & 15; return 8 * (i >> 2) + 4 * n + (i & 3); }

struct Unit { int pm, pn, e; };
struct Gemm { const bf16_t* A; const bf16_t* Bt; int lda, ldb, K, stag; const int* rowmap; void* dummy; };

struct DenseOrder {
    int nM, nN, nwg, G, c; size_t a_row, a_col, b_tile;
    __device__ __forceinline__ void init(int nM_, int nN_, int G_, int c_, int lda, int ldb, int a_col_elems, int esz = 2) { nM = nM_; nN = nN_; nwg = nM * nN; G = G_; c = c_; a_row = (size_t)BM * lda * esz; a_col = (size_t)a_col_elems * esz; b_tile = (size_t)BM * ldb * esz; }
    __device__ __forceinline__ bool next(int i, Unit& u) const {
        const long L = (long)i * G + c; if (L >= nwg) return false;
        int wgid = (int)L; { const int q = nwg / NXCD, r = nwg % NXCD, xcd = wgid % NXCD, off = wgid / NXCD; wgid = (xcd < r ? xcd * (q + 1) : r * (q + 1) + (xcd - r) * q) + off; }
        const int nig = WGM * nN, gid = wgid / nig, fm = gid * WGM, gsz = (nM - fm) < WGM ? (nM - fm) : WGM;
        u.pm = fm + ((wgid % nig) % gsz); u.pn = (wgid % nig) / gsz; u.e = 0; return true;
    }
    __device__ __forceinline__ size_t a_off(const Unit& u) const { return (size_t)u.pm * a_row + (size_t)u.pn * a_col; }
    __device__ __forceinline__ size_t b_off(const Unit& u) const { return (size_t)u.pn * b_tile; }
    __device__ __forceinline__ void a_ready(const Unit&) const {}
    __device__ __forceinline__ void done(const Unit&) const {}
};
struct GroupedOrder {
    int nM, nN, nwg, G, c; const PG8_LAS int* tp; const PG8_LAS unsigned char* te; size_t a_row, b_exp, b_tile;
    __device__ __forceinline__ void init(const PG8_LAS int* tp_, int nN_, int G_, int c_, int lda, int ldb, int n_w_rows, int esz) { tp = tp_; te = (const PG8_LAS unsigned char*)(tp_ + 64); nM = __builtin_amdgcn_readfirstlane(tp_[32]); nN = nN_; nwg = nM * nN; G = G_; c = c_; a_row = (size_t)BM * lda * esz; b_exp = (size_t)n_w_rows * ldb * esz; b_tile = (size_t)BM * ldb * esz; }
    __device__ __forceinline__ bool next(int i, Unit& u) const {
        const long L = (long)i * G + c; if (L >= nwg) return false;
        int wgid = (int)L; { const int q = nwg / NXCD, r = nwg % NXCD, xcd = wgid % NXCD, off = wgid / NXCD; wgid = (xcd < r ? xcd * (q + 1) : r * (q + 1) + (xcd - r) * q) + off; }
        const int nig = WGM * nN, gid = wgid / nig, fm = gid * WGM, gsz = (nM - fm) < WGM ? (nM - fm) : WGM;
        u.pm = fm + ((wgid % nig) % gsz); u.pn = (wgid % nig) / gsz;
        u.e = __builtin_amdgcn_readfirstlane((int)te[u.pm]); u.pm = __builtin_amdgcn_readfirstlane(u.pm); u.pn = __builtin_amdgcn_readfirstlane(u.pn); return true;
    }
    __device__ __forceinline__ size_t a_off(const Unit& u) const { return (size_t)u.pm * a_row; }
    __device__ __forceinline__ size_t b_off(const Unit& u) const { return (size_t)u.e * b_exp + (size_t)u.pn * b_tile; }
    __device__ __forceinline__ void a_ready(const Unit&) const {}
    __device__ __forceinline__ void done(const Unit&) const {}
};

__device__ __forceinline__ unsigned cvt_pk_bf16(float lo, float hi) { unsigned r; asm volatile("v_cvt_pk_bf16_f32 %0, %1, %2" : "=v"(r) : "v"(lo), "v"(hi)); return r; }
__device__ __forceinline__ float bf_lo(unsigned w) { return __builtin_bit_cast(float, w << 16); }
__device__ __forceinline__ float bf_hi(unsigned w) { return __builtin_bit_cast(float, w & 0xffff0000u); }
__device__ __forceinline__ float rstd_of(float ss) { return __builtin_amdgcn_rsqf(ss * (1.f / 1024.f) + 1e-6f); }
__device__ __forceinline__ u32x4 pack8(const f32x4& a, const f32x4& b) { u32x4 w; w.x = cvt_pk_bf16(a[0], a[1]); w.y = cvt_pk_bf16(a[2], a[3]); w.z = cvt_pk_bf16(b[0], b[1]); w.w = cvt_pk_bf16(b[2], b[3]); return w; }
__device__ __forceinline__ void unpack8(const u32x4& w, f32x4& a, f32x4& b) { a = (f32x4){bf_lo(w.x), bf_hi(w.x), bf_lo(w.y), bf_hi(w.y)}; b = (f32x4){bf_lo(w.z), bf_hi(w.z), bf_lo(w.w), bf_hi(w.w)}; }
__device__ __forceinline__ float dot4(const f32x4& a) { return (a[0] * a[0] + a[1] * a[1]) + (a[2] * a[2] + a[3] * a[3]); }
constexpr float W8INV = 1.0f / 16.0f;
typedef float f32x2 __attribute__((ext_vector_type(2)));
struct EpiCtx { PG8_LAS unsigned char* stg; int wr, wc, fr, fq, lane; };
constexpr int EPW = 2816, EP_RSL = 2304, EP_PITCH = 144, NTOKC = 65536;
typedef PG8_LAS u32x4* lds_u4p;
struct RawTile { u32x4 a, b; };
template <int MODE> __device__ __forceinline__ int piece_off(int fq, int k) { return MODE == 0 ? 64 * k + 16 * fq : 32 * fq + 16 * k; }
__device__ __forceinline__ RawTile tile_fetch(const EpiCtx& c, const char* gbase, size_t pitch) {
    const int r = c.lane >> 3, ch = c.lane & 7; RawTile t; t.a = *(const u32x4*)(gbase + (size_t)r * pitch + ch * 16); t.b = *(const u32x4*)(gbase + (size_t)(r + 8) * pitch + ch * 16); return t;
}
template <int MODE> __device__ __forceinline__ void tile_unstage(const EpiCtx& c, const RawTile& t, u32x4& v0, u32x4& v1) {
    const int r = c.lane >> 3, ch = c.lane & 7;
    *(lds_u4p)(c.stg + r * EP_PITCH + ch * 16) = t.a; *(lds_u4p)(c.stg + (r + 8) * EP_PITCH + ch * 16) = t.b;
    v0 = *(lds_u4p)(c.stg + c.fr * EP_PITCH + piece_off<MODE>(c.fq, 0)); v1 = *(lds_u4p)(c.stg + c.fr * EP_PITCH + piece_off<MODE>(c.fq, 1));
}
template <int MODE> __device__ __forceinline__ void tile_store(const EpiCtx& c, char* gbase, size_t pitch, const u32x4& v0, const u32x4& v1) {
    *(lds_u4p)(c.stg + c.fr * EP_PITCH + piece_off<MODE>(c.fq, 0)) = v0; *(lds_u4p)(c.stg + c.fr * EP_PITCH + piece_off<MODE>(c.fq, 1)) = v1;
    const int r = c.lane >> 3, ch = c.lane & 7;
    const u32x4 a = *(lds_u4p)(c.stg + r * EP_PITCH + ch * 16), b = *(lds_u4p)(c.stg + (r + 8) * EP_PITCH + ch * 16);
    *(u32x4*)(gbase + (size_t)r * pitch + ch * 16) = a; *(u32x4*)(gbase + (size_t)(r + 8) * pitch + ch * 16) = b;
}
__device__ __forceinline__ void tile_store_half(const EpiCtx& c, char* gbase, size_t pitch, const u32x4& v) {
    *(lds_u4p)(c.stg + c.fr * 80 + c.fq * 16) = v;
    const int r = c.lane >> 2, ch = c.lane & 3;
    const u32x4 a = *(lds_u4p)(c.stg + r * 80 + ch * 16);
    *(u32x4*)(gbase + (size_t)r * pitch + ch * 16) = a;
}
__device__ __forceinline__ float sum16(const float (&s)[16]) { return (((s[0] + s[1]) + (s[2] + s[3])) + ((s[4] + s[5]) + (s[6] + s[7]))) + (((s[8] + s[9]) + (s[10] + s[11])) + ((s[12] + s[13]) + (s[14] + s[15]))); }
__device__ __forceinline__ void ss_put(const EpiCtx& c, float* ssp, int unit_row0, const float (&sq)[2][4], int slot) {
    PG8_LAS float* t = (PG8_LAS float*)c.stg;
#pragma unroll
    for (int ai = 0; ai < 2; ++ai)
#pragma unroll
        for (int m = 0; m < 4; ++m) t[(ai * 64 + m * 16 + c.fr) * 4 + c.fq] = sq[ai][m];
#pragma unroll
    for (int hb = 0; hb < 2; ++hb) { const f32x4 v = *(PG8_LAS f32x4*)(t + (hb * 64 + c.lane) * 4); ssp[(size_t)slot * NTOKC + unit_row0 + hb * HALF + c.wr * 64 + c.lane] = (v[0] + v[1]) + (v[2] + v[3]); }
}
__device__ __forceinline__ void rstd_stage(const EpiCtx& c, const float* ssp, int unit_row0) {
    PG8_LAS float* rsl = (PG8_LAS float*)(c.stg + EP_RSL);
#pragma unroll
    for (int hb = 0; hb < 2; ++hb) { const int row = unit_row0 + hb * HALF + c.wr * 64 + c.lane; float s[16];
#pragma unroll
        for (int k = 0; k < 16; ++k) s[k] = ssp[(size_t)k * NTOKC + row];
        rsl[hb * 64 + c.lane] = rstd_of(sum16(s)); asm volatile("" ::: "memory"); }
}
__device__ __forceinline__ float rstd_get(const EpiCtx& c, int ai, int m) { return ((PG8_LAS float*)(c.stg + EP_RSL))[ai * 64 + m * 16 + c.fr]; }
#define EPI_ROW(g_) (u.pm * BM + ((g_) >> 2) * HALF + c.wr * 64 + ((g_) & 3) * 16)

__device__ __forceinline__ unsigned long long fp8x8_sat(f32x4 v0, f32x4 v1) {
#pragma unroll
    for (int j = 0; j < 4; ++j) { v0[j] = __builtin_amdgcn_fmed3f(v0[j], -448.0f, 448.0f); v1[j] = __builtin_amdgcn_fmed3f(v1[j], -448.0f, 448.0f); }
    unsigned w0 = 0u, w1 = 0u; w0 = __builtin_amdgcn_cvt_pk_fp8_f32(v0[0], v0[1], w0, false); w0 = __builtin_amdgcn_cvt_pk_fp8_f32(v0[2], v0[3], w0, true);
    w1 = __builtin_amdgcn_cvt_pk_fp8_f32(v1[0], v1[1], w1, false); w1 = __builtin_amdgcn_cvt_pk_fp8_f32(v1[2], v1[3], w1, true); return (unsigned long long)w0 | ((unsigned long long)w1 << 32); }
__device__ __forceinline__ void fp8_rows_store(const EpiCtx& c, unsigned char* dst  , unsigned long long q0, unsigned long long q1) {
    *(PG8_LAS unsigned long long*)(c.stg + c.fr * 80 + c.fq * 8) = q0; *(PG8_LAS unsigned long long*)(c.stg + c.fr * 80 + 32 + c.fq * 8) = q1;
    const int r = c.lane >> 2, ch = c.lane & 3; const u32x4 t8 = *(lds_u4p)(c.stg + r * 80 + ch * 16);
    *(u32x4*)(dst + (size_t)r * 1024 + ch * 16) = t8; }
struct EpiPool {
    struct Pre {}; __device__ __forceinline__ Pre fetch(const Unit&, const EpiCtx&) const { return Pre{}; }
    static constexpr int NST = 0;     static constexpr bool PERM = true, AFTER_DRAIN = false, TWICE = false;
    const float* xin; const float* scale; bf16_t* Xo; float* ss; unsigned char* X8;
    __device__ __forceinline__ void operator()(const f32x4 (&acc)[2][2][4][2], const Unit& u, const EpiCtx& c, const Pre& pre) const {
        const int colw = u.pn * BM + c.wc * 64;
        float sq[2][4]; RawTile rt[1][2];
#define EP_FETCH(g_) do { _Pragma("unroll") for (int bj = 0; bj < 2; ++bj) rt[0][bj] = tile_fetch(c, (const char*)(xin + (size_t)EPI_ROW(g_) * 1024 + colw + 32 * bj), 4096); } while (0)
#pragma unroll
        for (int g = 0; g < 8; ++g) { const int ai = g >> 2, m = g & 3; float s = 0.f; u32x4 o[2]; unsigned long long q8[2];
            EP_FETCH(g);
            f32x4 sc[2][2];
#pragma unroll
            for (int bj = 0; bj < 2; ++bj)
#pragma unroll
                for (int n = 0; n < 2; ++n) sc[bj][n] = *(const f32x4*)(scale + colw + 32 * bj + 8 * c.fq + 4 * n);
#pragma unroll
            for (int bj = 0; bj < 2; ++bj) { u32x4 r0, r1; tile_unstage<1>(c, rt[0][bj], r0, r1);
                const f32x4 v0 = __builtin_bit_cast(f32x4, r0) + sc[bj][0] * acc[ai][bj][m][0], v1 = __builtin_bit_cast(f32x4, r1) + sc[bj][1] * acc[ai][bj][m][1];
                s += dot4(v0) + dot4(v1); o[bj] = pack8(v0, v1); q8[bj] = fp8x8_sat(v0, v1); }
            tile_store<0>(c, (char*)(Xo + (size_t)EPI_ROW(g) * 1024 + colw), 2048, o[0], o[1]);
            fp8_rows_store(c, X8 + (size_t)EPI_ROW(g) * 1024 + colw, q8[0], q8[1]);
            sq[ai][m] = s; asm volatile("" ::: "memory"); }
#undef EP_FETCH
        ss_put(c, ss, u.pm * BM, sq, u.pn * 4 + c.wc);
    }
};
struct EpiRouter {
    struct Pre {}; __device__ __forceinline__ Pre fetch(const Unit&, const EpiCtx&) const { return Pre{}; }
    static constexpr int NST = 0;     static constexpr bool PERM = true, AFTER_DRAIN = false, TWICE = false;
    const float* ssin; const float* rb; float* logits;
    __device__ __forceinline__ void operator()(const f32x4 (&acc)[2][2][4][2], const Unit& u, const EpiCtx& c, const Pre& pre) const {
        if (c.wc != 0) return;
        rstd_stage(c, ssin, u.pm * BM);
        const f32x4 b0 = *(const f32x4*)(rb + 8 * c.fq), b1 = *(const f32x4*)(rb + 8 * c.fq + 4);
#pragma unroll
        for (int g = 0; g < 8; ++g) { const int ai = g >> 2, m = g & 3; const float rs = rstd_get(c, ai, m);
            const f32x4 v0 = acc[ai][0][m][0] * rs + b0, v1 = acc[ai][0][m][1] * rs + b1;
            tile_store<1>(c, (char*)(logits + (size_t)EPI_ROW(g) * 32), 128, __builtin_bit_cast(u32x4, v0), __builtin_bit_cast(u32x4, v1)); }
    }
};
constexpr float SW_A2 = 1.702f * 1.4426950408889634f;
struct EpiSwiGLU {
    struct Pre { u32x4 bg, bu; float rs[8]; };
    __device__ __forceinline__ Pre fetch(const Unit& u, const EpiCtx& c) const { const bf16_t* p = bgu16 + (size_t)u.e * 2048 + u.pn * HALF + c.wc * 32 + 8 * c.fq; Pre r; r.bg = *(const u32x4*)p; r.bu = *(const u32x4*)(p + 1024);
#pragma unroll
        for (int g = 0; g < 8; ++g) r.rs[g] = rowrstd[EPI_ROW(g) + c.fr];
        return r; }
    static constexpr int NST = 8;     static constexpr bool PERM = true, AFTER_DRAIN = false, TWICE = ((PROBE_MASK >> 16) & 1) != 0;
    const bf16_t* bgu16; unsigned char* act; const float* rowrstd;
    __device__ __forceinline__ void operator()(const f32x4 (&acc)[2][2][4][2], const Unit& u, const EpiCtx& c, const Pre& pre) const {
        const int cw = u.pn * HALF + c.wc * 32;
        f32x4 bgt[2], bup[2]; unpack8(pre.bg, bgt[0], bgt[1]); unpack8(pre.bu, bup[0], bup[1]);
#pragma unroll
        for (int g = 0; g < 8; ++g) { const int ai = g >> 2, m = g & 3; f32x4 y[2]; const float rs = W8INV * pre.rs[g];
#pragma unroll
            for (int n = 0; n < 2; ++n) { const f32x4 gt = acc[ai][0][m][n] * rs + bgt[n], up = acc[ai][1][m][n] * rs + bup[n];
#pragma unroll
                for (int hp = 0; hp < 2; ++hp) {
                    f32x2 gc, uc; gc.x = fminf(gt[2 * hp], 7.0f * SW_A2); gc.y = fminf(gt[2 * hp + 1], 7.0f * SW_A2); uc.x = fminf(fmaxf(up[2 * hp], -6.0f), 8.0f); uc.y = fminf(fmaxf(up[2 * hp + 1], -6.0f), 8.0f);
                    f32x2 e; e.x = __builtin_amdgcn_exp2f(-gc.x); e.y = __builtin_amdgcn_exp2f(-gc.y);
                    const f32x2 d = e + 1.0f; f32x2 sg; sg.x = __builtin_amdgcn_rcpf(d.x); sg.y = __builtin_amdgcn_rcpf(d.y);
                    const f32x2 yy = uc * (gc * sg); y[n][2 * hp] = yy.x; y[n][2 * hp + 1] = yy.y; } }
            unsigned w0 = 0u, w1 = 0u;
            w0 = __builtin_amdgcn_cvt_pk_fp8_f32(y[0][0], y[0][1], w0, false); w0 = __builtin_amdgcn_cvt_pk_fp8_f32(y[0][2], y[0][3], w0, true);
            w1 = __builtin_amdgcn_cvt_pk_fp8_f32(y[1][0], y[1][1], w1, false); w1 = __builtin_amdgcn_cvt_pk_fp8_f32(y[1][2], y[1][3], w1, true);
            *(PG8_LAS unsigned long long*)(c.stg + c.fr * 40 + c.fq * 8) = (unsigned long long)w0 | ((unsigned long long)w1 << 32);
            const int r = c.lane >> 2, ch = c.lane & 3; const unsigned long long q = *(PG8_LAS unsigned long long*)(c.stg + r * 40 + ch * 8);
            *(unsigned long long*)(act + (size_t)(EPI_ROW(g) + r) * 1024 + cw + ch * 8) = q; }
    }
};
constexpr float YSCALE = 8.0f, YSINV = 0.125f;
struct EpiDown {
    struct Pre { float gt[8]; u32x4 b0, b1; };
    __device__ __forceinline__ Pre fetch(const Unit& u, const EpiCtx& c) const { Pre r;
#pragma unroll
        for (int g = 0; g < 8; ++g) r.gt[g] = rowgate[EPI_ROW(g) + c.fr];
        const bf16_t* p = bd16 + (size_t)u.e * 1024 + u.pn * BM + c.wc * 64 + 8 * c.fq; r.b0 = *(const u32x4*)p; r.b1 = *(const u32x4*)(p + 32); return r; }
    static constexpr int NST = 8;     static constexpr bool PERM = true, AFTER_DRAIN = false, TWICE = ((PROBE_MASK >> 15) & 1) != 0;
    const float* rowgate; const bf16_t* bd16; unsigned char* Y;
    __device__ __forceinline__ void operator()(const f32x4 (&acc)[2][2][4][2], const Unit& u, const EpiCtx& c, const Pre& pre) const {
        const int colw = u.pn * BM + c.wc * 64;
        f32x4 bv[2][2]; unpack8(pre.b0, bv[0][0], bv[0][1]); unpack8(pre.b1, bv[1][0], bv[1][1]);
        const float osc = W8INV / SW_A2;
#pragma unroll
        for (int g = 0; g < 8; ++g) { const int ai = g >> 2, m = g & 3; const float gt = pre.gt[g] * YSCALE; unsigned long long q8[2];
#pragma unroll
            for (int bj = 0; bj < 2; ++bj) { f32x4 v0 = (acc[ai][bj][m][0] * osc + bv[bj][0]) * gt, v1 = (acc[ai][bj][m][1] * osc + bv[bj][1]) * gt;
#pragma unroll
                for (int j = 0; j < 4; ++j) { v0[j] = __builtin_amdgcn_fmed3f(v0[j], -448.0f, 448.0f); v1[j] = __builtin_amdgcn_fmed3f(v1[j], -448.0f, 448.0f); }
                unsigned w0 = 0u, w1 = 0u; w0 = __builtin_amdgcn_cvt_pk_fp8_f32(v0[0], v0[1], w0, false); w0 = __builtin_amdgcn_cvt_pk_fp8_f32(v0[2], v0[3], w0, true);
                w1 = __builtin_amdgcn_cvt_pk_fp8_f32(v1[0], v1[1], w1, false); w1 = __builtin_amdgcn_cvt_pk_fp8_f32(v1[2], v1[3], w1, true); q8[bj] = (unsigned long long)w0 | ((unsigned long long)w1 << 32); }
            *(PG8_LAS unsigned long long*)(c.stg + c.fr * 80 + c.fq * 8) = q8[0]; *(PG8_LAS unsigned long long*)(c.stg + c.fr * 80 + 32 + c.fq * 8) = q8[1];
            const int r = c.lane >> 2, ch = c.lane & 3; const u32x4 t8 = *(lds_u4p)(c.stg + r * 80 + ch * 16);
            *(u32x4*)(Y + (size_t)(EPI_ROW(g) + r) * 1024 + colw + ch * 16) = t8; asm volatile("" ::: "memory"); }
    }
};
constexpr float PJSCALE = 8.0f, PJSINV = 0.125f;
struct EpiStore {
    struct Pre {}; __device__ __forceinline__ Pre fetch(const Unit&, const EpiCtx&) const { return Pre{}; }
    static constexpr int NST = 0;     static constexpr bool PERM = true, AFTER_DRAIN = false, TWICE = false;
    unsigned char* O;
    __device__ __forceinline__ void operator()(const f32x4 (&acc)[2][2][4][2], const Unit& u, const EpiCtx& c, const Pre& pre) const {
        unsigned char* ob = O + ((size_t)(u.pm * 4 + u.pn) * 8 + (c.wr * 4 + c.wc)) * 8192 + c.lane * 16;
#pragma unroll
        for (int g = 0; g < 8; ++g) { const int ai = g >> 2, m = g & 3; u32x4 w;
#pragma unroll
            for (int bj = 0; bj < 2; ++bj)
#pragma unroll
                for (int n = 0; n < 2; ++n) { f32x4 v = acc[ai][bj][m][n] * PJSCALE;
#pragma unroll
                    for (int j = 0; j < 4; ++j) v[j] = __builtin_amdgcn_fmed3f(v[j], -448.0f, 448.0f);
                    unsigned w0 = 0u; w0 = __builtin_amdgcn_cvt_pk_fp8_f32(v[0], v[1], w0, false); w0 = __builtin_amdgcn_cvt_pk_fp8_f32(v[2], v[3], w0, true); w[2 * bj + n] = w0; }
            *(u32x4*)(ob + g * 1024) = w; }
    }
};
struct EpiPle {
    struct Pre { f32x4 b[2][2]; };
    __device__ __forceinline__ Pre fetch(const Unit& u, const EpiCtx& c) const { Pre r; const float* p = bgate + u.pn * BM + c.wc * 64 + 8 * c.fq;
#pragma unroll
        for (int bj = 0; bj < 2; ++bj)
#pragma unroll
            for (int n = 0; n < 2; ++n) r.b[bj][n] = *(const f32x4*)(p + 32 * bj + 4 * n);
        return r; }
    static constexpr int NST = 18;     static constexpr bool PERM = true, AFTER_DRAIN = false, TWICE = false;
    const float* bgate; const unsigned char* PJ; const bf16_t* Xi; bf16_t* Xo; float* ss; unsigned char* X8;
    __device__ __forceinline__ void operator()(const f32x4 (&acc)[2][2][4][2], const Unit& u, const EpiCtx& c, const Pre& pre) const {
        const int colw = u.pn * BM + c.wc * 64;
        float sq[2][4]; RawTile rx[2]; u32x4 pjv[2];
        const unsigned char* pjb = PJ + ((size_t)(u.pm * 4 + u.pn) * 8 + (c.wr * 4 + c.wc)) * 8192 + c.lane * 16;
#define EP_FETCH(g_) do { const size_t ro_ = (size_t)EPI_ROW(g_) * 1024 + colw; pjv[(g_) & 1] = *(const u32x4*)(pjb + (g_) * 1024); rx[(g_) & 1] = tile_fetch(c, (const char*)(Xi + ro_), 2048); } while (0)
        EP_FETCH(0);
#pragma unroll
        for (int g = 0; g < 8; ++g) { const int ai = g >> 2, m = g & 3; const float rs = W8INV; float s = 0.f; u32x4 o[2], xw[2]; unsigned long long q8[2];
            if (g + 1 < 8) EP_FETCH(g + 1);
            const u32x4 pj = pjv[g & 1];
            tile_unstage<0>(c, rx[g & 1], xw[0], xw[1]);
#pragma unroll
            for (int bj = 0; bj < 2; ++bj) { f32x4 p0, p1, x0, x1; unpack8(xw[bj], x0, x1);
                { const f32x2 a0 = __builtin_amdgcn_cvt_pk_f32_fp8((int)pj[2 * bj], false), a1 = __builtin_amdgcn_cvt_pk_f32_fp8((int)pj[2 * bj], true), b0 = __builtin_amdgcn_cvt_pk_f32_fp8((int)pj[2 * bj + 1], false), b1 = __builtin_amdgcn_cvt_pk_f32_fp8((int)pj[2 * bj + 1], true);
                  p0 = (f32x4){a0.x, a0.y, a1.x, a1.y} * PJSINV; p1 = (f32x4){b0.x, b0.y, b1.x, b1.y} * PJSINV; }
                f32x4 z0 = acc[ai][bj][m][0] * rs + pre.b[bj][0], z1 = acc[ai][bj][m][1] * rs + pre.b[bj][1];
#pragma unroll
                for (int hp = 0; hp < 2; ++hp) {
                    f32x2 a0 = {z0[2 * hp], z0[2 * hp + 1]}, a1 = {z1[2 * hp], z1[2 * hp + 1]}; a0 = a0 * -1.4426950408889634f; a1 = a1 * -1.4426950408889634f;
                    f32x2 e0, e1; e0.x = __builtin_amdgcn_exp2f(a0.x); e0.y = __builtin_amdgcn_exp2f(a0.y); e1.x = __builtin_amdgcn_exp2f(a1.x); e1.y = __builtin_amdgcn_exp2f(a1.y); e0 = e0 + 1.0f; e1 = e1 + 1.0f;
                    z0[2 * hp] = __builtin_amdgcn_rcpf(e0.x); z0[2 * hp + 1] = __builtin_amdgcn_rcpf(e0.y); z1[2 * hp] = __builtin_amdgcn_rcpf(e1.x); z1[2 * hp + 1] = __builtin_amdgcn_rcpf(e1.y); }
                const f32x4 v0 = x0 + z0 * p0, v1 = x1 + z1 * p1;
                s += dot4(v0) + dot4(v1); o[bj] = pack8(v0, v1);
                { unsigned w0 = 0u, w1 = 0u; w0 = __builtin_amdgcn_cvt_pk_fp8_f32(v0[0], v0[1], w0, false); w0 = __builtin_amdgcn_cvt_pk_fp8_f32(v0[2], v0[3], w0, true);
                  w1 = __builtin_amdgcn_cvt_pk_fp8_f32(v1[0], v1[1], w1, false); w1 = __builtin_amdgcn_cvt_pk_fp8_f32(v1[2], v1[3], w1, true); q8[bj] = (unsigned long long)w0 | ((unsigned long long)w1 << 32); } }
            tile_store<0>(c, (char*)(Xo + (size_t)EPI_ROW(g) * 1024 + colw), 2048, o[0], o[1]);
            if (X8) {
              *(PG8_LAS unsigned long long*)(c.stg + c.fr * 80 + c.fq * 8) = q8[0]; *(PG8_LAS unsigned long long*)(c.stg + c.fr * 80 + 32 + c.fq * 8) = q8[1];
              const int r = c.lane >> 2, ch = c.lane & 3; const u32x4 t8 = *(lds_u4p)(c.stg + r * 80 + ch * 16);
              *(u32x4*)(X8 + (size_t)(EPI_ROW(g) + r) * 1024 + colw + ch * 16) = t8; }
            sq[ai][m] = s; asm volatile("" ::: "memory"); }
#undef EP_FETCH
        ss_put(c, ss, u.pm * BM, sq, u.pn * 4 + c.wc);
    }
};
struct EpiQkv {
    struct Pre {}; __device__ __forceinline__ Pre fetch(const Unit&, const EpiCtx&) const { return Pre{}; }
    static constexpr int NST = 0;     static constexpr bool PERM = true, AFTER_DRAIN = false, TWICE = false;
    const float* ssin; bf16_t* Q; const float* bfg; float* LF; float qscale; float* nrm;
    __device__ __forceinline__ void operator()(const f32x4 (&acc)[2][2][4][2], const Unit& u, const EpiCtx& c, const Pre& pre) const {
        rstd_stage(c, ssin, u.pm * BM);
        if (u.pn < 12) {
            const int t = u.pn >> 2; bf16_t* base = Q + (size_t)t * (65536 * 1024); const float sc = t == 0 ? qscale : 1.0f;
            const int colw = (u.pn & 3) * BM + c.wc * 64; float mx = 0.f;
#pragma unroll
            for (int g = 0; g < 8; ++g) { const int ai = g >> 2, m = g & 3; const float rs = rstd_get(c, ai, m) * sc * W8INV; u32x4 o[2]; float q = 0.f;
#pragma unroll
                for (int bj = 0; bj < 2; ++bj) { const f32x4 a = acc[ai][bj][m][0] * rs, b = acc[ai][bj][m][1] * rs; q += dot4(a) + dot4(b); o[bj] = pack8(a, b); }
                tile_store<0>(c, (char*)(base + (size_t)EPI_ROW(g) * 1024 + colw), 2048, o[0], o[1]);
                if (t < 2) { q += __shfl_xor(q, 16); q += __shfl_xor(q, 32); mx = fmaxf(mx, q); } }
            if (t < 2) {
                mx = fmaxf(mx, __shfl_xor(mx, 1)); mx = fmaxf(mx, __shfl_xor(mx, 2)); mx = fmaxf(mx, __shfl_xor(mx, 4)); mx = fmaxf(mx, __shfl_xor(mx, 8));
                if (c.lane == 0) nrm[(((size_t)u.pm * 16 + 4 * (u.pn & 3) + c.wc) * 2 + t) * 2 + c.wr] = mx; }
        } else if (c.wc == 0) {
            const f32x4 b0 = *(const f32x4*)(bfg + 8 * (c.fq & 1)), b1 = *(const f32x4*)(bfg + 8 * (c.fq & 1) + 4);
#pragma unroll
            for (int g = 0; g < 8; ++g) { const int ai = g >> 2, m = g & 3; const float rs = rstd_get(c, ai, m) * W8INV;
                f32x4 z0 = acc[ai][0][m][0] * rs + b0, z1 = acc[ai][0][m][1] * rs + b1;
#pragma unroll
                for (int j = 0; j < 4; ++j) { z0[j] = fminf(z0[j], 0.f) - 0.6931471805599453f * __builtin_amdgcn_logf(1.0f + __builtin_amdgcn_exp2f(-1.4426950408889634f * fabsf(z0[j]))); z1[j] = fminf(z1[j], 0.f) - 0.6931471805599453f * __builtin_amdgcn_logf(1.0f + __builtin_amdgcn_exp2f(-1.4426950408889634f * fabsf(z1[j]))); }
                if (c.fq < 2) { float* o = LF + (size_t)(EPI_ROW(g) + c.fr) * 16 + 8 * c.fq; *(f32x4*)o = z0; *(f32x4*)(o + 4) = z1; } }
        }
    }
};
struct EpiWo {
    struct Pre {}; __device__ __forceinline__ Pre fetch(const Unit&, const EpiCtx&) const { return Pre{}; }
    static constexpr int NST = 18;     static constexpr bool PERM = true, AFTER_DRAIN = false, TWICE = ((PROBE_MASK >> 14) & 1) != 0;
    const bf16_t* Xi; bf16_t* Xo; float* ss; unsigned char* X8;
    __device__ __forceinline__ void operator()(const f32x4 (&acc)[2][2][4][2], const Unit& u, const EpiCtx& c, const Pre& pre) const {
        const int colw = u.pn * BM + c.wc * 64;
        float sq[2][4]; RawTile rx[2];
#define EP_FETCH(g_) do { rx[(g_) & 1] = tile_fetch(c, (const char*)(Xi + (size_t)EPI_ROW(g_) * 1024 + colw), 2048); } while (0)
        EP_FETCH(0);
#pragma unroll
        for (int g = 0; g < 8; ++g) { const int ai = g >> 2, m = g & 3; float s = 0.f; u32x4 o[2], xw[2]; unsigned long long q8[2];
            if (g + 1 < 8) EP_FETCH(g + 1);
            tile_unstage<0>(c, rx[g & 1], xw[0], xw[1]);
#pragma unroll
            for (int bj = 0; bj < 2; ++bj) { f32x4 x0, x1; unpack8(xw[bj], x0, x1);
                const f32x4 v0 = x0 + acc[ai][bj][m][0] * W8INV, v1 = x1 + acc[ai][bj][m][1] * W8INV;
                s += dot4(v0) + dot4(v1); o[bj] = pack8(v0, v1); q8[bj] = fp8x8_sat(v0, v1); }
            tile_store<0>(c, (char*)(Xo + (size_t)EPI_ROW(g) * 1024 + colw), 2048, o[0], o[1]);
            fp8_rows_store(c, X8 + (size_t)EPI_ROW(g) * 1024 + colw, q8[0], q8[1]);
            sq[ai][m] = s; asm volatile("" ::: "memory"); }
#undef EP_FETCH
        ss_put(c, ss, u.pm * BM, sq, u.pn * 4 + c.wc);
    }
};

typedef int v8i_t __attribute__((ext_vector_type(8))); typedef int v4i_t __attribute__((ext_vector_type(4)));
struct Frag2 { bf16x8 k0, k1; };
struct Frag1 { v8i_t v; };
template <int ESZ> struct FragSel { typedef Frag2 type; };
template <> struct FragSel<1> { typedef Frag1 type; };
__device__ __forceinline__ void ld_frag(Frag2& f, const PG8_LAS unsigned char* p) { f.k0 = *(const PG8_LAS bf16x8*)p; f.k1 = *(const PG8_LAS bf16x8*)(p + 1024); }
__device__ __forceinline__ void ld_frag(Frag1& f, const PG8_LAS unsigned char* p) { const v4i_t lo = *(const PG8_LAS v4i_t*)p, hi = *(const PG8_LAS v4i_t*)(p + 1024); f.v = __builtin_shufflevector(lo, hi, 0, 1, 2, 3, 4, 5, 6, 7); }
__device__ __forceinline__ void mma_frag(f32x4& acc, const Frag2& b, const Frag2& a) { acc = __builtin_amdgcn_mfma_f32_16x16x32_bf16(b.k0, a.k0, acc, 0, 0, 0); acc = __builtin_amdgcn_mfma_f32_16x16x32_bf16(b.k1, a.k1, acc, 0, 0, 0); }
__device__ __forceinline__ void mma_frag(f32x4& acc, const Frag1& b, const Frag1& a) {
#if defined(__HIP_DEVICE_COMPILE__)
    asm volatile("v_mfma_f32_16x16x128_f8f6f4 %0, %1, %2, %0" : "+v"(acc) : "v"(b.v), "v"(a.v));
#endif
}
#define PG8_KITER(SKIP11, WX, MMA0) do { \
            unsigned w2[2][2]; \
            if constexpr (GATHER) { if (last) { _Pragma("unroll") for (int h_ = 0; h_ < 2; ++h_) _Pragma("unroll") for (int i_ = 0; i_ < 2; ++i_) w2[h_][i_] = vgN[h_][i_]; } else { _Pragma("unroll") for (int h_ = 0; h_ < 2; ++h_) _Pragma("unroll") for (int i_ = 0; i_ < 2; ++i_) w2[h_][i_] = vgC[h_][i_]; } } \
            PG8_LDB(B0, 0, 0); PG8_LDB(B1, 0, 1); PG8_SCHED; PG8_LDA(At, 0, 0); if (!(SKIP11)) { if constexpr (GATHER) PG8_STAGE(PG8_SA(1, 1), a1, vgC[1]); else PG8_STAGE(PG8_SA(1, 1), a1 + hstepA, voffA); } \
            PG8_WAIT_V(WX); PG8_WAIT_L(0); PG8_BAR; MMA0(0, 0, At, B0); MMA0(0, 1, At, B1); PG8_BAR; PG8_SCHED; \
            PG8_LDA(At, 0, 1); PG8_STAGE(PG8_SB(0, 0), b2, voffB); PG8_STAGE(PG8_SB(0, 1), b2 + hstepB, voffB); if constexpr (GATHER) PG8_STAGE(PG8_SA(0, 0), a2, w2[0]); else PG8_STAGE(PG8_SA(0, 0), a2, voffA); \
            PG8_WAIT_V(WX); PG8_WAIT_L(0); PG8_BAR; MMA0(1, 0, At, B0); MMA0(1, 1, At, B1); PG8_BAR; PG8_SCHED; \
            PG8_LDB(B0, 1, 0); PG8_LDB(B1, 1, 1); PG8_SCHED; PG8_LDA(At, 1, 0); if constexpr (GATHER) PG8_STAGE(PG8_SA(0, 1), a2, w2[1]); else PG8_STAGE(PG8_SA(0, 1), a2 + hstepA, voffA); \
            PG8_WAIT_V(WX); PG8_WAIT_L(0); PG8_BAR; PG8_MMA(0, 0, At, B0); PG8_MMA(0, 1, At, B1); PG8_BAR; PG8_SCHED; \
            PG8_LDA(At, 1, 1); PG8_STAGE(PG8_SB(1, 0), b3, voffB); PG8_STAGE(PG8_SB(1, 1), b3 + hstepB, voffB); if constexpr (GATHER) PG8_STAGE(PG8_SA(1, 0), a3, w2[0]); else PG8_STAGE(PG8_SA(1, 0), a3, voffA); \
            PG8_WAIT_V(8); PG8_WAIT_L(0); PG8_BAR; PG8_MMA(1, 0, At, B0); PG8_MMA(1, 1, At, B1); PG8_BAR; PG8_SCHED; \
            } while (0)
__device__ __forceinline__ void mma_frag_z(f32x4& acc, const Frag1& b, const Frag1& a) {
#if defined(__HIP_DEVICE_COMPILE__)
    asm volatile("v_mfma_f32_16x16x128_f8f6f4 %0, %1, %2, 0" : "=&v"(acc) : "v"(b.v), "v"(a.v));
#endif
}
__device__ __forceinline__ void mma_frag_z(f32x4& acc, const Frag2& b, const Frag2& a) { acc = (f32x4){0.f, 0.f, 0.f, 0.f}; mma_frag(acc, b, a); }
template <class Epi, class Sched, bool GATHER = false, int ESZ = 2>
__device__ __forceinline__ void gemm_phase(PG8_LAS unsigned char* lds, PG8_LAS unsigned char* epi, const Gemm g, const Sched& S, const Epi& E) {
    int tid = threadIdx.x; asm volatile("" : "+v"(tid));
    const int wid = __builtin_amdgcn_readfirstlane(tid >> 6), lane = tid & 63, wr = wid >> 2, wc = wid & 3, fr = lane & 15, fq = lane >> 4;
    constexpr bool ALIGN_EPI = true, SP2 = true, RELAX = (ESZ == 1)  ; const int K = g.K, nt = (K * ESZ) / (BK * 2), lda = g.lda, ldb = g.ldb;
    unsigned voffA[2], voffB[2];
#pragma unroll
    for (int i = 0; i < 2; ++i) { int R, C; stage_rc(tid * 16 + i * 8192, R, C); const int Rb = 64 * (R >> 5) + 8 * ((R & 15) >> 2) + 4 * ((R >> 4) & 1) + (R & 3);
        voffA[i] = GATHER ? (unsigned)(R | (C << 16)) : (unsigned)(R * lda * ESZ + C * 2); voffB[i] = (unsigned)(Rb * ldb * ESZ + C * 2); }
    unsigned vgC[2][2], vgN[2][2];
#define PG8_ROWMAP(dst, pm_) do { _Pragma("unroll") for (int h_ = 0; h_ < 2; ++h_) _Pragma("unroll") for (int i_ = 0; i_ < 2; ++i_) { \
        const unsigned tok_ = (unsigned)g.rowmap[(size_t)(pm_) * BM + h_ * HALF + (voffA[i_] & 0xFFFFu)] & 0xFFFFu; dst[h_][i_] = tok_ * (unsigned)(lda * ESZ) + (voffA[i_] >> 16) * 2u; } } while (0)
    const size_t kstep = (size_t)(BK * 2);
    const size_t hstepA = (size_t)HALF * lda * ESZ, hstepB = (size_t)32 * ldb * ESZ;
    const unsigned ldsw = (unsigned)wid * 1024u;
    const int aoff = lds_byte(wr * 64 + fr, fq * 8), boff = lds_byte(wc * 32 + fr, fq * 8);
#define PG8_SA(b, h) (((b) * 2 + (h)) * HTB)
#define PG8_SB(b, h) ((4 + (b) * 2 + (h)) * HTB)
#define PG8_STAGE(bufoff, gbase, voff) do { _Pragma("unroll") for (int _i = 0; _i < 2; ++_i) \
        __builtin_amdgcn_global_load_lds((const unsigned*)((const char*)(gbase) + (voff)[_i]), (PG8_LAS unsigned*)(lds + (bufoff) + ldsw + _i * 8192), 16, 0, 0); } while (0)
#define PG8_LDA(dst, b, h) do { _Pragma("unroll") for (int m = 0; m < 4; ++m) ld_frag(dst[m], lds + PG8_SA(b, h) + aoff + m * 2048); } while (0)
#define PG8_LDB(dst, b, h) do { _Pragma("unroll") for (int n = 0; n < 2; ++n) ld_frag(dst[n], lds + PG8_SB(b, h) + boff + n * 2048); } while (0)
#define PG8_MMA(ai, bj, At, Bt) do { __builtin_amdgcn_s_setprio(1); _Pragma("unroll") for (int m = 0; m < 4; ++m) _Pragma("unroll") for (int n = 0; n < 2; ++n) mma_frag(acc[ai][bj][m][n], Bt[n], At[m]); __builtin_amdgcn_s_setprio(0); } while (0)
#define PG8_MMAZ(ai, bj, At, Bt) do { __builtin_amdgcn_s_setprio(1); _Pragma("unroll") for (int m = 0; m < 4; ++m) _Pragma("unroll") for (int n = 0; n < 2; ++n) mma_frag_z(acc[ai][bj][m][n], Bt[n], At[m]); __builtin_amdgcn_s_setprio(0); } while (0)
#define PG8_WAIT_V(n) asm volatile("s_waitcnt vmcnt(%0)" :: "n"(n) : "memory")
#define PG8_WAIT_L(n) asm volatile("s_waitcnt lgkmcnt(" #n ")" ::: "memory")
#define PG8_BAR __builtin_amdgcn_s_barrier()
#define PG8_SCHED __builtin_amdgcn_sched_barrier(0)
    Unit cur, nxt; int ui = 0;
    if (!S.next(0, cur)) return;
    if (g.stag > 0) { const unsigned long long t0 = __builtin_amdgcn_s_memrealtime(), d = (unsigned long long)((blockIdx.x & 15u) * (unsigned)g.stag); while (__builtin_amdgcn_s_memrealtime() - t0 < d) __builtin_amdgcn_s_sleep(8); }
    f32x4 acc[2][2][4][2];
#pragma unroll
    for (int a = 0; a < 2; ++a)
#pragma unroll
        for (int b = 0; b < 2; ++b)
#pragma unroll
            for (int m = 0; m < 4; ++m)
#pragma unroll
                for (int n = 0; n < 2; ++n) { if constexpr (!RELAX) { acc[a][b][m][n] = (f32x4){0.f, 0.f, 0.f, 0.f}; if constexpr (ESZ == 1) asm volatile("" : "+v"(acc[a][b][m][n])); } }
    typename FragSel<ESZ>::type At[4], B0[2], B1[2];
    const char* cA = GATHER ? (const char*)g.A : (const char*)g.A + S.a_off(cur); const char* cB = (const char*)g.Bt + S.b_off(cur);
    if constexpr (GATHER) { PG8_ROWMAP(vgC, cur.pm); _Pragma("unroll") for (int h_ = 0; h_ < 2; ++h_) _Pragma("unroll") for (int i_ = 0; i_ < 2; ++i_) vgN[h_][i_] = vgC[h_][i_]; }
    typename Epi::Pre pre;
#define PG8_FETCH() do { int t3 = threadIdx.x; asm volatile("" : "+v"(t3)); const int w3 = __builtin_amdgcn_readfirstlane(t3 >> 6), l3 = t3 & 63; const EpiCtx ec3{epi + w3 * EPW, w3 >> 2, w3 & 3, l3 & 15, l3 >> 4, l3}; pre = E.fetch(cur, ec3); } while (0)
    PG8_FETCH();
    S.a_ready(cur);
    {
        PG8_STAGE(PG8_SB(0, 0), cB, voffB); PG8_STAGE(PG8_SB(0, 1), cB + hstepB, voffB);
        if constexpr (GATHER) { PG8_STAGE(PG8_SA(0, 0), cA, vgC[0]); PG8_STAGE(PG8_SA(0, 1), cA, vgC[1]); } else { PG8_STAGE(PG8_SA(0, 0), cA, voffA); PG8_STAGE(PG8_SA(0, 1), cA + hstepA, voffA); }
        if (wr == 1) PG8_BAR;
        PG8_WAIT_V(2); PG8_BAR;
        PG8_STAGE(PG8_SB(1, 0), cB + kstep, voffB); if constexpr (GATHER) PG8_STAGE(PG8_SA(1, 0), cA + kstep, vgC[0]); else PG8_STAGE(PG8_SA(1, 0), cA + kstep, voffA); PG8_STAGE(PG8_SB(1, 1), cB + hstepB + kstep, voffB);
        if constexpr (RELAX) {
            if constexpr (GATHER) PG8_STAGE(PG8_SA(1, 1), cA + kstep, vgC[1]); else PG8_STAGE(PG8_SA(1, 1), cA + kstep + hstepA, voffA);
            volatile __attribute__((address_space(1))) u32x4* dm = (volatile __attribute__((address_space(1))) u32x4*)g.dummy + ((size_t)blockIdx.x * 512 + (size_t)tid);
#pragma unroll
            for (int k_ = 0; k_ < Epi::NST; ++k_) *dm = (u32x4){0u, 0u, 0u, 0u};
            PG8_WAIT_V(8 + Epi::NST); PG8_BAR;
        } else { PG8_WAIT_V(6); PG8_BAR; }
    }
    for (;;) {
        const bool has_next = S.next(ui + 1, nxt);
        const char* nA = (has_next && !GATHER) ? (const char*)g.A + S.a_off(nxt) : cA; const char* nB = has_next ? (const char*)g.Bt + S.b_off(nxt) : cB;
        if constexpr (GATHER) { if (has_next) PG8_ROWMAP(vgN, nxt.pm); }
#define PG8_KPTRS const bool last = (t == nt - 2); const char* a1 = cA + (size_t)(t + 1) * kstep; \
            const char* a2 = last ? nA : cA + (size_t)(t + 2) * kstep; const char* b2 = last ? nB : cB + (size_t)(t + 2) * kstep; const char* a3 = a2 + kstep; const char* b3 = b2 + kstep; (void)a1
        if constexpr (RELAX) {
            { const int t = 0; PG8_KPTRS; PG8_KITER(true, 8 + Epi::NST, PG8_MMAZ); }
            for (int t = 2; t < nt; t += 2) { PG8_KPTRS; PG8_KITER(false, 8, PG8_MMA); }
            if (has_next) { if constexpr (GATHER) PG8_STAGE(PG8_SA(1, 1), nA + kstep, vgN[1]); else PG8_STAGE(PG8_SA(1, 1), nA + kstep + hstepA, voffA); }
        } else {
            for (int t = 0; t < nt; t += 2) { PG8_KPTRS; PG8_KITER(false, 8, PG8_MMA); }
        }
#undef PG8_KPTRS
        if constexpr (ESZ == 1) asm volatile("s_nop 15\n\ts_nop 15" ::: "memory");
        if constexpr (ALIGN_EPI) { if (wr == 0) PG8_BAR; }
        { int t2 = threadIdx.x; asm volatile("" : "+v"(t2));
          const int w2 = __builtin_amdgcn_readfirstlane(t2 >> 6), l2 = t2 & 63; const EpiCtx ec{epi + w2 * EPW, w2 >> 2, w2 & 3, l2 & 15, l2 >> 4, l2}; E(acc, cur, ec, pre); if (Epi::TWICE) { asm volatile("" ::: "memory"); E(acc, cur, ec, pre); } S.done(cur); }
        if (!has_next) break;
#pragma unroll
        for (int a = 0; a < 2; ++a)
#pragma unroll
            for (int b = 0; b < 2; ++b)
#pragma unroll
                for (int m = 0; m < 4; ++m)
#pragma unroll
                    for (int n = 0; n < 2; ++n) { if constexpr (!RELAX) { acc[a][b][m][n] = (f32x4){0.f, 0.f, 0.f, 0.f}; if constexpr (ESZ == 1) asm volatile("" : "+v"(acc[a][b][m][n])); } }
        cur = nxt; cA = nA; cB = nB; ++ui;
        PG8_FETCH();
        if constexpr (GATHER) { _Pragma("unroll") for (int h_ = 0; h_ < 2; ++h_) _Pragma("unroll") for (int i_ = 0; i_ < 2; ++i_) vgC[h_][i_] = vgN[h_][i_]; }
        if constexpr (ALIGN_EPI) { if (wr == 1) PG8_BAR; }
    }
    PG8_WAIT_V(0);
    if constexpr (!ALIGN_EPI) { if (wr == 0) PG8_BAR; }
    PG8_BAR;
#undef PG8_SA
#undef PG8_FETCH
#undef PG8_ROWMAP
#undef PG8_SB
#undef PG8_STAGE
#undef PG8_LDA
#undef PG8_LDB
#undef PG8_MMA
#undef PG8_MMAZ
#undef PG8_WAIT_V
#undef PG8_WAIT_L
#undef PG8_BAR
#undef PG8_SCHED
}
}
#include <hip/hip_bf16.h>
#include <cmath>
namespace attn_body {
using bf16=__hip_bfloat16;
using bf16x8=__attribute__((ext_vector_type(8)))short;
using s16x4=__attribute__((ext_vector_type(4)))short;
using f32x16=__attribute__((ext_vector_type(16)))float;
using u32x4=__attribute__((ext_vector_type(4)))unsigned;
using f32x4_t=__attribute__((ext_vector_type(4)))float;
constexpr int BATCH=8,NHEAD=16,SEQ=8192,D=64,DM=NHEAD*D;
constexpr int NW=8,QBLK=32,QB=QBLK*NW,KVBLK=64,NQB=SEQ/QB;
constexpr int ATTN_PITCH=DM, ATTN_UNIT_ROWS=QB;
__device__ __forceinline__ int crow(int r,int hi){return (r&3)+8*(r>>2)+4*hi;}
#define SBAR() __builtin_amdgcn_sched_barrier(0)
__device__ __forceinline__ void cmask(f32x16&p0,f32x16&p1,int jb,int qrel,int hi){
  const float NEG=-INFINITY; int kb=64*jb+4*hi;
  #pragma unroll
  for(int r=0;r<16;++r){int kv=kb+(r&3)+8*(r>>2); if(kv>qrel)p0[r]=NEG; if(kv+32>qrel)p1[r]=NEG;}
}

constexpr int NSLOT=3, SLOTB=8192;
constexpr int LDS_K=0, LDS_V=NSLOT*SLOTB, LDS_WS=2*NSLOT*SLOTB, LDS_OST=LDS_WS+NW*64*4, LDS_BIAS=LDS_OST+NW*4096, LDS_BYTES=LDS_BIAS+SEQ*4;
constexpr float C2=0.125f*1.4426950408889634f;
__device__ __forceinline__ void glds16(const void*gsrc,unsigned lds_dst){unsigned keep;
  asm volatile("s_mov_b32 %0, m0\n\ts_mov_b32 m0, %2\n\ts_nop 0\n\tglobal_load_lds_dwordx4 %1, off\n\ts_mov_b32 m0, %0":"=&s"(keep):"v"(gsrc),"s"(lds_dst):"memory");}
__device__ __forceinline__ float max3f(float a,float b,float c){float r;asm("v_max3_f32 %0, %1, %2, %3":"=v"(r):"v"(a),"v"(b),"v"(c));return r;}
__device__ __forceinline__ float max2f(float a,float b){float r;asm("v_max_f32_e32 %0, %1, %2":"=v"(r):"v"(a),"v"(b));return r;}
__device__ __forceinline__ float fadd_s(float a,float b){float r;asm("v_add_f32_e32 %0, %1, %2":"=v"(r):"v"(a),"v"(b));return r;}
__device__ __forceinline__ float fsub_s(float a,float b){float r;asm("v_sub_f32_e32 %0, %1, %2":"=v"(r):"v"(a),"v"(b));return r;}
typedef float f32x2_t __attribute__((ext_vector_type(2))); typedef __bf16 bf16x2_t __attribute__((ext_vector_type(2)));
__device__ __forceinline__ unsigned cvtpk_s(float lo,float hi){f32x2_t v={lo,hi};bf16x2_t b=__builtin_convertvector(v,bf16x2_t);return __builtin_bit_cast(unsigned,b);}
#define WAIT_BAR(N) asm volatile("s_waitcnt vmcnt(" #N ") lgkmcnt(0)\n\ts_barrier":::"memory")

__device__ __forceinline__ void qkt(f32x16&p0,f32x16&p1,const char*Kslot,const bf16x8*qr,const f32x16&c0,const f32x16&c1,int r32,int hi){
  const char*kb=Kslot+hi*1024+r32*16;
  #pragma unroll
  for(int d0=0;d0<4;++d0){
    const bf16x8 b0=*reinterpret_cast<const bf16x8*>(kb+d0*2048);
    const bf16x8 b1=*reinterpret_cast<const bf16x8*>(kb+d0*2048+512);
    if(d0==0){p0=__builtin_amdgcn_mfma_f32_32x32x16_bf16(b0,qr[0],c0,0,0,0);p1=__builtin_amdgcn_mfma_f32_32x32x16_bf16(b1,qr[0],c1,0,0,0);}
    else{p0=__builtin_amdgcn_mfma_f32_32x32x16_bf16(b0,qr[d0],p0,0,0,0);p1=__builtin_amdgcn_mfma_f32_32x32x16_bf16(b1,qr[d0],p1,0,0,0);}}
}
typedef __attribute__((address_space(3))) const char* lds_cptr;
typedef short v4i16_t __attribute__((ext_vector_type(4)));
__device__ __forceinline__ void kload8(bf16x8*kf,lds_cptr kp){
  kf[0]=*(const __attribute__((address_space(3))) bf16x8*)(kp);      kf[1]=*(const __attribute__((address_space(3))) bf16x8*)(kp+512);
  kf[2]=*(const __attribute__((address_space(3))) bf16x8*)(kp+2048); kf[3]=*(const __attribute__((address_space(3))) bf16x8*)(kp+2560);
  kf[4]=*(const __attribute__((address_space(3))) bf16x8*)(kp+4096); kf[5]=*(const __attribute__((address_space(3))) bf16x8*)(kp+4608);
  kf[6]=*(const __attribute__((address_space(3))) bf16x8*)(kp+6144); kf[7]=*(const __attribute__((address_space(3))) bf16x8*)(kp+6656);
}
__device__ __forceinline__ void kload2(bf16x8*kf,lds_cptr kp,int j){ kf[2*j]=*(const __attribute__((address_space(3))) bf16x8*)(kp+j*2048); kf[2*j+1]=*(const __attribute__((address_space(3))) bf16x8*)(kp+j*2048+512); }
__device__ __forceinline__ s16x4 vtr(lds_cptr p){ return __builtin_bit_cast(s16x4,__builtin_amdgcn_ds_read_tr16_b64_v4i16((__attribute__((address_space(3))) v4i16_t*)p)); }
__device__ __forceinline__ float rowmax(const f32x16&p0,const f32x16&p1){
  float a=max3f(p0[0],p0[1],p1[0]),b=max3f(p0[2],p0[3],p1[1]);a=max3f(a,p1[2],p1[3]);
  #pragma unroll
  for(int r=4;r<16;r+=4){a=max3f(a,p0[r],p0[r+1]);b=max3f(b,p0[r+2],p0[r+3]);a=max3f(a,p1[r],p1[r+1]);b=max3f(b,p1[r+2],p1[r+3]);}
  const float m=max2f(a,b);
  auto rr=__builtin_amdgcn_permlane32_swap(__float_as_uint(m),__float_as_uint(m),false,false);
  return max2f(__uint_as_float(rr[0]),__uint_as_float(rr[1]));
}
__device__ __forceinline__ void pv(f32x16*o,int vb,bf16x8 pa0,bf16x8 pa1,bf16x8 pa2,bf16x8 pa3){
  #pragma unroll
  for(int d0=0;d0<2;++d0){s16x4 lo[4],hi[4];
    #pragma unroll
    for(int ks=0;ks<4;++ks){
      asm volatile("ds_read_b64_tr_b16 %0,%1 offset:%c2":"=&v"(lo[ks]):"v"(vb),"i"(d0*4096+ks*1024):"memory");
      asm volatile("ds_read_b64_tr_b16 %0,%1 offset:%c2":"=&v"(hi[ks]):"v"(vb),"i"(d0*4096+ks*1024+512):"memory");}
    asm volatile("s_waitcnt lgkmcnt(0)":::"memory");SBAR();
    #define PK(k) (bf16x8){lo[k][0],lo[k][1],lo[k][2],lo[k][3],hi[k][0],hi[k][1],hi[k][2],hi[k][3]}
    o[d0]=__builtin_amdgcn_mfma_f32_32x32x16_bf16(pa0,PK(0),o[d0],0,0,0);
    o[d0]=__builtin_amdgcn_mfma_f32_32x32x16_bf16(pa1,PK(1),o[d0],0,0,0);
    o[d0]=__builtin_amdgcn_mfma_f32_32x32x16_bf16(pa2,PK(2),o[d0],0,0,0);
    o[d0]=__builtin_amdgcn_mfma_f32_32x32x16_bf16(pa3,PK(3),o[d0],0,0,0);
    #undef PK
  }
}

#ifndef ATTN_STORE16
#define ATTN_STORE16(p,v) (*(u32x4*)(p)=(v))
#endif
template<int THRL,bool STATIC> __device__ __forceinline__ void attn_unit(int b,int h,int qb,int ts,const bf16*Q,const bf16*__restrict__ K,const bf16*__restrict__ V,bf16*O,const float*biasg,char*shm){
  int tid=threadIdx.x; asm volatile("":"+v"(tid)); const int lane=tid&63,r32=lane&31,hi=lane>>5; const int wid=__builtin_amdgcn_readfirstlane(tid>>6);
  const long rowbase=(long)b*SEQ; const int q0=qb*QB;
  const bf16*Qw=Q+(rowbase+q0+wid*QBLK)*DM+h*D;
  const bf16*Kh=K+(rowbase+(long)ts*KVBLK)*DM+h*D,*Vh=V+(rowbase+(long)ts*KVBLK)*DM+h*D;
  const unsigned lds0=(unsigned)(uintptr_t)shm;
  float*wsf=(float*)(shm+LDS_WS)+wid*64;
  const bf16*ksrc=Kh+(long)lane*DM+wid*8;
  const bf16*vsrc=Vh+(long)(16*(wid&3)+(lane>>2))*DM+(wid>>2)*32+(lane&3)*8;
  const unsigned kdst=lds0+LDS_K+wid*1024, vdst=lds0+LDS_V+wid*1024;
  #define DMA_K(t,slot) glds16(ksrc+(long)(t)*KVBLK*DM,(unsigned)__builtin_amdgcn_readfirstlane(kdst+(slot)))
  #define DMA_V(t,slot) glds16(vsrc+(long)(t)*KVBLK*DM,(unsigned)__builtin_amdgcn_readfirstlane(vdst+(slot)))
  const int vb0=(int)(lds0+LDS_V)+((lane>>4)&1)*32+(lane&3)*8+(4*hi+((lane&15)>>2))*64;
  const char*Kbase=shm+LDS_K; bf16x8 kf[8];
  const lds_cptr shm3=(lds_cptr)shm; const lds_cptr kp0=shm3+LDS_K+hi*1024+r32*16; const lds_cptr vp0=shm3+LDS_V+((lane>>4)&1)*32+(lane&3)*8+(4*hi+((lane&15)>>2))*64;
  const int NT=(q0+QB)/KVBLK-ts;
  if(!STATIC){ const float*bg=biasg+(long)(b*NHEAD+h)*SEQ+ts*KVBLK; const int nb=NT*KVBLK;
    for(int f0=wid*256;f0<nb;f0+=NW*256) glds16(bg+f0+lane*4,(unsigned)__builtin_amdgcn_readfirstlane(lds0+LDS_BIAS+f0*4)); }
  const lds_cptr bp0=shm3+LDS_BIAS+hi*16;
  DMA_K(0,0);DMA_V(0,0);DMA_K(1,SLOTB);
  bf16x8 qr[4];
  #pragma unroll
  for(int d0=0;d0<4;++d0)qr[d0]=*reinterpret_cast<const bf16x8*>(&Qw[(long)r32*DM+d0*16+hi*8]);
  float mhat=0.f,l_reg=0.f;f32x16 o[2];o[0]=f32x16{};o[1]=f32x16{};f32x16 cb0,cb1;
  #define LOADCB(t) do{ const lds_cptr bp_=bp0+(t)*256; _Pragma("unroll") for(int j_=0;j_<4;++j_){ \
      const f32x4_t u0_=*(const __attribute__((address_space(3))) f32x4_t*)(bp_+j_*32); const f32x4_t u1_=*(const __attribute__((address_space(3))) f32x4_t*)(bp_+128+j_*32); \
      _Pragma("unroll") for(int i_=0;i_<4;++i_){ if(STATIC){ cb0[4*j_+i_]=u0_[i_]; cb1[4*j_+i_]=u1_[i_]; } else { cb0[4*j_+i_]=u0_[i_]-mhat; cb1[4*j_+i_]=u1_[i_]-mhat; } } } }while(0)
  const int qrel=wid*QBLK+r32;
  #define CMASK(P0,P1,t) do{int jb_=(t)-(NT-4); if(jb_>=0)cmask(P0,P1,jb_,qrel,hi);}while(0)
  bool resc=false;
  #define START(P0,P1) do{ resc=false; \
    if(!STATIC){ const float rm=rowmax(P0,P1); const float dl=rm; mhat=fadd_s(mhat,dl); \
      _Pragma("unroll") for(int r=0;r<16;++r){P0[r]=fsub_s(P0[r],dl);P1[r]=fsub_s(P1[r],dl);} \
      } \
    _Pragma("unroll") for(int r=0;r<16;++r)P0[r]=__builtin_amdgcn_exp2f(P0[r]); }while(0)
  #define RESC() do{ if(resc){ asm volatile("s_waitcnt lgkmcnt(0)":::"memory"); \
      _Pragma("unroll") for(int d_=0;d_<2;++d_) _Pragma("unroll") for(int r=0;r<16;++r)o[d_][r]*=wsf[crow(r,hi)]; } }while(0)
  f32x16 pA0,pA1,pB0,pB1;
  int sl_prev=0,sl_cur=0,sl_next=SLOTB;
  #define ROT() do{sl_prev=sl_cur;sl_cur=sl_next;sl_next=(sl_next==(NSLOT-1)*SLOTB)?0:sl_next+SLOTB;}while(0)
  DMA_K(2,2*SLOTB);
  if(STATIC){ const float*bg=biasg+(long)(b*NHEAD+h)*SEQ; const float ref=bg[q0+QB-1]; const int nb=NT*KVBLK;
    for(int f0=tid*4;f0<nb;f0+=NW*256){ f32x4_t v=*(const f32x4_t*)(bg+ts*KVBLK+f0); v[0]-=ref; v[1]-=ref; v[2]-=ref; v[3]-=ref; *(__attribute__((address_space(3))) f32x4_t*)(shm3+LDS_BIAS+f0*4)=v; } }
  WAIT_BAR(3);
  LOADCB(0); qkt(pA0,pA1,Kbase,qr,cb0,cb1,r32,hi);asm volatile("s_nop 15\n\ts_nop 7":"+v"(pA0),"+v"(pA1));CMASK(pA0,pA1,0);
  START(pA0,pA1);
  _Pragma("unroll") for(int r=0;r<16;++r)pA1[r]=__builtin_amdgcn_exp2f(pA1[r]);
  WAIT_BAR(0);
  DMA_K(3,0);DMA_V(1,SLOTB);
  ROT();
  kload8(kf,kp0+sl_cur);
  WAIT_BAR(2);
  s16x4 vlo[8],vhi[8]; u32x4 pw0,pw1,pw2,pw3;
  #define PKW(P,B) cvtpk_s(P[B],P[B+1])
  #define PAF(k) __builtin_bit_cast(bf16x8,pw##k)
  #define VFR(i) (bf16x8){vlo[i][0],vlo[i][1],vlo[i][2],vlo[i][3],vhi[i][0],vhi[i][1],vhi[i][2],vhi[i][3]}
  #define PIN(x) asm volatile("":"+v"(x))
  #define MX3(a,b,c) __builtin_fmaxf(__builtin_fmaxf((a),(b)),(c))
  #define GAPA(MF,A0,A1,A2,A3,W0,W1,PW) do{ MF; sacc+=A0; sacc+=A1; sacc+=A2; sacc+=A3; PIN(sacc); W0; W1; PIN(PW); SBAR(); }while(0)
  #define EX(v) __builtin_amdgcn_exp2f(v)
  #define GAPB(MF,X,B) do{ MF; X[B]=EX(X[B]); X[B+1]=EX(X[B+1]); X[B+2]=EX(X[B+2]); X[B+3]=EX(X[B+3]); PIN(X); SBAR(); }while(0)
  #define VRD(i) do{ vlo[i]=vtr(vp_+(((i)>>2)*4096+((i)&3)*1024)); vhi[i]=vtr(vp_+(((i)>>2)*4096+((i)&3)*1024+512)); }while(0)
  #define KRD(G,j) do{ if(G){ kload2(kf,kp0+sl_next,j); SBAR(); } }while(0)
  #define STEP(C0,C1,P0,P1,t,GK,GV,GL) do{ SBAR(); \
    LOADCB(t); SBAR(); \
    const lds_cptr vp_=vp0+sl_prev; \
    VRD(0); SBAR(); float sacc=(P0[0]+P0[1]); \
    GAPA(C0=__builtin_amdgcn_mfma_f32_32x32x16_bf16(kf[0],qr[0],cb0,0,0,0), P0[2],P0[3],P0[4],P0[5],     pw0[0]=PKW(P0,0), pw0[1]=PKW(P0,2), pw0); \
    VRD(4); SBAR(); GAPA(C1=__builtin_amdgcn_mfma_f32_32x32x16_bf16(kf[1],qr[0],cb1,0,0,0), P0[6],P0[7],P0[8],P0[9],     pw0[2]=PKW(P0,4), pw0[3]=PKW(P0,6), pw0); \
    VRD(1); SBAR(); GAPA(C0=__builtin_amdgcn_mfma_f32_32x32x16_bf16(kf[2],qr[1],C0,0,0,0),   P0[10],P0[11],P0[12],P0[13], pw1[0]=PKW(P0,8), pw1[1]=PKW(P0,10), pw1); \
    VRD(5); SBAR(); GAPA(C1=__builtin_amdgcn_mfma_f32_32x32x16_bf16(kf[3],qr[1],C1,0,0,0),   P0[14],P0[15],P1[0],P1[1],   pw1[2]=PKW(P0,12),pw1[3]=PKW(P0,14), pw1); \
    VRD(2); SBAR(); GAPA(C0=__builtin_amdgcn_mfma_f32_32x32x16_bf16(kf[4],qr[2],C0,0,0,0),   P1[2],P1[3],P1[4],P1[5],     pw2[0]=PKW(P1,0), pw2[1]=PKW(P1,2), pw2); \
    VRD(6); SBAR(); GAPA(C1=__builtin_amdgcn_mfma_f32_32x32x16_bf16(kf[5],qr[2],C1,0,0,0),   P1[6],P1[7],P1[8],P1[9],     pw2[2]=PKW(P1,4), pw2[3]=PKW(P1,6), pw2); \
    VRD(3); SBAR(); GAPA(C0=__builtin_amdgcn_mfma_f32_32x32x16_bf16(kf[6],qr[3],C0,0,0,0),   P1[10],P1[11],P1[12],P1[13], pw3[0]=PKW(P1,8), pw3[1]=PKW(P1,10), pw3); \
    VRD(7); SBAR(); GAPA(C1=__builtin_amdgcn_mfma_f32_32x32x16_bf16(kf[7],qr[3],C1,0,0,0),   P1[14],P1[15],0.f,0.f,       pw3[2]=PKW(P1,12),pw3[3]=PKW(P1,14), pw3); \
    l_reg+=sacc; \
    if(GK){DMA_K((t)+3,sl_cur);} if(GV){DMA_V((t)+1,sl_next);} \
    CMASK(C0,C1,t); \
    if(!STATIC){ float a=MX3(C0[0],C0[1],C1[0]),b=MX3(C0[2],C0[3],C1[1]); a=MX3(a,C1[2],C1[3]); \
      _Pragma("unroll") for(int r=4;r<16;r+=4){a=MX3(a,C0[r],C0[r+1]);b=MX3(b,C0[r+2],C0[r+3]);a=MX3(a,C1[r],C1[r+1]);b=MX3(b,C1[r+2],C1[r+3]);} \
      float rm=__builtin_fmaxf(a,b); { auto rr=__builtin_amdgcn_permlane32_swap(__float_as_uint(rm),__float_as_uint(rm),false,false); rm=__builtin_fmaxf(__uint_as_float(rr[0]),__uint_as_float(rr[1])); } \
      resc=false; \
      if(__builtin_expect(__any(rm>(float)THRL),0)){ const float dl=__builtin_fmaxf(rm,0.f); mhat+=dl; \
        _Pragma("unroll") for(int r=0;r<16;++r){C0[r]-=dl;C1[r]-=dl;} \
        const float f=__builtin_amdgcn_exp2f(-dl); l_reg*=f; if(hi==0)wsf[r32]=f; resc=true; } } \
    SBAR(); \
    GAPB(o[0]=__builtin_amdgcn_mfma_f32_32x32x16_bf16(PAF(0),VFR(0),o[0],0,0,0), C0,0); \
    GAPB(o[1]=__builtin_amdgcn_mfma_f32_32x32x16_bf16(PAF(0),VFR(4),o[1],0,0,0), C0,4); \
    KRD(GL,0); GAPB(o[0]=__builtin_amdgcn_mfma_f32_32x32x16_bf16(PAF(1),VFR(1),o[0],0,0,0), C0,8); \
    KRD(GL,1); GAPB(o[1]=__builtin_amdgcn_mfma_f32_32x32x16_bf16(PAF(1),VFR(5),o[1],0,0,0), C0,12); \
    KRD(GL,2); GAPB(o[0]=__builtin_amdgcn_mfma_f32_32x32x16_bf16(PAF(2),VFR(2),o[0],0,0,0), C1,0); \
    KRD(GL,3); GAPB(o[1]=__builtin_amdgcn_mfma_f32_32x32x16_bf16(PAF(2),VFR(6),o[1],0,0,0), C1,4); \
    GAPB(o[0]=__builtin_amdgcn_mfma_f32_32x32x16_bf16(PAF(3),VFR(3),o[0],0,0,0), C1,8); \
    GAPB(o[1]=__builtin_amdgcn_mfma_f32_32x32x16_bf16(PAF(3),VFR(7),o[1],0,0,0), C1,12); \
    }while(0)
  int t=1;
  #undef CMASK
  #define CMASK(P0,P1,t) do{}while(0)
  for(;t+5<NT;t+=2){
    STEP(pB0,pB1,pA0,pA1,t,true,true,true);     WAIT_BAR(2); RESC(); ROT();
    STEP(pA0,pA1,pB0,pB1,t+1,true,true,true);   WAIT_BAR(2); RESC(); ROT();
  }
  #undef CMASK
  #define CMASK(P0,P1,t) do{int jb_=(t)-(NT-4); if(jb_>=0)cmask(P0,P1,jb_,qrel,hi);}while(0)
  #define ENDW(tt) do{ if((tt)+3<NT){WAIT_BAR(2);} else if((tt)+2<NT){WAIT_BAR(1);} else {WAIT_BAR(0);} }while(0)
  for(;t+1<NT;t+=2){
    STEP(pB0,pB1,pA0,pA1,t,(t+3<NT),(t+1<NT),(t+1<NT));       ENDW(t);   RESC(); ROT();
    STEP(pA0,pA1,pB0,pB1,t+1,(t+4<NT),(t+2<NT),(t+2<NT));     ENDW(t+1); RESC(); ROT();
  }
  STEP(pB0,pB1,pA0,pA1,NT-1,false,false,false); RESC();
  { float sacc=pB0[0]+pB0[1]; _Pragma("unroll") for(int r=2;r<16;++r)sacc+=pB0[r]; _Pragma("unroll") for(int r=0;r<16;++r)sacc+=pB1[r]; l_reg+=sacc;
    pw0=(u32x4){PKW(pB0,0),PKW(pB0,2),PKW(pB0,4),PKW(pB0,6)};pw1=(u32x4){PKW(pB0,8),PKW(pB0,10),PKW(pB0,12),PKW(pB0,14)};pw2=(u32x4){PKW(pB1,0),PKW(pB1,2),PKW(pB1,4),PKW(pB1,6)};pw3=(u32x4){PKW(pB1,8),PKW(pB1,10),PKW(pB1,12),PKW(pB1,14)};
    SBAR(); pv(o,vb0+sl_cur,PAF(0),PAF(1),PAF(2),PAF(3)); }
  #undef PKW
  #undef PAF
  #undef VFR
  #undef PIN
  #undef MX3
  #undef GAPA
  #undef GAPB
  #undef EX
  #undef VRD
  #undef KRD
  #undef STEP
  #undef ENDW
  {auto rr=__builtin_amdgcn_permlane32_swap(__float_as_uint(l_reg),__float_as_uint(l_reg),false,false);l_reg=__uint_as_float(rr[0])+__uint_as_float(rr[1]);}
  if(hi==0)wsf[32+r32]=l_reg;asm volatile("s_waitcnt lgkmcnt(0)":::"memory");
  float rli[16];
  #pragma unroll
  for(int r=0;r<16;++r)rli[r]=__builtin_amdgcn_rcpf(wsf[32+crow(r,hi)]);
  unsigned char*Ow=(unsigned char*)O+(rowbase+q0+wid*QBLK)*DM+h*D;
  { __attribute__((address_space(3))) unsigned char*stg=(__attribute__((address_space(3))) unsigned char*)(shm3+LDS_OST)+wid*2048;
    #pragma unroll
    for(int r=0;r<16;++r){const int orow=crow(r,hi);
      #pragma unroll
      for(int d0=0;d0<2;++d0){const float v=o[d0][r]*rli[r]; stg[orow*64+d0*32+r32]=(unsigned char)(__builtin_amdgcn_cvt_pk_fp8_f32(v,v,0u,false)&0xffu);}}
    asm volatile("s_waitcnt lgkmcnt(0)":::"memory");
    #pragma unroll
    for(int i=0;i<2;++i){const int row=i*16+(lane>>2),ch=lane&3; const u32x4 v=*(const __attribute__((address_space(3))) u32x4*)(stg+row*64+ch*16); ATTN_STORE16(Ow+(long)row*DM+ch*16,v);} }
  asm volatile("s_waitcnt lgkmcnt(0)\n\ts_barrier":::"memory");
  #undef DMA_K
  #undef DMA_V
  #undef CMASK
  #undef START
  #undef RESC
  #undef ROT
  #undef LOADCB
}
constexpr int ATTN_LDS_BYTES=LDS_BYTES;
struct AttnTensors { const bf16* Q; const bf16* K; const bf16* V; bf16* O; const float* bias; const int* ts; };
struct AttnUnit { int bh; int qb; };
struct StaticOrder {
  int vcu;
  __device__ __forceinline__ explicit StaticOrder(int grid,int block):vcu((block%8)*(grid/8)+block/8){}
  __device__ __forceinline__ bool next(int i,AttnUnit&u)const{ if(i>=16)return false; const int grp=i>>2,j=i&3,r=((vcu&7)+2*grp)&7; u.bh=(vcu>>3)+32*grp;
    u.qb=(r<5)?((j==0)?r:(4+3*r+j)):(20+4*(r-5)+j); return true; }
  __device__ __forceinline__ void a_ready(const AttnUnit&)const{}
  __device__ __forceinline__ void done(const AttnUnit&)const{}
};
template<class Sched,int THRL=60> __device__ __forceinline__ void attn_phase(char*lds,const AttnTensors&T,const Sched&S){
  AttnUnit u;
  for(int i=0;S.next(i,u);++i){ S.a_ready(u); const int ts_=__builtin_amdgcn_readfirstlane(T.ts[u.bh*NQB+u.qb]);
    if(ts_&0x10000) attn_unit<THRL,true>(u.bh/NHEAD,u.bh%NHEAD,u.qb,ts_&0xffff,T.Q,T.K,T.V,T.O,T.bias,lds); else attn_unit<THRL,false>(u.bh/NHEAD,u.bh%NHEAD,u.qb,ts_,T.Q,T.K,T.V,T.O,T.bias,lds);
    S.done(u); }
}
#undef SBAR
#undef WAIT_BAR
}
#define GAS __attribute__((address_space(1)))
#define LAS __attribute__((address_space(3)))
typedef unsigned short bf16;
typedef unsigned v4u __attribute__((ext_vector_type(4)));
typedef float f32x4 __attribute__((ext_vector_type(4)));
typedef short bf16x8 __attribute__((ext_vector_type(8)));
typedef GAS unsigned gu32;
typedef GAS unsigned long long gu64;
#define RLX_AGENT __ATOMIC_RELAXED, __HIP_MEMORY_SCOPE_AGENT
#define LDS_WAIT() asm volatile("s_waitcnt lgkmcnt(0)" ::: "memory")
#define VM_WAIT() asm volatile("s_waitcnt vmcnt(0)" ::: "memory")
__device__ __forceinline__ unsigned long long rt() { return __builtin_amdgcn_s_memrealtime(); }
__device__ __forceinline__ unsigned f2bf(float f) { unsigned u = __builtin_bit_cast(unsigned, f); return (u + 0x7fffu + ((u >> 16) & 1u)) >> 16; }
__device__ __forceinline__ unsigned pk2(float lo, float hi) { return f2bf(lo) | (f2bf(hi) << 16); }

#define XB_TMO      128
#define XB_XCNT(j)  (256  + 64 * (j))
#define XB_XSUB(j)  (1280 + 64 * (j))
#define XB_XGEN(j)  (2304 + 64 * (j))
#define XB_TOP      3328
#define XB_TOPGEN   3392
#define XCD_BAR_WORDS 3456
#define XB_SPIN_CAP (1u << 18)

__device__ __forceinline__ unsigned xb_ld(unsigned* p)              { return __hip_atomic_load(p, __ATOMIC_RELAXED, __HIP_MEMORY_SCOPE_AGENT); }
__device__ __forceinline__ unsigned xb_add(unsigned* p, unsigned v) { return __hip_atomic_fetch_add(p, v, __ATOMIC_RELAXED, __HIP_MEMORY_SCOPE_AGENT); }
__device__ __forceinline__ unsigned xb_xcc_id() { return (unsigned)__builtin_amdgcn_s_getreg((3 << 11) | 20) & 0xFu; }
#define XB_SPIN(cond, bar) do { unsigned _sp = 0; while (cond) { __builtin_amdgcn_s_sleep(1); \
    if ((++_sp & 255u) == 0u) { if (xb_ld(&(bar)[XB_TMO])) break; if (_sp > XB_SPIN_CAP) { atomicAdd(&(bar)[XB_TMO], 1u); break; } } } } while (0)

struct XcdBarrier {
    unsigned* bar; unsigned x;
    volatile LAS unsigned* st;
};

__device__ __forceinline__ XcdBarrier xcd_barrier_post(unsigned* bar, volatile LAS unsigned* st) {
    XcdBarrier b; b.bar = bar; b.x = xb_xcc_id(); b.st = st;
    if (threadIdx.x == 0) (void)xb_add(&bar[XB_XCNT(b.x)], 1u);
    return b;
}
__device__ __forceinline__ void xcd_barrier_complete(unsigned* bar, unsigned x, unsigned& nloc, unsigned& nx) {
    const unsigned G = gridDim.x * gridDim.y * gridDim.z;
    unsigned sum, cnt, mine, sp = 0u;
    for (;;) {
        sum = 0u; cnt = 0u; mine = 0u;
#pragma unroll
        for (unsigned j = 0; j < 16; ++j) { const unsigned c = xb_ld(&bar[XB_XCNT(j)]); sum += c; cnt += (c > 0u) ? 1u : 0u; mine = (j == x) ? c : mine; }
        if (sum == G) break;
        __builtin_amdgcn_s_sleep(1);
        if ((++sp & 255u) == 0u) { if (xb_ld(&bar[XB_TMO])) break; if (sp > XB_SPIN_CAP) { atomicAdd(&bar[XB_TMO], 1u); break; } }
    }
    nloc = mine > 0u ? mine : 1u; nx = cnt > 0u ? cnt : 1u;
}

__device__ __forceinline__ void xcd_barrier(const XcdBarrier& b) {
    asm volatile("s_waitcnt vmcnt(0)" ::: "memory");
    __syncthreads();
    if (threadIdx.x == 0) {
        unsigned* bar = b.bar;
        __builtin_amdgcn_s_waitcnt(0);
        unsigned nloc = b.st[0], nx = b.st[1];
        if (nloc == 0u) { xcd_barrier_complete(bar, b.x, nloc, nx); b.st[0] = nloc; b.st[1] = nx; }
        const unsigned old = xb_add(&bar[XB_XSUB(b.x)], 1u);
        const unsigned gen = old / nloc;
        if (old + 1u == (gen + 1u) * nloc) {
            __builtin_amdgcn_fence(__ATOMIC_RELEASE, "agent");
            asm volatile("s_waitcnt vmcnt(0)" ::: "memory");
            const unsigned og = xb_add(&bar[XB_TOP], 1u);
            const unsigned tg = og / nx;
            if (og + 1u == (tg + 1u) * nx) xb_add(&bar[XB_TOPGEN], 1u);
            else XB_SPIN(xb_ld(&bar[XB_TOPGEN]) == tg, bar);
            __builtin_amdgcn_fence(__ATOMIC_ACQUIRE, "agent");
            xb_add(&bar[XB_XGEN(b.x)], 1u);
            asm volatile("s_waitcnt vmcnt(0)" ::: "memory");
        } else {
            XB_SPIN(xb_ld(&bar[XB_XGEN(b.x)]) == gen, bar);
            __builtin_amdgcn_fence(__ATOMIC_ACQUIRE, "agent");
            asm volatile("s_waitcnt vmcnt(0)" ::: "memory");
        }
    }
    __syncthreads();
}

constexpr int NWAVES = 8;
constexpr int NB = 8, SEQ = 8192, D = 1024, NTOK = NB * SEQ, NE = 32, PLE = 256, NH = 16;
constexpr int MAXT = 1056;
constexpr int NCHUNK = NTOK / 256;
constexpr float LOG2E = 1.4426950408889634f;
constexpr float WSCALE8 = 1.0f / pg8::W8INV;
#ifndef MK_PER_PHASE
#define MK_PER_PHASE 0
#endif
constexpr int N_PHASES = 21;
#ifndef STAG_GU
#define STAG_GU 0
#endif
#ifndef STAG_DOWN
#define STAG_DOWN 0
#endif
#ifndef STAG_QKV
#define STAG_QKV 0
#endif
#ifndef STAG_PLE
#define STAG_PLE 0
#endif
#ifndef STAG_PJ
#define STAG_PJ 0
#endif
#ifndef STAG_WO
#define STAG_WO 0
#endif
#ifndef STAG_POOL
#define STAG_POOL 0
#endif

constexpr size_t MiB = 1u << 20;
constexpr size_t WS_CTL = 0, CTL_ZERO_BYTES = 1 * MiB;
constexpr size_t WS_META = 4 * MiB;
constexpr size_t WS_LOGITS = 5 * MiB;
constexpr size_t WS_TOKE = 13 * MiB;
constexpr size_t WS_TOKG = 14 * MiB;
constexpr size_t WS_TOKPOS = 15 * MiB;
constexpr size_t WS_SLOTG = 16 * MiB;
constexpr size_t WS_SLOTR = 18 * MiB;
constexpr size_t WS_LF = 20 * MiB;
constexpr size_t WS_BIAS = 24 * MiB;
constexpr size_t WS_TS = WS_META + 128 * 1024;
constexpr size_t WS_BGU16 = WS_META + 512 * 1024, WS_BD16 = WS_META + 768 * 1024;
constexpr size_t WS_NRM = WS_META + 256 * 1024;
constexpr size_t WS_WPOOL = 28 * MiB, WS_WROUTER = 29 * MiB, WS_WO = 30 * MiB, WS_WQKV = 32 * MiB, WS_WPG = 39 * MiB, WS_WPP = 43 * MiB, WS_WD = 44 * MiB, WS_WGU = 172 * MiB;
constexpr size_t WS_PB = 428 * MiB;
constexpr size_t WS_XA = 492 * MiB, WS_XB = 620 * MiB;
constexpr size_t WS_XA8 = 1276 * MiB + 384 * MiB;
constexpr size_t WS_XB8 = 1276 * MiB + 128 * MiB;
constexpr size_t WS_XT8 = 1276 * MiB + 448 * MiB;
constexpr size_t WS_XT = 1276 * MiB + 256 * MiB;
constexpr size_t WS_HS = 748 * MiB;
constexpr size_t WS_ACT = 1276 * MiB;
constexpr size_t WS_SS = 1804 * MiB;
constexpr size_t WS_SLOTT = 1828 * MiB;
constexpr size_t WS_DUMMY = 1830 * MiB;
constexpr size_t WS_END = 1832 * MiB;
constexpr size_t SSA = (size_t)NTOK * 16;
static_assert(WS_HS + (size_t)MAXT * 256 * D * 2 <= WS_ACT && WS_ACT + (size_t)MAXT * 256 * D * 2 <= WS_SS && WS_SS + 6 * SSA * 4 <= WS_SLOTT && WS_SLOTT + (size_t)MAXT * 256 * 4 <= WS_DUMMY, "d_ws map");
static_assert(WS_WGU + (size_t)2 * 32 * 2048 * 1024 * 2 <= WS_PB && WS_WD + (size_t)2 * 32 * 1024 * 1024 * 2 <= WS_WGU && WS_WQKV + (size_t)3328 * 1024 * 2 <= WS_WPG, "d_ws map (weights)");
constexpr int CW_TMO = 0, CW_BAR = 4096, CW_NRM = 8192;

constexpr int RING_OFF = 0, RING_BYTES = 131072;
constexpr int EPI_OFF = RING_BYTES, LDSCTL_OFF = EPI_OFF + 8 * pg8::EPW, MISC_OFF = LDSCTL_OFF + 320, TP_OFF = LDSCTL_OFF + 1024;
constexpr int LDS_BYTES = LDSCTL_OFF + 4096;
static_assert(attn_body::ATTN_LDS_BYTES <= RING_BYTES, "attention LDS");

__device__ __forceinline__ float wave_sum(float v) {
#pragma unroll
    for (int o = 1; o < 64; o <<= 1) v += __shfl_xor(v, o);
    return v;
}
__device__ __forceinline__ float dot4f(const f32x4& a) { return (a[0] * a[0] + a[1] * a[1]) + (a[2] * a[2] + a[3] * a[3]); }
__device__ __forceinline__ float rstd_tok(const float* ssp, size_t t) { float v[16];
#pragma unroll
    for (int k = 0; k < 16; ++k) v[k] = ssp[(size_t)k * NTOK + t];
    return pg8::rstd_of(pg8::sum16(v)); }
__device__ __forceinline__ float bflo(unsigned w) { return __builtin_bit_cast(float, w << 16); }
__device__ __forceinline__ float bfhi(unsigned w) { return __builtin_bit_cast(float, w & 0xffff0000u); }

__device__ __forceinline__ void conv_item(const float* W, int ldw, int k0, int n0, int nvalid, bf16* WT, int ldk, int drow0, const float* gain, LAS float* scr, int lane) {
    const bool ok = (lane & 31) < nvalid;
#pragma unroll 8
    for (int i = 0; i < 32; ++i) { const int kk = 2 * i + (lane >> 5); scr[kk * 33 + (lane & 31)] = ok ? W[(size_t)(k0 + kk) * ldw + n0 + (lane & 31)] : 0.f; }
    LDS_WAIT(); asm volatile("" ::: "memory");
    const int c = lane & 7;
    float gv[8];
#pragma unroll
    for (int i = 0; i < 8; ++i) gv[i] = gain ? gain[k0 + 8 * c + i] : 1.f;
#pragma unroll
    for (int j = 0; j < 4; ++j) { const int n = (lane >> 3) + 8 * j; const LAS float* s = scr + (8 * c) * 33 + n;
        v4u o; o.x = pk2(s[0 * 33] * gv[0], s[1 * 33] * gv[1]); o.y = pk2(s[2 * 33] * gv[2], s[3 * 33] * gv[3]); o.z = pk2(s[4 * 33] * gv[4], s[5 * 33] * gv[5]); o.w = pk2(s[6 * 33] * gv[6], s[7 * 33] * gv[7]);
        *(GAS v4u*)(WT + (size_t)(drow0 + n) * ldk + k0 + 8 * c) = o; }
    LDS_WAIT(); asm volatile("" ::: "memory");
}

__device__ __forceinline__ void conv_item8(const float* W, int ldw, int k0, int n0, unsigned char* WT, int ldk, int drow0, const float* gain, float wscale, LAS float* scr, int lane, int nvalid = 32) {
    { const int c8 = lane & 7, r8 = lane >> 3; const bool ok = 4 * c8 < nvalid; f32x4 wv[8];
      const float* wp = W + (size_t)(k0 + r8) * ldw + n0 + 4 * c8;
#pragma unroll
      for (int i = 0; i < 8; ++i) wv[i] = ok ? *(const f32x4*)(wp + (size_t)(8 * i) * ldw) : (f32x4){0.f, 0.f, 0.f, 0.f};
#pragma unroll
      for (int i = 0; i < 8; ++i)
#pragma unroll
          for (int j = 0; j < 4; ++j) scr[(r8 + 8 * i) * 33 + 4 * c8 + j] = wv[i][j]; }
    LDS_WAIT(); asm volatile("" ::: "memory");
    const int c = lane & 3, nn = lane >> 2;
    float gv[16];
#pragma unroll
    for (int i = 0; i < 16; ++i) gv[i] = (gain ? gain[k0 + 16 * c + i] : 1.f) * wscale;
#pragma unroll
    for (int j = 0; j < 2; ++j) { const int n = nn + 16 * j; const LAS float* s = scr + (16 * c) * 33 + n; pg8::u32x4 o;
#pragma unroll
        for (int q = 0; q < 4; ++q) { unsigned w0 = 0u;
            w0 = __builtin_amdgcn_cvt_pk_fp8_f32(s[(4 * q) * 33] * gv[4 * q], s[(4 * q + 1) * 33] * gv[4 * q + 1], w0, false); w0 = __builtin_amdgcn_cvt_pk_fp8_f32(s[(4 * q + 2) * 33] * gv[4 * q + 2], s[(4 * q + 3) * 33] * gv[4 * q + 3], w0, true); o[q] = w0; }
        *(pg8::u32x4*)(WT + (size_t)(drow0 + n) * ldk + k0 + 16 * c) = o; }
    LDS_WAIT(); asm volatile("" ::: "memory");
}

__device__ __forceinline__ void rstd8(const f32x4 (&xs)[8], LAS float* part  , int hw, int lane, float (&rs)[8]) {
    float p[8];
#pragma unroll
    for (int j = 0; j < 8; ++j) p[j] = wave_sum(dot4f(xs[j]));
    if (lane == 0) {
#pragma unroll
        for (int j = 0; j < 8; ++j) part[j * 4 + hw] = p[j]; }
    __syncthreads();
#pragma unroll
    for (int j = 0; j < 8; ++j) { const f32x4 q = *(const LAS f32x4*)(part + j * 4); rs[j] = pg8::rstd_of((q[0] + q[1]) + (q[2] + q[3])); }
}
template <int W> __device__ __forceinline__ void pool_run(const float* x, int t0, int c4, bool has_prev, int pos0, f32x4 g, bf16* diff, LAS float* part2  , int& buf, int hw, int lane) {
    f32x4 hh[16]; f32x4 xs[8], xn[8]; float rs[8];
#pragma unroll
    for (int hc = 0; hc < 2; ++hc) {
#pragma unroll
        for (int j = 0; j < 8; ++j) xs[j] = has_prev ? *(const f32x4*)(x + (size_t)(t0 - 16 + hc * 8 + j) * D + c4) : (f32x4){0.f, 0.f, 0.f, 0.f};
        rstd8(xs, part2 + buf * 32, hw, lane, rs); buf ^= 1;
#pragma unroll
        for (int j = 0; j < 8; ++j) hh[hc * 8 + j] = xs[j] * rs[j] * g;
    }
    f32x4 S = (f32x4){0.f, 0.f, 0.f, 0.f};
#pragma unroll
    for (int i = 16 - W; i < 16; ++i) S += hh[i];
#pragma unroll
    for (int j = 0; j < 8; ++j) xn[j] = *(const f32x4*)(x + (size_t)(t0 + j) * D + c4);
#pragma unroll 1
    for (int cb = 0; cb < 8; ++cb) {
        f32x4 hn[8];
#pragma unroll
        for (int j = 0; j < 8; ++j) xs[j] = xn[j];
        if (cb < 7) {
#pragma unroll
            for (int j = 0; j < 8; ++j) xn[j] = *(const f32x4*)(x + (size_t)(t0 + (cb + 1) * 8 + j) * D + c4); }
        rstd8(xs, part2 + buf * 32, hw, lane, rs); buf ^= 1;
#pragma unroll
        for (int j = 0; j < 8; ++j) {
            hn[j] = xs[j] * rs[j] * g;
            const f32x4 old = (j - W >= 0) ? hn[(j - W >= 0) ? j - W : 0] : hh[(16 + j - W) & 15];
            S = S + hn[j] - old;
            const int pos = pos0 + cb * 8 + j; const int cnt = (pos + 1 < W) ? pos + 1 : W; const float inv = 1.0f / (float)cnt;
            const f32x4 dv = S * inv - hn[j];
            unsigned long long o = (unsigned long long)pk2(dv[0], dv[1]) | ((unsigned long long)pk2(dv[2], dv[3]) << 32);
            *(GAS unsigned long long*)(diff + (size_t)(t0 + cb * 8 + j) * D + c4) = o;
        }
#pragma unroll
        for (int i = 0; i < 8; ++i) hh[i] = hh[i + 8];
#pragma unroll
        for (int i = 0; i < 8; ++i) hh[8 + i] = hn[i];
    }
}

struct Args { const float* in[24]; float* out; unsigned char* ws; int ph_lo, ph_hi; };
enum { I_X = 0, I_P, I_NMIX, I_NFFN, I_NPLE, I_NFIN, I_POOLW, I_POOLS, I_KVN, I_WK, I_WV, I_WF, I_BF, I_WQ, I_WO, I_RW, I_RB, I_WGU, I_BGU, I_WD, I_BD, I_PWG, I_PBG, I_PWP };
#define WSP(T, off) ((T*)(args.ws + (off)))
#ifdef ONLY
#define PHON(n) ((n) == ONLY)
#else
#define PHON(n) true
#endif
#define IN(k) (lo <= (k) && (k) < hi)
#define NREP(bit) ((((PROBE_MASK) >> (bit)) & 1) ? 2 : 1)
#define SEAM(k) do { if (IN(k) && IN((k) + 1)) xcd_barrier(bar); } while (0)
#define FRESH_IDS() int tid = threadIdx.x; asm volatile("" : "+v"(tid)); const int lane = tid & 63, wave = __builtin_amdgcn_readfirstlane(tid >> 6); (void)lane; (void)wave; \
    const int G = gridDim.x, bx = blockIdx.x; const int vcu = (G % 8 == 0) ? (bx % 8) * (G / 8) + bx / 8 : bx; const int gw = vcu * NWAVES + wave, NGW = G * NWAVES; (void)gw; (void)NGW; (void)vcu

__device__ __forceinline__ void phase_prologue(const Args& args, LAS unsigned char* lds) {
    FRESH_IDS();
    const float* norm_ffn = args.in[I_NFFN];
    unsigned char* Wqkv8 = WSP(unsigned char, WS_WQKV); bf16* Wrouter = WSP(bf16, WS_WROUTER);
    LAS float* scr = (LAS float*)(lds + RING_OFF + wave * 16384);
    constexpr int I_GU = 2 * 32 * 1024, I_D = 2 * 32 * 512, I_PG = 2 * 512, I_PP = 2 * 128, I_SQ = 512, I_F = 16, I_POOL = 128, I_R = 32;
    constexpr int NITEMS = I_GU + I_D + I_PG + I_PP + 4 * I_SQ + I_F + I_POOL + I_R;
    for (int it = gw; it < NITEMS; it += NGW) {
        int r = it;
        if (r < I_GU) { const int le = r >> 10, q = r & 1023, kb = q >> 6, nb = q & 63, n0 = nb * 32;
            const int drow0 = 256 * ((n0 & 1023) >> 7) + 64 * ((n0 & 127) >> 5) + 32 * (n0 >> 10);
            conv_item8(args.in[I_WGU] + (size_t)le * 1024 * 2048, 2048, kb * 64, n0, WSP(unsigned char, WS_WGU) + (size_t)le * 2048 * 1024, 1024, drow0, norm_ffn + (le >> 5) * 1024, (n0 < 1024) ? WSCALE8 * pg8::SW_A2 : WSCALE8, scr, lane); continue; } r -= I_GU;
        if (r < I_D) { const int le = r >> 9, q = r & 511, kb = q >> 5, nb = q & 31;
            conv_item8(args.in[I_WD] + (size_t)le * 1024 * 1024, 1024, kb * 64, nb * 32, WSP(unsigned char, WS_WD) + (size_t)le * 1024 * 1024, 1024, nb * 32, nullptr, WSCALE8, scr, lane); continue; } r -= I_D;
        if (r < I_PG) { const int l = r >> 9, q = r & 511, kb = q >> 5, nb = q & 31;
            conv_item8(args.in[I_PWG] + (size_t)l * 1024 * 1024, 1024, kb * 64, nb * 32, WSP(unsigned char, WS_WPG) + (size_t)l * 1024 * 1024, 1024, nb * 32, args.in[I_NPLE] + l * 1024, WSCALE8, scr, lane); continue; } r -= I_PG;
        if (r < I_PP) { const int l = r >> 7, q = r & 127, kb = q >> 5, nb = q & 31;
            conv_item(args.in[I_PWP] + (size_t)l * 256 * 1024, 1024, kb * 64, nb * 32, 32, WSP(bf16, WS_WPP) + (size_t)l * 1024 * 256, 256, nb * 32, nullptr, scr, lane); continue; } r -= I_PP;
        if (r < 4 * I_SQ) { const int w = r >> 9, q = r & 511, kb = q >> 5, nb = q & 31;
            const float* src = args.in[w == 0 ? I_WQ : (w == 1 ? I_WK : (w == 2 ? I_WV : I_WO))]; const float* gn = w == 0 ? args.in[I_NMIX] + 1024 : args.in[I_KVN];
            if (w == 3) conv_item8(src, 1024, kb * 64, nb * 32, WSP(unsigned char, WS_WO), 1024, nb * 32, nullptr, WSCALE8, scr, lane);
            else conv_item8(src, 1024, kb * 64, nb * 32, Wqkv8 + (size_t)w * 1024 * 1024, 1024, nb * 32, gn, WSCALE8, scr, lane);
            continue; } r -= 4 * I_SQ;
        if (r < I_F) { conv_item8(args.in[I_WF], 16, r * 64, 0, Wqkv8 + (size_t)3072 * 1024, 1024, 0, args.in[I_KVN], WSCALE8, scr, lane, 16); continue; } r -= I_F;
        if (r < I_POOL) { const int g = r >> 5, q = r & 31, kb = q >> 3, nb = q & 7;
            conv_item(args.in[I_POOLW] + (size_t)g * 256 * 256, 256, kb * 64, nb * 32, 32, WSP(bf16, WS_WPOOL) + (size_t)g * 256 * 256, 256, nb * 32, nullptr, scr, lane); continue; } r -= I_POOL;
        { const int l = r >> 4, kb = r & 15;
            conv_item(args.in[I_RW] + (size_t)l * 1024 * 32, 32, kb * 64, 0, 32, Wrouter + (size_t)l * 256 * 1024, 1024, 0, norm_ffn + l * 1024, scr, lane); }
    }
    {
        const int gt = vcu * NWAVES * 64 + tid, NGT = G * NWAVES * 64; const v4u z = (v4u){0u, 0u, 0u, 0u};
        for (int i = gt; i < 2 * 224 * 128; i += NGT) { const int l = i / (224 * 128), q = i % (224 * 128); *(GAS v4u*)(Wrouter + (size_t)l * 256 * 1024 + (size_t)32 * 1024 + (size_t)q * 8) = z; }
        for (int i = gt; i < 224 * 64; i += NGT) *(GAS v4u*)(Wqkv8 + (size_t)3104 * 1024 + (size_t)i * 16) = z;
        { const float* bgu = args.in[I_BGU]; const float* bd = args.in[I_BD]; bf16* o1 = WSP(bf16, WS_BGU16); bf16* o2 = WSP(bf16, WS_BD16);
          for (int i = gt; i < 2 * 32 * 2048 / 2; i += NGT) { const bool gate = ((2 * i) & 2047) < 1024; ((GAS unsigned*)o1)[i] = gate ? pk2(bgu[2 * i] * pg8::SW_A2, bgu[2 * i + 1] * pg8::SW_A2) : pk2(bgu[2 * i] + 1.0f, bgu[2 * i + 1] + 1.0f); }
          for (int i = gt; i < 2 * 32 * 1024 / 2; i += NGT) ((GAS unsigned*)o2)[i] = pk2(bd[2 * i], bd[2 * i + 1]); }
        const float* p_in = args.in[I_P]; bf16* PB = WSP(bf16, WS_PB);
        for (size_t i = gt; i < (size_t)2 * NTOK * PLE / 8; i += NGT) { const f32x4 a = *(const f32x4*)(p_in + i * 8), b = *(const f32x4*)(p_in + i * 8 + 4);
            v4u o; o.x = pk2(a[0], a[1]); o.y = pk2(a[2], a[3]); o.z = pk2(b[0], b[1]); o.w = pk2(b[2], b[3]); *(GAS v4u*)(PB + i * 8) = o; }
    }
    __syncthreads();
    {
        const float* x_in = args.in[I_X]; bf16* DIFF = WSP(bf16, WS_ACT);
        const int half = tid >> 8, ht = tid & 255, hw = wave & 3, c4 = ht * 4;
        LAS float* part2 = (LAS float*)(lds + RING_OFF) + half * 64;
        const f32x4 g = *(const f32x4*)(args.in[I_NMIX] + c4);
        const int grp = __builtin_amdgcn_readfirstlane(ht >> 6);
        int buf = 0;
        for (int it = bx; it < NTOK / 128; it += G) {
            const int t0 = (it * 2 + half) * 64, pos0 = t0 & (SEQ - 1); const bool has_prev = pos0 != 0;
            if (grp == 0) pool_run<2>(x_in, t0, c4, has_prev, pos0, g, DIFF, part2, buf, hw, lane);
            else if (grp == 1) pool_run<4>(x_in, t0, c4, has_prev, pos0, g, DIFF, part2, buf, hw, lane);
            else if (grp == 2) pool_run<8>(x_in, t0, c4, has_prev, pos0, g, DIFF, part2, buf, hw, lane);
            else pool_run<16>(x_in, t0, c4, has_prev, pos0, g, DIFF, part2, buf, hw, lane);
        }
        __syncthreads();
    }
}

template <int LAYER> __device__ __forceinline__ void ple_phase(const Args& args, LAS unsigned char* lds) {
    constexpr int SSM = LAYER == 0 ? 0 : 3; constexpr size_t XT_OFF = WS_XT, XN_OFF = WS_XB;
        { FRESH_IDS();
          pg8::Gemm g{WSP(bf16, WS_PB) + (size_t)LAYER * NTOK * PLE, WSP(bf16, WS_WPP) + (size_t)LAYER * 1024 * 256, PLE, PLE, PLE, STAG_PJ}; pg8::DenseOrder S; S.init(NTOK / 256, 4, G, bx, PLE, PLE, 0);
          pg8::EpiStore E{WSP(unsigned char, WS_ACT)};
          pg8::gemm_phase<pg8::EpiStore, pg8::DenseOrder>(lds + RING_OFF, lds + EPI_OFF, g, S, E); }
        VM_WAIT(); __syncthreads();
        { FRESH_IDS();
          pg8::Gemm g{(const pg8::bf16_t*)WSP(unsigned char, WS_XT8), (const pg8::bf16_t*)(WSP(unsigned char, WS_WPG) + (size_t)LAYER * 1024 * 1024), D, D, D, STAG_PLE, nullptr, WSP(unsigned char, WS_DUMMY)}; pg8::DenseOrder S; S.init(NTOK / 256, 4, G, bx, D, D, 0, 1);
          pg8::EpiPle E{args.in[I_PBG] + LAYER * 1024, WSP(unsigned char, WS_ACT), WSP(bf16, XT_OFF), WSP(bf16, XN_OFF), WSP(float, WS_SS) + (size_t)(SSM + 2) * SSA, LAYER == 0 ? WSP(unsigned char, WS_XB8) : (unsigned char*)nullptr};
          pg8::gemm_phase<pg8::EpiPle, pg8::DenseOrder, false, 1>(lds + RING_OFF, lds + EPI_OFF, g, S, E); }
}

template <int LAYER> __device__ __forceinline__ void moe_ple_block(const Args& args, LAS unsigned char* lds, const XcdBarrier& bar, const int lo, const int hi) {
    constexpr int PBASE = LAYER == 0 ? 2 : 13, SSM = LAYER == 0 ? 0 : 3;
    constexpr size_t XC_OFF = WS_XA, XT_OFF = WS_XT, XN_OFF = WS_XB;
    if (IN(PBASE) && PHON(2)) for (int rep_ = 0; rep_ < NREP(2); ++rep_) {
        FRESH_IDS();
        pg8::Gemm g{WSP(bf16, XC_OFF), WSP(bf16, WS_WROUTER) + (size_t)LAYER * 256 * 1024, D, D, D, 0}; pg8::DenseOrder S; S.init(NTOK / 256, 1, G, bx, D, D, 0);
        pg8::EpiRouter E{WSP(float, WS_SS) + (size_t)SSM * SSA, args.in[I_RB] + LAYER * 32, WSP(float, WS_LOGITS)};
        pg8::gemm_phase<pg8::EpiRouter, pg8::DenseOrder>(lds + RING_OFF, lds + EPI_OFF, g, S, E);
        VM_WAIT(); __syncthreads(); __builtin_amdgcn_fence(__ATOMIC_ACQUIRE, "agent"); VM_WAIT(); __syncthreads();
        const float* LOGITS = WSP(float, WS_LOGITS); unsigned* TOKE = WSP(unsigned, WS_TOKE); float* TOKG = WSP(float, WS_TOKG); int* CH = WSP(int, WS_META);
        LAS int* hist = (LAS int*)(lds + RING_OFF);
        pg8::Unit uu;
        for (int ui = 0; S.next(ui, uu); ++ui) { const int ch = uu.pm;
            if (tid < 32) hist[tid] = 0;
            __syncthreads();
            if (tid < 256) {
                const int t = ch * 256 + tid; float v[32];
#pragma unroll
                for (int j = 0; j < 8; ++j) { const f32x4 q = *(const f32x4*)(LOGITS + (size_t)t * 32 + 4 * j); v[4 * j] = q[0]; v[4 * j + 1] = q[1]; v[4 * j + 2] = q[2]; v[4 * j + 3] = q[3]; }
                float sv[4]; int si[4]; float pv = INFINITY; int pi = -1;
#pragma unroll
                for (int k = 0; k < 4; ++k) { float bv = -INFINITY; int bi = 0;
#pragma unroll
                    for (int i = 0; i < 32; ++i) { const bool after = (v[i] < pv) || (v[i] == pv && i > pi); if (after && v[i] > bv) { bv = v[i]; bi = i; } }
                    sv[k] = bv; si[k] = bi; pv = bv; pi = bi; }
                const float e1 = __expf(sv[1] - sv[0]), e2 = __expf(sv[2] - sv[0]), e3 = __expf(sv[3] - sv[0]); const float inv = 1.0f / (1.0f + e1 + e2 + e3);
                TOKE[t] = (unsigned)si[0] | ((unsigned)si[1] << 8) | ((unsigned)si[2] << 16) | ((unsigned)si[3] << 24);
                *(f32x4*)(TOKG + (size_t)t * 4) = (f32x4){inv, e1 * inv, e2 * inv, e3 * inv};
#pragma unroll
                for (int k = 0; k < 4; ++k) atomicAdd((int*)(hist + si[k]), 1);
            }
            __syncthreads();
            if (tid < 32) CH[ch * 32 + tid] = hist[tid];
            __syncthreads();
        }
    }
    if (IN(PBASE) && IN(PBASE + 2)) xcd_barrier(bar);
    if (IN(PBASE + 2) && PHON(4)) for (int rep_ = 0; rep_ < NREP(4); ++rep_) {
        FRESH_IDS();
        const int* CH = WSP(int, WS_META); int* TPg = WSP(int, WS_META + 65536); const unsigned* TOKE = WSP(unsigned, WS_TOKE); const float* TOKG = WSP(float, WS_TOKG); int* TOKPOS = WSP(int, WS_TOKPOS);
        float* SLOTG = WSP(float, WS_SLOTG); const float* ss_mix = WSP(float, WS_SS) + (size_t)SSM * SSA; int* SLOTT = WSP(int, WS_SLOTT); float* SLOTR = WSP(float, WS_SLOTR);
        LAS int* ptot = (LAS int*)(lds + RING_OFF); LAS int* pbef = ptot + 256; LAS int* ntile = pbef + 256; LAS int* befl = ntile + 32; LAS int* tpl = befl + 32; LAS int* lcur = tpl + 64; LAS int* lpos = lcur + 32;
        for (int ch = bx; ch < NCHUNK; ch += G) {
            if (tid < 256) { const int e = tid & 31, part = tid >> 5; int tot = 0, bef = 0;
                for (int c2 = part * 32; c2 < part * 32 + 32; ++c2) { const int v = CH[c2 * 32 + e]; tot += v; bef += (c2 < ch) ? v : 0; }
                ptot[part * 32 + e] = tot; pbef[part * 32 + e] = bef; }
            __syncthreads();
            if (tid < 32) { int tot = 0, bef = 0;
#pragma unroll
                for (int q = 0; q < 8; ++q) { tot += ptot[q * 32 + tid]; bef += pbef[q * 32 + tid]; }
                ntile[tid] = (tot + 255) >> 8; befl[tid] = bef; }
            __syncthreads();
            if (tid == 0) { int a = 0; for (int e = 0; e < 32; ++e) { tpl[e] = a; a += ntile[e]; } tpl[32] = a; }
            __syncthreads();
            if (tid < 32) lcur[tid] = tpl[tid] * 256 + befl[tid];
            if (ch == 0 && tid < 33) TPg[tid] = tpl[tid];
            __syncthreads();
            LAS int* wcnt = lpos + 1024;
            unsigned ev = 0u; int rk[4] = {0, 0, 0, 0};
            if (tid < 256) { ev = TOKE[ch * 256 + tid];
                const int e0 = ev & 255, e1 = (ev >> 8) & 255, e2 = (ev >> 16) & 255, e3 = (ev >> 24) & 255;
                const unsigned mask = (1u << e0) | (1u << e1) | (1u << e2) | (1u << e3);
                const unsigned long long below = (1ull << lane) - 1ull;
#pragma unroll 1
                for (int e = 0; e < 32; ++e) { const unsigned long long bal = __ballot((mask >> e) & 1u); const int r = __popcll(bal & below);
                    if (e0 == e) rk[0] = r; if (e1 == e) rk[1] = r; if (e2 == e) rk[2] = r; if (e3 == e) rk[3] = r;
                    if (lane == 0) wcnt[wave * 32 + e] = __popcll(bal); } }
            __syncthreads();
            if (tid < 256) { const int t = ch * 256 + tid; const f32x4 gv = *(const f32x4*)(TOKG + (size_t)t * 4); const float rst = rstd_tok(ss_mix, (size_t)t);
                int ps[4];
#pragma unroll
                for (int k = 0; k < 4; ++k) { const int e = (ev >> (8 * k)) & 255; int pos = lcur[e] + rk[k];
                    for (int w = 0; w < wave; ++w) pos += wcnt[w * 32 + e];
                    ps[k] = pos; SLOTG[pos] = gv[k]; SLOTT[pos] = t; SLOTR[pos] = rst; }
                *(GAS v4u*)(TOKPOS + (size_t)t * 4) = (v4u){(unsigned)ps[0], (unsigned)ps[1], (unsigned)ps[2], (unsigned)ps[3]}; }
            __syncthreads();
        }
    }
    SEAM(PBASE + 2);
    if (IN(PBASE + 3) && PHON(5)) for (int rep_ = 0; rep_ < NREP(5); ++rep_) {
        FRESH_IDS();
        LAS int* tpl = (LAS int*)(lds + TP_OFF);
        if (tid < 33) tpl[tid] = (int)__hip_atomic_load(WSP(gu32, WS_META + 65536) + tid, RLX_AGENT);
        __syncthreads();
        { LAS unsigned char* te = (LAS unsigned char*)(tpl + 64); const int nT = tpl[32];
          for (int j = tid; j < nT; j += NWAVES * 64) { int e = 0; for (int k = 1; k < 32; ++k) e += (tpl[k] <= j) ? 1 : 0; te[j] = (unsigned char)e; } }
        __syncthreads();
        pg8::Gemm g{(const pg8::bf16_t*)WSP(unsigned char, WS_XA8), (const pg8::bf16_t*)(WSP(unsigned char, WS_WGU) + (size_t)LAYER * 32 * 2048 * 1024), D, D, D, STAG_GU, WSP(int, WS_SLOTT), WSP(unsigned char, WS_DUMMY)}; pg8::GroupedOrder S; S.init(tpl, 8, G, bx, D, D, 2048, 1);
        pg8::EpiSwiGLU E{WSP(bf16, WS_BGU16) + (size_t)LAYER * 32 * 2048, WSP(unsigned char, WS_ACT), WSP(float, WS_SLOTR)};
        pg8::gemm_phase<pg8::EpiSwiGLU, pg8::GroupedOrder, true, 1>(lds + RING_OFF, lds + EPI_OFF, g, S, E);
    }
    SEAM(PBASE + 3);
    if (IN(PBASE + 4) && PHON(6)) for (int rep_ = 0; rep_ < NREP(6); ++rep_) {
        FRESH_IDS();
        LAS int* tpl = (LAS int*)(lds + TP_OFF);
        if (tid < 33) tpl[tid] = (int)__hip_atomic_load(WSP(gu32, WS_META + 65536) + tid, RLX_AGENT);
        __syncthreads();
        { LAS unsigned char* te = (LAS unsigned char*)(tpl + 64); const int nT = tpl[32];
          for (int j = tid; j < nT; j += NWAVES * 64) { int e = 0; for (int k = 1; k < 32; ++k) e += (tpl[k] <= j) ? 1 : 0; te[j] = (unsigned char)e; } }
        __syncthreads();
        pg8::Gemm g{(const pg8::bf16_t*)WSP(unsigned char, WS_ACT), (const pg8::bf16_t*)(WSP(unsigned char, WS_WD) + (size_t)LAYER * 32 * 1024 * 1024), D, D, D, STAG_DOWN, nullptr, WSP(unsigned char, WS_DUMMY)}; pg8::GroupedOrder S; S.init(tpl, 4, G, bx, D, D, 1024, 1);
        pg8::EpiDown E{WSP(float, WS_SLOTG), WSP(bf16, WS_BD16) + (size_t)LAYER * 32 * 1024, WSP(unsigned char, WS_HS)};
        pg8::gemm_phase<pg8::EpiDown, pg8::GroupedOrder, false, 1>(lds + RING_OFF, lds + EPI_OFF, g, S, E);
    }
    SEAM(PBASE + 4);
    if (IN(PBASE + 5) && PHON(7)) for (int rep_ = 0; rep_ < NREP(7); ++rep_) {
        FRESH_IDS();
        const int* TOKPOS = WSP(int, WS_TOKPOS); const bf16* Xc = WSP(bf16, XC_OFF); bf16* Xt = WSP(bf16, XT_OFF); const unsigned char* Y8 = WSP(unsigned char, WS_HS); unsigned char* Xt8 = WSP(unsigned char, WS_XT8); float* ss_moe = WSP(float, WS_SS) + (size_t)(SSM + 1) * SSA;
        for (int t = gw; t < NTOK; t += NGW) {
            const v4u ps = *(const GAS v4u*)(TOKPOS + (size_t)t * 4);
            const bf16* xr = Xc + (size_t)t * D + lane * 16; bf16* xo = Xt + (size_t)t * D + lane * 16; float sq = 0.f;
            const v4u xw0 = *(const GAS v4u*)(xr), xw1 = *(const GAS v4u*)(xr + 8);
            v4u yw[4];
#pragma unroll
            for (int k = 0; k < 4; ++k) { const unsigned pos = k == 0 ? ps.x : (k == 1 ? ps.y : (k == 2 ? ps.z : ps.w)); yw[k] = *(const GAS v4u*)(Y8 + (size_t)pos * D + lane * 16); }
            float a[16] = {bflo(xw0.x), bfhi(xw0.x), bflo(xw0.y), bfhi(xw0.y), bflo(xw0.z), bfhi(xw0.z), bflo(xw0.w), bfhi(xw0.w), bflo(xw1.x), bfhi(xw1.x), bflo(xw1.y), bfhi(xw1.y), bflo(xw1.z), bfhi(xw1.z), bflo(xw1.w), bfhi(xw1.w)};
#pragma unroll
            for (int k = 0; k < 4; ++k) {
#pragma unroll
                for (int w = 0; w < 4; ++w) { const unsigned wd = w == 0 ? yw[k].x : (w == 1 ? yw[k].y : (w == 2 ? yw[k].z : yw[k].w));
                    const pg8::f32x2 lo = __builtin_amdgcn_cvt_pk_f32_fp8((int)wd, false), hi = __builtin_amdgcn_cvt_pk_f32_fp8((int)wd, true);
                    a[4 * w] += lo.x * pg8::YSINV; a[4 * w + 1] += lo.y * pg8::YSINV; a[4 * w + 2] += hi.x * pg8::YSINV; a[4 * w + 3] += hi.y * pg8::YSINV; } }
#pragma unroll
            for (int j = 0; j < 16; ++j) sq += a[j] * a[j];
            { v4u o; o.x = pk2(a[0], a[1]); o.y = pk2(a[2], a[3]); o.z = pk2(a[4], a[5]); o.w = pk2(a[6], a[7]); *(GAS v4u*)(xo) = o;
              o.x = pk2(a[8], a[9]); o.y = pk2(a[10], a[11]); o.z = pk2(a[12], a[13]); o.w = pk2(a[14], a[15]); *(GAS v4u*)(xo + 8) = o; }
            sq = wave_sum(sq);
            { const float rs = pg8::rstd_of(sq);
              v4u o8;
#pragma unroll
              for (int w = 0; w < 4; ++w) { unsigned w0 = 0u; w0 = __builtin_amdgcn_cvt_pk_fp8_f32(a[4 * w] * rs, a[4 * w + 1] * rs, w0, false); w0 = __builtin_amdgcn_cvt_pk_fp8_f32(a[4 * w + 2] * rs, a[4 * w + 3] * rs, w0, true);
                if (w == 0) o8.x = w0; else if (w == 1) o8.y = w0; else if (w == 2) o8.z = w0; else o8.w = w0; }
              *(GAS v4u*)(Xt8 + (size_t)t * D + lane * 16) = o8; }
            (void)ss_moe;
        }
    }
    SEAM(PBASE + 5);
    if (IN(PBASE + 6) && PHON(8)) { if (NREP(8) == 2) ple_phase<LAYER>(args, lds); ple_phase<LAYER>(args, lds); }
    SEAM(PBASE + 6);
}

__global__ void __launch_bounds__(NWAVES * 64, 2) yoco_fwd(Args args) {
    extern __shared__ __attribute__((aligned(16))) unsigned char lds_raw[];
    LAS unsigned char* lds = (LAS unsigned char*)lds_raw;
    volatile LAS unsigned* MISC = (volatile LAS unsigned*)(lds + MISC_OFF);
    for (int u = threadIdx.x; u < (LDS_BYTES - LDSCTL_OFF) / 4; u += NWAVES * 64) ((LAS unsigned*)(lds + LDSCTL_OFF))[u] = 0u;
    __syncthreads();
    XcdBarrier bar; bar.bar = (unsigned*)(WSP(gu32, WS_CTL) + CW_BAR); bar.x = 0; bar.st = nullptr;
    if (!MK_PER_PHASE) bar = xcd_barrier_post((unsigned*)(WSP(gu32, WS_CTL) + CW_BAR), MISC + 8);
#if MK_PER_PHASE
    const int lo = args.ph_lo, hi = args.ph_hi;
#else
    constexpr int lo = 0, hi = N_PHASES;
#endif

    if (IN(0) && PHON(0)) for (int rep_ = 0; rep_ < NREP(0); ++rep_) phase_prologue(args, lds);
    SEAM(0);
    if (IN(1) && PHON(1)) for (int rep_ = 0; rep_ < NREP(1); ++rep_) {
        FRESH_IDS();
        pg8::Gemm g{WSP(bf16, WS_ACT), WSP(bf16, WS_WPOOL), D, 256, 256, STAG_POOL}; pg8::DenseOrder S; S.init(NTOK / 256, 4, G, bx, D, 256, 256);
        pg8::EpiPool E{args.in[I_X], args.in[I_POOLS], WSP(bf16, WS_XA), WSP(float, WS_SS), WSP(unsigned char, WS_XA8)};
        pg8::gemm_phase<pg8::EpiPool, pg8::DenseOrder>(lds + RING_OFF, lds + EPI_OFF, g, S, E);
    }
    SEAM(1);
    moe_ple_block<0>(args, lds, bar, lo, hi);
    if (IN(9) && PHON(9)) for (int rep_ = 0; rep_ < NREP(9); ++rep_) {
        FRESH_IDS();
        pg8::Gemm g{(const pg8::bf16_t*)WSP(unsigned char, WS_XB8), (const pg8::bf16_t*)WSP(unsigned char, WS_WQKV), D, D, D, STAG_QKV, nullptr, WSP(unsigned char, WS_DUMMY)}; pg8::DenseOrder S; S.init(NTOK / 256, 13, G, bx, D, D, 0, 1);
        pg8::EpiQkv E{WSP(float, WS_SS) + (size_t)2 * SSA, WSP(bf16, WS_HS), args.in[I_BF], WSP(float, WS_LF), attn_body::C2, WSP(float, WS_NRM)};
        pg8::gemm_phase<pg8::EpiQkv, pg8::DenseOrder, false, 1>(lds + RING_OFF, lds + EPI_OFF, g, S, E);
    }
    SEAM(9);
    if (IN(10) && PHON(10)) for (int rep_ = 0; rep_ < NREP(10); ++rep_) {
        FRESH_IDS();
        const float* LF = WSP(float, WS_LF); float* BIAS = WSP(float, WS_BIAS);
        LAS float* wtot = (LAS float*)(lds + RING_OFF);
        for (int item = bx; item < NB * NH; item += G) {
            const int b = item >> 4, h = item & 15; const int s0 = tid * 16; float v[16]; float run = 0.f;
#pragma unroll
            for (int j = 0; j < 16; ++j) { run += LF[(size_t)(b * SEQ + s0 + j) * 16 + h]; v[j] = run; }
            float incl = run;
#pragma unroll
            for (int o = 1; o < 64; o <<= 1) { const float n = __shfl_up(incl, o); if (lane >= o) incl += n; }
            if (lane == 63) wtot[wave] = incl;
            __syncthreads();
            float base = incl - run;
            for (int w = 0; w < wave; ++w) base += wtot[w];
            float* o = BIAS + (size_t)item * SEQ + s0; LAS float* lb = wtot + 64;
#pragma unroll
            for (int j = 0; j < 16; j += 4) { const f32x4 bv4 = (f32x4){-(base + v[j]) * LOG2E, -(base + v[j + 1]) * LOG2E, -(base + v[j + 2]) * LOG2E, -(base + v[j + 3]) * LOG2E}; *(f32x4*)(o + j) = bv4; *(LAS f32x4*)(lb + s0 + j) = bv4; }
            LAS float* LE = lb + SEQ; LAS float* wm = wtot + 16; LAS float* wsum = wtot + 32;
            float pm_ = -(base + v[15]) * LOG2E, ps_ = 0.f;
#pragma unroll
            for (int j = 0; j < 16; ++j) ps_ += exp2f(-(base + v[j]) * LOG2E - pm_);
#pragma unroll
            for (int o2 = 1; o2 < 64; o2 <<= 1) { const float m2 = __shfl_up(pm_, o2), s2 = __shfl_up(ps_, o2); if (lane >= o2) { const float M = fmaxf(pm_, m2); ps_ = ps_ * exp2f(pm_ - M) + s2 * exp2f(m2 - M); pm_ = M; } }
            if (lane == 63) { wm[wave] = pm_; wsum[wave] = ps_; }
            __syncthreads();
            for (int w = 0; w < wave; ++w) { const float m2 = wm[w], s2 = wsum[w]; const float M = fmaxf(pm_, m2); ps_ = ps_ * exp2f(pm_ - M) + s2 * exp2f(m2 - M); pm_ = M; }
            LE[tid] = pm_ + log2f(ps_);
            __syncthreads();
            if (tid < 32) {
                const float* nr = WSP(float, WS_NRM);
                const size_t e0 = (((size_t)(b * 32 + tid) * 16 + h) * 2) * 2;
                const float qn = sqrtf(fmaxf(nr[e0], nr[e0 + 1]) * 1.02f), kown = sqrtf(fmaxf(nr[e0 + 2], nr[e0 + 3]) * 1.02f);
                const int q0 = tid * 256, ntile = 4 * (tid + 1); const float bq = lb[q0]; int ts = 0; float kn2 = 0.f;
                float kp = fmaxf(nr[e0 + 2], nr[e0 + 3]) * 1.02f;
#pragma unroll
                for (int o = 1; o < 32; o <<= 1) { const float n = __shfl_up(kp, o); if (tid >= o) kp = fmaxf(kp, n); }
                LAS float* kpl = LE + 512; kpl[tid] = kp;
                for (int j = 0; j + 4 < ntile; ++j) {
                    if ((j & 3) == 0) kn2 = kpl[j >> 2];
                    const float bqk = qn * (sqrtf(kn2) + kown);
                    if (LE[4 * j + 3] + bqk - bq < -25.0f) ts = j + 1; else break; }
                const float kall = kp;
                const float bqs = qn * sqrtf(kall), dlt = lb[q0 + 255] - bq;
                const bool sok = (bqs <= 90.0f) && (bqs + dlt <= 100.0f) && (dlt >= 0.0f);
                WSP(int, WS_TS)[item * 32 + tid] = (ts & ~1) | (sok ? 0x10000 : 0);
            }
            __syncthreads();
        }
    }
    SEAM(10);
    if (IN(11) && PHON(11)) for (int rep_ = 0; rep_ < NREP(11); ++rep_) {
        const attn_body::AttnTensors AT{WSP(const attn_body::bf16, WS_HS), WSP(const attn_body::bf16, WS_HS) + (size_t)NTOK * D, WSP(const attn_body::bf16, WS_HS) + (size_t)2 * NTOK * D, WSP(attn_body::bf16, WS_ACT), WSP(const float, WS_BIAS), WSP(const int, WS_TS)};
        const attn_body::StaticOrder S((int)gridDim.x, (int)blockIdx.x);
#ifndef SKIP_ATTN
        attn_body::attn_phase<attn_body::StaticOrder>((char*)lds_raw + RING_OFF, AT, S);
#endif
    }
    SEAM(11);
    if (IN(12) && PHON(12)) for (int rep_ = 0; rep_ < NREP(12); ++rep_) {
        FRESH_IDS();
        pg8::Gemm g{(const pg8::bf16_t*)WSP(unsigned char, WS_ACT), (const pg8::bf16_t*)WSP(unsigned char, WS_WO), D, D, D, STAG_WO, nullptr, WSP(unsigned char, WS_DUMMY)}; pg8::DenseOrder S; S.init(NTOK / 256, 4, G, bx, D, D, 0, 1);
        pg8::EpiWo E{WSP(bf16, WS_XB), WSP(bf16, WS_XA), WSP(float, WS_SS) + (size_t)3 * SSA, WSP(unsigned char, WS_XA8)};
        pg8::gemm_phase<pg8::EpiWo, pg8::DenseOrder, false, 1>(lds + RING_OFF, lds + EPI_OFF, g, S, E);
    }
    SEAM(12);
    moe_ple_block<1>(args, lds, bar, lo, hi);
    if (IN(20) && PHON(20)) for (int rep_ = 0; rep_ < NREP(13); ++rep_) {
        FRESH_IDS();
        const float* ssf = WSP(float, WS_SS) + (size_t)5 * SSA; const bf16* XA = WSP(bf16, WS_XB); const float* norm_final = args.in[I_NFIN];
        for (int t = gw; t < NTOK; t += NGW) {
            const float rs = rstd_tok(ssf, (size_t)t); const bf16* xr = XA + (size_t)t * D; float* orow = args.out + (size_t)t * D;
#pragma unroll
            for (int hf = 0; hf < 2; ++hf) { const int c0 = hf * 512 + lane * 8; const v4u xw = *(const GAS v4u*)(xr + c0);
                const f32x4 g0 = *(const f32x4*)(norm_final + c0), g1 = *(const f32x4*)(norm_final + c0 + 4);
                *(f32x4*)(orow + c0) = (f32x4){bflo(xw.x) * rs * g0[0], bfhi(xw.x) * rs * g0[1], bflo(xw.y) * rs * g0[2], bfhi(xw.y) * rs * g0[3]};
                *(f32x4*)(orow + c0 + 4) = (f32x4){bflo(xw.z) * rs * g1[0], bfhi(xw.z) * rs * g1[1], bflo(xw.w) * rs * g1[2], bfhi(xw.w) * rs * g1[3]}; }
        }
    }
}
#undef IN
#undef SEAM

extern "C" void kernel_launch(void* const* d_in, const int* in_sizes, int n_in, void* d_out, int out_size, void* d_ws, size_t ws_size, hipStream_t stream) {
    static int grid = 0;
    if (grid == 0) {
        if (n_in != 24 || in_sizes[0] != NTOK * D || out_size != NTOK * D || ws_size < WS_END) { fprintf(stderr, "kernel_launch: unexpected shapes (n_in %d, in0 %d, out %d, ws %zu); nothing launched\n", n_in, n_in > 0 ? in_sizes[0] : -1, out_size, ws_size); grid = -1; return; }
        int dev = 0, cus = 0, per_cu = 0;
        if (hipGetDevice(&dev) != hipSuccess || hipDeviceGetAttribute(&cus, hipDeviceAttributeMultiprocessorCount, dev) != hipSuccess) { grid = -1; return; }
        if (hipFuncSetAttribute((const void*)yoco_fwd, hipFuncAttributeMaxDynamicSharedMemorySize, LDS_BYTES) != hipSuccess) { fprintf(stderr, "kernel_launch: hipFuncSetAttribute failed\n"); grid = -1; return; }
        if (hipOccupancyMaxActiveBlocksPerMultiprocessor(&per_cu, (const void*)yoco_fwd, NWAVES * 64, LDS_BYTES) != hipSuccess || per_cu < 1) { fprintf(stderr, "kernel_launch: occupancy query says %d blocks per CU\n", per_cu); }
        (void)hipGetLastError();
        grid = cus > 0 ? cus : 256;
    }
    if (grid < 0) return;
    if (hipMemsetAsync((char*)d_ws + WS_CTL, 0, CTL_ZERO_BYTES, stream) != hipSuccess) return;
    Args a{};
    for (int i = 0; i < 24; ++i) a.in[i] = (const float*)d_in[i];
    a.out = (float*)d_out; a.ws = (unsigned char*)d_ws;
#if MK_PER_PHASE
    for (int ph = 0; ph < N_PHASES; ++ph) { a.ph_lo = ph; a.ph_hi = ph + 1; hipLaunchKernelGGL(yoco_fwd, dim3(grid), dim3(NWAVES * 64), LDS_BYTES, stream, a); }
#else
    a.ph_lo = 0; a.ph_hi = N_PHASES; hipLaunchKernelGGL(yoco_fwd, dim3(grid), dim3(NWAVES * 64), LDS_BYTES, stream, a);
#endif
}
```

```cpp
#include <hip/hip_runtime.h>
#ifndef PROBE_MASK
#define PROBE_MASK 0
#endif
#include <cstdio>
#include <cstdint>
namespace pg8 {
#define PG8_LAS __attribute__((address_space(3)))
typedef unsigned short bf16_t;
typedef short bf16x8 __attribute__((ext_vector_type(8)));
typedef float f32x4 __attribute__((ext_vector_type(4)));
typedef unsigned u32x4 __attribute__((ext_vector_type(4)));
constexpr int BM = 256, BK = 64, HALF = 128, HTB = HALF * BK * 2  , STAGE_BYTES = 8 * HTB, NXCD = 8, WGM = 8;

__host__ __device__ __forceinline__ int lds_byte(int r, int c) { const int st = (r >> 4) * 2 + (c >> 5), rr = r & 15, cc = c & 31, ob = rr * 64 + cc * 2; return st * 1024 + (ob ^ (((ob >> 9) & 1) << 5)); }
__host__ __device__ __forceinline__ void stage_rc(int b, int& R, int& C) { const int st = b / 1024, sb = b % 1024, swz = sb ^ (((sb >> 9) & 1) << 5); R = (st >> 1) * 16 + swz / 64; C = (st & 1) * 32 + (swz % 64) / 2; }
__host__ __device__ __forceinline__ int perm32(int rho) { const int n = rho >> 4, i = rho & 15; return 8 * (i >> 2) + 4 * n + (i & 3); }

struct Unit { int pm, pn, e; };
struct Gemm { const bf16_t* A; const bf16_t* Bt; int lda, ldb, K, stag; const int* rowmap; void* dummy; };

struct DenseOrder {
    int nM, nN, nwg, G, c; size_t a_row, a_col, b_tile;
    __device__ __forceinline__ void init(int nM_, int nN_, int G_, int c_, int lda, int ldb, int a_col_elems, int esz = 2) { nM = nM_; nN = nN_; nwg = nM * nN; G = G_; c = c_; a_row = (size_t)BM * lda * esz; a_col = (size_t)a_col_elems * esz; b_tile = (size_t)BM * ldb * esz; }
    __device__ __forceinline__ bool next(int i, Unit& u) const {
        const long L = (long)i * G + c; if (L >= nwg) return false;
        int wgid = (int)L; { const int q = nwg / NXCD, r = nwg % NXCD, xcd = wgid % NXCD, off = wgid / NXCD; wgid = (xcd < r ? xcd * (q + 1) : r * (q + 1) + (xcd - r) * q) + off; }
        const int nig = WGM * nN, gid = wgid / nig, fm = gid * WGM, gsz = (nM - fm) < WGM ? (nM - fm) : WGM;
        u.pm = fm + ((wgid % nig) % gsz); u.pn = (wgid % nig) / gsz; u.e = 0; return true;
    }
    __device__ __forceinline__ size_t a_off(const Unit& u) const { return (size_t)u.pm * a_row + (size_t)u.pn * a_col; }
    __device__ __forceinline__ size_t b_off(const Unit& u) const { return (size_t)u.pn * b_tile; }
    __device__ __forceinline__ void a_ready(const Unit&) const {}
    __device__ __forceinline__ void done(const Unit&) const {}
};
struct GroupedOrder {
    int nM, nN, nwg, G, c; const PG8_LAS int* tp; const PG8_LAS unsigned char* te; size_t a_row, b_exp, b_tile;
    __device__ __forceinline__ void init(const PG8_LAS int* tp_, int nN_, int G_, int c_, int lda, int ldb, int n_w_rows, int esz) { tp = tp_; te = (const PG8_LAS unsigned char*)(tp_ + 64); nM = __builtin_amdgcn_readfirstlane(tp_[32]); nN = nN_; nwg = nM * nN; G = G_; c = c_; a_row = (size_t)BM * lda * esz; b_exp = (size_t)n_w_rows * ldb * esz; b_tile = (size_t)BM * ldb * esz; }
    __device__ __forceinline__ bool next(int i, Unit& u) const {
        const long L = (long)i * G + c; if (L >= nwg) return false;
        int wgid = (int)L; { const int q = nwg / NXCD, r = nwg % NXCD, xcd = wgid % NXCD, off = wgid / NXCD; wgid = (xcd < r ? xcd * (q + 1) : r * (q + 1) + (xcd - r) * q) + off; }
        const int nig = WGM * nN, gid = wgid / nig, fm = gid * WGM, gsz = (nM - fm) < WGM ? (nM - fm) : WGM;
        u.pm = fm + ((wgid % nig) % gsz); u.pn = (wgid % nig) / gsz;
        u.e = __builtin_amdgcn_readfirstlane((int)te[u.pm]); u.pm = __builtin_amdgcn_readfirstlane(u.pm); u.pn = __builtin_amdgcn_readfirstlane(u.pn); return true;
    }
    __device__ __forceinline__ size_t a_off(const Unit& u) const { return (size_t)u.pm * a_row; }
    __device__ __forceinline__ size_t b_off(const Unit& u) const { return (size_t)u.e * b_exp + (size_t)u.pn * b_tile; }
    __device__ __forceinline__ void a_ready(const Unit&) const {}
    __device__ __forceinline__ void done(const Unit&) const {}
};

__device__ __forceinline__ unsigned cvt_pk_bf16(float lo, float hi) { unsigned r; asm volatile("v_cvt_pk_bf16_f32 %0, %1, %2" : "=v"(r) : "v"(lo), "v"(hi)); return r; }
__device__ __forceinline__ float bf_lo(unsigned w) { return __builtin_bit_cast(float, w << 16); }
__device__ __forceinline__ float bf_hi(unsigned w) { return __builtin_bit_cast(float, w & 0xffff0000u); }
__device__ __forceinline__ float rstd_of(float ss) { return __builtin_amdgcn_rsqf(ss * (1.f / 1024.f) + 1e-6f); }
__device__ __forceinline__ u32x4 pack8(const f32x4& a, const f32x4& b) { u32x4 w; w.x = cvt_pk_bf16(a[0], a[1]); w.y = cvt_pk_bf16(a[2], a[3]); w.z = cvt_pk_bf16(b[0], b[1]); w.w = cvt_pk_bf16(b[2], b[3]); return w; }
__device__ __forceinline__ void unpack8(const u32x4& w, f32x4& a, f32x4& b) { a = (f32x4){bf_lo(w.x), bf_hi(w.x), bf_lo(w.y), bf_hi(w.y)}; b = (f32x4){bf_lo(w.z), bf_hi(w.z), bf_lo(w.w), bf_hi(w.w)}; }
__device__ __forceinline__ float dot4(const f32x4& a) { return (a[0] * a[0] + a[1] * a[1]) + (a[2] * a[2] + a[3] * a[3]); }
constexpr float W8INV = 1.0f / 16.0f;
typedef float f32x2 __attribute__((ext_vector_type(2)));
struct EpiCtx { PG8_LAS unsigned char* stg; int wr, wc, fr, fq, lane; };
constexpr int EPW = 2816, EP_RSL = 2304, EP_PITCH = 144, NTOKC = 65536;
typedef PG8_LAS u32x4* lds_u4p;
struct RawTile { u32x4 a, b; };
template <int MODE> __device__ __forceinline__ int piece_off(int fq, int k) { return MODE == 0 ? 64 * k + 16 * fq : 32 * fq + 16 * k; }
__device__ __forceinline__ RawTile tile_fetch(const EpiCtx& c, const char* gbase, size_t pitch) {
    const int r = c.lane >> 3, ch = c.lane & 7; RawTile t; t.a = *(const u32x4*)(gbase + (size_t)r * pitch + ch * 16); t.b = *(const u32x4*)(gbase + (size_t)(r + 8) * pitch + ch * 16); return t;
}
template <int MODE> __device__ __forceinline__ void tile_unstage(const EpiCtx& c, const RawTile& t, u32x4& v0, u32x4& v1) {
    const int r = c.lane >> 3, ch = c.lane & 7;
    *(lds_u4p)(c.stg + r * EP_PITCH + ch * 16) = t.a; *(lds_u4p)(c.stg + (r + 8) * EP_PITCH + ch * 16) = t.b;
    v0 = *(lds_u4p)(c.stg + c.fr * EP_PITCH + piece_off<MODE>(c.fq, 0)); v1 = *(lds_u4p)(c.stg + c.fr * EP_PITCH + piece_off<MODE>(c.fq, 1));
}
template <int MODE> __device__ __forceinline__ void tile_store(const EpiCtx& c, char* gbase, size_t pitch, const u32x4& v0, const u32x4& v1) {
    *(lds_u4p)(c.stg + c.fr * EP_PITCH + piece_off<MODE>(c.fq, 0)) = v0; *(lds_u4p)(c.stg + c.fr * EP_PITCH + piece_off<MODE>(c.fq, 1)) = v1;
    const int r = c.lane >> 3, ch = c.lane & 7;
    const u32x4 a = *(lds_u4p)(c.stg + r * EP_PITCH + ch * 16), b = *(lds_u4p)(c.stg + (r + 8) * EP_PITCH + ch * 16);
    *(u32x4*)(gbase + (size_t)r * pitch + ch * 16) = a; *(u32x4*)(gbase + (size_t)(r + 8) * pitch + ch * 16) = b;
}
__device__ __forceinline__ void tile_store_half(const EpiCtx& c, char* gbase, size_t pitch, const u32x4& v) {
    *(lds_u4p)(c.stg + c.fr * 80 + c.fq * 16) = v;
    const int r = c.lane >> 2, ch = c.lane & 3;
    const u32x4 a = *(lds_u4p)(c.stg + r * 80 + ch * 16);
    *(u32x4*)(gbase + (size_t)r * pitch + ch * 16) = a;
}
__device__ __forceinline__ float sum16(const float (&s)[16]) { return (((s[0] + s[1]) + (s[2] + s[3])) + ((s[4] + s[5]) + (s[6] + s[7]))) + (((s[8] + s[9]) + (s[10] + s[11])) + ((s[12] + s[13]) + (s[14] + s[15]))); }
__device__ __forceinline__ void ss_put(const EpiCtx& c, float* ssp, int unit_row0, const float (&sq)[2][4], int slot) {
    PG8_LAS float* t = (PG8_LAS float*)c.stg;
#pragma unroll
    for (int ai = 0; ai < 2; ++ai)
#pragma unroll
        for (int m = 0; m < 4; ++m) t[(ai * 64 + m * 16 + c.fr) * 4 + c.fq] = sq[ai][m];
#pragma unroll
    for (int hb = 0; hb < 2; ++hb) { const f32x4 v = *(PG8_LAS f32x4*)(t + (hb * 64 + c.lane) * 4); ssp[(size_t)slot * NTOKC + unit_row0 + hb * HALF + c.wr * 64 + c.lane] = (v[0] + v[1]) + (v[2] + v[3]); }
}
__device__ __forceinline__ void rstd_stage(const EpiCtx& c, const float* ssp, int unit_row0) {
    PG8_LAS float* rsl = (PG8_LAS float*)(c.stg + EP_RSL);
#pragma unroll
    for (int hb = 0; hb < 2; ++hb) { const int row = unit_row0 + hb * HALF + c.wr * 64 + c.lane; float s[16];
#pragma unroll
        for (int k = 0; k < 16; ++k) s[k] = ssp[(size_t)k * NTOKC + row];
        rsl[hb * 64 + c.lane] = rstd_of(sum16(s)); asm volatile("" ::: "memory"); }
}
__device__ __forceinline__ float rstd_get(const EpiCtx& c, int ai, int m) { return ((PG8_LAS float*)(c.stg + EP_RSL))[ai * 64 + m * 16 + c.fr]; }
#define EPI_ROW(g_) (u.pm * BM + ((g_) >> 2) * HALF + c.wr * 64 + ((g_) & 3) * 16)

__device__ __forceinline__ unsigned long long fp8x8_sat(f32x4 v0, f32x4 v1) {
#pragma unroll
    for (int j = 0; j < 4; ++j) { v0[j] = __builtin_amdgcn_fmed3f(v0[j], -448.0f, 448.0f); v1[j] = __builtin_amdgcn_fmed3f(v1[j], -448.0f, 448.0f); }
    unsigned w0 = 0u, w1 = 0u; w0 = __builtin_amdgcn_cvt_pk_fp8_f32(v0[0], v0[1], w0, false); w0 = __builtin_amdgcn_cvt_pk_fp8_f32(v0[2], v0[3], w0, true);
    w1 = __builtin_amdgcn_cvt_pk_fp8_f32(v1[0], v1[1], w1, false); w1 = __builtin_amdgcn_cvt_pk_fp8_f32(v1[2], v1[3], w1, true); return (unsigned long long)w0 | ((unsigned long long)w1 << 32); }
__device__ __forceinline__ void fp8_rows_store(const EpiCtx& c, unsigned char* dst  , unsigned long long q0, unsigned long long q1) {
    *(PG8_LAS unsigned long long*)(c.stg + c.fr * 80 + c.fq * 8) = q0; *(PG8_LAS unsigned long long*)(c.stg + c.fr * 80 + 32 + c.fq * 8) = q1;
    const int r = c.lane >> 2, ch = c.lane & 3; const u32x4 t8 = *(lds_u4p)(c.stg + r * 80 + ch * 16);
    *(u32x4*)(dst + (size_t)r * 1024 + ch * 16) = t8; }
struct EpiPool {
    struct Pre {}; __device__ __forceinline__ Pre fetch(const Unit&, const EpiCtx&) const { return Pre{}; }
    static constexpr int NST = 0;     static constexpr bool PERM = true, AFTER_DRAIN = false, TWICE = false;
    const float* xin; const float* scale; bf16_t* Xo; float* ss; unsigned char* X8;
    __device__ __forceinline__ void operator()(const f32x4 (&acc)[2][2][4][2], const Unit& u, const EpiCtx& c, const Pre& pre) const {
        const int colw = u.pn * BM + c.wc * 64;
        float sq[2][4]; RawTile rt[1][2];
#define EP_FETCH(g_) do { _Pragma("unroll") for (int bj = 0; bj < 2; ++bj) rt[0][bj] = tile_fetch(c, (const char*)(xin + (size_t)EPI_ROW(g_) * 1024 + colw + 32 * bj), 4096); } while (0)
#pragma unroll
        for (int g = 0; g < 8; ++g) { const int ai = g >> 2, m = g & 3; float s = 0.f; u32x4 o[2]; unsigned long long q8[2];
            EP_FETCH(g);
            f32x4 sc[2][2];
#pragma unroll
            for (int bj = 0; bj < 2; ++bj)
#pragma unroll
                for (int n = 0; n < 2; ++n) sc[bj][n] = *(const f32x4*)(scale + colw + 32 * bj + 8 * c.fq + 4 * n);
#pragma unroll
            for (int bj = 0; bj < 2; ++bj) { u32x4 r0, r1; tile_unstage<1>(c, rt[0][bj], r0, r1);
                const f32x4 v0 = __builtin_bit_cast(f32x4, r0) + sc[bj][0] * acc[ai][bj][m][0], v1 = __builtin_bit_cast(f32x4, r1) + sc[bj][1] * acc[ai][bj][m][1];
                s += dot4(v0) + dot4(v1); o[bj] = pack8(v0, v1); q8[bj] = fp8x8_sat(v0, v1); }
            tile_store<0>(c, (char*)(Xo + (size_t)EPI_ROW(g) * 1024 + colw), 2048, o[0], o[1]);
            fp8_rows_store(c, X8 + (size_t)EPI_ROW(g) * 1024 + colw, q8[0], q8[1]);
            sq[ai][m] = s; asm volatile("" ::: "memory"); }
#undef EP_FETCH
        ss_put(c, ss, u.pm * BM, sq, u.pn * 4 + c.wc);
    }
};
struct EpiRouter {
    struct Pre {}; __device__ __forceinline__ Pre fetch(const Unit&, const EpiCtx&) const { return Pre{}; }
    static constexpr int NST = 0;     static constexpr bool PERM = true, AFTER_DRAIN = false, TWICE = false;
    const float* ssin; const float* rb; float* logits;
    __device__ __forceinline__ void operator()(const f32x4 (&acc)[2][2][4][2], const Unit& u, const EpiCtx& c, const Pre& pre) const {
        if (c.wc != 0) return;
        rstd_stage(c, ssin, u.pm * BM);
        const f32x4 b0 = *(const f32x4*)(rb + 8 * c.fq), b1 = *(const f32x4*)(rb + 8 * c.fq + 4);
#pragma unroll
        for (int g = 0; g < 8; ++g) { const int ai = g >> 2, m = g & 3; const float rs = rstd_get(c, ai, m);
            const f32x4 v0 = acc[ai][0][m][0] * rs + b0, v1 = acc[ai][0][m][1] * rs + b1;
            tile_store<1>(c, (char*)(logits + (size_t)EPI_ROW(g) * 32), 128, __builtin_bit_cast(u32x4, v0), __builtin_bit_cast(u32x4, v1)); }
    }
};
constexpr float SW_A2 = 1.702f * 1.4426950408889634f;
struct EpiSwiGLU {
    struct Pre { u32x4 bg, bu; float rs[8]; };
    __device__ __forceinline__ Pre fetch(const Unit& u, const EpiCtx& c) const { const bf16_t* p = bgu16 + (size_t)u.e * 2048 + u.pn * HALF + c.wc * 32 + 8 * c.fq; Pre r; r.bg = *(const u32x4*)p; r.bu = *(const u32x4*)(p + 1024);
#pragma unroll
        for (int g = 0; g < 8; ++g) r.rs[g] = rowrstd[EPI_ROW(g) + c.fr];
        return r; }
    static constexpr int NST = 4;     static constexpr bool PERM = true, AFTER_DRAIN = false, TWICE = ((PROBE_MASK >> 16) & 1) != 0;
    const bf16_t* bgu16; unsigned char* act; const float* rowrstd;
    __device__ __forceinline__ void operator()(const f32x4 (&acc)[2][2][4][2], const Unit& u, const EpiCtx& c, const Pre& pre) const {
        const int cw = u.pn * HALF + c.wc * 32;
        f32x4 bgt[2], bup[2]; unpack8(pre.bg, bgt[0], bgt[1]); unpack8(pre.bu, bup[0], bup[1]);
#pragma unroll
        for (int g = 0; g < 8; ++g) { const int ai = g >> 2, m = g & 3; f32x4 y[2]; const float rs = W8INV * pre.rs[g];
#pragma unroll
            for (int n = 0; n < 2; ++n) { const f32x4 gt = acc[ai][0][m][n] * rs + bgt[n], up = acc[ai][1][m][n] * rs + bup[n];
#pragma unroll
                for (int hp = 0; hp < 2; ++hp) {
                    f32x2 gc, uc; gc.x = fminf(gt[2 * hp], 7.0f * SW_A2); gc.y = fminf(gt[2 * hp + 1], 7.0f * SW_A2); uc.x = fminf(fmaxf(up[2 * hp], -6.0f), 8.0f); uc.y = fminf(fmaxf(up[2 * hp + 1], -6.0f), 8.0f);
                    f32x2 e; e.x = __builtin_amdgcn_exp2f(-gc.x); e.y = __builtin_amdgcn_exp2f(-gc.y);
                    const f32x2 d = e + 1.0f; f32x2 sg; sg.x = __builtin_amdgcn_rcpf(d.x); sg.y = __builtin_amdgcn_rcpf(d.y);
                    const f32x2 yy = uc * (gc * sg); y[n][2 * hp] = yy.x; y[n][2 * hp + 1] = yy.y; } }
            unsigned w0 = 0u, w1 = 0u;
            w0 = __builtin_amdgcn_cvt_pk_fp8_f32(y[0][0], y[0][1], w0, false); w0 = __builtin_amdgcn_cvt_pk_fp8_f32(y[0][2], y[0][3], w0, true);
            w1 = __builtin_amdgcn_cvt_pk_fp8_f32(y[1][0], y[1][1], w1, false); w1 = __builtin_amdgcn_cvt_pk_fp8_f32(y[1][2], y[1][3], w1, true);
            *(PG8_LAS unsigned long long*)(c.stg + ((g & 1) * 16 + c.fr) * 48 + c.fq * 8) = (unsigned long long)w0 | ((unsigned long long)w1 << 32);
            if (g & 1) { const int r = c.lane >> 1, hh = c.lane & 1; const u32x4 q = *(lds_u4p)(c.stg + r * 48 + hh * 16);
                *(u32x4*)(act + (size_t)(EPI_ROW(g - 1) + r) * 1024 + cw + hh * 16) = q; } }
    }
};
constexpr float YSCALE = 8.0f, YSINV = 0.125f;
struct EpiDown {
    struct Pre { float gt[8]; u32x4 b0, b1; };
    __device__ __forceinline__ Pre fetch(const Unit& u, const EpiCtx& c) const { Pre r;
#pragma unroll
        for (int g = 0; g < 8; ++g) r.gt[g] = rowgate[EPI_ROW(g) + c.fr];
        const bf16_t* p = bd16 + (size_t)u.e * 1024 + u.pn * BM + c.wc * 64 + 8 * c.fq; r.b0 = *(const u32x4*)p; r.b1 = *(const u32x4*)(p + 32); return r; }
    static constexpr int NST = 8;     static constexpr bool PERM = true, AFTER_DRAIN = false, TWICE = ((PROBE_MASK >> 15) & 1) != 0;
    const float* rowgate; const bf16_t* bd16; unsigned char* Y;
    __device__ __forceinline__ void operator()(const f32x4 (&acc)[2][2][4][2], const Unit& u, const EpiCtx& c, const Pre& pre) const {
        const int colw = u.pn * BM + c.wc * 64;
        f32x4 bv[2][2]; unpack8(pre.b0, bv[0][0], bv[0][1]); unpack8(pre.b1, bv[1][0], bv[1][1]);
        const float osc = W8INV / SW_A2;
#pragma unroll
        for (int g = 0; g < 8; ++g) { const int ai = g >> 2, m = g & 3; const float gt = pre.gt[g] * YSCALE; unsigned long long q8[2];
#pragma unroll
            for (int bj = 0; bj < 2; ++bj) { f32x4 v0 = (acc[ai][bj][m][0] * osc + bv[bj][0]) * gt, v1 = (acc[ai][bj][m][1] * osc + bv[bj][1]) * gt;
#pragma unroll
                for (int j = 0; j < 4; ++j) { v0[j] = __builtin_amdgcn_fmed3f(v0[j], -448.0f, 448.0f); v1[j] = __builtin_amdgcn_fmed3f(v1[j], -448.0f, 448.0f); }
                unsigned w0 = 0u, w1 = 0u; w0 = __builtin_amdgcn_cvt_pk_fp8_f32(v0[0], v0[1], w0, false); w0 = __builtin_amdgcn_cvt_pk_fp8_f32(v0[2], v0[3], w0, true);
                w1 = __builtin_amdgcn_cvt_pk_fp8_f32(v1[0], v1[1], w1, false); w1 = __builtin_amdgcn_cvt_pk_fp8_f32(v1[2], v1[3], w1, true); q8[bj] = (unsigned long long)w0 | ((unsigned long long)w1 << 32); }
            *(PG8_LAS unsigned long long*)(c.stg + c.fr * 80 + c.fq * 8) = q8[0]; *(PG8_LAS unsigned long long*)(c.stg + c.fr * 80 + 32 + c.fq * 8) = q8[1];
            const int r = c.lane >> 2, ch = c.lane & 3; const u32x4 t8 = *(lds_u4p)(c.stg + r * 80 + ch * 16);
            *(u32x4*)(Y + (size_t)(EPI_ROW(g) + r) * 1024 + colw + ch * 16) = t8; asm volatile("" ::: "memory"); }
    }
};
constexpr float PJSCALE = 8.0f, PJSINV = 0.125f;
struct EpiStore {
    struct Pre {}; __device__ __forceinline__ Pre fetch(const Unit&, const EpiCtx&) const { return Pre{}; }
    static constexpr int NST = 0;     static constexpr bool PERM = true, AFTER_DRAIN = false, TWICE = false;
    unsigned char* O;
    __device__ __forceinline__ void operator()(const f32x4 (&acc)[2][2][4][2], const Unit& u, const EpiCtx& c, const Pre& pre) const {
        unsigned char* ob = O + ((size_t)(u.pm * 4 + u.pn) * 8 + (c.wr * 4 + c.wc)) * 8192 + c.lane * 16;
#pragma unroll
        for (int g = 0; g < 8; ++g) { const int ai = g >> 2, m = g & 3; u32x4 w;
#pragma unroll
            for (int bj = 0; bj < 2; ++bj)
#pragma unroll
                for (int n = 0; n < 2; ++n) { f32x4 v = acc[ai][bj][m][n] * PJSCALE;
#pragma unroll
                    for (int j = 0; j < 4; ++j) v[j] = __builtin_amdgcn_fmed3f(v[j], -448.0f, 448.0f);
                    unsigned w0 = 0u; w0 = __builtin_amdgcn_cvt_pk_fp8_f32(v[0], v[1], w0, false); w0 = __builtin_amdgcn_cvt_pk_fp8_f32(v[2], v[3], w0, true); w[2 * bj + n] = w0; }
            *(u32x4*)(ob + g * 1024) = w; }
    }
};
struct EpiPle {
    struct Pre { f32x4 b[2][2]; };
    __device__ __forceinline__ Pre fetch(const Unit& u, const EpiCtx& c) const { Pre r; const float* p = bgate + u.pn * BM + c.wc * 64 + 8 * c.fq;
#pragma unroll
        for (int bj = 0; bj < 2; ++bj)
#pragma unroll
            for (int n = 0; n < 2; ++n) r.b[bj][n] = *(const f32x4*)(p + 32 * bj + 4 * n);
        return r; }
    static constexpr int NST = 18;     static constexpr bool PERM = true, AFTER_DRAIN = false, TWICE = false;
    const float* bgate; const unsigned char* PJ; const bf16_t* Xi; bf16_t* Xo; float* ss; unsigned char* X8;
    __device__ __forceinline__ void operator()(const f32x4 (&acc)[2][2][4][2], const Unit& u, const EpiCtx& c, const Pre& pre) const {
        const int colw = u.pn * BM + c.wc * 64;
        float sq[2][4]; RawTile rx[2]; u32x4 pjv[2];
        const unsigned char* pjb = PJ + ((size_t)(u.pm * 4 + u.pn) * 8 + (c.wr * 4 + c.wc)) * 8192 + c.lane * 16;
#define EP_FETCH(g_) do { const size_t ro_ = (size_t)EPI_ROW(g_) * 1024 + colw; pjv[(g_) & 1] = *(const u32x4*)(pjb + (g_) * 1024); rx[(g_) & 1] = tile_fetch(c, (const char*)(Xi + ro_), 2048); } while (0)
        EP_FETCH(0);
#pragma unroll
        for (int g = 0; g < 8; ++g) { const int ai = g >> 2, m = g & 3; const float rs = W8INV; float s = 0.f; u32x4 o[2], xw[2]; unsigned long long q8[2];
            if (g + 1 < 8) EP_FETCH(g + 1);
            const u32x4 pj = pjv[g & 1];
            tile_unstage<0>(c, rx[g & 1], xw[0], xw[1]);
#pragma unroll
            for (int bj = 0; bj < 2; ++bj) { f32x4 p0, p1, x0, x1; unpack8(xw[bj], x0, x1);
                { const f32x2 a0 = __builtin_amdgcn_cvt_pk_f32_fp8((int)pj[2 * bj], false), a1 = __builtin_amdgcn_cvt_pk_f32_fp8((int)pj[2 * bj], true), b0 = __builtin_amdgcn_cvt_pk_f32_fp8((int)pj[2 * bj + 1], false), b1 = __builtin_amdgcn_cvt_pk_f32_fp8((int)pj[2 * bj + 1], true);
                  p0 = (f32x4){a0.x, a0.y, a1.x, a1.y} * PJSINV; p1 = (f32x4){b0.x, b0.y, b1.x, b1.y} * PJSINV; }
                f32x4 z0 = acc[ai][bj][m][0] * rs + pre.b[bj][0], z1 = acc[ai][bj][m][1] * rs + pre.b[bj][1];
#pragma unroll
                for (int hp = 0; hp < 2; ++hp) {
                    f32x2 a0 = {z0[2 * hp], z0[2 * hp + 1]}, a1 = {z1[2 * hp], z1[2 * hp + 1]}; a0 = a0 * -1.4426950408889634f; a1 = a1 * -1.4426950408889634f;
                    f32x2 e0, e1; e0.x = __builtin_amdgcn_exp2f(a0.x); e0.y = __builtin_amdgcn_exp2f(a0.y); e1.x = __builtin_amdgcn_exp2f(a1.x); e1.y = __builtin_amdgcn_exp2f(a1.y); e0 = e0 + 1.0f; e1 = e1 + 1.0f;
                    z0[2 * hp] = __builtin_amdgcn_rcpf(e0.x); z0[2 * hp + 1] = __builtin_amdgcn_rcpf(e0.y); z1[2 * hp] = __builtin_amdgcn_rcpf(e1.x); z1[2 * hp + 1] = __builtin_amdgcn_rcpf(e1.y); }
                const f32x4 v0 = x0 + z0 * p0, v1 = x1 + z1 * p1;
                s += dot4(v0) + dot4(v1); o[bj] = pack8(v0, v1);
                { unsigned w0 = 0u, w1 = 0u; w0 = __builtin_amdgcn_cvt_pk_fp8_f32(v0[0], v0[1], w0, false); w0 = __builtin_amdgcn_cvt_pk_fp8_f32(v0[2], v0[3], w0, true);
                  w1 = __builtin_amdgcn_cvt_pk_fp8_f32(v1[0], v1[1], w1, false); w1 = __builtin_amdgcn_cvt_pk_fp8_f32(v1[2], v1[3], w1, true); q8[bj] = (unsigned long long)w0 | ((unsigned long long)w1 << 32); } }
            tile_store<0>(c, (char*)(Xo + (size_t)EPI_ROW(g) * 1024 + colw), 2048, o[0], o[1]);
            if (X8) {
              *(PG8_LAS unsigned long long*)(c.stg + c.fr * 80 + c.fq * 8) = q8[0]; *(PG8_LAS unsigned long long*)(c.stg + c.fr * 80 + 32 + c.fq * 8) = q8[1];
              const int r = c.lane >> 2, ch = c.lane & 3; const u32x4 t8 = *(lds_u4p)(c.stg + r * 80 + ch * 16);
              *(u32x4*)(X8 + (size_t)(EPI_ROW(g) + r) * 1024 + colw + ch * 16) = t8; }
            sq[ai][m] = s; asm volatile("" ::: "memory"); }
#undef EP_FETCH
        ss_put(c, ss, u.pm * BM, sq, u.pn * 4 + c.wc);
    }
};
struct EpiQkv {
    struct Pre {}; __device__ __forceinline__ Pre fetch(const Unit&, const EpiCtx&) const { return Pre{}; }
    static constexpr int NST = 0;     static constexpr bool PERM = true, AFTER_DRAIN = false, TWICE = false;
    const float* ssin; bf16_t* Q; const float* bfg; float* LF; float qscale; float* nrm;
    __device__ __forceinline__ void operator()(const f32x4 (&acc)[2][2][4][2], const Unit& u, const EpiCtx& c, const Pre& pre) const {
        rstd_stage(c, ssin, u.pm * BM);
        if (u.pn < 12) {
            const int t = u.pn >> 2; bf16_t* base = Q + (size_t)t * (65536 * 1024); const float sc = t == 0 ? qscale : 1.0f;
            const int colw = (u.pn & 3) * BM + c.wc * 64; float mx = 0.f;
#pragma unroll
            for (int g = 0; g < 8; ++g) { const int ai = g >> 2, m = g & 3; const float rs = rstd_get(c, ai, m) * sc * W8INV; u32x4 o[2]; float q = 0.f;
#pragma unroll
                for (int bj = 0; bj < 2; ++bj) { const f32x4 a = acc[ai][bj][m][0] * rs, b = acc[ai][bj][m][1] * rs; q += dot4(a) + dot4(b); o[bj] = pack8(a, b); }
                tile_store<0>(c, (char*)(base + (size_t)EPI_ROW(g) * 1024 + colw), 2048, o[0], o[1]);
                if (t < 2) { q += __shfl_xor(q, 16); q += __shfl_xor(q, 32); mx = fmaxf(mx, q); } }
            if (t < 2) {
                mx = fmaxf(mx, __shfl_xor(mx, 1)); mx = fmaxf(mx, __shfl_xor(mx, 2)); mx = fmaxf(mx, __shfl_xor(mx, 4)); mx = fmaxf(mx, __shfl_xor(mx, 8));
                if (c.lane == 0) nrm[(((size_t)u.pm * 16 + 4 * (u.pn & 3) + c.wc) * 2 + t) * 2 + c.wr] = mx; }
        } else if (c.wc == 0) {
            const f32x4 b0 = *(const f32x4*)(bfg + 8 * (c.fq & 1)), b1 = *(const f32x4*)(bfg + 8 * (c.fq & 1) + 4);
#pragma unroll
            for (int g = 0; g < 8; ++g) { const int ai = g >> 2, m = g & 3; const float rs = rstd_get(c, ai, m) * W8INV;
                f32x4 z0 = acc[ai][0][m][0] * rs + b0, z1 = acc[ai][0][m][1] * rs + b1;
#pragma unroll
                for (int j = 0; j < 4; ++j) { z0[j] = fminf(z0[j], 0.f) - 0.6931471805599453f * __builtin_amdgcn_logf(1.0f + __builtin_amdgcn_exp2f(-1.4426950408889634f * fabsf(z0[j]))); z1[j] = fminf(z1[j], 0.f) - 0.6931471805599453f * __builtin_amdgcn_logf(1.0f + __builtin_amdgcn_exp2f(-1.4426950408889634f * fabsf(z1[j]))); }
                if (c.fq < 2) { float* o = LF + (size_t)(EPI_ROW(g) + c.fr) * 16 + 8 * c.fq; *(f32x4*)o = z0; *(f32x4*)(o + 4) = z1; } }
        }
    }
};
struct EpiWo {
    struct Pre {}; __device__ __forceinline__ Pre fetch(const Unit&, const EpiCtx&) const { return Pre{}; }
    static constexpr int NST = 18;     static constexpr bool PERM = true, AFTER_DRAIN = false, TWICE = ((PROBE_MASK >> 14) & 1) != 0;
    const bf16_t* Xi; bf16_t* Xo; float* ss; unsigned char* X8;
    __device__ __forceinline__ void operator()(const f32x4 (&acc)[2][2][4][2], const Unit& u, const EpiCtx& c, const Pre& pre) const {
        const int colw = u.pn * BM + c.wc * 64;
        float sq[2][4]; RawTile rx[2];
#define EP_FETCH(g_) do { rx[(g_) & 1] = tile_fetch(c, (const char*)(Xi + (size_t)EPI_ROW(g_) * 1024 + colw), 2048); } while (0)
        EP_FETCH(0);
#pragma unroll
        for (int g = 0; g < 8; ++g) { const int ai = g >> 2, m = g & 3; float s = 0.f; u32x4 o[2], xw[2]; unsigned long long q8[2];
            if (g + 1 < 8) EP_FETCH(g + 1);
            tile_unstage<0>(c, rx[g & 1], xw[0], xw[1]);
#pragma unroll
            for (int bj = 0; bj < 2; ++bj) { f32x4 x0, x1; unpack8(xw[bj], x0, x1);
                const f32x4 v0 = x0 + acc[ai][bj][m][0] * W8INV, v1 = x1 + acc[ai][bj][m][1] * W8INV;
                s += dot4(v0) + dot4(v1); o[bj] = pack8(v0, v1); q8[bj] = fp8x8_sat(v0, v1); }
            tile_store<0>(c, (char*)(Xo + (size_t)EPI_ROW(g) * 1024 + colw), 2048, o[0], o[1]);
            fp8_rows_store(c, X8 + (size_t)EPI_ROW(g) * 1024 + colw, q8[0], q8[1]);
            sq[ai][m] = s; asm volatile("" ::: "memory"); }
#undef EP_FETCH
        ss_put(c, ss, u.pm * BM, sq, u.pn * 4 + c.wc);
    }
};

typedef int v8i_t __attribute__((ext_vector_type(8))); typedef int v4i_t __attribute__((ext_vector_type(4)));
struct Frag2 { bf16x8 k0, k1; };
struct Frag1 { v8i_t v; };
template <int ESZ> struct FragSel { typedef Frag2 type; };
template <> struct FragSel<1> { typedef Frag1 type; };
__device__ __forceinline__ void ld_frag(Frag2& f, const PG8_LAS unsigned char* p) { f.k0 = *(const PG8_LAS bf16x8*)p; f.k1 = *(const PG8_LAS bf16x8*)(p + 1024); }
__device__ __forceinline__ void ld_frag(Frag1& f, const PG8_LAS unsigned char* p) { const v4i_t lo = *(const PG8_LAS v4i_t*)p, hi = *(const PG8_LAS v4i_t*)(p + 1024); f.v = __builtin_shufflevector(lo, hi, 0, 1, 2, 3, 4, 5, 6, 7); }
__device__ __forceinline__ void mma_frag(f32x4& acc, const Frag2& b, const Frag2& a) { acc = __builtin_amdgcn_mfma_f32_16x16x32_bf16(b.k0, a.k0, acc, 0, 0, 0); acc = __builtin_amdgcn_mfma_f32_16x16x32_bf16(b.k1, a.k1, acc, 0, 0, 0); }
__device__ __forceinline__ void mma_frag(f32x4& acc, const Frag1& b, const Frag1& a) {
#if defined(__HIP_DEVICE_COMPILE__)
    asm volatile("v_mfma_f32_16x16x128_f8f6f4 %0, %1, %2, %0" : "+v"(acc) : "v"(b.v), "v"(a.v));
#endif
}
#define PG8_KITER(SKIP11, WX, MMA0) do { \
            unsigned w2[2][2]; \
            if constexpr (GATHER) { if (last) { _Pragma("unroll") for (int h_ = 0; h_ < 2; ++h_) _Pragma("unroll") for (int i_ = 0; i_ < 2; ++i_) w2[h_][i_] = vgN[h_][i_]; } else { _Pragma("unroll") for (int h_ = 0; h_ < 2; ++h_) _Pragma("unroll") for (int i_ = 0; i_ < 2; ++i_) w2[h_][i_] = vgC[h_][i_]; } } \
            PG8_LDB(B0, 0, 0); PG8_LDB(B1, 0, 1); PG8_SCHED; PG8_LDA(At, 0, 0); if (!(SKIP11)) { if constexpr (GATHER) PG8_STAGE(PG8_SA(1, 1), a1, vgC[1]); else PG8_STAGE(PG8_SA(1, 1), a1 + hstepA, voffA); } \
            PG8_WAIT_V(WX); PG8_WAIT_L(0); PG8_BAR; MMA0(0, 0, At, B0); MMA0(0, 1, At, B1); PG8_BAR; PG8_SCHED; \
            PG8_LDA(At, 0, 1); PG8_STAGE(PG8_SB(0, 0), b2, voffB); PG8_STAGE(PG8_SB(0, 1), b2 + hstepB, voffB); if constexpr (GATHER) PG8_STAGE(PG8_SA(0, 0), a2, w2[0]); else PG8_STAGE(PG8_SA(0, 0), a2, voffA); \
            PG8_WAIT_V(WX); PG8_WAIT_L(0); PG8_BAR; MMA0(1, 0, At, B0); MMA0(1, 1, At, B1); PG8_BAR; PG8_SCHED; \
            PG8_LDB(B0, 1, 0); PG8_LDB(B1, 1, 1); PG8_SCHED; PG8_LDA(At, 1, 0); if constexpr (GATHER) PG8_STAGE(PG8_SA(0, 1), a2, w2[1]); else PG8_STAGE(PG8_SA(0, 1), a2 + hstepA, voffA); \
            PG8_WAIT_V(WX); PG8_WAIT_L(0); PG8_BAR; PG8_MMA(0, 0, At, B0); PG8_MMA(0, 1, At, B1); PG8_BAR; PG8_SCHED; \
            PG8_LDA(At, 1, 1); PG8_STAGE(PG8_SB(1, 0), b3, voffB); PG8_STAGE(PG8_SB(1, 1), b3 + hstepB, voffB); if constexpr (GATHER) PG8_STAGE(PG8_SA(1, 0), a3, w2[0]); else PG8_STAGE(PG8_SA(1, 0), a3, voffA); \
            PG8_WAIT_V(8); PG8_WAIT_L(0); PG8_BAR; PG8_MMA(1, 0, At, B0); PG8_MMA(1, 1, At, B1); PG8_BAR; PG8_SCHED; \
            } while (0)
__device__ __forceinline__ void mma_frag_z(f32x4& acc, const Frag1& b, const Frag1& a) {
#if defined(__HIP_DEVICE_COMPILE__)
    asm volatile("v_mfma_f32_16x16x128_f8f6f4 %0, %1, %2, 0" : "=&v"(acc) : "v"(b.v), "v"(a.v));
#endif
}
__device__ __forceinline__ void mma_frag_z(f32x4& acc, const Frag2& b, const Frag2& a) { acc = (f32x4){0.f, 0.f, 0.f, 0.f}; mma_frag(acc, b, a); }
template <class Epi, class Sched, bool GATHER = false, int ESZ = 2>
__device__ __forceinline__ void gemm_phase(PG8_LAS unsigned char* lds, PG8_LAS unsigned char* epi, const Gemm g, const Sched& S, const Epi& E) {
    int tid = threadIdx.x; asm volatile("" : "+v"(tid));
    const int wid = __builtin_amdgcn_readfirstlane(tid >> 6), lane = tid & 63, wr = wid >> 2, wc = wid & 3, fr = lane & 15, fq = lane >> 4;
    constexpr bool ALIGN_EPI = true, SP2 = true, RELAX = (ESZ == 1)  ; const int K = g.K, nt = (K * ESZ) / (BK * 2), lda = g.lda, ldb = g.ldb;
    unsigned voffA[2], voffB[2];
#pragma unroll
    for (int i = 0; i < 2; ++i) { int R, C; stage_rc(tid * 16 + i * 8192, R, C); const int Rb = 64 * (R >> 5) + 8 * ((R & 15) >> 2) + 4 * ((R >> 4) & 1) + (R & 3);
        voffA[i] = GATHER ? (unsigned)(R | (C << 16)) : (unsigned)(R * lda * ESZ + C * 2); voffB[i] = (unsigned)(Rb * ldb * ESZ + C * 2); }
    unsigned vgC[2][2], vgN[2][2];
#define PG8_ROWMAP(dst, pm_) do { _Pragma("unroll") for (int h_ = 0; h_ < 2; ++h_) _Pragma("unroll") for (int i_ = 0; i_ < 2; ++i_) { \
        const unsigned tok_ = (unsigned)g.rowmap[(size_t)(pm_) * BM + h_ * HALF + (voffA[i_] & 0xFFFFu)] & 0xFFFFu; dst[h_][i_] = tok_ * (unsigned)(lda * ESZ) + (voffA[i_] >> 16) * 2u; } } while (0)
    const size_t kstep = (size_t)(BK * 2);
    const size_t hstepA = (size_t)HALF * lda * ESZ, hstepB = (size_t)32 * ldb * ESZ;
    const unsigned ldsw = (unsigned)wid * 1024u;
    const int aoff = lds_byte(wr * 64 + fr, fq * 8), boff = lds_byte(wc * 32 + fr, fq * 8);
#define PG8_SA(b, h) (((b) * 2 + (h)) * HTB)
#define PG8_SB(b, h) ((4 + (b) * 2 + (h)) * HTB)
#define PG8_STAGE(bufoff, gbase, voff) do { _Pragma("unroll") for (int _i = 0; _i < 2; ++_i) \
        __builtin_amdgcn_global_load_lds((const unsigned*)((const char*)(gbase) + (voff)[_i]), (PG8_LAS unsigned*)(lds + (bufoff) + ldsw + _i * 8192), 16, 0, 0); } while (0)
#define PG8_LDA(dst, b, h) do { _Pragma("unroll") for (int m = 0; m < 4; ++m) ld_frag(dst[m], lds + PG8_SA(b, h) + aoff + m * 2048); } while (0)
#define PG8_LDB(dst, b, h) do { _Pragma("unroll") for (int n = 0; n < 2; ++n) ld_frag(dst[n], lds + PG8_SB(b, h) + boff + n * 2048); } while (0)
#define PG8_MMA(ai, bj, At, Bt) do { __builtin_amdgcn_s_setprio(1); _Pragma("unroll") for (int m = 0; m < 4; ++m) _Pragma("unroll") for (int n = 0; n < 2; ++n) mma_frag(acc[ai][bj][m][n], Bt[n], At[m]); __builtin_amdgcn_s_setprio(0); } while (0)
#define PG8_MMAZ(ai, bj, At, Bt) do { __builtin_amdgcn_s_setprio(1); _Pragma("unroll") for (int m = 0; m < 4; ++m) _Pragma("unroll") for (int n = 0; n < 2; ++n) mma_frag_z(acc[ai][bj][m][n], Bt[n], At[m]); __builtin_amdgcn_s_setprio(0); } while (0)
#define PG8_WAIT_V(n) asm volatile("s_waitcnt vmcnt(%0)" :: "n"(n) : "memory")
#define PG8_WAIT_L(n) asm volatile("s_waitcnt lgkmcnt(" #n ")" ::: "memory")
#define PG8_BAR __builtin_amdgcn_s_barrier()
#define PG8_SCHED __builtin_amdgcn_sched_barrier(0)
    Unit cur, nxt; int ui = 0;
    if (!S.next(0, cur)) return;
    if (g.stag > 0) { const unsigned long long t0 = __builtin_amdgcn_s_memrealtime(), d = (unsigned long long)((blockIdx.x & 15u) * (unsigned)g.stag); while (__builtin_amdgcn_s_memrealtime() - t0 < d) __builtin_amdgcn_s_sleep(8); }
    f32x4 acc[2][2][4][2];
#pragma unroll
    for (int a = 0; a < 2; ++a)
#pragma unroll
        for (int b = 0; b < 2; ++b)
#pragma unroll
            for (int m = 0; m < 4; ++m)
#pragma unroll
                for (int n = 0; n < 2; ++n) { if constexpr (!RELAX) { acc[a][b][m][n] = (f32x4){0.f, 0.f, 0.f, 0.f}; if constexpr (ESZ == 1) asm volatile("" : "+v"(acc[a][b][m][n])); } }
    typename FragSel<ESZ>::type At[4], B0[2], B1[2];
    const char* cA = GATHER ? (const char*)g.A : (const char*)g.A + S.a_off(cur); const char* cB = (const char*)g.Bt + S.b_off(cur);
    if constexpr (GATHER) { PG8_ROWMAP(vgC, cur.pm); _Pragma("unroll") for (int h_ = 0; h_ < 2; ++h_) _Pragma("unroll") for (int i_ = 0; i_ < 2; ++i_) vgN[h_][i_] = vgC[h_][i_]; }
    typename Epi::Pre pre;
#define PG8_FETCH() do { int t3 = threadIdx.x; asm volatile("" : "+v"(t3)); const int w3 = __builtin_amdgcn_readfirstlane(t3 >> 6), l3 = t3 & 63; const EpiCtx ec3{epi + w3 * EPW, w3 >> 2, w3 & 3, l3 & 15, l3 >> 4, l3}; pre = E.fetch(cur, ec3); } while (0)
    PG8_FETCH();
    S.a_ready(cur);
    {
        PG8_STAGE(PG8_SB(0, 0), cB, voffB); PG8_STAGE(PG8_SB(0, 1), cB + hstepB, voffB);
        if constexpr (GATHER) { PG8_STAGE(PG8_SA(0, 0), cA, vgC[0]); PG8_STAGE(PG8_SA(0, 1), cA, vgC[1]); } else { PG8_STAGE(PG8_SA(0, 0), cA, voffA); PG8_STAGE(PG8_SA(0, 1), cA + hstepA, voffA); }
        if (wr == 1) PG8_BAR;
        PG8_WAIT_V(2); PG8_BAR;
        PG8_STAGE(PG8_SB(1, 0), cB + kstep, voffB); if constexpr (GATHER) PG8_STAGE(PG8_SA(1, 0), cA + kstep, vgC[0]); else PG8_STAGE(PG8_SA(1, 0), cA + kstep, voffA); PG8_STAGE(PG8_SB(1, 1), cB + hstepB + kstep, voffB);
        if constexpr (RELAX) {
            if constexpr (GATHER) PG8_STAGE(PG8_SA(1, 1), cA + kstep, vgC[1]); else PG8_STAGE(PG8_SA(1, 1), cA + kstep + hstepA, voffA);
            volatile __attribute__((address_space(1))) u32x4* dm = (volatile __attribute__((address_space(1))) u32x4*)g.dummy + ((size_t)blockIdx.x * 512 + (size_t)tid);
#pragma unroll
            for (int k_ = 0; k_ < Epi::NST; ++k_) *dm = (u32x4){0u, 0u, 0u, 0u};
            PG8_WAIT_V(8 + Epi::NST); PG8_BAR;
        } else { PG8_WAIT_V(6); PG8_BAR; }
    }
    for (;;) {
        const bool has_next = S.next(ui + 1, nxt);
        const char* nA = (has_next && !GATHER) ? (const char*)g.A + S.a_off(nxt) : cA; const char* nB = has_next ? (const char*)g.Bt + S.b_off(nxt) : cB;
        if constexpr (GATHER) { if (has_next) PG8_ROWMAP(vgN, nxt.pm); }
#define PG8_KPTRS const bool last = (t == nt - 2); const char* a1 = cA + (size_t)(t + 1) * kstep; \
            const char* a2 = last ? nA : cA + (size_t)(t + 2) * kstep; const char* b2 = last ? nB : cB + (size_t)(t + 2) * kstep; const char* a3 = a2 + kstep; const char* b3 = b2 + kstep; (void)a1
        if constexpr (RELAX) {
            { const int t = 0; PG8_KPTRS; PG8_KITER(true, 8 + Epi::NST, PG8_MMAZ); }
            for (int t = 2; t < nt; t += 2) { PG8_KPTRS; PG8_KITER(false, 8, PG8_MMA); }
            if (has_next) { if constexpr (GATHER) PG8_STAGE(PG8_SA(1, 1), nA + kstep, vgN[1]); else PG8_STAGE(PG8_SA(1, 1), nA + kstep + hstepA, voffA); }
        } else {
            for (int t = 0; t < nt; t += 2) { PG8_KPTRS; PG8_KITER(false, 8, PG8_MMA); }
        }
#undef PG8_KPTRS
        if constexpr (ESZ == 1) asm volatile("s_nop 15\n\ts_nop 15" ::: "memory");
        if constexpr (ALIGN_EPI) { if (wr == 0) PG8_BAR; }
        { int t2 = threadIdx.x; asm volatile("" : "+v"(t2));
          const int w2 = __builtin_amdgcn_readfirstlane(t2 >> 6), l2 = t2 & 63; const EpiCtx ec{epi + w2 * EPW, w2 >> 2, w2 & 3, l2 & 15, l2 >> 4, l2}; E(acc, cur, ec, pre); if (Epi::TWICE) { asm volatile("" ::: "memory"); E(acc, cur, ec, pre); } S.done(cur); }
        if (!has_next) break;
#pragma unroll
        for (int a = 0; a < 2; ++a)
#pragma unroll
            for (int b = 0; b < 2; ++b)
#pragma unroll
                for (int m = 0; m < 4; ++m)
#pragma unroll
                    for (int n = 0; n < 2; ++n) { if constexpr (!RELAX) { acc[a][b][m][n] = (f32x4){0.f, 0.f, 0.f, 0.f}; if constexpr (ESZ == 1) asm volatile("" : "+v"(acc[a][b][m][n])); } }
        cur = nxt; cA = nA; cB = nB; ++ui;
        PG8_FETCH();
        if constexpr (GATHER) { _Pragma("unroll") for (int h_ = 0; h_ < 2; ++h_) _Pragma("unroll") for (int i_ = 0; i_ < 2; ++i_) vgC[h_][i_] = vgN[h_][i_]; }
        if constexpr (ALIGN_EPI) { if (wr == 1) PG8_BAR; }
    }
    PG8_WAIT_V(0);
    if constexpr (!ALIGN_EPI) { if (wr == 0) PG8_BAR; }
    PG8_BAR;
#undef PG8_SA
#undef PG8_FETCH
#undef PG8_ROWMAP
#undef PG8_SB
#undef PG8_STAGE
#undef PG8_LDA
#undef PG8_LDB
#undef PG8_MMA
#undef PG8_MMAZ
#undef PG8_WAIT_V
#undef PG8_WAIT_L
#undef PG8_BAR
#undef PG8_SCHED
}
}
#include <hip/hip_bf16.h>
#include <cmath>
namespace attn_body {
using bf16=__hip_bfloat16;
using bf16x8=__attribute__((ext_vector_type(8)))short;
using s16x4=__attribute__((ext_vector_type(4)))short;
using f32x16=__attribute__((ext_vector_type(16)))float;
using u32x4=__attribute__((ext_vector_type(4)))unsigned;
using f32x4_t=__attribute__((ext_vector_type(4)))float;
constexpr int BATCH=8,NHEAD=16,SEQ=8192,D=64,DM=NHEAD*D;
constexpr int NW=8,QBLK=32,QB=QBLK*NW,KVBLK=64,NQB=SEQ/QB;
constexpr int ATTN_PITCH=DM, ATTN_UNIT_ROWS=QB;
__device__ __forceinline__ int crow(int r,int hi){return (r&3)+8*(r>>2)+4*hi;}
#define SBAR() __builtin_amdgcn_sched_barrier(0)
__device__ __forceinline__ void cmask(f32x16&p0,f32x16&p1,int jb,int qrel,int hi){
  const float NEG=-INFINITY; int kb=64*jb+4*hi;
  #pragma unroll
  for(int r=0;r<16;++r){int kv=kb+(r&3)+8*(r>>2); if(kv>qrel)p0[r]=NEG; if(kv+32>qrel)p1[r]=NEG;}
}

constexpr int NSLOT=3, SLOTB=8192;
constexpr int LDS_K=0, LDS_V=NSLOT*SLOTB, LDS_WS=2*NSLOT*SLOTB, LDS_OST=LDS_WS+NW*64*4, LDS_BIAS=LDS_OST+NW*4096, LDS_BYTES=LDS_BIAS+SEQ*4;
constexpr float C2=0.125f*1.4426950408889634f;
__device__ __forceinline__ void glds16(const void*gsrc,unsigned lds_dst){unsigned keep;
  asm volatile("s_mov_b32 %0, m0\n\ts_mov_b32 m0, %2\n\ts_nop 0\n\tglobal_load_lds_dwordx4 %1, off\n\ts_mov_b32 m0, %0":"=&s"(keep):"v"(gsrc),"s"(lds_dst):"memory");}
__device__ __forceinline__ float max3f(float a,float b,float c){float r;asm("v_max3_f32 %0, %1, %2, %3":"=v"(r):"v"(a),"v"(b),"v"(c));return r;}
__device__ __forceinline__ float max2f(float a,float b){float r;asm("v_max_f32_e32 %0, %1, %2":"=v"(r):"v"(a),"v"(b));return r;}
__device__ __forceinline__ float fadd_s(float a,float b){float r;asm("v_add_f32_e32 %0, %1, %2":"=v"(r):"v"(a),"v"(b));return r;}
__device__ __forceinline__ float fsub_s(float a,float b){float r;asm("v_sub_f32_e32 %0, %1, %2":"=v"(r):"v"(a),"v"(b));return r;}
typedef float f32x2_t __attribute__((ext_vector_type(2))); typedef __bf16 bf16x2_t __attribute__((ext_vector_type(2)));
__device__ __forceinline__ unsigned cvtpk_s(float lo,float hi){f32x2_t v={lo,hi};bf16x2_t b=__builtin_convertvector(v,bf16x2_t);return __builtin_bit_cast(unsigned,b);}
#define WAIT_BAR(N) asm volatile("s_waitcnt vmcnt(" #N ") lgkmcnt(0)\n\ts_barrier":::"memory")

__device__ __forceinline__ void qkt(f32x16&p0,f32x16&p1,const char*Kslot,const bf16x8*qr,const f32x16&c0,const f32x16&c1,int r32,int hi){
  const char*kb=Kslot+hi*1024+r32*16;
  #pragma unroll
  for(int d0=0;d0<4;++d0){
    const bf16x8 b0=*reinterpret_cast<const bf16x8*>(kb+d0*2048);
    const bf16x8 b1=*reinterpret_cast<const bf16x8*>(kb+d0*2048+512);
    if(d0==0){p0=__builtin_amdgcn_mfma_f32_32x32x16_bf16(b0,qr[0],c0,0,0,0);p1=__builtin_amdgcn_mfma_f32_32x32x16_bf16(b1,qr[0],c1,0,0,0);}
    else{p0=__builtin_amdgcn_mfma_f32_32x32x16_bf16(b0,qr[d0],p0,0,0,0);p1=__builtin_amdgcn_mfma_f32_32x32x16_bf16(b1,qr[d0],p1,0,0,0);}}
}
typedef __attribute__((address_space(3))) const char* lds_cptr;
typedef short v4i16_t __attribute__((ext_vector_type(4)));
__device__ __forceinline__ void kload8(bf16x8*kf,lds_cptr kp){
  kf[0]=*(const __attribute__((address_space(3))) bf16x8*)(kp);      kf[1]=*(const __attribute__((address_space(3))) bf16x8*)(kp+512);
  kf[2]=*(const __attribute__((address_space(3))) bf16x8*)(kp+2048); kf[3]=*(const __attribute__((address_space(3))) bf16x8*)(kp+2560);
  kf[4]=*(const __attribute__((address_space(3))) bf16x8*)(kp+4096); kf[5]=*(const __attribute__((address_space(3))) bf16x8*)(kp+4608);
  kf[6]=*(const __attribute__((address_space(3))) bf16x8*)(kp+6144); kf[7]=*(const __attribute__((address_space(3))) bf16x8*)(kp+6656);
}
__device__ __forceinline__ void kload2(bf16x8*kf,lds_cptr kp,int j){ kf[2*j]=*(const __attribute__((address_space(3))) bf16x8*)(kp+j*2048); kf[2*j+1]=*(const __attribute__((address_space(3))) bf16x8*)(kp+j*2048+512); }
__device__ __forceinline__ s16x4 vtr(lds_cptr p){ return __builtin_bit_cast(s16x4,__builtin_amdgcn_ds_read_tr16_b64_v4i16((__attribute__((address_space(3))) v4i16_t*)p)); }
__device__ __forceinline__ float rowmax(const f32x16&p0,const f32x16&p1){
  float a=max3f(p0[0],p0[1],p1[0]),b=max3f(p0[2],p0[3],p1[1]);a=max3f(a,p1[2],p1[3]);
  #pragma unroll
  for(int r=4;r<16;r+=4){a=max3f(a,p0[r],p0[r+1]);b=max3f(b,p0[r+2],p0[r+3]);a=max3f(a,p1[r],p1[r+1]);b=max3f(b,p1[r+2],p1[r+3]);}
  const float m=max2f(a,b);
  auto rr=__builtin_amdgcn_permlane32_swap(__float_as_uint(m),__float_as_uint(m),false,false);
  return max2f(__uint_as_float(rr[0]),__uint_as_float(rr[1]));
}
__device__ __forceinline__ void pv(f32x16*o,int vb,bf16x8 pa0,bf16x8 pa1,bf16x8 pa2,bf16x8 pa3){
  #pragma unroll
  for(int d0=0;d0<2;++d0){s16x4 lo[4],hi[4];
    #pragma unroll
    for(int ks=0;ks<4;++ks){
      asm volatile("ds_read_b64_tr_b16 %0,%1 offset:%c2":"=&v"(lo[ks]):"v"(vb),"i"(d0*4096+ks*1024):"memory");
      asm volatile("ds_read_b64_tr_b16 %0,%1 offset:%c2":"=&v"(hi[ks]):"v"(vb),"i"(d0*4096+ks*1024+512):"memory");}
    asm volatile("s_waitcnt lgkmcnt(0)":::"memory");SBAR();
    #define PK(k) (bf16x8){lo[k][0],lo[k][1],lo[k][2],lo[k][3],hi[k][0],hi[k][1],hi[k][2],hi[k][3]}
    o[d0]=__builtin_amdgcn_mfma_f32_32x32x16_bf16(pa0,PK(0),o[d0],0,0,0);
    o[d0]=__builtin_amdgcn_mfma_f32_32x32x16_bf16(pa1,PK(1),o[d0],0,0,0);
    o[d0]=__builtin_amdgcn_mfma_f32_32x32x16_bf16(pa2,PK(2),o[d0],0,0,0);
    o[d0]=__builtin_amdgcn_mfma_f32_32x32x16_bf16(pa3,PK(3),o[d0],0,0,0);
    #undef PK
  }
}

#ifndef ATTN_STORE16
#define ATTN_STORE16(p,v) (*(u32x4*)(p)=(v))
#endif
template<int THRL,bool STATIC> __device__ __forceinline__ void attn_unit(int b,int h,int qb,int ts,const bf16*Q,const bf16*__restrict__ K,const bf16*__restrict__ V,bf16*O,const float*biasg,char*shm){
  int tid=threadIdx.x; asm volatile("":"+v"(tid)); const int lane=tid&63,r32=lane&31,hi=lane>>5; const int wid=__builtin_amdgcn_readfirstlane(tid>>6);
  const long rowbase=(long)b*SEQ; const int q0=qb*QB;
  const bf16*Qw=Q+(rowbase+q0+wid*QBLK)*DM+h*D;
  const bf16*Kh=K+(rowbase+(long)ts*KVBLK)*DM+h*D,*Vh=V+(rowbase+(long)ts*KVBLK)*DM+h*D;
  const unsigned lds0=(unsigned)(uintptr_t)shm;
  float*wsf=(float*)(shm+LDS_WS)+wid*64;
  const bf16*ksrc=Kh+(long)lane*DM+wid*8;
  const bf16*vsrc=Vh+(long)(16*(wid&3)+(lane>>2))*DM+(wid>>2)*32+(lane&3)*8;
  const unsigned kdst=lds0+LDS_K+wid*1024, vdst=lds0+LDS_V+wid*1024;
  #define DMA_K(t,slot) glds16(ksrc+(long)(t)*KVBLK*DM,(unsigned)__builtin_amdgcn_readfirstlane(kdst+(slot)))
  #define DMA_V(t,slot) glds16(vsrc+(long)(t)*KVBLK*DM,(unsigned)__builtin_amdgcn_readfirstlane(vdst+(slot)))
  const int vb0=(int)(lds0+LDS_V)+((lane>>4)&1)*32+(lane&3)*8+(4*hi+((lane&15)>>2))*64;
  const char*Kbase=shm+LDS_K; bf16x8 kf[8];
  const lds_cptr shm3=(lds_cptr)shm; const lds_cptr kp0=shm3+LDS_K+hi*1024+r32*16; const lds_cptr vp0=shm3+LDS_V+((lane>>4)&1)*32+(lane&3)*8+(4*hi+((lane&15)>>2))*64;
  const int NT=(q0+QB)/KVBLK-ts;
  if(!STATIC){ const float*bg=biasg+(long)(b*NHEAD+h)*SEQ+ts*KVBLK; const int nb=NT*KVBLK;
    for(int f0=wid*256;f0<nb;f0+=NW*256) glds16(bg+f0+lane*4,(unsigned)__builtin_amdgcn_readfirstlane(lds0+LDS_BIAS+f0*4)); }
  const lds_cptr bp0=shm3+LDS_BIAS+hi*16;
  DMA_K(0,0);DMA_V(0,0);DMA_K(1,SLOTB);
  bf16x8 qr[4];
  #pragma unroll
  for(int d0=0;d0<4;++d0)qr[d0]=*reinterpret_cast<const bf16x8*>(&Qw[(long)r32*DM+d0*16+hi*8]);
  float mhat=0.f,l_reg=0.f;f32x16 o[2];o[0]=f32x16{};o[1]=f32x16{};f32x16 cb0,cb1;
  #define LOADCB(t) do{ const lds_cptr bp_=bp0+(t)*256; _Pragma("unroll") for(int j_=0;j_<4;++j_){ \
      const f32x4_t u0_=*(const __attribute__((address_space(3))) f32x4_t*)(bp_+j_*32); const f32x4_t u1_=*(const __attribute__((address_space(3))) f32x4_t*)(bp_+128+j_*32); \
      _Pragma("unroll") for(int i_=0;i_<4;++i_){ if(STATIC){ cb0[4*j_+i_]=u0_[i_]; cb1[4*j_+i_]=u1_[i_]; } else { cb0[4*j_+i_]=u0_[i_]-mhat; cb1[4*j_+i_]=u1_[i_]-mhat; } } } }while(0)
  const int qrel=wid*QBLK+r32;
  #define CMASK(P0,P1,t) do{int jb_=(t)-(NT-4); if(jb_>=0)cmask(P0,P1,jb_,qrel,hi);}while(0)
  bool resc=false;
  #define START(P0,P1) do{ resc=false; \
    if(!STATIC){ const float rm=rowmax(P0,P1); const float dl=rm; mhat=fadd_s(mhat,dl); \
      _Pragma("unroll") for(int r=0;r<16;++r){P0[r]=fsub_s(P0[r],dl);P1[r]=fsub_s(P1[r],dl);} \
      } \
    _Pragma("unroll") for(int r=0;r<16;++r)P0[r]=__builtin_amdgcn_exp2f(P0[r]); }while(0)
  #define RESC() do{ if(resc){ asm volatile("s_waitcnt lgkmcnt(0)":::"memory"); \
      _Pragma("unroll") for(int d_=0;d_<2;++d_) _Pragma("unroll") for(int r=0;r<16;++r)o[d_][r]*=wsf[crow(r,hi)]; } }while(0)
  f32x16 pA0,pA1,pB0,pB1;
  int sl_prev=0,sl_cur=0,sl_next=SLOTB;
  #define ROT() do{sl_prev=sl_cur;sl_cur=sl_next;sl_next=(sl_next==(NSLOT-1)*SLOTB)?0:sl_next+SLOTB;}while(0)
  DMA_K(2,2*SLOTB);
  if(STATIC){ const float*bg=biasg+(long)(b*NHEAD+h)*SEQ; const float ref=bg[q0+QB-1]; const int nb=NT*KVBLK;
    for(int f0=tid*4;f0<nb;f0+=NW*256){ f32x4_t v=*(const f32x4_t*)(bg+ts*KVBLK+f0); v[0]-=ref; v[1]-=ref; v[2]-=ref; v[3]-=ref; *(__attribute__((address_space(3))) f32x4_t*)(shm3+LDS_BIAS+f0*4)=v; } }
  WAIT_BAR(3);
  LOADCB(0); qkt(pA0,pA1,Kbase,qr,cb0,cb1,r32,hi);asm volatile("s_nop 15\n\ts_nop 7":"+v"(pA0),"+v"(pA1));CMASK(pA0,pA1,0);
  START(pA0,pA1);
  _Pragma("unroll") for(int r=0;r<16;++r)pA1[r]=__builtin_amdgcn_exp2f(pA1[r]);
  WAIT_BAR(0);
  DMA_K(3,0);DMA_V(1,SLOTB);
  ROT();
  kload8(kf,kp0+sl_cur);
  WAIT_BAR(2);
  s16x4 vlo[8],vhi[8]; u32x4 pw0,pw1,pw2,pw3;
  #define PKW(P,B) cvtpk_s(P[B],P[B+1])
  #define PAF(k) __builtin_bit_cast(bf16x8,pw##k)
  #define VFR(i) (bf16x8){vlo[i][0],vlo[i][1],vlo[i][2],vlo[i][3],vhi[i][0],vhi[i][1],vhi[i][2],vhi[i][3]}
  #define PIN(x) asm volatile("":"+v"(x))
  #define MX3(a,b,c) __builtin_fmaxf(__builtin_fmaxf((a),(b)),(c))
  #define GAPA(MF,A0,A1,A2,A3,W0,W1,PW) do{ MF; sacc+=A0; sacc+=A1; sacc+=A2; sacc+=A3; PIN(sacc); W0; W1; PIN(PW); SBAR(); }while(0)
  #define EX(v) __builtin_amdgcn_exp2f(v)
  #define GAPB(MF,X,B) do{ MF; X[B]=EX(X[B]); X[B+1]=EX(X[B+1]); X[B+2]=EX(X[B+2]); X[B+3]=EX(X[B+3]); PIN(X); SBAR(); }while(0)
  #define VRD(i) do{ vlo[i]=vtr(vp_+(((i)>>2)*4096+((i)&3)*1024)); vhi[i]=vtr(vp_+(((i)>>2)*4096+((i)&3)*1024+512)); }while(0)
  #define KRD(G,j) do{ if(G){ kload2(kf,kp0+sl_next,j); SBAR(); } }while(0)
  #define STEP(C0,C1,P0,P1,t,GK,GV,GL) do{ SBAR(); \
    LOADCB(t); SBAR(); \
    const lds_cptr vp_=vp0+sl_prev; \
    VRD(0); SBAR(); float sacc=(P0[0]+P0[1]); \
    GAPA(C0=__builtin_amdgcn_mfma_f32_32x32x16_bf16(kf[0],qr[0],cb0,0,0,0), P0[2],P0[3],P0[4],P0[5],     pw0[0]=PKW(P0,0), pw0[1]=PKW(P0,2), pw0); \
    VRD(4); SBAR(); GAPA(C1=__builtin_amdgcn_mfma_f32_32x32x16_bf16(kf[1],qr[0],cb1,0,0,0), P0[6],P0[7],P0[8],P0[9],     pw0[2]=PKW(P0,4), pw0[3]=PKW(P0,6), pw0); \
    VRD(1); SBAR(); GAPA(C0=__builtin_amdgcn_mfma_f32_32x32x16_bf16(kf[2],qr[1],C0,0,0,0),   P0[10],P0[11],P0[12],P0[13], pw1[0]=PKW(P0,8), pw1[1]=PKW(P0,10), pw1); \
    VRD(5); SBAR(); GAPA(C1=__builtin_amdgcn_mfma_f32_32x32x16_bf16(kf[3],qr[1],C1,0,0,0),   P0[14],P0[15],P1[0],P1[1],   pw1[2]=PKW(P0,12),pw1[3]=PKW(P0,14), pw1); \
    VRD(2); SBAR(); GAPA(C0=__builtin_amdgcn_mfma_f32_32x32x16_bf16(kf[4],qr[2],C0,0,0,0),   P1[2],P1[3],P1[4],P1[5],     pw2[0]=PKW(P1,0), pw2[1]=PKW(P1,2), pw2); \
    VRD(6); SBAR(); GAPA(C1=__builtin_amdgcn_mfma_f32_32x32x16_bf16(kf[5],qr[2],C1,0,0,0),   P1[6],P1[7],P1[8],P1[9],     pw2[2]=PKW(P1,4), pw2[3]=PKW(P1,6), pw2); \
    VRD(3); SBAR(); GAPA(C0=__builtin_amdgcn_mfma_f32_32x32x16_bf16(kf[6],qr[3],C0,0,0,0),   P1[10],P1[11],P1[12],P1[13], pw3[0]=PKW(P1,8), pw3[1]=PKW(P1,10), pw3); \
    VRD(7); SBAR(); GAPA(C1=__builtin_amdgcn_mfma_f32_32x32x16_bf16(kf[7],qr[3],C1,0,0,0),   P1[14],P1[15],0.f,0.f,       pw3[2]=PKW(P1,12),pw3[3]=PKW(P1,14), pw3); \
    l_reg+=sacc; \
    if(GK){DMA_K((t)+3,sl_cur);} if(GV){DMA_V((t)+1,sl_next);} \
    CMASK(C0,C1,t); \
    if(!STATIC){ float a=MX3(C0[0],C0[1],C1[0]),b=MX3(C0[2],C0[3],C1[1]); a=MX3(a,C1[2],C1[3]); \
      _Pragma("unroll") for(int r=4;r<16;r+=4){a=MX3(a,C0[r],C0[r+1]);b=MX3(b,C0[r+2],C0[r+3]);a=MX3(a,C1[r],C1[r+1]);b=MX3(b,C1[r+2],C1[r+3]);} \
      float rm=__builtin_fmaxf(a,b); { auto rr=__builtin_amdgcn_permlane32_swap(__float_as_uint(rm),__float_as_uint(rm),false,false); rm=__builtin_fmaxf(__uint_as_float(rr[0]),__uint_as_float(rr[1])); } \
      resc=false; \
      if(__builtin_expect(__any(rm>(float)THRL),0)){ const float dl=__builtin_fmaxf(rm,0.f); mhat+=dl; \
        _Pragma("unroll") for(int r=0;r<16;++r){C0[r]-=dl;C1[r]-=dl;} \
        const float f=__builtin_amdgcn_exp2f(-dl); l_reg*=f; if(hi==0)wsf[r32]=f; resc=true; } } \
    SBAR(); \
    GAPB(o[0]=__builtin_amdgcn_mfma_f32_32x32x16_bf16(PAF(0),VFR(0),o[0],0,0,0), C0,0); \
    GAPB(o[1]=__builtin_amdgcn_mfma_f32_32x32x16_bf16(PAF(0),VFR(4),o[1],0,0,0), C0,4); \
    KRD(GL,0); GAPB(o[0]=__builtin_amdgcn_mfma_f32_32x32x16_bf16(PAF(1),VFR(1),o[0],0,0,0), C0,8); \
    KRD(GL,1); GAPB(o[1]=__builtin_amdgcn_mfma_f32_32x32x16_bf16(PAF(1),VFR(5),o[1],0,0,0), C0,12); \
    KRD(GL,2); GAPB(o[0]=__builtin_amdgcn_mfma_f32_32x32x16_bf16(PAF(2),VFR(2),o[0],0,0,0), C1,0); \
    KRD(GL,3); GAPB(o[1]=__builtin_amdgcn_mfma_f32_32x32x16_bf16(PAF(2),VFR(6),o[1],0,0,0), C1,4); \
    GAPB(o[0]=__builtin_amdgcn_mfma_f32_32x32x16_bf16(PAF(3),VFR(3),o[0],0,0,0), C1,8); \
    GAPB(o[1]=__builtin_amdgcn_mfma_f32_32x32x16_bf16(PAF(3),VFR(7),o[1],0,0,0), C1,12); \
    }while(0)
  int t=1;
  #undef CMASK
  #define CMASK(P0,P1,t) do{}while(0)
  for(;t+5<NT;t+=2){
    STEP(pB0,pB1,pA0,pA1,t,true,true,true);     WAIT_BAR(2); RESC(); ROT();
    STEP(pA0,pA1,pB0,pB1,t+1,true,true,true);   WAIT_BAR(2); RESC(); ROT();
  }
  #undef CMASK
  #define CMASK(P0,P1,t) do{int jb_=(t)-(NT-4); if(jb_>=0)cmask(P0,P1,jb_,qrel,hi);}while(0)
  #define ENDW(tt) do{ if((tt)+3<NT){WAIT_BAR(2);} else if((tt)+2<NT){WAIT_BAR(1);} else {WAIT_BAR(0);} }while(0)
  for(;t+1<NT;t+=2){
    STEP(pB0,pB1,pA0,pA1,t,(t+3<NT),(t+1<NT),(t+1<NT));       ENDW(t);   RESC(); ROT();
    STEP(pA0,pA1,pB0,pB1,t+1,(t+4<NT),(t+2<NT),(t+2<NT));     ENDW(t+1); RESC(); ROT();
  }
  STEP(pB0,pB1,pA0,pA1,NT-1,false,false,false); RESC();
  { float sacc=pB0[0]+pB0[1]; _Pragma("unroll") for(int r=2;r<16;++r)sacc+=pB0[r]; _Pragma("unroll") for(int r=0;r<16;++r)sacc+=pB1[r]; l_reg+=sacc;
    pw0=(u32x4){PKW(pB0,0),PKW(pB0,2),PKW(pB0,4),PKW(pB0,6)};pw1=(u32x4){PKW(pB0,8),PKW(pB0,10),PKW(pB0,12),PKW(pB0,14)};pw2=(u32x4){PKW(pB1,0),PKW(pB1,2),PKW(pB1,4),PKW(pB1,6)};pw3=(u32x4){PKW(pB1,8),PKW(pB1,10),PKW(pB1,12),PKW(pB1,14)};
    SBAR(); pv(o,vb0+sl_cur,PAF(0),PAF(1),PAF(2),PAF(3)); }
  #undef PKW
  #undef PAF
  #undef VFR
  #undef PIN
  #undef MX3
  #undef GAPA
  #undef GAPB
  #undef EX
  #undef VRD
  #undef KRD
  #undef STEP
  #undef ENDW
  {auto rr=__builtin_amdgcn_permlane32_swap(__float_as_uint(l_reg),__float_as_uint(l_reg),false,false);l_reg=__uint_as_float(rr[0])+__uint_as_float(rr[1]);}
  if(hi==0)wsf[32+r32]=l_reg;asm volatile("s_waitcnt lgkmcnt(0)":::"memory");
  float rli[16];
  #pragma unroll
  for(int r=0;r<16;++r)rli[r]=__builtin_amdgcn_rcpf(wsf[32+crow(r,hi)]);
  unsigned char*Ow=(unsigned char*)O+(rowbase+q0+wid*QBLK)*DM+h*D;
  { __attribute__((address_space(3))) unsigned char*stg=(__attribute__((address_space(3))) unsigned char*)(shm3+LDS_OST)+wid*2048;
    #pragma unroll
    for(int r=0;r<16;++r){const int orow=crow(r,hi);
      #pragma unroll
      for(int d0=0;d0<2;++d0){const float v=o[d0][r]*rli[r]; stg[orow*64+d0*32+r32]=(unsigned char)(__builtin_amdgcn_cvt_pk_fp8_f32(v,v,0u,false)&0xffu);}}
    asm volatile("s_waitcnt lgkmcnt(0)":::"memory");
    #pragma unroll
    for(int i=0;i<2;++i){const int row=i*16+(lane>>2),ch=lane&3; const u32x4 v=*(const __attribute__((address_space(3))) u32x4*)(stg+row*64+ch*16); ATTN_STORE16(Ow+(long)row*DM+ch*16,v);} }
  asm volatile("s_waitcnt lgkmcnt(0)\n\ts_barrier":::"memory");
  #undef DMA_K
  #undef DMA_V
  #undef CMASK
  #undef START
  #undef RESC
  #undef ROT
  #undef LOADCB
}
constexpr int ATTN_LDS_BYTES=LDS_BYTES;
struct AttnTensors { const bf16* Q; const bf16* K; const bf16* V; bf16* O; const float* bias; const int* ts; };
struct AttnUnit { int bh; int qb; };
struct StaticOrder {
  int vcu;
  __device__ __forceinline__ explicit StaticOrder(int grid,int block):vcu((block%8)*(grid/8)+block/8){}
  __device__ __forceinline__ bool next(int i,AttnUnit&u)const{ if(i>=16)return false; const int grp=i>>2,j=i&3,r=((vcu&7)+2*grp)&7; u.bh=(vcu>>3)+32*grp;
    u.qb=(r<5)?((j==0)?r:(4+3*r+j)):(20+4*(r-5)+j); return true; }
  __device__ __forceinline__ void a_ready(const AttnUnit&)const{}
  __device__ __forceinline__ void done(const AttnUnit&)const{}
};
template<class Sched,int THRL=60> __device__ __forceinline__ void attn_phase(char*lds,const AttnTensors&T,const Sched&S){
  AttnUnit u;
  for(int i=0;S.next(i,u);++i){ S.a_ready(u); const int ts_=__builtin_amdgcn_readfirstlane(T.ts[u.bh*NQB+u.qb]);
    if(ts_&0x10000) attn_unit<THRL,true>(u.bh/NHEAD,u.bh%NHEAD,u.qb,ts_&0xffff,T.Q,T.K,T.V,T.O,T.bias,lds); else attn_unit<THRL,false>(u.bh/NHEAD,u.bh%NHEAD,u.qb,ts_,T.Q,T.K,T.V,T.O,T.bias,lds);
    S.done(u); }
}
#undef SBAR
#undef WAIT_BAR
}
#define GAS __attribute__((address_space(1)))
#define LAS __attribute__((address_space(3)))
typedef unsigned short bf16;
typedef unsigned v4u __attribute__((ext_vector_type(4)));
typedef float f32x4 __attribute__((ext_vector_type(4)));
typedef short bf16x8 __attribute__((ext_vector_type(8)));
typedef GAS unsigned gu32;
typedef GAS unsigned long long gu64;
#define RLX_AGENT __ATOMIC_RELAXED, __HIP_MEMORY_SCOPE_AGENT
#define LDS_WAIT() asm volatile("s_waitcnt lgkmcnt(0)" ::: "memory")
#define VM_WAIT() asm volatile("s_waitcnt vmcnt(0)" ::: "memory")
__device__ __forceinline__ unsigned long long rt() { return __builtin_amdgcn_s_memrealtime(); }
__device__ __forceinline__ unsigned f2bf(float f) { unsigned u = __builtin_bit_cast(unsigned, f); return (u + 0x7fffu + ((u >> 16) & 1u)) >> 16; }
__device__ __forceinline__ unsigned pk2(float lo, float hi) { return f2bf(lo) | (f2bf(hi) << 16); }

#define XB_TMO      128
#define XB_XCNT(j)  (256  + 64 * (j))
#define XB_XSUB(j)  (1280 + 64 * (j))
#define XB_XGEN(j)  (2304 + 64 * (j))
#define XB_TOP      3328
#define XB_TOPGEN   3392
#define XCD_BAR_WORDS 3456
#define XB_SPIN_CAP (1u << 18)

__device__ __forceinline__ unsigned xb_ld(unsigned* p)              { return __hip_atomic_load(p, __ATOMIC_RELAXED, __HIP_MEMORY_SCOPE_AGENT); }
__device__ __forceinline__ unsigned xb_add(unsigned* p, unsigned v) { return __hip_atomic_fetch_add(p, v, __ATOMIC_RELAXED, __HIP_MEMORY_SCOPE_AGENT); }
__device__ __forceinline__ unsigned xb_xcc_id() { return (unsigned)__builtin_amdgcn_s_getreg((3 << 11) | 20) & 0xFu; }
#define XB_SPIN(cond, bar) do { unsigned _sp = 0; while (cond) { __builtin_amdgcn_s_sleep(1); \
    if ((++_sp & 255u) == 0u) { if (xb_ld(&(bar)[XB_TMO])) break; if (_sp > XB_SPIN_CAP) { atomicAdd(&(bar)[XB_TMO], 1u); break; } } } } while (0)

struct XcdBarrier {
    unsigned* bar; unsigned x;
    volatile LAS unsigned* st;
};

__device__ __forceinline__ XcdBarrier xcd_barrier_post(unsigned* bar, volatile LAS unsigned* st) {
    XcdBarrier b; b.bar = bar; b.x = xb_xcc_id(); b.st = st;
    if (threadIdx.x == 0) (void)xb_add(&bar[XB_XCNT(b.x)], 1u);
    return b;
}
__device__ __forceinline__ void xcd_barrier_complete(unsigned* bar, unsigned x, unsigned& nloc, unsigned& nx) {
    const unsigned G = gridDim.x * gridDim.y * gridDim.z;
    unsigned sum, cnt, mine, sp = 0u;
    for (;;) {
        sum = 0u; cnt = 0u; mine = 0u;
#pragma unroll
        for (unsigned j = 0; j < 16; ++j) { const unsigned c = xb_ld(&bar[XB_XCNT(j)]); sum += c; cnt += (c > 0u) ? 1u : 0u; mine = (j == x) ? c : mine; }
        if (sum == G) break;
        __builtin_amdgcn_s_sleep(1);
        if ((++sp & 255u) == 0u) { if (xb_ld(&bar[XB_TMO])) break; if (sp > XB_SPIN_CAP) { atomicAdd(&bar[XB_TMO], 1u); break; } }
    }
    nloc = mine > 0u ? mine : 1u; nx = cnt > 0u ? cnt : 1u;
}

__device__ __forceinline__ void xcd_barrier(const XcdBarrier& b) {
    asm volatile("s_waitcnt vmcnt(0)" ::: "memory");
    __syncthreads();
    if (threadIdx.x == 0) {
        unsigned* bar = b.bar;
        __builtin_amdgcn_s_waitcnt(0);
        unsigned nloc = b.st[0], nx = b.st[1];
        if (nloc == 0u) { xcd_barrier_complete(bar, b.x, nloc, nx); b.st[0] = nloc; b.st[1] = nx; }
        const unsigned old = xb_add(&bar[XB_XSUB(b.x)], 1u);
        const unsigned gen = old / nloc;
        if (old + 1u == (gen + 1u) * nloc) {
            __builtin_amdgcn_fence(__ATOMIC_RELEASE, "agent");
            asm volatile("s_waitcnt vmcnt(0)" ::: "memory");
            const unsigned og = xb_add(&bar[XB_TOP], 1u);
            const unsigned tg = og / nx;
            if (og + 1u == (tg + 1u) * nx) xb_add(&bar[XB_TOPGEN], 1u);
            else XB_SPIN(xb_ld(&bar[XB_TOPGEN]) == tg, bar);
            __builtin_amdgcn_fence(__ATOMIC_ACQUIRE, "agent");
            xb_add(&bar[XB_XGEN(b.x)], 1u);
            asm volatile("s_waitcnt vmcnt(0)" ::: "memory");
        } else {
            XB_SPIN(xb_ld(&bar[XB_XGEN(b.x)]) == gen, bar);
            __builtin_amdgcn_fence(__ATOMIC_ACQUIRE, "agent");
            asm volatile("s_waitcnt vmcnt(0)" ::: "memory");
        }
    }
    __syncthreads();
}

constexpr int NWAVES = 8;
constexpr int NB = 8, SEQ = 8192, D = 1024, NTOK = NB * SEQ, NE = 32, PLE = 256, NH = 16;
constexpr int MAXT = 1056;
constexpr int NCHUNK = NTOK / 256;
constexpr float LOG2E = 1.4426950408889634f;
constexpr float WSCALE8 = 1.0f / pg8::W8INV;
#ifndef MK_PER_PHASE
#define MK_PER_PHASE 0
#endif
constexpr int N_PHASES = 21;
#ifndef STAG_GU
#define STAG_GU 0
#endif
#ifndef STAG_DOWN
#define STAG_DOWN 0
#endif
#ifndef STAG_QKV
#define STAG_QKV 0
#endif
#ifndef STAG_PLE
#define STAG_PLE 0
#endif
#ifndef STAG_PJ
#define STAG_PJ 0
#endif
#ifndef STAG_WO
#define STAG_WO 0
#endif
#ifndef STAG_POOL
#define STAG_POOL 0
#endif

constexpr size_t MiB = 1u << 20;
constexpr size_t WS_CTL = 0, CTL_ZERO_BYTES = 1 * MiB;
constexpr size_t WS_META = 4 * MiB;
constexpr size_t WS_LOGITS = 5 * MiB;
constexpr size_t WS_TOKE = 13 * MiB;
constexpr size_t WS_TOKG = 14 * MiB;
constexpr size_t WS_TOKPOS = 15 * MiB;
constexpr size_t WS_SLOTG = 16 * MiB;
constexpr size_t WS_SLOTR = 18 * MiB;
constexpr size_t WS_LF = 20 * MiB;
constexpr size_t WS_BIAS = 24 * MiB;
constexpr size_t WS_TS = WS_META + 128 * 1024;
constexpr size_t WS_BGU16 = WS_META + 512 * 1024, WS_BD16 = WS_META + 768 * 1024;
constexpr size_t WS_NRM = WS_META + 256 * 1024;
constexpr size_t WS_WPOOL = 28 * MiB, WS_WROUTER = 29 * MiB, WS_WO = 30 * MiB, WS_WQKV = 32 * MiB, WS_WPG = 39 * MiB, WS_WPP = 43 * MiB, WS_WD = 44 * MiB, WS_WGU = 172 * MiB;
constexpr size_t WS_PB = 428 * MiB;
constexpr size_t WS_XA = 492 * MiB, WS_XB = 620 * MiB;
constexpr size_t WS_XA8 = 1276 * MiB + 384 * MiB;
constexpr size_t WS_XB8 = 1276 * MiB + 128 * MiB;
constexpr size_t WS_XT8 = 1276 * MiB + 448 * MiB;
constexpr size_t WS_XT = 1276 * MiB + 256 * MiB;
constexpr size_t WS_HS = 748 * MiB;
constexpr size_t WS_ACT = 1276 * MiB;
constexpr size_t WS_SS = 1804 * MiB;
constexpr size_t WS_SLOTT = 1828 * MiB;
constexpr size_t WS_DUMMY = 1830 * MiB;
constexpr size_t WS_END = 1832 * MiB;
constexpr size_t SSA = (size_t)NTOK * 16;
static_assert(WS_HS + (size_t)MAXT * 256 * D * 2 <= WS_ACT && WS_ACT + (size_t)MAXT * 256 * D * 2 <= WS_SS && WS_SS + 6 * SSA * 4 <= WS_SLOTT && WS_SLOTT + (size_t)MAXT * 256 * 4 <= WS_DUMMY, "d_ws map");
static_assert(WS_WGU + (size_t)2 * 32 * 2048 * 1024 * 2 <= WS_PB && WS_WD + (size_t)2 * 32 * 1024 * 1024 * 2 <= WS_WGU && WS_WQKV + (size_t)3328 * 1024 * 2 <= WS_WPG, "d_ws map (weights)");
constexpr int CW_TMO = 0, CW_BAR = 4096, CW_NRM = 8192;

constexpr int RING_OFF = 0, RING_BYTES = 131072;
constexpr int EPI_OFF = RING_BYTES, LDSCTL_OFF = EPI_OFF + 8 * pg8::EPW, MISC_OFF = LDSCTL_OFF + 320, TP_OFF = LDSCTL_OFF + 1024;
constexpr int LDS_BYTES = LDSCTL_OFF + 4096;
static_assert(attn_body::ATTN_LDS_BYTES <= RING_BYTES, "attention LDS");

__device__ __forceinline__ float wave_sum(float v) {
#pragma unroll
    for (int o = 1; o < 64; o <<= 1) v += __shfl_xor(v, o);
    return v;
}
__device__ __forceinline__ float dot4f(const f32x4& a) { return (a[0] * a[0] + a[1] * a[1]) + (a[2] * a[2] + a[3] * a[3]); }
__device__ __forceinline__ float rstd_tok(const float* ssp, size_t t) { float v[16];
#pragma unroll
    for (int k = 0; k < 16; ++k) v[k] = ssp[(size_t)k * NTOK + t];
    return pg8::rstd_of(pg8::sum16(v)); }
__device__ __forceinline__ float bflo(unsigned w) { return __builtin_bit_cast(float, w << 16); }
__device__ __forceinline__ float bfhi(unsigned w) { return __builtin_bit_cast(float, w & 0xffff0000u); }

__device__ __forceinline__ void conv_item(const float* W, int ldw, int k0, int n0, int nvalid, bf16* WT, int ldk, int drow0, const float* gain, LAS float* scr, int lane) {
    const bool ok = (lane & 31) < nvalid;
#pragma unroll 8
    for (int i = 0; i < 32; ++i) { const int kk = 2 * i + (lane >> 5); scr[kk * 33 + (lane & 31)] = ok ? W[(size_t)(k0 + kk) * ldw + n0 + (lane & 31)] : 0.f; }
    LDS_WAIT(); asm volatile("" ::: "memory");
    const int c = lane & 7;
    float gv[8];
#pragma unroll
    for (int i = 0; i < 8; ++i) gv[i] = gain ? gain[k0 + 8 * c + i] : 1.f;
#pragma unroll
    for (int j = 0; j < 4; ++j) { const int n = (lane >> 3) + 8 * j; const LAS float* s = scr + (8 * c) * 33 + n;
        v4u o; o.x = pk2(s[0 * 33] * gv[0], s[1 * 33] * gv[1]); o.y = pk2(s[2 * 33] * gv[2], s[3 * 33] * gv[3]); o.z = pk2(s[4 * 33] * gv[4], s[5 * 33] * gv[5]); o.w = pk2(s[6 * 33] * gv[6], s[7 * 33] * gv[7]);
        *(GAS v4u*)(WT + (size_t)(drow0 + n) * ldk + k0 + 8 * c) = o; }
    LDS_WAIT(); asm volatile("" ::: "memory");
}

__device__ __forceinline__ void conv_item8(const float* W, int ldw, int k0, int n0, unsigned char* WT, int ldk, int drow0, const float* gain, float wscale, LAS float* scr, int lane, int nvalid = 32) {
    { const int c8 = lane & 7, r8 = lane >> 3; const bool ok = 4 * c8 < nvalid; f32x4 wv[8];
      const float* wp = W + (size_t)(k0 + r8) * ldw + n0 + 4 * c8;
#pragma unroll
      for (int i = 0; i < 8; ++i) wv[i] = ok ? *(const f32x4*)(wp + (size_t)(8 * i) * ldw) : (f32x4){0.f, 0.f, 0.f, 0.f};
#pragma unroll
      for (int i = 0; i < 8; ++i)
#pragma unroll
          for (int j = 0; j < 4; ++j) scr[(r8 + 8 * i) * 33 + 4 * c8 + j] = wv[i][j]; }
    LDS_WAIT(); asm volatile("" ::: "memory");
    const int c = lane & 3, nn = lane >> 2;
    float gv[16];
#pragma unroll
    for (int i = 0; i < 16; ++i) gv[i] = (gain ? gain[k0 + 16 * c + i] : 1.f) * wscale;
#pragma unroll
    for (int j = 0; j < 2; ++j) { const int n = nn + 16 * j; const LAS float* s = scr + (16 * c) * 33 + n; pg8::u32x4 o;
#pragma unroll
        for (int q = 0; q < 4; ++q) { unsigned w0 = 0u;
            w0 = __builtin_amdgcn_cvt_pk_fp8_f32(s[(4 * q) * 33] * gv[4 * q], s[(4 * q + 1) * 33] * gv[4 * q + 1], w0, false); w0 = __builtin_amdgcn_cvt_pk_fp8_f32(s[(4 * q + 2) * 33] * gv[4 * q + 2], s[(4 * q + 3) * 33] * gv[4 * q + 3], w0, true); o[q] = w0; }
        *(pg8::u32x4*)(WT + (size_t)(drow0 + n) * ldk + k0 + 16 * c) = o; }
    LDS_WAIT(); asm volatile("" ::: "memory");
}

__device__ __forceinline__ void rstd8(const f32x4 (&xs)[8], LAS float* part  , int hw, int lane, float (&rs)[8]) {
    float p[8];
#pragma unroll
    for (int j = 0; j < 8; ++j) p[j] = wave_sum(dot4f(xs[j]));
    if (lane == 0) {
#pragma unroll
        for (int j = 0; j < 8; ++j) part[j * 4 + hw] = p[j]; }
    __syncthreads();
#pragma unroll
    for (int j = 0; j < 8; ++j) { const f32x4 q = *(const LAS f32x4*)(part + j * 4); rs[j] = pg8::rstd_of((q[0] + q[1]) + (q[2] + q[3])); }
}
template <int W> __device__ __forceinline__ void pool_run(const float* x, int t0, int c4, bool has_prev, int pos0, f32x4 g, bf16* diff, LAS float* part2  , int& buf, int hw, int lane) {
    f32x4 hh[16]; f32x4 xs[8], xn[8]; float rs[8];
#pragma unroll
    for (int hc = 0; hc < 2; ++hc) {
#pragma unroll
        for (int j = 0; j < 8; ++j) xs[j] = has_prev ? *(const f32x4*)(x + (size_t)(t0 - 16 + hc * 8 + j) * D + c4) : (f32x4){0.f, 0.f, 0.f, 0.f};
        rstd8(xs, part2 + buf * 32, hw, lane, rs); buf ^= 1;
#pragma unroll
        for (int j = 0; j < 8; ++j) hh[hc * 8 + j] = xs[j] * rs[j] * g;
    }
    f32x4 S = (f32x4){0.f, 0.f, 0.f, 0.f};
#pragma unroll
    for (int i = 16 - W; i < 16; ++i) S += hh[i];
#pragma unroll
    for (int j = 0; j < 8; ++j) xn[j] = *(const f32x4*)(x + (size_t)(t0 + j) * D + c4);
#pragma unroll 1
    for (int cb = 0; cb < 8; ++cb) {
        f32x4 hn[8];
#pragma unroll
        for (int j = 0; j < 8; ++j) xs[j] = xn[j];
        if (cb < 7) {
#pragma unroll
            for (int j = 0; j < 8; ++j) xn[j] = *(const f32x4*)(x + (size_t)(t0 + (cb + 1) * 8 + j) * D + c4); }
        rstd8(xs, part2 + buf * 32, hw, lane, rs); buf ^= 1;
#pragma unroll
        for (int j = 0; j < 8; ++j) {
            hn[j] = xs[j] * rs[j] * g;
            const f32x4 old = (j - W >= 0) ? hn[(j - W >= 0) ? j - W : 0] : hh[(16 + j - W) & 15];
            S = S + hn[j] - old;
            const int pos = pos0 + cb * 8 + j; const int cnt = (pos + 1 < W) ? pos + 1 : W; const float inv = 1.0f / (float)cnt;
            const f32x4 dv = S * inv - hn[j];
            unsigned long long o = (unsigned long long)pk2(dv[0], dv[1]) | ((unsigned long long)pk2(dv[2], dv[3]) << 32);
            *(GAS unsigned long long*)(diff + (size_t)(t0 + cb * 8 + j) * D + c4) = o;
        }
#pragma unroll
        for (int i = 0; i < 8; ++i) hh[i] = hh[i + 8];
#pragma unroll
        for (int i = 0; i < 8; ++i) hh[8 + i] = hn[i];
    }
}

struct Args { const float* in[24]; float* out; unsigned char* ws; int ph_lo, ph_hi; };
enum { I_X = 0, I_P, I_NMIX, I_NFFN, I_NPLE, I_NFIN, I_POOLW, I_POOLS, I_KVN, I_WK, I_WV, I_WF, I_BF, I_WQ, I_WO, I_RW, I_RB, I_WGU, I_BGU, I_WD, I_BD, I_PWG, I_PBG, I_PWP };
#define WSP(T, off) ((T*)(args.ws + (off)))
#ifdef ONLY
#define PHON(n) ((n) == ONLY)
#else
#define PHON(n) true
#endif
#define IN(k) (lo <= (k) && (k) < hi)
#define NREP(bit) ((((PROBE_MASK) >> (bit)) & 1) ? 2 : 1)
#define SEAM(k) do { if (IN(k) && IN((k) + 1)) xcd_barrier(bar); } while (0)
#define FRESH_IDS() int tid = threadIdx.x; asm volatile("" : "+v"(tid)); const int lane = tid & 63, wave = __builtin_amdgcn_readfirstlane(tid >> 6); (void)lane; (void)wave; \
    const int G = gridDim.x, bx = blockIdx.x; const int vcu = (G % 8 == 0) ? (bx % 8) * (G / 8) + bx / 8 : bx; const int gw = vcu * NWAVES + wave, NGW = G * NWAVES; (void)gw; (void)NGW; (void)vcu

__device__ __forceinline__ void phase_prologue(const Args& args, LAS unsigned char* lds) {
    FRESH_IDS();
    const float* norm_ffn = args.in[I_NFFN];
    unsigned char* Wqkv8 = WSP(unsigned char, WS_WQKV); bf16* Wrouter = WSP(bf16, WS_WROUTER);
    LAS float* scr = (LAS float*)(lds + RING_OFF + wave * 16384);
    constexpr int I_GU = 2 * 32 * 1024, I_D = 2 * 32 * 512, I_PG = 2 * 512, I_PP = 2 * 128, I_SQ = 512, I_F = 16, I_POOL = 128, I_R = 32;
    constexpr int NITEMS = I_GU + I_D + I_PG + I_PP + 4 * I_SQ + I_F + I_POOL + I_R;
    for (int it = gw; it < NITEMS; it += NGW) {
        int r = it;
        if (r < I_GU) { const int le = r >> 10, q = r & 1023, kb = q >> 6, nb = q & 63, n0 = nb * 32;
            const int drow0 = 256 * ((n0 & 1023) >> 7) + 64 * ((n0 & 127) >> 5) + 32 * (n0 >> 10);
            conv_item8(args.in[I_WGU] + (size_t)le * 1024 * 2048, 2048, kb * 64, n0, WSP(unsigned char, WS_WGU) + (size_t)le * 2048 * 1024, 1024, drow0, norm_ffn + (le >> 5) * 1024, (n0 < 1024) ? WSCALE8 * pg8::SW_A2 : WSCALE8, scr, lane); continue; } r -= I_GU;
        if (r < I_D) { const int le = r >> 9, q = r & 511, kb = q >> 5, nb = q & 31;
            conv_item8(args.in[I_WD] + (size_t)le * 1024 * 1024, 1024, kb * 64, nb * 32, WSP(unsigned char, WS_WD) + (size_t)le * 1024 * 1024, 1024, nb * 32, nullptr, WSCALE8, scr, lane); continue; } r -= I_D;
        if (r < I_PG) { const int l = r >> 9, q = r & 511, kb = q >> 5, nb = q & 31;
            conv_item8(args.in[I_PWG] + (size_t)l * 1024 * 1024, 1024, kb * 64, nb * 32, WSP(unsigned char, WS_WPG) + (size_t)l * 1024 * 1024, 1024, nb * 32, args.in[I_NPLE] + l * 1024, WSCALE8, scr, lane); continue; } r -= I_PG;
        if (r < I_PP) { const int l = r >> 7, q = r & 127, kb = q >> 5, nb = q & 31;
            conv_item(args.in[I_PWP] + (size_t)l * 256 * 1024, 1024, kb * 64, nb * 32, 32, WSP(bf16, WS_WPP) + (size_t)l * 1024 * 256, 256, nb * 32, nullptr, scr, lane); continue; } r -= I_PP;
        if (r < 4 * I_SQ) { const int w = r >> 9, q = r & 511, kb = q >> 5, nb = q & 31;
            const float* src = args.in[w == 0 ? I_WQ : (w == 1 ? I_WK : (w == 2 ? I_WV : I_WO))]; const float* gn = w == 0 ? args.in[I_NMIX] + 1024 : args.in[I_KVN];
            if (w == 3) conv_item8(src, 1024, kb * 64, nb * 32, WSP(unsigned char, WS_WO), 1024, nb * 32, nullptr, WSCALE8, scr, lane);
            else conv_item8(src, 1024, kb * 64, nb * 32, Wqkv8 + (size_t)w * 1024 * 1024, 1024, nb * 32, gn, WSCALE8, scr, lane);
            continue; } r -= 4 * I_SQ;
        if (r < I_F) { conv_item8(args.in[I_WF], 16, r * 64, 0, Wqkv8 + (size_t)3072 * 1024, 1024, 0, args.in[I_KVN], WSCALE8, scr, lane, 16); continue; } r -= I_F;
        if (r < I_POOL) { const int g = r >> 5, q = r & 31, kb = q >> 3, nb = q & 7;
            conv_item(args.in[I_POOLW] + (size_t)g * 256 * 256, 256, kb * 64, nb * 32, 32, WSP(bf16, WS_WPOOL) + (size_t)g * 256 * 256, 256, nb * 32, nullptr, scr, lane); continue; } r -= I_POOL;
        { const int l = r >> 4, kb = r & 15;
            conv_item(args.in[I_RW] + (size_t)l * 1024 * 32, 32, kb * 64, 0, 32, Wrouter + (size_t)l * 256 * 1024, 1024, 0, norm_ffn + l * 1024, scr, lane); }
    }
    {
        const int gt = vcu * NWAVES * 64 + tid, NGT = G * NWAVES * 64; const v4u z = (v4u){0u, 0u, 0u, 0u};
        for (int i = gt; i < 2 * 224 * 128; i += NGT) { const int l = i / (224 * 128), q = i % (224 * 128); *(GAS v4u*)(Wrouter + (size_t)l * 256 * 1024 + (size_t)32 * 1024 + (size_t)q * 8) = z; }
        for (int i = gt; i < 224 * 64; i += NGT) *(GAS v4u*)(Wqkv8 + (size_t)3104 * 1024 + (size_t)i * 16) = z;
        { const float* bgu = args.in[I_BGU]; const float* bd = args.in[I_BD]; bf16* o1 = WSP(bf16, WS_BGU16); bf16* o2 = WSP(bf16, WS_BD16);
          for (int i = gt; i < 2 * 32 * 2048 / 2; i += NGT) { const bool gate = ((2 * i) & 2047) < 1024; ((GAS unsigned*)o1)[i] = gate ? pk2(bgu[2 * i] * pg8::SW_A2, bgu[2 * i + 1] * pg8::SW_A2) : pk2(bgu[2 * i] + 1.0f, bgu[2 * i + 1] + 1.0f); }
          for (int i = gt; i < 2 * 32 * 1024 / 2; i += NGT) ((GAS unsigned*)o2)[i] = pk2(bd[2 * i], bd[2 * i + 1]); }
        const float* p_in = args.in[I_P]; bf16* PB = WSP(bf16, WS_PB);
        for (size_t i = gt; i < (size_t)2 * NTOK * PLE / 8; i += NGT) { const f32x4 a = *(const f32x4*)(p_in + i * 8), b = *(const f32x4*)(p_in + i * 8 + 4);
            v4u o; o.x = pk2(a[0], a[1]); o.y = pk2(a[2], a[3]); o.z = pk2(b[0], b[1]); o.w = pk2(b[2], b[3]); *(GAS v4u*)(PB + i * 8) = o; }
    }
    __syncthreads();
    {
        const float* x_in = args.in[I_X]; bf16* DIFF = WSP(bf16, WS_ACT);
        const int half = tid >> 8, ht = tid & 255, hw = wave & 3, c4 = ht * 4;
        LAS float* part2 = (LAS float*)(lds + RING_OFF) + half * 64;
        const f32x4 g = *(const f32x4*)(args.in[I_NMIX] + c4);
        const int grp = __builtin_amdgcn_readfirstlane(ht >> 6);
        int buf = 0;
        for (int it = bx; it < NTOK / 128; it += G) {
            const int t0 = (it * 2 + half) * 64, pos0 = t0 & (SEQ - 1); const bool has_prev = pos0 != 0;
            if (grp == 0) pool_run<2>(x_in, t0, c4, has_prev, pos0, g, DIFF, part2, buf, hw, lane);
            else if (grp == 1) pool_run<4>(x_in, t0, c4, has_prev, pos0, g, DIFF, part2, buf, hw, lane);
            else if (grp == 2) pool_run<8>(x_in, t0, c4, has_prev, pos0, g, DIFF, part2, buf, hw, lane);
            else pool_run<16>(x_in, t0, c4, has_prev, pos0, g, DIFF, part2, buf, hw, lane);
        }
        __syncthreads();
    }
}

template <int LAYER> __device__ __forceinline__ void ple_phase(const Args& args, LAS unsigned char* lds) {
    constexpr int SSM = LAYER == 0 ? 0 : 3; constexpr size_t XT_OFF = WS_XT, XN_OFF = WS_XB;
        { FRESH_IDS();
          pg8::Gemm g{WSP(bf16, WS_PB) + (size_t)LAYER * NTOK * PLE, WSP(bf16, WS_WPP) + (size_t)LAYER * 1024 * 256, PLE, PLE, PLE, STAG_PJ}; pg8::DenseOrder S; S.init(NTOK / 256, 4, G, bx, PLE, PLE, 0);
          pg8::EpiStore E{WSP(unsigned char, WS_ACT)};
          pg8::gemm_phase<pg8::EpiStore, pg8::DenseOrder>(lds + RING_OFF, lds + EPI_OFF, g, S, E); }
        VM_WAIT(); __syncthreads();
        { FRESH_IDS();
          pg8::Gemm g{(const pg8::bf16_t*)WSP(unsigned char, WS_XT8), (const pg8::bf16_t*)(WSP(unsigned char, WS_WPG) + (size_t)LAYER * 1024 * 1024), D, D, D, STAG_PLE, nullptr, WSP(unsigned char, WS_DUMMY)}; pg8::DenseOrder S; S.init(NTOK / 256, 4, G, bx, D, D, 0, 1);
          pg8::EpiPle E{args.in[I_PBG] + LAYER * 1024, WSP(unsigned char, WS_ACT), WSP(bf16, XT_OFF), WSP(bf16, XN_OFF), WSP(float, WS_SS) + (size_t)(SSM + 2) * SSA, LAYER == 0 ? WSP(unsigned char, WS_XB8) : (unsigned char*)nullptr};
          pg8::gemm_phase<pg8::EpiPle, pg8::DenseOrder, false, 1>(lds + RING_OFF, lds + EPI_OFF, g, S, E); }
}

template <int LAYER> __device__ __forceinline__ void moe_ple_block(const Args& args, LAS unsigned char* lds, const XcdBarrier& bar, const int lo, const int hi) {
    constexpr int PBASE = LAYER == 0 ? 2 : 13, SSM = LAYER == 0 ? 0 : 3;
    constexpr size_t XC_OFF = WS_XA, XT_OFF = WS_XT, XN_OFF = WS_XB;
    if (IN(PBASE) && PHON(2)) for (int rep_ = 0; rep_ < NREP(2); ++rep_) {
        FRESH_IDS();
        pg8::Gemm g{WSP(bf16, XC_OFF), WSP(bf16, WS_WROUTER) + (size_t)LAYER * 256 * 1024, D, D, D, 0}; pg8::DenseOrder S; S.init(NTOK / 256, 1, G, bx, D, D, 0);
        pg8::EpiRouter E{WSP(float, WS_SS) + (size_t)SSM * SSA, args.in[I_RB] + LAYER * 32, WSP(float, WS_LOGITS)};
        pg8::gemm_phase<pg8::EpiRouter, pg8::DenseOrder>(lds + RING_OFF, lds + EPI_OFF, g, S, E);
        VM_WAIT(); __syncthreads(); __builtin_amdgcn_fence(__ATOMIC_ACQUIRE, "agent"); VM_WAIT(); __syncthreads();
        const float* LOGITS = WSP(float, WS_LOGITS); unsigned* TOKE = WSP(unsigned, WS_TOKE); float* TOKG = WSP(float, WS_TOKG); int* CH = WSP(int, WS_META);
        LAS int* hist = (LAS int*)(lds + RING_OFF);
        pg8::Unit uu;
        for (int ui = 0; S.next(ui, uu); ++ui) { const int ch = uu.pm;
            if (tid < 32) hist[tid] = 0;
            __syncthreads();
            if (tid < 256) {
                const int t = ch * 256 + tid; float v[32];
#pragma unroll
                for (int j = 0; j < 8; ++j) { const f32x4 q = *(const f32x4*)(LOGITS + (size_t)t * 32 + 4 * j); v[4 * j] = q[0]; v[4 * j + 1] = q[1]; v[4 * j + 2] = q[2]; v[4 * j + 3] = q[3]; }
                float sv[4]; int si[4]; float pv = INFINITY; int pi = -1;
#pragma unroll
                for (int k = 0; k < 4; ++k) { float bv = -INFINITY; int bi = 0;
#pragma unroll
                    for (int i = 0; i < 32; ++i) { const bool after = (v[i] < pv) || (v[i] == pv && i > pi); if (after && v[i] > bv) { bv = v[i]; bi = i; } }
                    sv[k] = bv; si[k] = bi; pv = bv; pi = bi; }
                const float e1 = __expf(sv[1] - sv[0]), e2 = __expf(sv[2] - sv[0]), e3 = __expf(sv[3] - sv[0]); const float inv = 1.0f / (1.0f + e1 + e2 + e3);
                TOKE[t] = (unsigned)si[0] | ((unsigned)si[1] << 8) | ((unsigned)si[2] << 16) | ((unsigned)si[3] << 24);
                *(f32x4*)(TOKG + (size_t)t * 4) = (f32x4){inv, e1 * inv, e2 * inv, e3 * inv};
#pragma unroll
                for (int k = 0; k < 4; ++k) atomicAdd((int*)(hist + si[k]), 1);
            }
            __syncthreads();
            if (tid < 32) CH[ch * 32 + tid] = hist[tid];
            __syncthreads();
        }
    }
    if (IN(PBASE) && IN(PBASE + 2)) xcd_barrier(bar);
    if (IN(PBASE + 2) && PHON(4)) for (int rep_ = 0; rep_ < NREP(4); ++rep_) {
        FRESH_IDS();
        const int* CH = WSP(int, WS_META); int* TPg = WSP(int, WS_META + 65536); const unsigned* TOKE = WSP(unsigned, WS_TOKE); const float* TOKG = WSP(float, WS_TOKG); int* TOKPOS = WSP(int, WS_TOKPOS);
        float* SLOTG = WSP(float, WS_SLOTG); const float* ss_mix = WSP(float, WS_SS) + (size_t)SSM * SSA; int* SLOTT = WSP(int, WS_SLOTT); float* SLOTR = WSP(float, WS_SLOTR);
        LAS int* ptot = (LAS int*)(lds + RING_OFF); LAS int* pbef = ptot + 256; LAS int* ntile = pbef + 256; LAS int* befl = ntile + 32; LAS int* tpl = befl + 32; LAS int* lcur = tpl + 64; LAS int* lpos = lcur + 32;
        for (int ch = bx; ch < NCHUNK; ch += G) {
            if (tid < 256) { const int e = tid & 31, part = tid >> 5; int tot = 0, bef = 0;
                for (int c2 = part * 32; c2 < part * 32 + 32; ++c2) { const int v = CH[c2 * 32 + e]; tot += v; bef += (c2 < ch) ? v : 0; }
                ptot[part * 32 + e] = tot; pbef[part * 32 + e] = bef; }
            __syncthreads();
            if (tid < 32) { int tot = 0, bef = 0;
#pragma unroll
                for (int q = 0; q < 8; ++q) { tot += ptot[q * 32 + tid]; bef += pbef[q * 32 + tid]; }
                ntile[tid] = (tot + 255) >> 8; befl[tid] = bef; }
            __syncthreads();
            if (tid == 0) { int a = 0; for (int e = 0; e < 32; ++e) { tpl[e] = a; a += ntile[e]; } tpl[32] = a; }
            __syncthreads();
            if (tid < 32) lcur[tid] = tpl[tid] * 256 + befl[tid];
            if (ch == 0 && tid < 33) TPg[tid] = tpl[tid];
            __syncthreads();
            LAS int* wcnt = lpos + 1024;
            unsigned ev = 0u; int rk[4] = {0, 0, 0, 0};
            if (tid < 256) { ev = TOKE[ch * 256 + tid];
                const int e0 = ev & 255, e1 = (ev >> 8) & 255, e2 = (ev >> 16) & 255, e3 = (ev >> 24) & 255;
                const unsigned mask = (1u << e0) | (1u << e1) | (1u << e2) | (1u << e3);
                const unsigned long long below = (1ull << lane) - 1ull;
#pragma unroll 1
                for (int e = 0; e < 32; ++e) { const unsigned long long bal = __ballot((mask >> e) & 1u); const int r = __popcll(bal & below);
                    if (e0 == e) rk[0] = r; if (e1 == e) rk[1] = r; if (e2 == e) rk[2] = r; if (e3 == e) rk[3] = r;
                    if (lane == 0) wcnt[wave * 32 + e] = __popcll(bal); } }
            __syncthreads();
            if (tid < 256) { const int t = ch * 256 + tid; const f32x4 gv = *(const f32x4*)(TOKG + (size_t)t * 4); const float rst = rstd_tok(ss_mix, (size_t)t);
                int ps[4];
#pragma unroll
                for (int k = 0; k < 4; ++k) { const int e = (ev >> (8 * k)) & 255; int pos = lcur[e] + rk[k];
                    for (int w = 0; w < wave; ++w) pos += wcnt[w * 32 + e];
                    ps[k] = pos; SLOTG[pos] = gv[k]; SLOTT[pos] = t; SLOTR[pos] = rst; }
                *(GAS v4u*)(TOKPOS + (size_t)t * 4) = (v4u){(unsigned)ps[0], (unsigned)ps[1], (unsigned)ps[2], (unsigned)ps[3]}; }
            __syncthreads();
        }
    }
    SEAM(PBASE + 2);
    if (IN(PBASE + 3) && PHON(5)) for (int rep_ = 0; rep_ < NREP(5); ++rep_) {
        FRESH_IDS();
        LAS int* tpl = (LAS int*)(lds + TP_OFF);
        if (tid < 33) tpl[tid] = (int)__hip_atomic_load(WSP(gu32, WS_META + 65536) + tid, RLX_AGENT);
        __syncthreads();
        { LAS unsigned char* te = (LAS unsigned char*)(tpl + 64); const int nT = tpl[32];
          for (int j = tid; j < nT; j += NWAVES * 64) { int e = 0; for (int k = 1; k < 32; ++k) e += (tpl[k] <= j) ? 1 : 0; te[j] = (unsigned char)e; } }
        __syncthreads();
        pg8::Gemm g{(const pg8::bf16_t*)WSP(unsigned char, WS_XA8), (const pg8::bf16_t*)(WSP(unsigned char, WS_WGU) + (size_t)LAYER * 32 * 2048 * 1024), D, D, D, STAG_GU, WSP(int, WS_SLOTT), WSP(unsigned char, WS_DUMMY)}; pg8::GroupedOrder S; S.init(tpl, 8, G, bx, D, D, 2048, 1);
        pg8::EpiSwiGLU E{WSP(bf16, WS_BGU16) + (size_t)LAYER * 32 * 2048, WSP(unsigned char, WS_ACT), WSP(float, WS_SLOTR)};
        pg8::gemm_phase<pg8::EpiSwiGLU, pg8::GroupedOrder, true, 1>(lds + RING_OFF, lds + EPI_OFF, g, S, E);
    }
    SEAM(PBASE + 3);
    if (IN(PBASE + 4) && PHON(6)) for (int rep_ = 0; rep_ < NREP(6); ++rep_) {
        FRESH_IDS();
        LAS int* tpl = (LAS int*)(lds + TP_OFF);
        if (tid < 33) tpl[tid] = (int)__hip_atomic_load(WSP(gu32, WS_META + 65536) + tid, RLX_AGENT);
        __syncthreads();
        { LAS unsigned char* te = (LAS unsigned char*)(tpl + 64); const int nT = tpl[32];
          for (int j = tid; j < nT; j += NWAVES * 64) { int e = 0; for (int k = 1; k < 32; ++k) e += (tpl[k] <= j) ? 1 : 0; te[j] = (unsigned char)e; } }
        __syncthreads();
        pg8::Gemm g{(const pg8::bf16_t*)WSP(unsigned char, WS_ACT), (const pg8::bf16_t*)(WSP(unsigned char, WS_WD) + (size_t)LAYER * 32 * 1024 * 1024), D, D, D, STAG_DOWN, nullptr, WSP(unsigned char, WS_DUMMY)}; pg8::GroupedOrder S; S.init(tpl, 4, G, bx, D, D, 1024, 1);
        pg8::EpiDown E{WSP(float, WS_SLOTG), WSP(bf16, WS_BD16) + (size_t)LAYER * 32 * 1024, WSP(unsigned char, WS_HS)};
        pg8::gemm_phase<pg8::EpiDown, pg8::GroupedOrder, false, 1>(lds + RING_OFF, lds + EPI_OFF, g, S, E);
    }
    SEAM(PBASE + 4);
    if (IN(PBASE + 5) && PHON(7)) for (int rep_ = 0; rep_ < NREP(7); ++rep_) {
        FRESH_IDS();
        const int* TOKPOS = WSP(int, WS_TOKPOS); const bf16* Xc = WSP(bf16, XC_OFF); bf16* Xt = WSP(bf16, XT_OFF); const unsigned char* Y8 = WSP(unsigned char, WS_HS); unsigned char* Xt8 = WSP(unsigned char, WS_XT8); float* ss_moe = WSP(float, WS_SS) + (size_t)(SSM + 1) * SSA;
        for (int t = gw; t < NTOK; t += NGW) {
            const v4u ps = *(const GAS v4u*)(TOKPOS + (size_t)t * 4);
            const bf16* xr = Xc + (size_t)t * D + lane * 16; bf16* xo = Xt + (size_t)t * D + lane * 16; float sq = 0.f;
            const v4u xw0 = *(const GAS v4u*)(xr), xw1 = *(const GAS v4u*)(xr + 8);
            v4u yw[4];
#pragma unroll
            for (int k = 0; k < 4; ++k) { const unsigned pos = k == 0 ? ps.x : (k == 1 ? ps.y : (k == 2 ? ps.z : ps.w)); yw[k] = *(const GAS v4u*)(Y8 + (size_t)pos * D + lane * 16); }
            float a[16] = {bflo(xw0.x), bfhi(xw0.x), bflo(xw0.y), bfhi(xw0.y), bflo(xw0.z), bfhi(xw0.z), bflo(xw0.w), bfhi(xw0.w), bflo(xw1.x), bfhi(xw1.x), bflo(xw1.y), bfhi(xw1.y), bflo(xw1.z), bfhi(xw1.z), bflo(xw1.w), bfhi(xw1.w)};
#pragma unroll
            for (int k = 0; k < 4; ++k) {
#pragma unroll
                for (int w = 0; w < 4; ++w) { const unsigned wd = w == 0 ? yw[k].x : (w == 1 ? yw[k].y : (w == 2 ? yw[k].z : yw[k].w));
                    const pg8::f32x2 lo = __builtin_amdgcn_cvt_pk_f32_fp8((int)wd, false), hi = __builtin_amdgcn_cvt_pk_f32_fp8((int)wd, true);
                    a[4 * w] += lo.x * pg8::YSINV; a[4 * w + 1] += lo.y * pg8::YSINV; a[4 * w + 2] += hi.x * pg8::YSINV; a[4 * w + 3] += hi.y * pg8::YSINV; } }
#pragma unroll
            for (int j = 0; j < 16; ++j) sq += a[j] * a[j];
            { v4u o; o.x = pk2(a[0], a[1]); o.y = pk2(a[2], a[3]); o.z = pk2(a[4], a[5]); o.w = pk2(a[6], a[7]); *(GAS v4u*)(xo) = o;
              o.x = pk2(a[8], a[9]); o.y = pk2(a[10], a[11]); o.z = pk2(a[12], a[13]); o.w = pk2(a[14], a[15]); *(GAS v4u*)(xo + 8) = o; }
            sq = wave_sum(sq);
            { const float rs = pg8::rstd_of(sq);
              v4u o8;
#pragma unroll
              for (int w = 0; w < 4; ++w) { unsigned w0 = 0u; w0 = __builtin_amdgcn_cvt_pk_fp8_f32(a[4 * w] * rs, a[4 * w + 1] * rs, w0, false); w0 = __builtin_amdgcn_cvt_pk_fp8_f32(a[4 * w + 2] * rs, a[4 * w + 3] * rs, w0, true);
                if (w == 0) o8.x = w0; else if (w == 1) o8.y = w0; else if (w == 2) o8.z = w0; else o8.w = w0; }
              *(GAS v4u*)(Xt8 + (size_t)t * D + lane * 16) = o8; }
            (void)ss_moe;
        }
    }
    SEAM(PBASE + 5);
    if (IN(PBASE + 6) && PHON(8)) { if (NREP(8) == 2) ple_phase<LAYER>(args, lds); ple_phase<LAYER>(args, lds); }
    SEAM(PBASE + 6);
}

__global__ void __launch_bounds__(NWAVES * 64, 2) yoco_fwd(Args args) {
    extern __shared__ __attribute__((aligned(16))) unsigned char lds_raw[];
    LAS unsigned char* lds = (LAS unsigned char*)lds_raw;
    volatile LAS unsigned* MISC = (volatile LAS unsigned*)(lds + MISC_OFF);
    for (int u = threadIdx.x; u < (LDS_BYTES - LDSCTL_OFF) / 4; u += NWAVES * 64) ((LAS unsigned*)(lds + LDSCTL_OFF))[u] = 0u;
    __syncthreads();
    XcdBarrier bar; bar.bar = (unsigned*)(WSP(gu32, WS_CTL) + CW_BAR); bar.x = 0; bar.st = nullptr;
    if (!MK_PER_PHASE) bar = xcd_barrier_post((unsigned*)(WSP(gu32, WS_CTL) + CW_BAR), MISC + 8);
#if MK_PER_PHASE
    const int lo = args.ph_lo, hi = args.ph_hi;
#else
    constexpr int lo = 0, hi = N_PHASES;
#endif

    if (IN(0) && PHON(0)) for (int rep_ = 0; rep_ < NREP(0); ++rep_) phase_prologue(args, lds);
    SEAM(0);
    if (IN(1) && PHON(1)) for (int rep_ = 0; rep_ < NREP(1); ++rep_) {
        FRESH_IDS();
        pg8::Gemm g{WSP(bf16, WS_ACT), WSP(bf16, WS_WPOOL), D, 256, 256, STAG_POOL}; pg8::DenseOrder S; S.init(NTOK / 256, 4, G, bx, D, 256, 256);
        pg8::EpiPool E{args.in[I_X], args.in[I_POOLS], WSP(bf16, WS_XA), WSP(float, WS_SS), WSP(unsigned char, WS_XA8)};
        pg8::gemm_phase<pg8::EpiPool, pg8::DenseOrder>(lds + RING_OFF, lds + EPI_OFF, g, S, E);
    }
    SEAM(1);
    moe_ple_block<0>(args, lds, bar, lo, hi);
    if (IN(9) && PHON(9)) for (int rep_ = 0; rep_ < NREP(9); ++rep_) {
        FRESH_IDS();
        pg8::Gemm g{(const pg8::bf16_t*)WSP(unsigned char, WS_XB8), (const pg8::bf16_t*)WSP(unsigned char, WS_WQKV), D, D, D, STAG_QKV, nullptr, WSP(unsigned char, WS_DUMMY)}; pg8::DenseOrder S; S.init(NTOK / 256, 13, G, bx, D, D, 0, 1);
        pg8::EpiQkv E{WSP(float, WS_SS) + (size_t)2 * SSA, WSP(bf16, WS_HS), args.in[I_BF], WSP(float, WS_LF), attn_body::C2, WSP(float, WS_NRM)};
        pg8::gemm_phase<pg8::EpiQkv, pg8::DenseOrder, false, 1>(lds + RING_OFF, lds + EPI_OFF, g, S, E);
    }
    SEAM(9);
    if (IN(10) && PHON(10)) for (int rep_ = 0; rep_ < NREP(10); ++rep_) {
        FRESH_IDS();
        const float* LF = WSP(float, WS_LF); float* BIAS = WSP(float, WS_BIAS);
        LAS float* wtot = (LAS float*)(lds + RING_OFF);
        for (int item = bx; item < NB * NH; item += G) {
            const int b = item >> 4, h = item & 15; const int s0 = tid * 16; float v[16]; float run = 0.f;
#pragma unroll
            for (int j = 0; j < 16; ++j) { run += LF[(size_t)(b * SEQ + s0 + j) * 16 + h]; v[j] = run; }
            float incl = run;
#pragma unroll
            for (int o = 1; o < 64; o <<= 1) { const float n = __shfl_up(incl, o); if (lane >= o) incl += n; }
            if (lane == 63) wtot[wave] = incl;
            __syncthreads();
            float base = incl - run;
            for (int w = 0; w < wave; ++w) base += wtot[w];
            float* o = BIAS + (size_t)item * SEQ + s0; LAS float* lb = wtot + 64;
#pragma unroll
            for (int j = 0; j < 16; j += 4) { const f32x4 bv4 = (f32x4){-(base + v[j]) * LOG2E, -(base + v[j + 1]) * LOG2E, -(base + v[j + 2]) * LOG2E, -(base + v[j + 3]) * LOG2E}; *(f32x4*)(o + j) = bv4; *(LAS f32x4*)(lb + s0 + j) = bv4; }
            LAS float* LE = lb + SEQ; LAS float* wm = wtot + 16; LAS float* wsum = wtot + 32;
            float pm_ = -(base + v[15]) * LOG2E, ps_ = 0.f;
#pragma unroll
            for (int j = 0; j < 16; ++j) ps_ += exp2f(-(base + v[j]) * LOG2E - pm_);
#pragma unroll
            for (int o2 = 1; o2 < 64; o2 <<= 1) { const float m2 = __shfl_up(pm_, o2), s2 = __shfl_up(ps_, o2); if (lane >= o2) { const float M = fmaxf(pm_, m2); ps_ = ps_ * exp2f(pm_ - M) + s2 * exp2f(m2 - M); pm_ = M; } }
            if (lane == 63) { wm[wave] = pm_; wsum[wave] = ps_; }
            __syncthreads();
            for (int w = 0; w < wave; ++w) { const float m2 = wm[w], s2 = wsum[w]; const float M = fmaxf(pm_, m2); ps_ = ps_ * exp2f(pm_ - M) + s2 * exp2f(m2 - M); pm_ = M; }
            LE[tid] = pm_ + log2f(ps_);
            __syncthreads();
            if (tid < 32) {
                const float* nr = WSP(float, WS_NRM);
                const size_t e0 = (((size_t)(b * 32 + tid) * 16 + h) * 2) * 2;
                const float qn = sqrtf(fmaxf(nr[e0], nr[e0 + 1]) * 1.02f), kown = sqrtf(fmaxf(nr[e0 + 2], nr[e0 + 3]) * 1.02f);
                const int q0 = tid * 256, ntile = 4 * (tid + 1); const float bq = lb[q0]; int ts = 0; float kn2 = 0.f;
                float kp = fmaxf(nr[e0 + 2], nr[e0 + 3]) * 1.02f;
#pragma unroll
                for (int o = 1; o < 32; o <<= 1) { const float n = __shfl_up(kp, o); if (tid >= o) kp = fmaxf(kp, n); }
                LAS float* kpl = LE + 512; kpl[tid] = kp;
                for (int j = 0; j + 4 < ntile; ++j) {
                    if ((j & 3) == 0) kn2 = kpl[j >> 2];
                    const float bqk = qn * (sqrtf(kn2) + kown);
                    if (LE[4 * j + 3] + bqk - bq < -25.0f) ts = j + 1; else break; }
                const float kall = kp;
                const float bqs = qn * sqrtf(kall), dlt = lb[q0 + 255] - bq;
                const bool sok = (bqs <= 90.0f) && (bqs + dlt <= 100.0f) && (dlt >= 0.0f);
                WSP(int, WS_TS)[item * 32 + tid] = (ts & ~1) | (sok ? 0x10000 : 0);
            }
            __syncthreads();
        }
    }
    SEAM(10);
    if (IN(11) && PHON(11)) for (int rep_ = 0; rep_ < NREP(11); ++rep_) {
        const attn_body::AttnTensors AT{WSP(const attn_body::bf16, WS_HS), WSP(const attn_body::bf16, WS_HS) + (size_t)NTOK * D, WSP(const attn_body::bf16, WS_HS) + (size_t)2 * NTOK * D, WSP(attn_body::bf16, WS_ACT), WSP(const float, WS_BIAS), WSP(const int, WS_TS)};
        const attn_body::StaticOrder S((int)gridDim.x, (int)blockIdx.x);
#ifndef SKIP_ATTN
        attn_body::attn_phase<attn_body::StaticOrder>((char*)lds_raw + RING_OFF, AT, S);
#endif
    }
    SEAM(11);
    if (IN(12) && PHON(12)) for (int rep_ = 0; rep_ < NREP(12); ++rep_) {
        FRESH_IDS();
        pg8::Gemm g{(const pg8::bf16_t*)WSP(unsigned char, WS_ACT), (const pg8::bf16_t*)WSP(unsigned char, WS_WO), D, D, D, STAG_WO, nullptr, WSP(unsigned char, WS_DUMMY)}; pg8::DenseOrder S; S.init(NTOK / 256, 4, G, bx, D, D, 0, 1);
        pg8::EpiWo E{WSP(bf16, WS_XB), WSP(bf16, WS_XA), WSP(float, WS_SS) + (size_t)3 * SSA, WSP(unsigned char, WS_XA8)};
        pg8::gemm_phase<pg8::EpiWo, pg8::DenseOrder, false, 1>(lds + RING_OFF, lds + EPI_OFF, g, S, E);
    }
    SEAM(12);
    moe_ple_block<1>(args, lds, bar, lo, hi);
    if (IN(20) && PHON(20)) for (int rep_ = 0; rep_ < NREP(13); ++rep_) {
        FRESH_IDS();
        const float* ssf = WSP(float, WS_SS) + (size_t)5 * SSA; const bf16* XA = WSP(bf16, WS_XB); const float* norm_final = args.in[I_NFIN];
        for (int t = gw; t < NTOK; t += NGW) {
            const float rs = rstd_tok(ssf, (size_t)t); const bf16* xr = XA + (size_t)t * D; float* orow = args.out + (size_t)t * D;
#pragma unroll
            for (int hf = 0; hf < 2; ++hf) { const int c0 = hf * 512 + lane * 8; const v4u xw = *(const GAS v4u*)(xr + c0);
                const f32x4 g0 = *(const f32x4*)(norm_final + c0), g1 = *(const f32x4*)(norm_final + c0 + 4);
                *(f32x4*)(orow + c0) = (f32x4){bflo(xw.x) * rs * g0[0], bfhi(xw.x) * rs * g0[1], bflo(xw.y) * rs * g0[2], bfhi(xw.y) * rs * g0[3]};
                *(f32x4*)(orow + c0 + 4) = (f32x4){bflo(xw.z) * rs * g1[0], bfhi(xw.z) * rs * g1[1], bflo(xw.w) * rs * g1[2], bfhi(xw.w) * rs * g1[3]}; }
        }
    }
}
#undef IN
#undef SEAM

extern "C" void kernel_launch(void* const* d_in, const int* in_sizes, int n_in, void* d_out, int out_size, void* d_ws, size_t ws_size, hipStream_t stream) {
    static int grid = 0;
    if (grid == 0) {
        if (n_in != 24 || in_sizes[0] != NTOK * D || out_size != NTOK * D || ws_size < WS_END) { fprintf(stderr, "kernel_launch: unexpected shapes (n_in %d, in0 %d, out %d, ws %zu); nothing launched\n", n_in, n_in > 0 ? in_sizes[0] : -1, out_size, ws_size); grid = -1; return; }
        int dev = 0, cus = 0, per_cu = 0;
        if (hipGetDevice(&dev) != hipSuccess || hipDeviceGetAttribute(&cus, hipDeviceAttributeMultiprocessorCount, dev) != hipSuccess) { grid = -1; return; }
        if (hipFuncSetAttribute((const void*)yoco_fwd, hipFuncAttributeMaxDynamicSharedMemorySize, LDS_BYTES) != hipSuccess) { fprintf(stderr, "kernel_launch: hipFuncSetAttribute failed\n"); grid = -1; return; }
        if (hipOccupancyMaxActiveBlocksPerMultiprocessor(&per_cu, (const void*)yoco_fwd, NWAVES * 64, LDS_BYTES) != hipSuccess || per_cu < 1) { fprintf(stderr, "kernel_launch: occupancy query says %d blocks per CU\n", per_cu); }
        (void)hipGetLastError();
        grid = cus > 0 ? cus : 256;
    }
    if (grid < 0) return;
    if (hipMemsetAsync((char*)d_ws + WS_CTL, 0, CTL_ZERO_BYTES, stream) != hipSuccess) return;
    Args a{};
    for (int i = 0; i < 24; ++i) a.in[i] = (const float*)d_in[i];
    a.out = (float*)d_out; a.ws = (unsigned char*)d_ws;
#if MK_PER_PHASE
    for (int ph = 0; ph < N_PHASES; ++ph) { a.ph_lo = ph; a.ph_hi = ph + 1; hipLaunchKernelGGL(yoco_fwd, dim3(grid), dim3(NWAVES * 64), LDS_BYTES, stream, a); }
#else
    a.ph_lo = 0; a.ph_hi = N_PHASES; hipLaunchKernelGGL(yoco_fwd, dim3(grid), dim3(NWAVES * 64), LDS_BYTES, stream, a);
#endif
}
```

```cpp
#include <hip/hip_runtime.h>
#ifndef PROBE_MASK
#define PROBE_MASK 0
#endif
#include <cstdio>
#include <cstdint>
namespace pg8 {
#define PG8_LAS __attribute__((address_space(3)))
typedef unsigned short bf16_t;
typedef short bf16x8 __attribute__((ext_vector_type(8)));
typedef float f32x4 __attribute__((ext_vector_type(4)));
typedef unsigned u32x4 __attribute__((ext_vector_type(4)));
constexpr int BM = 256, BK = 64, HALF = 128, HTB = HALF * BK * 2  , STAGE_BYTES = 8 * HTB, NXCD = 8, WGM = 8;

__host__ __device__ __forceinline__ int lds_byte(int r, int c) { const int st = (r >> 4) * 2 + (c >> 5), rr = r & 15, cc = c & 31, ob = rr * 64 + cc * 2; return st * 1024 + (ob ^ (((ob >> 9) & 1) << 5)); }
__host__ __device__ __forceinline__ void stage_rc(int b, int& R, int& C) { const int st = b / 1024, sb = b % 1024, swz = sb ^ (((sb >> 9) & 1) << 5); R = (st >> 1) * 16 + swz / 64; C = (st & 1) * 32 + (swz % 64) / 2; }
__host__ __device__ __forceinline__ int perm32(int rho) { const int n = rho >> 4, i = rho & 15; return 8 * (i >> 2) + 4 * n + (i & 3); }

struct Unit { int pm, pn, e; };
struct Gemm { const bf16_t* A; const bf16_t* Bt; int lda, ldb, K, stag; const int* rowmap; void* dummy; };

struct DenseOrder {
    int nM, nN, nwg, G, c; size_t a_row, a_col, b_tile;
    __device__ __forceinline__ void init(int nM_, int nN_, int G_, int c_, int lda, int ldb, int a_col_elems, int esz = 2) { nM = nM_; nN = nN_; nwg = nM * nN; G = G_; c = c_; a_row = (size_t)BM * lda * esz; a_col = (size_t)a_col_elems * esz; b_tile = (size_t)BM * ldb * esz; }
    __device__ __forceinline__ bool next(int i, Unit& u) const {
        const long L = (long)i * G + c; if (L >= nwg) return false;
        int wgid = (int)L; { const int q = nwg / NXCD, r = nwg % NXCD, xcd = wgid % NXCD, off = wgid / NXCD; wgid = (xcd < r ? xcd * (q + 1) : r * (q + 1) + (xcd - r) * q) + off; }
        const int nig = WGM * nN, gid = wgid / nig, fm = gid * WGM, gsz = (nM - fm) < WGM ? (nM - fm) : WGM;
        u.pm = fm + ((wgid % nig) % gsz); u.pn = (wgid % nig) / gsz; u.e = 0; return true;
    }
    __device__ __forceinline__ size_t a_off(const Unit& u) const { return (size_t)u.pm * a_row + (size_t)u.pn * a_col; }
    __device__ __forceinline__ size_t b_off(const Unit& u) const { return (size_t)u.pn * b_tile; }
    __device__ __forceinline__ void a_ready(const Unit&) const {}
    __device__ __forceinline__ void done(const Unit&) const {}
};
struct GroupedOrder {
    int nM, nN, nwg, G, c; const PG8_LAS int* tp; const PG8_LAS unsigned char* te; size_t a_row, b_exp, b_tile;
    __device__ __forceinline__ void init(const PG8_LAS int* tp_, int nN_, int G_, int c_, int lda, int ldb, int n_w_rows, int esz) { tp = tp_; te = (const PG8_LAS unsigned char*)(tp_ + 64); nM = __builtin_amdgcn_readfirstlane(tp_[32]); nN = nN_; nwg = nM * nN; G = G_; c = c_; a_row = (size_t)BM * lda * esz; b_exp = (size_t)n_w_rows * ldb * esz; b_tile = (size_t)BM * ldb * esz; }
    __device__ __forceinline__ bool next(int i, Unit& u) const {
        const long L = (long)i * G + c; if (L >= nwg) return false;
        int wgid = (int)L; { const int q = nwg / NXCD, r = nwg % NXCD, xcd = wgid % NXCD, off = wgid / NXCD; wgid = (xcd < r ? xcd * (q + 1) : r * (q + 1) + (xcd - r) * q) + off; }
        const int nig = WGM * nN, gid = wgid / nig, fm = gid * WGM, gsz = (nM - fm) < WGM ? (nM - fm) : WGM;
        u.pm = fm + ((wgid % nig) % gsz); u.pn = (wgid % nig) / gsz;
        u.e = __builtin_amdgcn_readfirstlane((int)te[u.pm]); u.pm = __builtin_amdgcn_readfirstlane(u.pm); u.pn = __builtin_amdgcn_readfirstlane(u.pn); return true;
    }
    __device__ __forceinline__ size_t a_off(const Unit& u) const { return (size_t)u.pm * a_row; }
    __device__ __forceinline__ size_t b_off(const Unit& u) const { return (size_t)u.e * b_exp + (size_t)u.pn * b_tile; }
    __device__ __forceinline__ void a_ready(const Unit&) const {}
    __device__ __forceinline__ void done(const Unit&) const {}
};

__device__ __forceinline__ unsigned cvt_pk_bf16(float lo, float hi) { unsigned r; asm volatile("v_cvt_pk_bf16_f32 %0, %1, %2" : "=v"(r) : "v"(lo), "v"(hi)); return r; }
__device__ __forceinline__ float bf_lo(unsigned w) { return __builtin_bit_cast(float, w << 16); }
__device__ __forceinline__ float bf_hi(unsigned w) { return __builtin_bit_cast(float, w & 0xffff0000u); }
__device__ __forceinline__ float rstd_of(float ss) { return __builtin_amdgcn_rsqf(ss * (1.f / 1024.f) + 1e-6f); }
__device__ __forceinline__ u32x4 pack8(const f32x4& a, const f32x4& b) { u32x4 w; w.x = cvt_pk_bf16(a[0], a[1]); w.y = cvt_pk_bf16(a[2], a[3]); w.z = cvt_pk_bf16(b[0], b[1]); w.w = cvt_pk_bf16(b[2], b[3]); return w; }
__device__ __forceinline__ void unpack8(const u32x4& w, f32x4& a, f32x4& b) { a = (f32x4){bf_lo(w.x), bf_hi(w.x), bf_lo(w.y), bf_hi(w.y)}; b = (f32x4){bf_lo(w.z), bf_hi(w.z), bf_lo(w.w), bf_hi(w.w)}; }
__device__ __forceinline__ float dot4(const f32x4& a) { return (a[0] * a[0] + a[1] * a[1]) + (a[2] * a[2] + a[3] * a[3]); }
constexpr float W8INV = 1.0f / 16.0f;
typedef float f32x2 __attribute__((ext_vector_type(2)));
struct EpiCtx { PG8_LAS unsigned char* stg; int wr, wc, fr, fq, lane; };
constexpr int EPW = 2816, EP_RSL = 2304, EP_PITCH = 144, NTOKC = 65536;
typedef PG8_LAS u32x4* lds_u4p;
struct RawTile { u32x4 a, b; };
template <int MODE> __device__ __forceinline__ int piece_off(int fq, int k) { return MODE == 0 ? 64 * k + 16 * fq : 32 * fq + 16 * k; }
__device__ __forceinline__ RawTile tile_fetch(const EpiCtx& c, const char* gbase, size_t pitch) {
    const int r = c.lane >> 3, ch = c.lane & 7; RawTile t; t.a = *(const u32x4*)(gbase + (size_t)r * pitch + ch * 16); t.b = *(const u32x4*)(gbase + (size_t)(r + 8) * pitch + ch * 16); return t;
}
template <int MODE> __device__ __forceinline__ void tile_unstage(const EpiCtx& c, const RawTile& t, u32x4& v0, u32x4& v1) {
    const int r = c.lane >> 3, ch = c.lane & 7;
    *(lds_u4p)(c.stg + r * EP_PITCH + ch * 16) = t.a; *(lds_u4p)(c.stg + (r + 8) * EP_PITCH + ch * 16) = t.b;
    v0 = *(lds_u4p)(c.stg + c.fr * EP_PITCH + piece_off<MODE>(c.fq, 0)); v1 = *(lds_u4p)(c.stg + c.fr * EP_PITCH + piece_off<MODE>(c.fq, 1));
}
template <int MODE> __device__ __forceinline__ void tile_store(const EpiCtx& c, char* gbase, size_t pitch, const u32x4& v0, const u32x4& v1) {
    *(lds_u4p)(c.stg + c.fr * EP_PITCH + piece_off<MODE>(c.fq, 0)) = v0; *(lds_u4p)(c.stg + c.fr * EP_PITCH + piece_off<MODE>(c.fq, 1)) = v1;
    const int r = c.lane >> 3, ch = c.lane & 7;
    const u32x4 a = *(lds_u4p)(c.stg + r * EP_PITCH + ch * 16), b = *(lds_u4p)(c.stg + (r + 8) * EP_PITCH + ch * 16);
    *(u32x4*)(gbase + (size_t)r * pitch + ch * 16) = a; *(u32x4*)(gbase + (size_t)(r + 8) * pitch + ch * 16) = b;
}
__device__ __forceinline__ void tile_store_half(const EpiCtx& c, char* gbase, size_t pitch, const u32x4& v) {
    *(lds_u4p)(c.stg + c.fr * 80 + c.fq * 16) = v;
    const int r = c.lane >> 2, ch = c.lane & 3;
    const u32x4 a = *(lds_u4p)(c.stg + r * 80 + ch * 16);
    *(u32x4*)(gbase + (size_t)r * pitch + ch * 16) = a;
}
__device__ __forceinline__ float sum16(const float (&s)[16]) { return (((s[0] + s[1]) + (s[2] + s[3])) + ((s[4] + s[5]) + (s[6] + s[7]))) + (((s[8] + s[9]) + (s[10] + s[11])) + ((s[12] + s[13]) + (s[14] + s[15]))); }
__device__ __forceinline__ void ss_put(const EpiCtx& c, float* ssp, int unit_row0, const float (&sq)[2][4], int slot) {
    PG8_LAS float* t = (PG8_LAS float*)c.stg;
#pragma unroll
    for (int ai = 0; ai < 2; ++ai)
#pragma unroll
        for (int m = 0; m < 4; ++m) t[(ai * 64 + m * 16 + c.fr) * 4 + c.fq] = sq[ai][m];
#pragma unroll
    for (int hb = 0; hb < 2; ++hb) { const f32x4 v = *(PG8_LAS f32x4*)(t + (hb * 64 + c.lane) * 4); ssp[(size_t)slot * NTOKC + unit_row0 + hb * HALF + c.wr * 64 + c.lane] = (v[0] + v[1]) + (v[2] + v[3]); }
}
__device__ __forceinline__ void rstd_stage(const EpiCtx& c, const float* ssp, int unit_row0) {
    PG8_LAS float* rsl = (PG8_LAS float*)(c.stg + EP_RSL);
#pragma unroll
    for (int hb = 0; hb < 2; ++hb) { const int row = unit_row0 + hb * HALF + c.wr * 64 + c.lane; float s[16];
#pragma unroll
        for (int k = 0; k < 16; ++k) s[k] = ssp[(size_t)k * NTOKC + row];
        rsl[hb * 64 + c.lane] = rstd_of(sum16(s)); asm volatile("" ::: "memory"); }
}
__device__ __forceinline__ float rstd_get(const EpiCtx& c, int ai, int m) { return ((PG8_LAS float*)(c.stg + EP_RSL))[ai * 64 + m * 16 + c.fr]; }
#define EPI_ROW(g_) (u.pm * BM + ((g_) >> 2) * HALF + c.wr * 64 + ((g_) & 3) * 16)

__device__ __forceinline__ unsigned long long fp8x8_sat(f32x4 v0, f32x4 v1) {
#pragma unroll
    for (int j = 0; j < 4; ++j) { v0[j] = __builtin_amdgcn_fmed3f(v0[j], -448.0f, 448.0f); v1[j] = __builtin_amdgcn_fmed3f(v1[j], -448.0f, 448.0f); }
    unsigned w0 = 0u, w1 = 0u; w0 = __builtin_amdgcn_cvt_pk_fp8_f32(v0[0], v0[1], w0, false); w0 = __builtin_amdgcn_cvt_pk_fp8_f32(v0[2], v0[3], w0, true);
    w1 = __builtin_amdgcn_cvt_pk_fp8_f32(v1[0], v1[1], w1, false); w1 = __builtin_amdgcn_cvt_pk_fp8_f32(v1[2], v1[3], w1, true); return (unsigned long long)w0 | ((unsigned long long)w1 << 32); }
__device__ __forceinline__ void fp8_rows_store(const EpiCtx& c, unsigned char* dst  , unsigned long long q0, unsigned long long q1) {
    *(PG8_LAS unsigned long long*)(c.stg + c.fr * 80 + c.fq * 8) = q0; *(PG8_LAS unsigned long long*)(c.stg + c.fr * 80 + 32 + c.fq * 8) = q1;
    const int r = c.lane >> 2, ch = c.lane & 3; const u32x4 t8 = *(lds_u4p)(c.stg + r * 80 + ch * 16);
    *(u32x4*)(dst + (size_t)r * 1024 + ch * 16) = t8; }
struct EpiPool {
    struct Pre {}; __device__ __forceinline__ Pre fetch(const Unit&, const EpiCtx&) const { return Pre{}; }
    static constexpr int NST = 0;     static constexpr bool PERM = true, AFTER_DRAIN = false, TWICE = false;
    const float* xin; const float* scale; bf16_t* Xo; float* ss; unsigned char* X8;
    __device__ __forceinline__ void operator()(const f32x4 (&acc)[2][2][4][2], const Unit& u, const EpiCtx& c, const Pre& pre) const {
        const int colw = u.pn * BM + c.wc * 64;
        float sq[2][4]; RawTile rt[1][2];
#define EP_FETCH(g_) do { _Pragma("unroll") for (int bj = 0; bj < 2; ++bj) rt[0][bj] = tile_fetch(c, (const char*)(xin + (size_t)EPI_ROW(g_) * 1024 + colw + 32 * bj), 4096); } while (0)
#pragma unroll
        for (int g = 0; g < 8; ++g) { const int ai = g >> 2, m = g & 3; float s = 0.f; u32x4 o[2]; unsigned long long q8[2];
            EP_FETCH(g);
            f32x4 sc[2][2];
#pragma unroll
            for (int bj = 0; bj < 2; ++bj)
#pragma unroll
                for (int n = 0; n < 2; ++n) sc[bj][n] = *(const f32x4*)(scale + colw + 32 * bj + 8 * c.fq + 4 * n);
#pragma unroll
            for (int bj = 0; bj < 2; ++bj) { u32x4 r0, r1; tile_unstage<1>(c, rt[0][bj], r0, r1);
                const f32x4 v0 = __builtin_bit_cast(f32x4, r0) + sc[bj][0] * acc[ai][bj][m][0], v1 = __builtin_bit_cast(f32x4, r1) + sc[bj][1] * acc[ai][bj][m][1];
                s += dot4(v0) + dot4(v1); o[bj] = pack8(v0, v1); q8[bj] = fp8x8_sat(v0, v1); }
            tile_store<0>(c, (char*)(Xo + (size_t)EPI_ROW(g) * 1024 + colw), 2048, o[0], o[1]);
            fp8_rows_store(c, X8 + (size_t)EPI_ROW(g) * 1024 + colw, q8[0], q8[1]);
            sq[ai][m] = s; asm volatile("" ::: "memory"); }
#undef EP_FETCH
        ss_put(c, ss, u.pm * BM, sq, u.pn * 4 + c.wc);
    }
};
struct EpiRouter {
    struct Pre {}; __device__ __forceinline__ Pre fetch(const Unit&, const EpiCtx&) const { return Pre{}; }
    static constexpr int NST = 0;     static constexpr bool PERM = true, AFTER_DRAIN = false, TWICE = false;
    const float* ssin; const float* rb; float* logits;
    __device__ __forceinline__ void operator()(const f32x4 (&acc)[2][2][4][2], const Unit& u, const EpiCtx& c, const Pre& pre) const {
        if (c.wc != 0) return;
        rstd_stage(c, ssin, u.pm * BM);
        const f32x4 b0 = *(const f32x4*)(rb + 8 * c.fq), b1 = *(const f32x4*)(rb + 8 * c.fq + 4);
#pragma unroll
        for (int g = 0; g < 8; ++g) { const int ai = g >> 2, m = g & 3; const float rs = rstd_get(c, ai, m);
            const f32x4 v0 = acc[ai][0][m][0] * rs + b0, v1 = acc[ai][0][m][1] * rs + b1;
            tile_store<1>(c, (char*)(logits + (size_t)EPI_ROW(g) * 32), 128, __builtin_bit_cast(u32x4, v0), __builtin_bit_cast(u32x4, v1)); }
    }
};
constexpr float SW_A2 = 1.702f * 1.4426950408889634f;
struct EpiSwiGLU {
    struct Pre { u32x4 bg, bu; float rs[8]; };
    __device__ __forceinline__ Pre fetch(const Unit& u, const EpiCtx& c) const { const bf16_t* p = bgu16 + (size_t)u.e * 2048 + u.pn * HALF + c.wc * 32 + 8 * c.fq; Pre r; r.bg = *(const u32x4*)p; r.bu = *(const u32x4*)(p + 1024);
#pragma unroll
        for (int g = 0; g < 8; ++g) r.rs[g] = rowrstd[EPI_ROW(g) + c.fr];
        return r; }
    static constexpr int NST = 4;     static constexpr bool PERM = true, AFTER_DRAIN = false, TWICE = ((PROBE_MASK >> 16) & 1) != 0;
    const bf16_t* bgu16; unsigned char* act; const float* rowrstd;
    __device__ __forceinline__ void operator()(const f32x4 (&acc)[2][2][4][2], const Unit& u, const EpiCtx& c, const Pre& pre) const {
        const int cw = u.pn * HALF + c.wc * 32;
        f32x4 bgt[2], bup[2]; unpack8(pre.bg, bgt[0], bgt[1]); unpack8(pre.bu, bup[0], bup[1]);
#pragma unroll
        for (int g = 0; g < 8; ++g) { const int ai = g >> 2, m = g & 3; f32x4 y[2]; const float rs = W8INV * pre.rs[g];
#pragma unroll
            for (int n = 0; n < 2; ++n) { const f32x4 gt = acc[ai][0][m][n] * rs + bgt[n], up = acc[ai][1][m][n] * rs + bup[n];
#pragma unroll
                for (int hp = 0; hp < 2; ++hp) {
                    f32x2 gc, uc; gc.x = fminf(gt[2 * hp], 7.0f * SW_A2); gc.y = fminf(gt[2 * hp + 1], 7.0f * SW_A2); uc.x = fminf(fmaxf(up[2 * hp], -6.0f), 8.0f); uc.y = fminf(fmaxf(up[2 * hp + 1], -6.0f), 8.0f);
                    f32x2 e; e.x = __builtin_amdgcn_exp2f(-gc.x); e.y = __builtin_amdgcn_exp2f(-gc.y);
                    const f32x2 d = e + 1.0f; f32x2 sg; sg.x = __builtin_amdgcn_rcpf(d.x); sg.y = __builtin_amdgcn_rcpf(d.y);
                    const f32x2 yy = uc * (gc * sg); y[n][2 * hp] = yy.x; y[n][2 * hp + 1] = yy.y; } }
            unsigned w0 = 0u, w1 = 0u;
            w0 = __builtin_amdgcn_cvt_pk_fp8_f32(y[0][0], y[0][1], w0, false); w0 = __builtin_amdgcn_cvt_pk_fp8_f32(y[0][2], y[0][3], w0, true);
            w1 = __builtin_amdgcn_cvt_pk_fp8_f32(y[1][0], y[1][1], w1, false); w1 = __builtin_amdgcn_cvt_pk_fp8_f32(y[1][2], y[1][3], w1, true);
            *(PG8_LAS unsigned long long*)(c.stg + ((g & 1) * 16 + c.fr) * 48 + c.fq * 8) = (unsigned long long)w0 | ((unsigned long long)w1 << 32);
            if (g & 1) { const int r = c.lane >> 1, hh = c.lane & 1; const u32x4 q = *(lds_u4p)(c.stg + r * 48 + hh * 16);
                *(u32x4*)(act + (size_t)(EPI_ROW(g - 1) + r) * 1024 + cw + hh * 16) = q; } }
    }
};
constexpr float YSCALE = 8.0f, YSINV = 0.125f;
struct EpiDown {
    struct Pre { float gt[8]; u32x4 b0, b1; };
    __device__ __forceinline__ Pre fetch(const Unit& u, const EpiCtx& c) const { Pre r;
#pragma unroll
        for (int g = 0; g < 8; ++g) r.gt[g] = rowgate[EPI_ROW(g) + c.fr];
        const bf16_t* p = bd16 + (size_t)u.e * 1024 + u.pn * BM + c.wc * 64 + 8 * c.fq; r.b0 = *(const u32x4*)p; r.b1 = *(const u32x4*)(p + 32); return r; }
    static constexpr int NST = 8;     static constexpr bool PERM = true, AFTER_DRAIN = false, TWICE = ((PROBE_MASK >> 15) & 1) != 0;
    const float* rowgate; const bf16_t* bd16; unsigned char* Y;
    __device__ __forceinline__ void operator()(const f32x4 (&acc)[2][2][4][2], const Unit& u, const EpiCtx& c, const Pre& pre) const {
        const int colw = u.pn * BM + c.wc * 64;
        f32x4 bv[2][2]; unpack8(pre.b0, bv[0][0], bv[0][1]); unpack8(pre.b1, bv[1][0], bv[1][1]);
        const float osc = W8INV / SW_A2;
#pragma unroll
        for (int g = 0; g < 8; ++g) { const int ai = g >> 2, m = g & 3; const float gt = pre.gt[g] * YSCALE; unsigned long long q8[2];
#pragma unroll
            for (int bj = 0; bj < 2; ++bj) { f32x4 v0 = (acc[ai][bj][m][0] * osc + bv[bj][0]) * gt, v1 = (acc[ai][bj][m][1] * osc + bv[bj][1]) * gt;
#pragma unroll
                for (int j = 0; j < 4; ++j) { v0[j] = __builtin_amdgcn_fmed3f(v0[j], -448.0f, 448.0f); v1[j] = __builtin_amdgcn_fmed3f(v1[j], -448.0f, 448.0f); }
                unsigned w0 = 0u, w1 = 0u; w0 = __builtin_amdgcn_cvt_pk_fp8_f32(v0[0], v0[1], w0, false); w0 = __builtin_amdgcn_cvt_pk_fp8_f32(v0[2], v0[3], w0, true);
                w1 = __builtin_amdgcn_cvt_pk_fp8_f32(v1[0], v1[1], w1, false); w1 = __builtin_amdgcn_cvt_pk_fp8_f32(v1[2], v1[3], w1, true); q8[bj] = (unsigned long long)w0 | ((unsigned long long)w1 << 32); }
            *(PG8_LAS unsigned long long*)(c.stg + c.fr * 80 + c.fq * 8) = q8[0]; *(PG8_LAS unsigned long long*)(c.stg + c.fr * 80 + 32 + c.fq * 8) = q8[1];
            const int r = c.lane >> 2, ch = c.lane & 3; const u32x4 t8 = *(lds_u4p)(c.stg + r * 80 + ch * 16);
            *(u32x4*)(Y + (size_t)(EPI_ROW(g) + r) * 1024 + colw + ch * 16) = t8; asm volatile("" ::: "memory"); }
    }
};
constexpr float PJSCALE = 8.0f, PJSINV = 0.125f;
struct EpiStore {
    struct Pre {}; __device__ __forceinline__ Pre fetch(const Unit&, const EpiCtx&) const { return Pre{}; }
    static constexpr int NST = 0;     static constexpr bool PERM = true, AFTER_DRAIN = false, TWICE = false;
    unsigned char* O;
    __device__ __forceinline__ void operator()(const f32x4 (&acc)[2][2][4][2], const Unit& u, const EpiCtx& c, const Pre& pre) const {
        unsigned char* ob = O + ((size_t)(u.pm * 4 + u.pn) * 8 + (c.wr * 4 + c.wc)) * 8192 + c.lane * 16;
#pragma unroll
        for (int g = 0; g < 8; ++g) { const int ai = g >> 2, m = g & 3; u32x4 w;
#pragma unroll
            for (int bj = 0; bj < 2; ++bj)
#pragma unroll
                for (int n = 0; n < 2; ++n) { f32x4 v = acc[ai][bj][m][n] * PJSCALE;
#pragma unroll
                    for (int j = 0; j < 4; ++j) v[j] = __builtin_amdgcn_fmed3f(v[j], -448.0f, 448.0f);
                    unsigned w0 = 0u; w0 = __builtin_amdgcn_cvt_pk_fp8_f32(v[0], v[1], w0, false); w0 = __builtin_amdgcn_cvt_pk_fp8_f32(v[2], v[3], w0, true); w[2 * bj + n] = w0; }
            *(u32x4*)(ob + g * 1024) = w; }
    }
};
struct EpiPle {
    struct Pre { f32x4 b[2][2]; };
    __device__ __forceinline__ Pre fetch(const Unit& u, const EpiCtx& c) const { Pre r; const float* p = bgate + u.pn * BM + c.wc * 64 + 8 * c.fq;
#pragma unroll
        for (int bj = 0; bj < 2; ++bj)
#pragma unroll
            for (int n = 0; n < 2; ++n) r.b[bj][n] = *(const f32x4*)(p + 32 * bj + 4 * n);
        return r; }
    static constexpr int NST = 18;     static constexpr bool PERM = true, AFTER_DRAIN = false, TWICE = false;
    const float* bgate; const unsigned char* PJ; const bf16_t* Xi; bf16_t* Xo; float* ss; unsigned char* X8;
    __device__ __forceinline__ void operator()(const f32x4 (&acc)[2][2][4][2], const Unit& u, const EpiCtx& c, const Pre& pre) const {
        const int colw = u.pn * BM + c.wc * 64;
        float sq[2][4]; RawTile rx[2]; u32x4 pjv[2];
        const unsigned char* pjb = PJ + ((size_t)(u.pm * 4 + u.pn) * 8 + (c.wr * 4 + c.wc)) * 8192 + c.lane * 16;
#define EP_FETCH(g_) do { const size_t ro_ = (size_t)EPI_ROW(g_) * 1024 + colw; pjv[(g_) & 1] = *(const u32x4*)(pjb + (g_) * 1024); rx[(g_) & 1] = tile_fetch(c, (const char*)(Xi + ro_), 2048); } while (0)
        EP_FETCH(0);
#pragma unroll
        for (int g = 0; g < 8; ++g) { const int ai = g >> 2, m = g & 3; const float rs = W8INV; float s = 0.f; u32x4 o[2], xw[2]; unsigned long long q8[2];
            if (g + 1 < 8) EP_FETCH(g + 1);
            const u32x4 pj = pjv[g & 1];
            tile_unstage<0>(c, rx[g & 1], xw[0], xw[1]);
#pragma unroll
            for (int bj = 0; bj < 2; ++bj) { f32x4 p0, p1, x0, x1; unpack8(xw[bj], x0, x1);
                { const f32x2 a0 = __builtin_amdgcn_cvt_pk_f32_fp8((int)pj[2 * bj], false), a1 = __builtin_amdgcn_cvt_pk_f32_fp8((int)pj[2 * bj], true), b0 = __builtin_amdgcn_cvt_pk_f32_fp8((int)pj[2 * bj + 1], false), b1 = __builtin_amdgcn_cvt_pk_f32_fp8((int)pj[2 * bj + 1], true);
                  p0 = (f32x4){a0.x, a0.y, a1.x, a1.y} * PJSINV; p1 = (f32x4){b0.x, b0.y, b1.x, b1.y} * PJSINV; }
                f32x4 z0 = acc[ai][bj][m][0] * rs + pre.b[bj][0], z1 = acc[ai][bj][m][1] * rs + pre.b[bj][1];
#pragma unroll
                for (int hp = 0; hp < 2; ++hp) {
                    f32x2 a0 = {z0[2 * hp], z0[2 * hp + 1]}, a1 = {z1[2 * hp], z1[2 * hp + 1]}; a0 = a0 * -1.4426950408889634f; a1 = a1 * -1.4426950408889634f;
                    f32x2 e0, e1; e0.x = __builtin_amdgcn_exp2f(a0.x); e0.y = __builtin_amdgcn_exp2f(a0.y); e1.x = __builtin_amdgcn_exp2f(a1.x); e1.y = __builtin_amdgcn_exp2f(a1.y); e0 = e0 + 1.0f; e1 = e1 + 1.0f;
                    z0[2 * hp] = __builtin_amdgcn_rcpf(e0.x); z0[2 * hp + 1] = __builtin_amdgcn_rcpf(e0.y); z1[2 * hp] = __builtin_amdgcn_rcpf(e1.x); z1[2 * hp + 1] = __builtin_amdgcn_rcpf(e1.y); }
                const f32x4 v0 = x0 + z0 * p0, v1 = x1 + z1 * p1;
                s += dot4(v0) + dot4(v1); o[bj] = pack8(v0, v1);
                { unsigned w0 = 0u, w1 = 0u; w0 = __builtin_amdgcn_cvt_pk_fp8_f32(v0[0], v0[1], w0, false); w0 = __builtin_amdgcn_cvt_pk_fp8_f32(v0[2], v0[3], w0, true);
                  w1 = __builtin_amdgcn_cvt_pk_fp8_f32(v1[0], v1[1], w1, false); w1 = __builtin_amdgcn_cvt_pk_fp8_f32(v1[2], v1[3], w1, true); q8[bj] = (unsigned long long)w0 | ((unsigned long long)w1 << 32); } }
            tile_store<0>(c, (char*)(Xo + (size_t)EPI_ROW(g) * 1024 + colw), 2048, o[0], o[1]);
            if (X8) {
              *(PG8_LAS unsigned long long*)(c.stg + c.fr * 80 + c.fq * 8) = q8[0]; *(PG8_LAS unsigned long long*)(c.stg + c.fr * 80 + 32 + c.fq * 8) = q8[1];
              const int r = c.lane >> 2, ch = c.lane & 3; const u32x4 t8 = *(lds_u4p)(c.stg + r * 80 + ch * 16);
              *(u32x4*)(X8 + (size_t)(EPI_ROW(g) + r) * 1024 + colw + ch * 16) = t8; }
            sq[ai][m] = s; asm volatile("" ::: "memory"); }
#undef EP_FETCH
        ss_put(c, ss, u.pm * BM, sq, u.pn * 4 + c.wc);
    }
};
struct EpiQkv {
    struct Pre {}; __device__ __forceinline__ Pre fetch(const Unit&, const EpiCtx&) const { return Pre{}; }
    static constexpr int NST = 0;     static constexpr bool PERM = true, AFTER_DRAIN = false, TWICE = false;
    const float* ssin; bf16_t* Q; const float* bfg; float* LF; float qscale; float* nrm;
    __device__ __forceinline__ void operator()(const f32x4 (&acc)[2][2][4][2], const Unit& u, const EpiCtx& c, const Pre& pre) const {
        rstd_stage(c, ssin, u.pm * BM);
        if (u.pn < 12) {
            const int t = u.pn >> 2; bf16_t* base = Q + (size_t)t * (65536 * 1024); const float sc = t == 0 ? qscale : 1.0f;
            const int colw = (u.pn & 3) * BM + c.wc * 64; float mx = 0.f;
#pragma unroll
            for (int g = 0; g < 8; ++g) { const int ai = g >> 2, m = g & 3; const float rs = rstd_get(c, ai, m) * sc * W8INV; u32x4 o[2]; float q = 0.f;
#pragma unroll
                for (int bj = 0; bj < 2; ++bj) { const f32x4 a = acc[ai][bj][m][0] * rs, b = acc[ai][bj][m][1] * rs; q += dot4(a) + dot4(b); o[bj] = pack8(a, b); }
                if (t == 0) tile_store<0>(c, (char*)(base + (size_t)EPI_ROW(g) * 1024 + colw), 2048, o[0], o[1]);
                else {
                    *(lds_u4p)(c.stg + c.fr * EP_PITCH + piece_off<0>(c.fq, 0)) = o[0]; *(lds_u4p)(c.stg + c.fr * EP_PITCH + piece_off<0>(c.fq, 1)) = o[1];
                    const int r = c.lane >> 3, ch = c.lane & 7; const u32x4 a = *(lds_u4p)(c.stg + r * EP_PITCH + ch * 16), b = *(lds_u4p)(c.stg + (r + 8) * EP_PITCH + ch * 16);
                    const int row0 = EPI_ROW(g); const int head = (u.pn & 3) * 4 + c.wc;
                    char* tb = (char*)base + ((size_t)((row0 >> 13) * 16 + head) * 128 + ((row0 & 8191) >> 6)) * 8192; const int sr = (row0 & 63) + r;
                    if (t == 1) { *(u32x4*)(tb + ch * 1024 + sr * 16) = a; *(u32x4*)(tb + ch * 1024 + (sr + 8) * 16) = b; }
                    else { *(u32x4*)(tb + (ch >> 2) * 4096 + sr * 64 + (ch & 3) * 16) = a; *(u32x4*)(tb + (ch >> 2) * 4096 + (sr + 8) * 64 + (ch & 3) * 16) = b; } }
                if (t < 2) { q += __shfl_xor(q, 16); q += __shfl_xor(q, 32); mx = fmaxf(mx, q); } }
            if (t < 2) {
                mx = fmaxf(mx, __shfl_xor(mx, 1)); mx = fmaxf(mx, __shfl_xor(mx, 2)); mx = fmaxf(mx, __shfl_xor(mx, 4)); mx = fmaxf(mx, __shfl_xor(mx, 8));
                if (c.lane == 0) nrm[(((size_t)u.pm * 16 + 4 * (u.pn & 3) + c.wc) * 2 + t) * 2 + c.wr] = mx; }
        } else if (c.wc == 0) {
            const f32x4 b0 = *(const f32x4*)(bfg + 8 * (c.fq & 1)), b1 = *(const f32x4*)(bfg + 8 * (c.fq & 1) + 4);
#pragma unroll
            for (int g = 0; g < 8; ++g) { const int ai = g >> 2, m = g & 3; const float rs = rstd_get(c, ai, m) * W8INV;
                f32x4 z0 = acc[ai][0][m][0] * rs + b0, z1 = acc[ai][0][m][1] * rs + b1;
#pragma unroll
                for (int j = 0; j < 4; ++j) { z0[j] = fminf(z0[j], 0.f) - 0.6931471805599453f * __builtin_amdgcn_logf(1.0f + __builtin_amdgcn_exp2f(-1.4426950408889634f * fabsf(z0[j]))); z1[j] = fminf(z1[j], 0.f) - 0.6931471805599453f * __builtin_amdgcn_logf(1.0f + __builtin_amdgcn_exp2f(-1.4426950408889634f * fabsf(z1[j]))); }
                if (c.fq < 2) { float* o = LF + (size_t)(EPI_ROW(g) + c.fr) * 16 + 8 * c.fq; *(f32x4*)o = z0; *(f32x4*)(o + 4) = z1; } }
        }
    }
};
struct EpiWo {
    struct Pre {}; __device__ __forceinline__ Pre fetch(const Unit&, const EpiCtx&) const { return Pre{}; }
    static constexpr int NST = 18;     static constexpr bool PERM = true, AFTER_DRAIN = false, TWICE = ((PROBE_MASK >> 14) & 1) != 0;
    const bf16_t* Xi; bf16_t* Xo; float* ss; unsigned char* X8;
    __device__ __forceinline__ void operator()(const f32x4 (&acc)[2][2][4][2], const Unit& u, const EpiCtx& c, const Pre& pre) const {
        const int colw = u.pn * BM + c.wc * 64;
        float sq[2][4]; RawTile rx[2];
#define EP_FETCH(g_) do { rx[(g_) & 1] = tile_fetch(c, (const char*)(Xi + (size_t)EPI_ROW(g_) * 1024 + colw), 2048); } while (0)
        EP_FETCH(0);
#pragma unroll
        for (int g = 0; g < 8; ++g) { const int ai = g >> 2, m = g & 3; float s = 0.f; u32x4 o[2], xw[2]; unsigned long long q8[2];
            if (g + 1 < 8) EP_FETCH(g + 1);
            tile_unstage<0>(c, rx[g & 1], xw[0], xw[1]);
#pragma unroll
            for (int bj = 0; bj < 2; ++bj) { f32x4 x0, x1; unpack8(xw[bj], x0, x1);
                const f32x4 v0 = x0 + acc[ai][bj][m][0] * W8INV, v1 = x1 + acc[ai][bj][m][1] * W8INV;
                s += dot4(v0) + dot4(v1); o[bj] = pack8(v0, v1); q8[bj] = fp8x8_sat(v0, v1); }
            tile_store<0>(c, (char*)(Xo + (size_t)EPI_ROW(g) * 1024 + colw), 2048, o[0], o[1]);
            fp8_rows_store(c, X8 + (size_t)EPI_ROW(g) * 1024 + colw, q8[0], q8[1]);
            sq[ai][m] = s; asm volatile("" ::: "memory"); }
#undef EP_FETCH
        ss_put(c, ss, u.pm * BM, sq, u.pn * 4 + c.wc);
    }
};

typedef int v8i_t __attribute__((ext_vector_type(8))); typedef int v4i_t __attribute__((ext_vector_type(4)));
struct Frag2 { bf16x8 k0, k1; };
struct Frag1 { v8i_t v; };
template <int ESZ> struct FragSel { typedef Frag2 type; };
template <> struct FragSel<1> { typedef Frag1 type; };
__device__ __forceinline__ void ld_frag(Frag2& f, const PG8_LAS unsigned char* p) { f.k0 = *(const PG8_LAS bf16x8*)p; f.k1 = *(const PG8_LAS bf16x8*)(p + 1024); }
__device__ __forceinline__ void ld_frag(Frag1& f, const PG8_LAS unsigned char* p) { const v4i_t lo = *(const PG8_LAS v4i_t*)p, hi = *(const PG8_LAS v4i_t*)(p + 1024); f.v = __builtin_shufflevector(lo, hi, 0, 1, 2, 3, 4, 5, 6, 7); }
__device__ __forceinline__ void mma_frag(f32x4& acc, const Frag2& b, const Frag2& a) { acc = __builtin_amdgcn_mfma_f32_16x16x32_bf16(b.k0, a.k0, acc, 0, 0, 0); acc = __builtin_amdgcn_mfma_f32_16x16x32_bf16(b.k1, a.k1, acc, 0, 0, 0); }
__device__ __forceinline__ void mma_frag(f32x4& acc, const Frag1& b, const Frag1& a) {
#if defined(__HIP_DEVICE_COMPILE__)
    asm volatile("v_mfma_f32_16x16x128_f8f6f4 %0, %1, %2, %0" : "+v"(acc) : "v"(b.v), "v"(a.v));
#endif
}
#define PG8_KITER(SKIP11, WX, MMA0) do { \
            unsigned w2[2][2]; \
            if constexpr (GATHER) { if (last) { _Pragma("unroll") for (int h_ = 0; h_ < 2; ++h_) _Pragma("unroll") for (int i_ = 0; i_ < 2; ++i_) w2[h_][i_] = vgN[h_][i_]; } else { _Pragma("unroll") for (int h_ = 0; h_ < 2; ++h_) _Pragma("unroll") for (int i_ = 0; i_ < 2; ++i_) w2[h_][i_] = vgC[h_][i_]; } } \
            PG8_LDB(B0, 0, 0); PG8_LDB(B1, 0, 1); PG8_SCHED; PG8_LDA(At, 0, 0); if (!(SKIP11)) { if constexpr (GATHER) PG8_STAGE(PG8_SA(1, 1), a1, vgC[1]); else PG8_STAGE(PG8_SA(1, 1), a1 + hstepA, voffA); } \
            PG8_WAIT_V(WX); PG8_WAIT_L(0); PG8_BAR; MMA0(0, 0, At, B0); MMA0(0, 1, At, B1); PG8_BAR; PG8_SCHED; \
            PG8_LDA(At, 0, 1); PG8_STAGE(PG8_SB(0, 0), b2, voffB); PG8_STAGE(PG8_SB(0, 1), b2 + hstepB, voffB); if constexpr (GATHER) PG8_STAGE(PG8_SA(0, 0), a2, w2[0]); else PG8_STAGE(PG8_SA(0, 0), a2, voffA); \
            PG8_WAIT_V(WX); PG8_WAIT_L(0); PG8_BAR; MMA0(1, 0, At, B0); MMA0(1, 1, At, B1); PG8_BAR; PG8_SCHED; \
            PG8_LDB(B0, 1, 0); PG8_LDB(B1, 1, 1); PG8_SCHED; PG8_LDA(At, 1, 0); if constexpr (GATHER) PG8_STAGE(PG8_SA(0, 1), a2, w2[1]); else PG8_STAGE(PG8_SA(0, 1), a2 + hstepA, voffA); \
            PG8_WAIT_V(WX); PG8_WAIT_L(0); PG8_BAR; PG8_MMA(0, 0, At, B0); PG8_MMA(0, 1, At, B1); PG8_BAR; PG8_SCHED; \
            PG8_LDA(At, 1, 1); PG8_STAGE(PG8_SB(1, 0), b3, voffB); PG8_STAGE(PG8_SB(1, 1), b3 + hstepB, voffB); if constexpr (GATHER) PG8_STAGE(PG8_SA(1, 0), a3, w2[0]); else PG8_STAGE(PG8_SA(1, 0), a3, voffA); \
            PG8_WAIT_V(8); PG8_WAIT_L(0); PG8_BAR; PG8_MMA(1, 0, At, B0); PG8_MMA(1, 1, At, B1); PG8_BAR; PG8_SCHED; \
            } while (0)
__device__ __forceinline__ void mma_frag_z(f32x4& acc, const Frag1& b, const Frag1& a) {
#if defined(__HIP_DEVICE_COMPILE__)
    asm volatile("v_mfma_f32_16x16x128_f8f6f4 %0, %1, %2, 0" : "=&v"(acc) : "v"(b.v), "v"(a.v));
#endif
}
__device__ __forceinline__ void mma_frag_z(f32x4& acc, const Frag2& b, const Frag2& a) { acc = (f32x4){0.f, 0.f, 0.f, 0.f}; mma_frag(acc, b, a); }
template <class Epi, class Sched, bool GATHER = false, int ESZ = 2>
__device__ __forceinline__ void gemm_phase(PG8_LAS unsigned char* lds, PG8_LAS unsigned char* epi, const Gemm g, const Sched& S, const Epi& E) {
    int tid = threadIdx.x; asm volatile("" : "+v"(tid));
    const int wid = __builtin_amdgcn_readfirstlane(tid >> 6), lane = tid & 63, wr = wid >> 2, wc = wid & 3, fr = lane & 15, fq = lane >> 4;
    constexpr bool ALIGN_EPI = true, SP2 = true, RELAX = (ESZ == 1)  ; const int K = g.K, nt = (K * ESZ) / (BK * 2), lda = g.lda, ldb = g.ldb;
    unsigned voffA[2], voffB[2];
#pragma unroll
    for (int i = 0; i < 2; ++i) { int R, C; stage_rc(tid * 16 + i * 8192, R, C); const int Rb = 64 * (R >> 5) + 8 * ((R & 15) >> 2) + 4 * ((R >> 4) & 1) + (R & 3);
        voffA[i] = GATHER ? (unsigned)(R | (C << 16)) : (unsigned)(R * lda * ESZ + C * 2); voffB[i] = (unsigned)(Rb * ldb * ESZ + C * 2); }
    unsigned vgC[2][2], vgN[2][2];
#define PG8_ROWMAP(dst, pm_) do { _Pragma("unroll") for (int h_ = 0; h_ < 2; ++h_) _Pragma("unroll") for (int i_ = 0; i_ < 2; ++i_) { \
        const unsigned tok_ = (unsigned)g.rowmap[(size_t)(pm_) * BM + h_ * HALF + (voffA[i_] & 0xFFFFu)] & 0xFFFFu; dst[h_][i_] = tok_ * (unsigned)(lda * ESZ) + (voffA[i_] >> 16) * 2u; } } while (0)
    const size_t kstep = (size_t)(BK * 2);
    const size_t hstepA = (size_t)HALF * lda * ESZ, hstepB = (size_t)32 * ldb * ESZ;
    const unsigned ldsw = (unsigned)wid * 1024u;
    const int aoff = lds_byte(wr * 64 + fr, fq * 8), boff = lds_byte(wc * 32 + fr, fq * 8);
#define PG8_SA(b, h) (((b) * 2 + (h)) * HTB)
#define PG8_SB(b, h) ((4 + (b) * 2 + (h)) * HTB)
#define PG8_STAGE(bufoff, gbase, voff) do { _Pragma("unroll") for (int _i = 0; _i < 2; ++_i) \
        __builtin_amdgcn_global_load_lds((const unsigned*)((const char*)(gbase) + (voff)[_i]), (PG8_LAS unsigned*)(lds + (bufoff) + ldsw + _i * 8192), 16, 0, 0); } while (0)
#define PG8_LDA(dst, b, h) do { _Pragma("unroll") for (int m = 0; m < 4; ++m) ld_frag(dst[m], lds + PG8_SA(b, h) + aoff + m * 2048); } while (0)
#define PG8_LDB(dst, b, h) do { _Pragma("unroll") for (int n = 0; n < 2; ++n) ld_frag(dst[n], lds + PG8_SB(b, h) + boff + n * 2048); } while (0)
#define PG8_MMA(ai, bj, At, Bt) do { __builtin_amdgcn_s_setprio(1); _Pragma("unroll") for (int m = 0; m < 4; ++m) _Pragma("unroll") for (int n = 0; n < 2; ++n) mma_frag(acc[ai][bj][m][n], Bt[n], At[m]); __builtin_amdgcn_s_setprio(0); } while (0)
#define PG8_MMAZ(ai, bj, At, Bt) do { __builtin_amdgcn_s_setprio(1); _Pragma("unroll") for (int m = 0; m < 4; ++m) _Pragma("unroll") for (int n = 0; n < 2; ++n) mma_frag_z(acc[ai][bj][m][n], Bt[n], At[m]); __builtin_amdgcn_s_setprio(0); } while (0)
#define PG8_WAIT_V(n) asm volatile("s_waitcnt vmcnt(%0)" :: "n"(n) : "memory")
#define PG8_WAIT_L(n) asm volatile("s_waitcnt lgkmcnt(" #n ")" ::: "memory")
#define PG8_BAR __builtin_amdgcn_s_barrier()
#define PG8_SCHED __builtin_amdgcn_sched_barrier(0)
    Unit cur, nxt; int ui = 0;
    if (!S.next(0, cur)) return;
    if (g.stag > 0) { const unsigned long long t0 = __builtin_amdgcn_s_memrealtime(), d = (unsigned long long)((blockIdx.x & 15u) * (unsigned)g.stag); while (__builtin_amdgcn_s_memrealtime() - t0 < d) __builtin_amdgcn_s_sleep(8); }
    f32x4 acc[2][2][4][2];
#pragma unroll
    for (int a = 0; a < 2; ++a)
#pragma unroll
        for (int b = 0; b < 2; ++b)
#pragma unroll
            for (int m = 0; m < 4; ++m)
#pragma unroll
                for (int n = 0; n < 2; ++n) { if constexpr (!RELAX) { acc[a][b][m][n] = (f32x4){0.f, 0.f, 0.f, 0.f}; if constexpr (ESZ == 1) asm volatile("" : "+v"(acc[a][b][m][n])); } }
    typename FragSel<ESZ>::type At[4], B0[2], B1[2];
    const char* cA = GATHER ? (const char*)g.A : (const char*)g.A + S.a_off(cur); const char* cB = (const char*)g.Bt + S.b_off(cur);
    if constexpr (GATHER) { PG8_ROWMAP(vgC, cur.pm); _Pragma("unroll") for (int h_ = 0; h_ < 2; ++h_) _Pragma("unroll") for (int i_ = 0; i_ < 2; ++i_) vgN[h_][i_] = vgC[h_][i_]; }
    typename Epi::Pre pre;
#define PG8_FETCH() do { int t3 = threadIdx.x; asm volatile("" : "+v"(t3)); const int w3 = __builtin_amdgcn_readfirstlane(t3 >> 6), l3 = t3 & 63; const EpiCtx ec3{epi + w3 * EPW, w3 >> 2, w3 & 3, l3 & 15, l3 >> 4, l3}; pre = E.fetch(cur, ec3); } while (0)
    PG8_FETCH();
    S.a_ready(cur);
    {
        PG8_STAGE(PG8_SB(0, 0), cB, voffB); PG8_STAGE(PG8_SB(0, 1), cB + hstepB, voffB);
        if constexpr (GATHER) { PG8_STAGE(PG8_SA(0, 0), cA, vgC[0]); PG8_STAGE(PG8_SA(0, 1), cA, vgC[1]); } else { PG8_STAGE(PG8_SA(0, 0), cA, voffA); PG8_STAGE(PG8_SA(0, 1), cA + hstepA, voffA); }
        if (wr == 1) PG8_BAR;
        PG8_WAIT_V(2); PG8_BAR;
        PG8_STAGE(PG8_SB(1, 0), cB + kstep, voffB); if constexpr (GATHER) PG8_STAGE(PG8_SA(1, 0), cA + kstep, vgC[0]); else PG8_STAGE(PG8_SA(1, 0), cA + kstep, voffA); PG8_STAGE(PG8_SB(1, 1), cB + hstepB + kstep, voffB);
        if constexpr (RELAX) {
            if constexpr (GATHER) PG8_STAGE(PG8_SA(1, 1), cA + kstep, vgC[1]); else PG8_STAGE(PG8_SA(1, 1), cA + kstep + hstepA, voffA);
            volatile __attribute__((address_space(1))) u32x4* dm = (volatile __attribute__((address_space(1))) u32x4*)g.dummy + ((size_t)blockIdx.x * 512 + (size_t)tid);
#pragma unroll
            for (int k_ = 0; k_ < Epi::NST; ++k_) *dm = (u32x4){0u, 0u, 0u, 0u};
            PG8_WAIT_V(8 + Epi::NST); PG8_BAR;
        } else { PG8_WAIT_V(6); PG8_BAR; }
    }
    for (;;) {
        const bool has_next = S.next(ui + 1, nxt);
        const char* nA = (has_next && !GATHER) ? (const char*)g.A + S.a_off(nxt) : cA; const char* nB = has_next ? (const char*)g.Bt + S.b_off(nxt) : cB;
        if constexpr (GATHER) { if (has_next) PG8_ROWMAP(vgN, nxt.pm); }
#define PG8_KPTRS const bool last = (t == nt - 2); const char* a1 = cA + (size_t)(t + 1) * kstep; \
            const char* a2 = last ? nA : cA + (size_t)(t + 2) * kstep; const char* b2 = last ? nB : cB + (size_t)(t + 2) * kstep; const char* a3 = a2 + kstep; const char* b3 = b2 + kstep; (void)a1
        if constexpr (RELAX) {
            { const int t = 0; PG8_KPTRS; PG8_KITER(true, 8 + Epi::NST, PG8_MMAZ); }
            for (int t = 2; t < nt; t += 2) { PG8_KPTRS; PG8_KITER(false, 8, PG8_MMA); }
            if (has_next) { if constexpr (GATHER) PG8_STAGE(PG8_SA(1, 1), nA + kstep, vgN[1]); else PG8_STAGE(PG8_SA(1, 1), nA + kstep + hstepA, voffA); }
        } else {
            for (int t = 0; t < nt; t += 2) { PG8_KPTRS; PG8_KITER(false, 8, PG8_MMA); }
        }
#undef PG8_KPTRS
        if constexpr (ESZ == 1) asm volatile("s_nop 15\n\ts_nop 15" ::: "memory");
        if constexpr (ALIGN_EPI) { if (wr == 0) PG8_BAR; }
        { int t2 = threadIdx.x; asm volatile("" : "+v"(t2));
          const int w2 = __builtin_amdgcn_readfirstlane(t2 >> 6), l2 = t2 & 63; const EpiCtx ec{epi + w2 * EPW, w2 >> 2, w2 & 3, l2 & 15, l2 >> 4, l2}; E(acc, cur, ec, pre); if (Epi::TWICE) { asm volatile("" ::: "memory"); E(acc, cur, ec, pre); } S.done(cur); }
        if (!has_next) break;
#pragma unroll
        for (int a = 0; a < 2; ++a)
#pragma unroll
            for (int b = 0; b < 2; ++b)
#pragma unroll
                for (int m = 0; m < 4; ++m)
#pragma unroll
                    for (int n = 0; n < 2; ++n) { if constexpr (!RELAX) { acc[a][b][m][n] = (f32x4){0.f, 0.f, 0.f, 0.f}; if constexpr (ESZ == 1) asm volatile("" : "+v"(acc[a][b][m][n])); } }
        cur = nxt; cA = nA; cB = nB; ++ui;
        PG8_FETCH();
        if constexpr (GATHER) { _Pragma("unroll") for (int h_ = 0; h_ < 2; ++h_) _Pragma("unroll") for (int i_ = 0; i_ < 2; ++i_) vgC[h_][i_] = vgN[h_][i_]; }
        if constexpr (ALIGN_EPI) { if (wr == 1) PG8_BAR; }
    }
    PG8_WAIT_V(0);
    if constexpr (!ALIGN_EPI) { if (wr == 0) PG8_BAR; }
    PG8_BAR;
#undef PG8_SA
#undef PG8_FETCH
#undef PG8_ROWMAP
#undef PG8_SB
#undef PG8_STAGE
#undef PG8_LDA
#undef PG8_LDB
#undef PG8_MMA
#undef PG8_MMAZ
#undef PG8_WAIT_V
#undef PG8_WAIT_L
#undef PG8_BAR
#undef PG8_SCHED
}
}
#include <hip/hip_bf16.h>
#include <cmath>
namespace attn_body {
using bf16=__hip_bfloat16;
using bf16x8=__attribute__((ext_vector_type(8)))short;
using s16x4=__attribute__((ext_vector_type(4)))short;
using f32x16=__attribute__((ext_vector_type(16)))float;
using u32x4=__attribute__((ext_vector_type(4)))unsigned;
using f32x4_t=__attribute__((ext_vector_type(4)))float;
constexpr int BATCH=8,NHEAD=16,SEQ=8192,D=64,DM=NHEAD*D;
constexpr int NW=8,QBLK=32,QB=QBLK*NW,KVBLK=64,NQB=SEQ/QB;
constexpr int ATTN_PITCH=DM, ATTN_UNIT_ROWS=QB;
__device__ __forceinline__ int crow(int r,int hi){return (r&3)+8*(r>>2)+4*hi;}
#define SBAR() __builtin_amdgcn_sched_barrier(0)
__device__ __forceinline__ void cmask(f32x16&p0,f32x16&p1,int jb,int qrel,int hi){
  const float NEG=-INFINITY; int kb=64*jb+4*hi;
  #pragma unroll
  for(int r=0;r<16;++r){int kv=kb+(r&3)+8*(r>>2); if(kv>qrel)p0[r]=NEG; if(kv+32>qrel)p1[r]=NEG;}
}

constexpr int NSLOT=3, SLOTB=8192;
constexpr int LDS_K=0, LDS_V=NSLOT*SLOTB, LDS_WS=2*NSLOT*SLOTB, LDS_OST=LDS_WS+NW*64*4, LDS_BIAS=LDS_OST+NW*4096, LDS_BYTES=LDS_BIAS+SEQ*4;
constexpr float C2=0.125f*1.4426950408889634f;
__device__ __forceinline__ void glds16(const void*gsrc,unsigned lds_dst){unsigned keep;
  asm volatile("s_mov_b32 %0, m0\n\ts_mov_b32 m0, %2\n\ts_nop 0\n\tglobal_load_lds_dwordx4 %1, off\n\ts_mov_b32 m0, %0":"=&s"(keep):"v"(gsrc),"s"(lds_dst):"memory");}
__device__ __forceinline__ float max3f(float a,float b,float c){float r;asm("v_max3_f32 %0, %1, %2, %3":"=v"(r):"v"(a),"v"(b),"v"(c));return r;}
__device__ __forceinline__ float max2f(float a,float b){float r;asm("v_max_f32_e32 %0, %1, %2":"=v"(r):"v"(a),"v"(b));return r;}
__device__ __forceinline__ float fadd_s(float a,float b){float r;asm("v_add_f32_e32 %0, %1, %2":"=v"(r):"v"(a),"v"(b));return r;}
__device__ __forceinline__ float fsub_s(float a,float b){float r;asm("v_sub_f32_e32 %0, %1, %2":"=v"(r):"v"(a),"v"(b));return r;}
typedef float f32x2_t __attribute__((ext_vector_type(2))); typedef __bf16 bf16x2_t __attribute__((ext_vector_type(2)));
__device__ __forceinline__ unsigned cvtpk_s(float lo,float hi){f32x2_t v={lo,hi};bf16x2_t b=__builtin_convertvector(v,bf16x2_t);return __builtin_bit_cast(unsigned,b);}
#define WAIT_BAR(N) asm volatile("s_waitcnt vmcnt(" #N ") lgkmcnt(0)\n\ts_barrier":::"memory")

__device__ __forceinline__ void qkt(f32x16&p0,f32x16&p1,const char*Kslot,const bf16x8*qr,const f32x16&c0,const f32x16&c1,int r32,int hi){
  const char*kb=Kslot+hi*1024+r32*16;
  #pragma unroll
  for(int d0=0;d0<4;++d0){
    const bf16x8 b0=*reinterpret_cast<const bf16x8*>(kb+d0*2048);
    const bf16x8 b1=*reinterpret_cast<const bf16x8*>(kb+d0*2048+512);
    if(d0==0){p0=__builtin_amdgcn_mfma_f32_32x32x16_bf16(b0,qr[0],c0,0,0,0);p1=__builtin_amdgcn_mfma_f32_32x32x16_bf16(b1,qr[0],c1,0,0,0);}
    else{p0=__builtin_amdgcn_mfma_f32_32x32x16_bf16(b0,qr[d0],p0,0,0,0);p1=__builtin_amdgcn_mfma_f32_32x32x16_bf16(b1,qr[d0],p1,0,0,0);}}
}
typedef __attribute__((address_space(3))) const char* lds_cptr;
typedef short v4i16_t __attribute__((ext_vector_type(4)));
__device__ __forceinline__ void kload8(bf16x8*kf,lds_cptr kp){
  kf[0]=*(const __attribute__((address_space(3))) bf16x8*)(kp);      kf[1]=*(const __attribute__((address_space(3))) bf16x8*)(kp+512);
  kf[2]=*(const __attribute__((address_space(3))) bf16x8*)(kp+2048); kf[3]=*(const __attribute__((address_space(3))) bf16x8*)(kp+2560);
  kf[4]=*(const __attribute__((address_space(3))) bf16x8*)(kp+4096); kf[5]=*(const __attribute__((address_space(3))) bf16x8*)(kp+4608);
  kf[6]=*(const __attribute__((address_space(3))) bf16x8*)(kp+6144); kf[7]=*(const __attribute__((address_space(3))) bf16x8*)(kp+6656);
}
__device__ __forceinline__ void kload2(bf16x8*kf,lds_cptr kp,int j){ kf[2*j]=*(const __attribute__((address_space(3))) bf16x8*)(kp+j*2048); kf[2*j+1]=*(const __attribute__((address_space(3))) bf16x8*)(kp+j*2048+512); }
__device__ __forceinline__ s16x4 vtr(lds_cptr p){ return __builtin_bit_cast(s16x4,__builtin_amdgcn_ds_read_tr16_b64_v4i16((__attribute__((address_space(3))) v4i16_t*)p)); }
__device__ __forceinline__ float rowmax(const f32x16&p0,const f32x16&p1){
  float a=max3f(p0[0],p0[1],p1[0]),b=max3f(p0[2],p0[3],p1[1]);a=max3f(a,p1[2],p1[3]);
  #pragma unroll
  for(int r=4;r<16;r+=4){a=max3f(a,p0[r],p0[r+1]);b=max3f(b,p0[r+2],p0[r+3]);a=max3f(a,p1[r],p1[r+1]);b=max3f(b,p1[r+2],p1[r+3]);}
  const float m=max2f(a,b);
  auto rr=__builtin_amdgcn_permlane32_swap(__float_as_uint(m),__float_as_uint(m),false,false);
  return max2f(__uint_as_float(rr[0]),__uint_as_float(rr[1]));
}
__device__ __forceinline__ void pv(f32x16*o,int vb,bf16x8 pa0,bf16x8 pa1,bf16x8 pa2,bf16x8 pa3){
  #pragma unroll
  for(int d0=0;d0<2;++d0){s16x4 lo[4],hi[4];
    #pragma unroll
    for(int ks=0;ks<4;++ks){
      asm volatile("ds_read_b64_tr_b16 %0,%1 offset:%c2":"=&v"(lo[ks]):"v"(vb),"i"(d0*4096+ks*1024):"memory");
      asm volatile("ds_read_b64_tr_b16 %0,%1 offset:%c2":"=&v"(hi[ks]):"v"(vb),"i"(d0*4096+ks*1024+512):"memory");}
    asm volatile("s_waitcnt lgkmcnt(0)":::"memory");SBAR();
    #define PK(k) (bf16x8){lo[k][0],lo[k][1],lo[k][2],lo[k][3],hi[k][0],hi[k][1],hi[k][2],hi[k][3]}
    o[d0]=__builtin_amdgcn_mfma_f32_32x32x16_bf16(pa0,PK(0),o[d0],0,0,0);
    o[d0]=__builtin_amdgcn_mfma_f32_32x32x16_bf16(pa1,PK(1),o[d0],0,0,0);
    o[d0]=__builtin_amdgcn_mfma_f32_32x32x16_bf16(pa2,PK(2),o[d0],0,0,0);
    o[d0]=__builtin_amdgcn_mfma_f32_32x32x16_bf16(pa3,PK(3),o[d0],0,0,0);
    #undef PK
  }
}

#ifndef ATTN_STORE16
#define ATTN_STORE16(p,v) (*(u32x4*)(p)=(v))
#endif
template<int THRL,bool STATIC> __device__ __forceinline__ void attn_unit(int b,int h,int qb,int ts,const bf16*Q,const bf16*__restrict__ K,const bf16*__restrict__ V,bf16*O,const float*biasg,char*shm){
  int tid=threadIdx.x; asm volatile("":"+v"(tid)); const int lane=tid&63,r32=lane&31,hi=lane>>5; const int wid=__builtin_amdgcn_readfirstlane(tid>>6);
  const long rowbase=(long)b*SEQ; const int q0=qb*QB;
  const bf16*Qw=Q+(rowbase+q0+wid*QBLK)*DM+h*D;
  const long tile0=((long)(b*NHEAD+h)*(SEQ/KVBLK)+ts)*(KVBLK*D);
  const unsigned lds0=(unsigned)(uintptr_t)shm;
  float*wsf=(float*)(shm+LDS_WS)+wid*64;
  const bf16*ksrc=K+tile0+wid*512+lane*8;
  const bf16*vsrc=V+tile0+(wid>>2)*2048+(wid&3)*512+lane*8;
  const unsigned kdst=lds0+LDS_K+wid*1024, vdst=lds0+LDS_V+wid*1024;
  #define DMA_K(t,slot) glds16(ksrc+(long)(t)*(KVBLK*D),(unsigned)__builtin_amdgcn_readfirstlane(kdst+(slot)))
  #define DMA_V(t,slot) glds16(vsrc+(long)(t)*(KVBLK*D),(unsigned)__builtin_amdgcn_readfirstlane(vdst+(slot)))
  const int vb0=(int)(lds0+LDS_V)+((lane>>4)&1)*32+(lane&3)*8+(4*hi+((lane&15)>>2))*64;
  const char*Kbase=shm+LDS_K; bf16x8 kf[8];
  const lds_cptr shm3=(lds_cptr)shm; const lds_cptr kp0=shm3+LDS_K+hi*1024+r32*16; const lds_cptr vp0=shm3+LDS_V+((lane>>4)&1)*32+(lane&3)*8+(4*hi+((lane&15)>>2))*64;
  const int NT=(q0+QB)/KVBLK-ts;
  if(!STATIC){ const float*bg=biasg+(long)(b*NHEAD+h)*SEQ+ts*KVBLK; const int nb=NT*KVBLK;
    for(int f0=wid*256;f0<nb;f0+=NW*256) glds16(bg+f0+lane*4,(unsigned)__builtin_amdgcn_readfirstlane(lds0+LDS_BIAS+f0*4)); }
  const lds_cptr bp0=shm3+LDS_BIAS+hi*16;
  DMA_K(0,0);DMA_V(0,0);DMA_K(1,SLOTB);
  bf16x8 qr[4];
  #pragma unroll
  for(int d0=0;d0<4;++d0)qr[d0]=*reinterpret_cast<const bf16x8*>(&Qw[(long)r32*DM+d0*16+hi*8]);
  float mhat=0.f,l_reg=0.f;f32x16 o[2];o[0]=f32x16{};o[1]=f32x16{};f32x16 cb0,cb1;
  #define LOADCB(t) do{ const lds_cptr bp_=bp0+(t)*256; _Pragma("unroll") for(int j_=0;j_<4;++j_){ \
      const f32x4_t u0_=*(const __attribute__((address_space(3))) f32x4_t*)(bp_+j_*32); const f32x4_t u1_=*(const __attribute__((address_space(3))) f32x4_t*)(bp_+128+j_*32); \
      _Pragma("unroll") for(int i_=0;i_<4;++i_){ if(STATIC){ cb0[4*j_+i_]=u0_[i_]; cb1[4*j_+i_]=u1_[i_]; } else { cb0[4*j_+i_]=u0_[i_]-mhat; cb1[4*j_+i_]=u1_[i_]-mhat; } } } }while(0)
  const int qrel=wid*QBLK+r32;
  #define CMASK(P0,P1,t) do{int jb_=(t)-(NT-4); if(jb_>=0)cmask(P0,P1,jb_,qrel,hi);}while(0)
  bool resc=false;
  #define START(P0,P1) do{ resc=false; \
    if(!STATIC){ const float rm=rowmax(P0,P1); const float dl=rm; mhat=fadd_s(mhat,dl); \
      _Pragma("unroll") for(int r=0;r<16;++r){P0[r]=fsub_s(P0[r],dl);P1[r]=fsub_s(P1[r],dl);} \
      } \
    _Pragma("unroll") for(int r=0;r<16;++r)P0[r]=__builtin_amdgcn_exp2f(P0[r]); }while(0)
  #define RESC() do{ if(resc){ asm volatile("s_waitcnt lgkmcnt(0)":::"memory"); \
      _Pragma("unroll") for(int d_=0;d_<2;++d_) _Pragma("unroll") for(int r=0;r<16;++r)o[d_][r]*=wsf[crow(r,hi)]; } }while(0)
  f32x16 pA0,pA1,pB0,pB1;
  int sl_prev=0,sl_cur=0,sl_next=SLOTB;
  #define ROT() do{sl_prev=sl_cur;sl_cur=sl_next;sl_next=(sl_next==(NSLOT-1)*SLOTB)?0:sl_next+SLOTB;}while(0)
  DMA_K(2,2*SLOTB);
  if(STATIC){ const float*bg=biasg+(long)(b*NHEAD+h)*SEQ; const float ref=bg[q0+QB-1]; const int nb=NT*KVBLK;
    for(int f0=tid*4;f0<nb;f0+=NW*256){ f32x4_t v=*(const f32x4_t*)(bg+ts*KVBLK+f0); v[0]-=ref; v[1]-=ref; v[2]-=ref; v[3]-=ref; *(__attribute__((address_space(3))) f32x4_t*)(shm3+LDS_BIAS+f0*4)=v; } }
  WAIT_BAR(3);
  LOADCB(0); qkt(pA0,pA1,Kbase,qr,cb0,cb1,r32,hi);asm volatile("s_nop 15\n\ts_nop 7":"+v"(pA0),"+v"(pA1));CMASK(pA0,pA1,0);
  START(pA0,pA1);
  _Pragma("unroll") for(int r=0;r<16;++r)pA1[r]=__builtin_amdgcn_exp2f(pA1[r]);
  WAIT_BAR(0);
  DMA_K(3,0);DMA_V(1,SLOTB);
  ROT();
  kload8(kf,kp0+sl_cur);
  WAIT_BAR(2);
  s16x4 vlo[8],vhi[8]; u32x4 pw0,pw1,pw2,pw3;
  #define PKW(P,B) cvtpk_s(P[B],P[B+1])
  #define PAF(k) __builtin_bit_cast(bf16x8,pw##k)
  #define VFR(i) (bf16x8){vlo[i][0],vlo[i][1],vlo[i][2],vlo[i][3],vhi[i][0],vhi[i][1],vhi[i][2],vhi[i][3]}
  #define PIN(x) asm volatile("":"+v"(x))
  #define MX3(a,b,c) __builtin_fmaxf(__builtin_fmaxf((a),(b)),(c))
  #define GAPA(MF,A0,A1,A2,A3,W0,W1,PW) do{ MF; sacc+=A0; sacc+=A1; sacc+=A2; sacc+=A3; PIN(sacc); W0; W1; PIN(PW); SBAR(); }while(0)
  #define EX(v) __builtin_amdgcn_exp2f(v)
  #define GAPB(MF,X,B) do{ MF; X[B]=EX(X[B]); X[B+1]=EX(X[B+1]); X[B+2]=EX(X[B+2]); X[B+3]=EX(X[B+3]); PIN(X); SBAR(); }while(0)
  #define VRD(i) do{ vlo[i]=vtr(vp_+(((i)>>2)*4096+((i)&3)*1024)); vhi[i]=vtr(vp_+(((i)>>2)*4096+((i)&3)*1024+512)); }while(0)
  #define KRD(G,j) do{ if(G){ kload2(kf,kp0+sl_next,j); SBAR(); } }while(0)
  #define STEP(C0,C1,P0,P1,t,GK,GV,GL) do{ SBAR(); \
    LOADCB(t); SBAR(); \
    const lds_cptr vp_=vp0+sl_prev; \
    VRD(0); SBAR(); float sacc=(P0[0]+P0[1]); \
    GAPA(C0=__builtin_amdgcn_mfma_f32_32x32x16_bf16(kf[0],qr[0],cb0,0,0,0), P0[2],P0[3],P0[4],P0[5],     pw0[0]=PKW(P0,0), pw0[1]=PKW(P0,2), pw0); \
    VRD(4); SBAR(); GAPA(C1=__builtin_amdgcn_mfma_f32_32x32x16_bf16(kf[1],qr[0],cb1,0,0,0), P0[6],P0[7],P0[8],P0[9],     pw0[2]=PKW(P0,4), pw0[3]=PKW(P0,6), pw0); \
    VRD(1); SBAR(); GAPA(C0=__builtin_amdgcn_mfma_f32_32x32x16_bf16(kf[2],qr[1],C0,0,0,0),   P0[10],P0[11],P0[12],P0[13], pw1[0]=PKW(P0,8), pw1[1]=PKW(P0,10), pw1); \
    VRD(5); SBAR(); GAPA(C1=__builtin_amdgcn_mfma_f32_32x32x16_bf16(kf[3],qr[1],C1,0,0,0),   P0[14],P0[15],P1[0],P1[1],   pw1[2]=PKW(P0,12),pw1[3]=PKW(P0,14), pw1); \
    VRD(2); SBAR(); GAPA(C0=__builtin_amdgcn_mfma_f32_32x32x16_bf16(kf[4],qr[2],C0,0,0,0),   P1[2],P1[3],P1[4],P1[5],     pw2[0]=PKW(P1,0), pw2[1]=PKW(P1,2), pw2); \
    VRD(6); SBAR(); GAPA(C1=__builtin_amdgcn_mfma_f32_32x32x16_bf16(kf[5],qr[2],C1,0,0,0),   P1[6],P1[7],P1[8],P1[9],     pw2[2]=PKW(P1,4), pw2[3]=PKW(P1,6), pw2); \
    VRD(3); SBAR(); GAPA(C0=__builtin_amdgcn_mfma_f32_32x32x16_bf16(kf[6],qr[3],C0,0,0,0),   P1[10],P1[11],P1[12],P1[13], pw3[0]=PKW(P1,8), pw3[1]=PKW(P1,10), pw3); \
    VRD(7); SBAR(); GAPA(C1=__builtin_amdgcn_mfma_f32_32x32x16_bf16(kf[7],qr[3],C1,0,0,0),   P1[14],P1[15],0.f,0.f,       pw3[2]=PKW(P1,12),pw3[3]=PKW(P1,14), pw3); \
    l_reg+=sacc; \
    if(GK){DMA_K((t)+3,sl_cur);} if(GV){DMA_V((t)+1,sl_next);} \
    CMASK(C0,C1,t); \
    if(!STATIC){ float a=MX3(C0[0],C0[1],C1[0]),b=MX3(C0[2],C0[3],C1[1]); a=MX3(a,C1[2],C1[3]); \
      _Pragma("unroll") for(int r=4;r<16;r+=4){a=MX3(a,C0[r],C0[r+1]);b=MX3(b,C0[r+2],C0[r+3]);a=MX3(a,C1[r],C1[r+1]);b=MX3(b,C1[r+2],C1[r+3]);} \
      float rm=__builtin_fmaxf(a,b); { auto rr=__builtin_amdgcn_permlane32_swap(__float_as_uint(rm),__float_as_uint(rm),false,false); rm=__builtin_fmaxf(__uint_as_float(rr[0]),__uint_as_float(rr[1])); } \
      resc=false; \
      if(__builtin_expect(__any(rm>(float)THRL),0)){ const float dl=__builtin_fmaxf(rm,0.f); mhat+=dl; \
        _Pragma("unroll") for(int r=0;r<16;++r){C0[r]-=dl;C1[r]-=dl;} \
        const float f=__builtin_amdgcn_exp2f(-dl); l_reg*=f; if(hi==0)wsf[r32]=f; resc=true; } } \
    SBAR(); \
    GAPB(o[0]=__builtin_amdgcn_mfma_f32_32x32x16_bf16(PAF(0),VFR(0),o[0],0,0,0), C0,0); \
    GAPB(o[1]=__builtin_amdgcn_mfma_f32_32x32x16_bf16(PAF(0),VFR(4),o[1],0,0,0), C0,4); \
    KRD(GL,0); GAPB(o[0]=__builtin_amdgcn_mfma_f32_32x32x16_bf16(PAF(1),VFR(1),o[0],0,0,0), C0,8); \
    KRD(GL,1); GAPB(o[1]=__builtin_amdgcn_mfma_f32_32x32x16_bf16(PAF(1),VFR(5),o[1],0,0,0), C0,12); \
    KRD(GL,2); GAPB(o[0]=__builtin_amdgcn_mfma_f32_32x32x16_bf16(PAF(2),VFR(2),o[0],0,0,0), C1,0); \
    KRD(GL,3); GAPB(o[1]=__builtin_amdgcn_mfma_f32_32x32x16_bf16(PAF(2),VFR(6),o[1],0,0,0), C1,4); \
    GAPB(o[0]=__builtin_amdgcn_mfma_f32_32x32x16_bf16(PAF(3),VFR(3),o[0],0,0,0), C1,8); \
    GAPB(o[1]=__builtin_amdgcn_mfma_f32_32x32x16_bf16(PAF(3),VFR(7),o[1],0,0,0), C1,12); \
    }while(0)
  int t=1;
  #undef CMASK
  #define CMASK(P0,P1,t) do{}while(0)
  for(;t+5<NT;t+=2){
    STEP(pB0,pB1,pA0,pA1,t,true,true,true);     WAIT_BAR(2); RESC(); ROT();
    STEP(pA0,pA1,pB0,pB1,t+1,true,true,true);   WAIT_BAR(2); RESC(); ROT();
  }
  #undef CMASK
  #define CMASK(P0,P1,t) do{int jb_=(t)-(NT-4); if(jb_>=0)cmask(P0,P1,jb_,qrel,hi);}while(0)
  #define ENDW(tt) do{ if((tt)+3<NT){WAIT_BAR(2);} else if((tt)+2<NT){WAIT_BAR(1);} else {WAIT_BAR(0);} }while(0)
  for(;t+1<NT;t+=2){
    STEP(pB0,pB1,pA0,pA1,t,(t+3<NT),(t+1<NT),(t+1<NT));       ENDW(t);   RESC(); ROT();
    STEP(pA0,pA1,pB0,pB1,t+1,(t+4<NT),(t+2<NT),(t+2<NT));     ENDW(t+1); RESC(); ROT();
  }
  STEP(pB0,pB1,pA0,pA1,NT-1,false,false,false); RESC();
  { float sacc=pB0[0]+pB0[1]; _Pragma("unroll") for(int r=2;r<16;++r)sacc+=pB0[r]; _Pragma("unroll") for(int r=0;r<16;++r)sacc+=pB1[r]; l_reg+=sacc;
    pw0=(u32x4){PKW(pB0,0),PKW(pB0,2),PKW(pB0,4),PKW(pB0,6)};pw1=(u32x4){PKW(pB0,8),PKW(pB0,10),PKW(pB0,12),PKW(pB0,14)};pw2=(u32x4){PKW(pB1,0),PKW(pB1,2),PKW(pB1,4),PKW(pB1,6)};pw3=(u32x4){PKW(pB1,8),PKW(pB1,10),PKW(pB1,12),PKW(pB1,14)};
    SBAR(); pv(o,vb0+sl_cur,PAF(0),PAF(1),PAF(2),PAF(3)); }
  #undef PKW
  #undef PAF
  #undef VFR
  #undef PIN
  #undef MX3
  #undef GAPA
  #undef GAPB
  #undef EX
  #undef VRD
  #undef KRD
  #undef STEP
  #undef ENDW
  {auto rr=__builtin_amdgcn_permlane32_swap(__float_as_uint(l_reg),__float_as_uint(l_reg),false,false);l_reg=__uint_as_float(rr[0])+__uint_as_float(rr[1]);}
  if(hi==0)wsf[32+r32]=l_reg;asm volatile("s_waitcnt lgkmcnt(0)":::"memory");
  float rli[16];
  #pragma unroll
  for(int r=0;r<16;++r)rli[r]=__builtin_amdgcn_rcpf(wsf[32+crow(r,hi)]);
  unsigned char*Ow=(unsigned char*)O+(rowbase+q0+wid*QBLK)*DM+h*D;
  { __attribute__((address_space(3))) unsigned char*stg=(__attribute__((address_space(3))) unsigned char*)(shm3+LDS_OST)+wid*2048;
    #pragma unroll
    for(int r=0;r<16;++r){const int orow=crow(r,hi);
      #pragma unroll
      for(int d0=0;d0<2;++d0){const float v=o[d0][r]*rli[r]; stg[orow*64+d0*32+r32]=(unsigned char)(__builtin_amdgcn_cvt_pk_fp8_f32(v,v,0u,false)&0xffu);}}
    asm volatile("s_waitcnt lgkmcnt(0)":::"memory");
    #pragma unroll
    for(int i=0;i<2;++i){const int row=i*16+(lane>>2),ch=lane&3; const u32x4 v=*(const __attribute__((address_space(3))) u32x4*)(stg+row*64+ch*16); ATTN_STORE16(Ow+(long)row*DM+ch*16,v);} }
  asm volatile("s_waitcnt lgkmcnt(0)\n\ts_barrier":::"memory");
  #undef DMA_K
  #undef DMA_V
  #undef CMASK
  #undef START
  #undef RESC
  #undef ROT
  #undef LOADCB
}
constexpr int ATTN_LDS_BYTES=LDS_BYTES;
struct AttnTensors { const bf16* Q; const bf16* K; const bf16* V; bf16* O; const float* bias; const int* ts; };
struct AttnUnit { int bh; int qb; };
struct StaticOrder {
  int vcu;
  __device__ __forceinline__ explicit StaticOrder(int grid,int block):vcu((block%8)*(grid/8)+block/8){}
  __device__ __forceinline__ bool next(int i,AttnUnit&u)const{ if(i>=16)return false; const int grp=i>>2,j=i&3,r=((vcu&7)+2*grp)&7; u.bh=(vcu>>3)+32*grp;
    u.qb=(r<5)?((j==0)?r:(4+3*r+j)):(20+4*(r-5)+j); return true; }
  __device__ __forceinline__ void a_ready(const AttnUnit&)const{}
  __device__ __forceinline__ void done(const AttnUnit&)const{}
};
template<class Sched,int THRL=60> __device__ __forceinline__ void attn_phase(char*lds,const AttnTensors&T,const Sched&S){
  AttnUnit u;
  for(int i=0;S.next(i,u);++i){ S.a_ready(u); const int ts_=__builtin_amdgcn_readfirstlane(T.ts[u.bh*NQB+u.qb]);
    if(ts_&0x10000) attn_unit<THRL,true>(u.bh/NHEAD,u.bh%NHEAD,u.qb,ts_&0xffff,T.Q,T.K,T.V,T.O,T.bias,lds); else attn_unit<THRL,false>(u.bh/NHEAD,u.bh%NHEAD,u.qb,ts_,T.Q,T.K,T.V,T.O,T.bias,lds);
    S.done(u); }
}
#undef SBAR
#undef WAIT_BAR
}
#define GAS __attribute__((address_space(1)))
#define LAS __attribute__((address_space(3)))
typedef unsigned short bf16;
typedef unsigned v4u __attribute__((ext_vector_type(4)));
typedef float f32x4 __attribute__((ext_vector_type(4)));
typedef short bf16x8 __attribute__((ext_vector_type(8)));
typedef GAS unsigned gu32;
typedef GAS unsigned long long gu64;
#define RLX_AGENT __ATOMIC_RELAXED, __HIP_MEMORY_SCOPE_AGENT
#define LDS_WAIT() asm volatile("s_waitcnt lgkmcnt(0)" ::: "memory")
#define VM_WAIT() asm volatile("s_waitcnt vmcnt(0)" ::: "memory")
__device__ __forceinline__ unsigned long long rt() { return __builtin_amdgcn_s_memrealtime(); }
__device__ __forceinline__ unsigned f2bf(float f) { unsigned u = __builtin_bit_cast(unsigned, f); return (u + 0x7fffu + ((u >> 16) & 1u)) >> 16; }
__device__ __forceinline__ unsigned pk2(float lo, float hi) { return f2bf(lo) | (f2bf(hi) << 16); }

#define XB_TMO      128
#define XB_XCNT(j)  (256  + 64 * (j))
#define XB_XSUB(j)  (1280 + 64 * (j))
#define XB_XGEN(j)  (2304 + 64 * (j))
#define XB_TOP      3328
#define XB_TOPGEN   3392
#define XCD_BAR_WORDS 3456
#define XB_SPIN_CAP (1u << 18)

__device__ __forceinline__ unsigned xb_ld(unsigned* p)              { return __hip_atomic_load(p, __ATOMIC_RELAXED, __HIP_MEMORY_SCOPE_AGENT); }
__device__ __forceinline__ unsigned xb_add(unsigned* p, unsigned v) { return __hip_atomic_fetch_add(p, v, __ATOMIC_RELAXED, __HIP_MEMORY_SCOPE_AGENT); }
__device__ __forceinline__ unsigned xb_xcc_id() { return (unsigned)__builtin_amdgcn_s_getreg((3 << 11) | 20) & 0xFu; }
#define XB_SPIN(cond, bar) do { unsigned _sp = 0; while (cond) { __builtin_amdgcn_s_sleep(1); \
    if ((++_sp & 255u) == 0u) { if (xb_ld(&(bar)[XB_TMO])) break; if (_sp > XB_SPIN_CAP) { atomicAdd(&(bar)[XB_TMO], 1u); break; } } } } while (0)

struct XcdBarrier {
    unsigned* bar; unsigned x;
    volatile LAS unsigned* st;
};

__device__ __forceinline__ XcdBarrier xcd_barrier_post(unsigned* bar, volatile LAS unsigned* st) {
    XcdBarrier b; b.bar = bar; b.x = xb_xcc_id(); b.st = st;
    if (threadIdx.x == 0) (void)xb_add(&bar[XB_XCNT(b.x)], 1u);
    return b;
}
__device__ __forceinline__ void xcd_barrier_complete(unsigned* bar, unsigned x, unsigned& nloc, unsigned& nx) {
    const unsigned G = gridDim.x * gridDim.y * gridDim.z;
    unsigned sum, cnt, mine, sp = 0u;
    for (;;) {
        sum = 0u; cnt = 0u; mine = 0u;
#pragma unroll
        for (unsigned j = 0; j < 16; ++j) { const unsigned c = xb_ld(&bar[XB_XCNT(j)]); sum += c; cnt += (c > 0u) ? 1u : 0u; mine = (j == x) ? c : mine; }
        if (sum == G) break;
        __builtin_amdgcn_s_sleep(1);
        if ((++sp & 255u) == 0u) { if (xb_ld(&bar[XB_TMO])) break; if (sp > XB_SPIN_CAP) { atomicAdd(&bar[XB_TMO], 1u); break; } }
    }
    nloc = mine > 0u ? mine : 1u; nx = cnt > 0u ? cnt : 1u;
}

__device__ __forceinline__ void xcd_barrier(const XcdBarrier& b) {
    asm volatile("s_waitcnt vmcnt(0)" ::: "memory");
    __syncthreads();
    if (threadIdx.x == 0) {
        unsigned* bar = b.bar;
        __builtin_amdgcn_s_waitcnt(0);
        unsigned nloc = b.st[0], nx = b.st[1];
        if (nloc == 0u) { xcd_barrier_complete(bar, b.x, nloc, nx); b.st[0] = nloc; b.st[1] = nx; }
        const unsigned old = xb_add(&bar[XB_XSUB(b.x)], 1u);
        const unsigned gen = old / nloc;
        if (old + 1u == (gen + 1u) * nloc) {
            __builtin_amdgcn_fence(__ATOMIC_RELEASE, "agent");
            asm volatile("s_waitcnt vmcnt(0)" ::: "memory");
            const unsigned og = xb_add(&bar[XB_TOP], 1u);
            const unsigned tg = og / nx;
            if (og + 1u == (tg + 1u) * nx) xb_add(&bar[XB_TOPGEN], 1u);
            else XB_SPIN(xb_ld(&bar[XB_TOPGEN]) == tg, bar);
            __builtin_amdgcn_fence(__ATOMIC_ACQUIRE, "agent");
            xb_add(&bar[XB_XGEN(b.x)], 1u);
            asm volatile("s_waitcnt vmcnt(0)" ::: "memory");
        } else {
            XB_SPIN(xb_ld(&bar[XB_XGEN(b.x)]) == gen, bar);
            __builtin_amdgcn_fence(__ATOMIC_ACQUIRE, "agent");
            asm volatile("s_waitcnt vmcnt(0)" ::: "memory");
        }
    }
    __syncthreads();
}

constexpr int NWAVES = 8;
constexpr int NB = 8, SEQ = 8192, D = 1024, NTOK = NB * SEQ, NE = 32, PLE = 256, NH = 16;
constexpr int MAXT = 1056;
constexpr int NCHUNK = NTOK / 256;
constexpr float LOG2E = 1.4426950408889634f;
constexpr float WSCALE8 = 1.0f / pg8::W8INV;
#ifndef MK_PER_PHASE
#define MK_PER_PHASE 0
#endif
constexpr int N_PHASES = 21;
#ifndef STAG_GU
#define STAG_GU 0
#endif
#ifndef STAG_DOWN
#define STAG_DOWN 0
#endif
#ifndef STAG_QKV
#define STAG_QKV 0
#endif
#ifndef STAG_PLE
#define STAG_PLE 0
#endif
#ifndef STAG_PJ
#define STAG_PJ 0
#endif
#ifndef STAG_WO
#define STAG_WO 0
#endif
#ifndef STAG_POOL
#define STAG_POOL 0
#endif

constexpr size_t MiB = 1u << 20;
constexpr size_t WS_CTL = 0, CTL_ZERO_BYTES = 1 * MiB;
constexpr size_t WS_META = 4 * MiB;
constexpr size_t WS_LOGITS = 5 * MiB;
constexpr size_t WS_TOKE = 13 * MiB;
constexpr size_t WS_TOKG = 14 * MiB;
constexpr size_t WS_TOKPOS = 15 * MiB;
constexpr size_t WS_SLOTG = 16 * MiB;
constexpr size_t WS_SLOTR = 18 * MiB;
constexpr size_t WS_LF = 20 * MiB;
constexpr size_t WS_BIAS = 24 * MiB;
constexpr size_t WS_TS = WS_META + 128 * 1024;
constexpr size_t WS_BGU16 = WS_META + 512 * 1024, WS_BD16 = WS_META + 768 * 1024;
constexpr size_t WS_NRM = WS_META + 256 * 1024;
constexpr size_t WS_WPOOL = 28 * MiB, WS_WROUTER = 29 * MiB, WS_WO = 30 * MiB, WS_WQKV = 32 * MiB, WS_WPG = 39 * MiB, WS_WPP = 43 * MiB, WS_WD = 44 * MiB, WS_WGU = 172 * MiB;
constexpr size_t WS_PB = 428 * MiB;
constexpr size_t WS_XA = 492 * MiB, WS_XB = 620 * MiB;
constexpr size_t WS_XA8 = 1276 * MiB + 384 * MiB;
constexpr size_t WS_XB8 = 1276 * MiB + 128 * MiB;
constexpr size_t WS_XT8 = 1276 * MiB + 448 * MiB;
constexpr size_t WS_XT = 1276 * MiB + 256 * MiB;
constexpr size_t WS_HS = 748 * MiB;
constexpr size_t WS_ACT = 1276 * MiB;
constexpr size_t WS_SS = 1804 * MiB;
constexpr size_t WS_SLOTT = 1828 * MiB;
constexpr size_t WS_DUMMY = 1830 * MiB;
constexpr size_t WS_END = 1832 * MiB;
constexpr size_t SSA = (size_t)NTOK * 16;
static_assert(WS_HS + (size_t)MAXT * 256 * D * 2 <= WS_ACT && WS_ACT + (size_t)MAXT * 256 * D * 2 <= WS_SS && WS_SS + 6 * SSA * 4 <= WS_SLOTT && WS_SLOTT + (size_t)MAXT * 256 * 4 <= WS_DUMMY, "d_ws map");
static_assert(WS_WGU + (size_t)2 * 32 * 2048 * 1024 * 2 <= WS_PB && WS_WD + (size_t)2 * 32 * 1024 * 1024 * 2 <= WS_WGU && WS_WQKV + (size_t)3328 * 1024 * 2 <= WS_WPG, "d_ws map (weights)");
constexpr int CW_TMO = 0, CW_BAR = 4096, CW_NRM = 8192;

constexpr int RING_OFF = 0, RING_BYTES = 131072;
constexpr int EPI_OFF = RING_BYTES, LDSCTL_OFF = EPI_OFF + 8 * pg8::EPW, MISC_OFF = LDSCTL_OFF + 320, TP_OFF = LDSCTL_OFF + 1024;
constexpr int LDS_BYTES = LDSCTL_OFF + 4096;
static_assert(attn_body::ATTN_LDS_BYTES <= RING_BYTES, "attention LDS");

__device__ __forceinline__ float wave_sum(float v) {
#pragma unroll
    for (int o = 1; o < 64; o <<= 1) v += __shfl_xor(v, o);
    return v;
}
__device__ __forceinline__ float dot4f(const f32x4& a) { return (a[0] * a[0] + a[1] * a[1]) + (a[2] * a[2] + a[3] * a[3]); }
__device__ __forceinline__ float rstd_tok(const float* ssp, size_t t) { float v[16];
#pragma unroll
    for (int k = 0; k < 16; ++k) v[k] = ssp[(size_t)k * NTOK + t];
    return pg8::rstd_of(pg8::sum16(v)); }
__device__ __forceinline__ float bflo(unsigned w) { return __builtin_bit_cast(float, w << 16); }
__device__ __forceinline__ float bfhi(unsigned w) { return __builtin_bit_cast(float, w & 0xffff0000u); }

__device__ __forceinline__ void conv_item(const float* W, int ldw, int k0, int n0, int nvalid, bf16* WT, int ldk, int drow0, const float* gain, LAS float* scr, int lane) {
    const bool ok = (lane & 31) < nvalid;
#pragma unroll 8
    for (int i = 0; i < 32; ++i) { const int kk = 2 * i + (lane >> 5); scr[kk * 33 + (lane & 31)] = ok ? W[(size_t)(k0 + kk) * ldw + n0 + (lane & 31)] : 0.f; }
    LDS_WAIT(); asm volatile("" ::: "memory");
    const int c = lane & 7;
    float gv[8];
#pragma unroll
    for (int i = 0; i < 8; ++i) gv[i] = gain ? gain[k0 + 8 * c + i] : 1.f;
#pragma unroll
    for (int j = 0; j < 4; ++j) { const int n = (lane >> 3) + 8 * j; const LAS float* s = scr + (8 * c) * 33 + n;
        v4u o; o.x = pk2(s[0 * 33] * gv[0], s[1 * 33] * gv[1]); o.y = pk2(s[2 * 33] * gv[2], s[3 * 33] * gv[3]); o.z = pk2(s[4 * 33] * gv[4], s[5 * 33] * gv[5]); o.w = pk2(s[6 * 33] * gv[6], s[7 * 33] * gv[7]);
        *(GAS v4u*)(WT + (size_t)(drow0 + n) * ldk + k0 + 8 * c) = o; }
    LDS_WAIT(); asm volatile("" ::: "memory");
}

__device__ __forceinline__ void conv_item8(const float* W, int ldw, int k0, int n0, unsigned char* WT, int ldk, int drow0, const float* gain, float wscale, LAS float* scr, int lane, int nvalid = 32) {
    { const int c8 = lane & 7, r8 = lane >> 3; const bool ok = 4 * c8 < nvalid; f32x4 wv[8];
      const float* wp = W + (size_t)(k0 + r8) * ldw + n0 + 4 * c8;
#pragma unroll
      for (int i = 0; i < 8; ++i) wv[i] = ok ? *(const f32x4*)(wp + (size_t)(8 * i) * ldw) : (f32x4){0.f, 0.f, 0.f, 0.f};
#pragma unroll
      for (int i = 0; i < 8; ++i)
#pragma unroll
          for (int j = 0; j < 4; ++j) scr[(r8 + 8 * i) * 33 + 4 * c8 + j] = wv[i][j]; }
    LDS_WAIT(); asm volatile("" ::: "memory");
    const int c = lane & 3, nn = lane >> 2;
    float gv[16];
#pragma unroll
    for (int i = 0; i < 16; ++i) gv[i] = (gain ? gain[k0 + 16 * c + i] : 1.f) * wscale;
#pragma unroll
    for (int j = 0; j < 2; ++j) { const int n = nn + 16 * j; const LAS float* s = scr + (16 * c) * 33 + n; pg8::u32x4 o;
#pragma unroll
        for (int q = 0; q < 4; ++q) { unsigned w0 = 0u;
            w0 = __builtin_amdgcn_cvt_pk_fp8_f32(s[(4 * q) * 33] * gv[4 * q], s[(4 * q + 1) * 33] * gv[4 * q + 1], w0, false); w0 = __builtin_amdgcn_cvt_pk_fp8_f32(s[(4 * q + 2) * 33] * gv[4 * q + 2], s[(4 * q + 3) * 33] * gv[4 * q + 3], w0, true); o[q] = w0; }
        *(pg8::u32x4*)(WT + (size_t)(drow0 + n) * ldk + k0 + 16 * c) = o; }
    LDS_WAIT(); asm volatile("" ::: "memory");
}

__device__ __forceinline__ void rstd8(const f32x4 (&xs)[8], LAS float* part  , int hw, int lane, float (&rs)[8]) {
    float p[8];
#pragma unroll
    for (int j = 0; j < 8; ++j) p[j] = wave_sum(dot4f(xs[j]));
    if (lane == 0) {
#pragma unroll
        for (int j = 0; j < 8; ++j) part[j * 4 + hw] = p[j]; }
    __syncthreads();
#pragma unroll
    for (int j = 0; j < 8; ++j) { const f32x4 q = *(const LAS f32x4*)(part + j * 4); rs[j] = pg8::rstd_of((q[0] + q[1]) + (q[2] + q[3])); }
}
template <int W> __device__ __forceinline__ void pool_run(const float* x, int t0, int c4, bool has_prev, int pos0, f32x4 g, bf16* diff, LAS float* part2  , int& buf, int hw, int lane) {
    f32x4 hh[16]; f32x4 xs[8], xn[8]; float rs[8];
#pragma unroll
    for (int hc = 0; hc < 2; ++hc) {
#pragma unroll
        for (int j = 0; j < 8; ++j) xs[j] = has_prev ? *(const f32x4*)(x + (size_t)(t0 - 16 + hc * 8 + j) * D + c4) : (f32x4){0.f, 0.f, 0.f, 0.f};
        rstd8(xs, part2 + buf * 32, hw, lane, rs); buf ^= 1;
#pragma unroll
        for (int j = 0; j < 8; ++j) hh[hc * 8 + j] = xs[j] * rs[j] * g;
    }
    f32x4 S = (f32x4){0.f, 0.f, 0.f, 0.f};
#pragma unroll
    for (int i = 16 - W; i < 16; ++i) S += hh[i];
#pragma unroll
    for (int j = 0; j < 8; ++j) xn[j] = *(const f32x4*)(x + (size_t)(t0 + j) * D + c4);
#pragma unroll 1
    for (int cb = 0; cb < 8; ++cb) {
        f32x4 hn[8];
#pragma unroll
        for (int j = 0; j < 8; ++j) xs[j] = xn[j];
        if (cb < 7) {
#pragma unroll
            for (int j = 0; j < 8; ++j) xn[j] = *(const f32x4*)(x + (size_t)(t0 + (cb + 1) * 8 + j) * D + c4); }
        rstd8(xs, part2 + buf * 32, hw, lane, rs); buf ^= 1;
#pragma unroll
        for (int j = 0; j < 8; ++j) {
            hn[j] = xs[j] * rs[j] * g;
            const f32x4 old = (j - W >= 0) ? hn[(j - W >= 0) ? j - W : 0] : hh[(16 + j - W) & 15];
            S = S + hn[j] - old;
            const int pos = pos0 + cb * 8 + j; const int cnt = (pos + 1 < W) ? pos + 1 : W; const float inv = 1.0f / (float)cnt;
            const f32x4 dv = S * inv - hn[j];
            unsigned long long o = (unsigned long long)pk2(dv[0], dv[1]) | ((unsigned long long)pk2(dv[2], dv[3]) << 32);
            *(GAS unsigned long long*)(diff + (size_t)(t0 + cb * 8 + j) * D + c4) = o;
        }
#pragma unroll
        for (int i = 0; i < 8; ++i) hh[i] = hh[i + 8];
#pragma unroll
        for (int i = 0; i < 8; ++i) hh[8 + i] = hn[i];
    }
}

struct Args { const float* in[24]; float* out; unsigned char* ws; int ph_lo, ph_hi; };
enum { I_X = 0, I_P, I_NMIX, I_NFFN, I_NPLE, I_NFIN, I_POOLW, I_POOLS, I_KVN, I_WK, I_WV, I_WF, I_BF, I_WQ, I_WO, I_RW, I_RB, I_WGU, I_BGU, I_WD, I_BD, I_PWG, I_PBG, I_PWP };
#define WSP(T, off) ((T*)(args.ws + (off)))
#ifdef ONLY
#define PHON(n) ((n) == ONLY)
#else
#define PHON(n) true
#endif
#define IN(k) (lo <= (k) && (k) < hi)
#define NREP(bit) ((((PROBE_MASK) >> (bit)) & 1) ? 2 : 1)
#define SEAM(k) do { if (IN(k) && IN((k) + 1)) xcd_barrier(bar); } while (0)
#define FRESH_IDS() int tid = threadIdx.x; asm volatile("" : "+v"(tid)); const int lane = tid & 63, wave = __builtin_amdgcn_readfirstlane(tid >> 6); (void)lane; (void)wave; \
    const int G = gridDim.x, bx = blockIdx.x; const int vcu = (G % 8 == 0) ? (bx % 8) * (G / 8) + bx / 8 : bx; const int gw = vcu * NWAVES + wave, NGW = G * NWAVES; (void)gw; (void)NGW; (void)vcu

__device__ __forceinline__ void phase_prologue(const Args& args, LAS unsigned char* lds) {
    FRESH_IDS();
    const float* norm_ffn = args.in[I_NFFN];
    unsigned char* Wqkv8 = WSP(unsigned char, WS_WQKV); bf16* Wrouter = WSP(bf16, WS_WROUTER);
    LAS float* scr = (LAS float*)(lds + RING_OFF + wave * 16384);
    constexpr int I_GU = 2 * 32 * 1024, I_D = 2 * 32 * 512, I_PG = 2 * 512, I_PP = 2 * 128, I_SQ = 512, I_F = 16, I_POOL = 128, I_R = 32;
    constexpr int NITEMS = I_GU + I_D + I_PG + I_PP + 4 * I_SQ + I_F + I_POOL + I_R;
    for (int it = gw; it < NITEMS; it += NGW) {
        int r = it;
        if (r < I_GU) { const int le = r >> 10, q = r & 1023, kb = q >> 6, nb = q & 63, n0 = nb * 32;
            const int drow0 = 256 * ((n0 & 1023) >> 7) + 64 * ((n0 & 127) >> 5) + 32 * (n0 >> 10);
            conv_item8(args.in[I_WGU] + (size_t)le * 1024 * 2048, 2048, kb * 64, n0, WSP(unsigned char, WS_WGU) + (size_t)le * 2048 * 1024, 1024, drow0, norm_ffn + (le >> 5) * 1024, (n0 < 1024) ? WSCALE8 * pg8::SW_A2 : WSCALE8, scr, lane); continue; } r -= I_GU;
        if (r < I_D) { const int le = r >> 9, q = r & 511, kb = q >> 5, nb = q & 31;
            conv_item8(args.in[I_WD] + (size_t)le * 1024 * 1024, 1024, kb * 64, nb * 32, WSP(unsigned char, WS_WD) + (size_t)le * 1024 * 1024, 1024, nb * 32, nullptr, WSCALE8, scr, lane); continue; } r -= I_D;
        if (r < I_PG) { const int l = r >> 9, q = r & 511, kb = q >> 5, nb = q & 31;
            conv_item8(args.in[I_PWG] + (size_t)l * 1024 * 1024, 1024, kb * 64, nb * 32, WSP(unsigned char, WS_WPG) + (size_t)l * 1024 * 1024, 1024, nb * 32, args.in[I_NPLE] + l * 1024, WSCALE8, scr, lane); continue; } r -= I_PG;
        if (r < I_PP) { const int l = r >> 7, q = r & 127, kb = q >> 5, nb = q & 31;
            conv_item(args.in[I_PWP] + (size_t)l * 256 * 1024, 1024, kb * 64, nb * 32, 32, WSP(bf16, WS_WPP) + (size_t)l * 1024 * 256, 256, nb * 32, nullptr, scr, lane); continue; } r -= I_PP;
        if (r < 4 * I_SQ) { const int w = r >> 9, q = r & 511, kb = q >> 5, nb = q & 31;
            const float* src = args.in[w == 0 ? I_WQ : (w == 1 ? I_WK : (w == 2 ? I_WV : I_WO))]; const float* gn = w == 0 ? args.in[I_NMIX] + 1024 : args.in[I_KVN];
            if (w == 3) conv_item8(src, 1024, kb * 64, nb * 32, WSP(unsigned char, WS_WO), 1024, nb * 32, nullptr, WSCALE8, scr, lane);
            else conv_item8(src, 1024, kb * 64, nb * 32, Wqkv8 + (size_t)w * 1024 * 1024, 1024, nb * 32, gn, WSCALE8, scr, lane);
            continue; } r -= 4 * I_SQ;
        if (r < I_F) { conv_item8(args.in[I_WF], 16, r * 64, 0, Wqkv8 + (size_t)3072 * 1024, 1024, 0, args.in[I_KVN], WSCALE8, scr, lane, 16); continue; } r -= I_F;
        if (r < I_POOL) { const int g = r >> 5, q = r & 31, kb = q >> 3, nb = q & 7;
            conv_item(args.in[I_POOLW] + (size_t)g * 256 * 256, 256, kb * 64, nb * 32, 32, WSP(bf16, WS_WPOOL) + (size_t)g * 256 * 256, 256, nb * 32, nullptr, scr, lane); continue; } r -= I_POOL;
        { const int l = r >> 4, kb = r & 15;
            conv_item(args.in[I_RW] + (size_t)l * 1024 * 32, 32, kb * 64, 0, 32, Wrouter + (size_t)l * 256 * 1024, 1024, 0, norm_ffn + l * 1024, scr, lane); }
    }
    {
        const int gt = vcu * NWAVES * 64 + tid, NGT = G * NWAVES * 64; const v4u z = (v4u){0u, 0u, 0u, 0u};
        for (int i = gt; i < 2 * 224 * 128; i += NGT) { const int l = i / (224 * 128), q = i % (224 * 128); *(GAS v4u*)(Wrouter + (size_t)l * 256 * 1024 + (size_t)32 * 1024 + (size_t)q * 8) = z; }
        for (int i = gt; i < 224 * 64; i += NGT) *(GAS v4u*)(Wqkv8 + (size_t)3104 * 1024 + (size_t)i * 16) = z;
        { const float* bgu = args.in[I_BGU]; const float* bd = args.in[I_BD]; bf16* o1 = WSP(bf16, WS_BGU16); bf16* o2 = WSP(bf16, WS_BD16);
          for (int i = gt; i < 2 * 32 * 2048 / 2; i += NGT) { const bool gate = ((2 * i) & 2047) < 1024; ((GAS unsigned*)o1)[i] = gate ? pk2(bgu[2 * i] * pg8::SW_A2, bgu[2 * i + 1] * pg8::SW_A2) : pk2(bgu[2 * i] + 1.0f, bgu[2 * i + 1] + 1.0f); }
          for (int i = gt; i < 2 * 32 * 1024 / 2; i += NGT) ((GAS unsigned*)o2)[i] = pk2(bd[2 * i], bd[2 * i + 1]); }
        const float* p_in = args.in[I_P]; bf16* PB = WSP(bf16, WS_PB);
        for (size_t i = gt; i < (size_t)2 * NTOK * PLE / 8; i += NGT) { const f32x4 a = *(const f32x4*)(p_in + i * 8), b = *(const f32x4*)(p_in + i * 8 + 4);
            v4u o; o.x = pk2(a[0], a[1]); o.y = pk2(a[2], a[3]); o.z = pk2(b[0], b[1]); o.w = pk2(b[2], b[3]); *(GAS v4u*)(PB + i * 8) = o; }
    }
    __syncthreads();
    {
        const float* x_in = args.in[I_X]; bf16* DIFF = WSP(bf16, WS_ACT);
        const int half = tid >> 8, ht = tid & 255, hw = wave & 3, c4 = ht * 4;
        LAS float* part2 = (LAS float*)(lds + RING_OFF) + half * 64;
        const f32x4 g = *(const f32x4*)(args.in[I_NMIX] + c4);
        const int grp = __builtin_amdgcn_readfirstlane(ht >> 6);
        int buf = 0;
        for (int it = bx; it < NTOK / 128; it += G) {
            const int t0 = (it * 2 + half) * 64, pos0 = t0 & (SEQ - 1); const bool has_prev = pos0 != 0;
            if (grp == 0) pool_run<2>(x_in, t0, c4, has_prev, pos0, g, DIFF, part2, buf, hw, lane);
            else if (grp == 1) pool_run<4>(x_in, t0, c4, has_prev, pos0, g, DIFF, part2, buf, hw, lane);
            else if (grp == 2) pool_run<8>(x_in, t0, c4, has_prev, pos0, g, DIFF, part2, buf, hw, lane);
            else pool_run<16>(x_in, t0, c4, has_prev, pos0, g, DIFF, part2, buf, hw, lane);
        }
        __syncthreads();
    }
}

template <int LAYER> __device__ __forceinline__ void ple_phase(const Args& args, LAS unsigned char* lds) {
    constexpr int SSM = LAYER == 0 ? 0 : 3; constexpr size_t XT_OFF = WS_XT, XN_OFF = WS_XB;
        { FRESH_IDS();
          pg8::Gemm g{WSP(bf16, WS_PB) + (size_t)LAYER * NTOK * PLE, WSP(bf16, WS_WPP) + (size_t)LAYER * 1024 * 256, PLE, PLE, PLE, STAG_PJ}; pg8::DenseOrder S; S.init(NTOK / 256, 4, G, bx, PLE, PLE, 0);
          pg8::EpiStore E{WSP(unsigned char, WS_ACT)};
          pg8::gemm_phase<pg8::EpiStore, pg8::DenseOrder>(lds + RING_OFF, lds + EPI_OFF, g, S, E); }
        VM_WAIT(); __syncthreads();
        { FRESH_IDS();
          pg8::Gemm g{(const pg8::bf16_t*)WSP(unsigned char, WS_XT8), (const pg8::bf16_t*)(WSP(unsigned char, WS_WPG) + (size_t)LAYER * 1024 * 1024), D, D, D, STAG_PLE, nullptr, WSP(unsigned char, WS_DUMMY)}; pg8::DenseOrder S; S.init(NTOK / 256, 4, G, bx, D, D, 0, 1);
          pg8::EpiPle E{args.in[I_PBG] + LAYER * 1024, WSP(unsigned char, WS_ACT), WSP(bf16, XT_OFF), WSP(bf16, XN_OFF), WSP(float, WS_SS) + (size_t)(SSM + 2) * SSA, LAYER == 0 ? WSP(unsigned char, WS_XB8) : (unsigned char*)nullptr};
          pg8::gemm_phase<pg8::EpiPle, pg8::DenseOrder, false, 1>(lds + RING_OFF, lds + EPI_OFF, g, S, E); }
}

template <int LAYER> __device__ __forceinline__ void moe_ple_block(const Args& args, LAS unsigned char* lds, const XcdBarrier& bar, const int lo, const int hi) {
    constexpr int PBASE = LAYER == 0 ? 2 : 13, SSM = LAYER == 0 ? 0 : 3;
    constexpr size_t XC_OFF = WS_XA, XT_OFF = WS_XT, XN_OFF = WS_XB;
    if (IN(PBASE) && PHON(2)) for (int rep_ = 0; rep_ < NREP(2); ++rep_) {
        FRESH_IDS();
        pg8::Gemm g{WSP(bf16, XC_OFF), WSP(bf16, WS_WROUTER) + (size_t)LAYER * 256 * 1024, D, D, D, 0}; pg8::DenseOrder S; S.init(NTOK / 256, 1, G, bx, D, D, 0);
        pg8::EpiRouter E{WSP(float, WS_SS) + (size_t)SSM * SSA, args.in[I_RB] + LAYER * 32, WSP(float, WS_LOGITS)};
        pg8::gemm_phase<pg8::EpiRouter, pg8::DenseOrder>(lds + RING_OFF, lds + EPI_OFF, g, S, E);
        VM_WAIT(); __syncthreads(); __builtin_amdgcn_fence(__ATOMIC_ACQUIRE, "agent"); VM_WAIT(); __syncthreads();
        const float* LOGITS = WSP(float, WS_LOGITS); unsigned* TOKE = WSP(unsigned, WS_TOKE); float* TOKG = WSP(float, WS_TOKG); int* CH = WSP(int, WS_META);
        LAS int* hist = (LAS int*)(lds + RING_OFF);
        pg8::Unit uu;
        for (int ui = 0; S.next(ui, uu); ++ui) { const int ch = uu.pm;
            if (tid < 32) hist[tid] = 0;
            __syncthreads();
            if (tid < 256) {
                const int t = ch * 256 + tid; float v[32];
#pragma unroll
                for (int j = 0; j < 8; ++j) { const f32x4 q = *(const f32x4*)(LOGITS + (size_t)t * 32 + 4 * j); v[4 * j] = q[0]; v[4 * j + 1] = q[1]; v[4 * j + 2] = q[2]; v[4 * j + 3] = q[3]; }
                float sv[4]; int si[4]; float pv = INFINITY; int pi = -1;
#pragma unroll
                for (int k = 0; k < 4; ++k) { float bv = -INFINITY; int bi = 0;
#pragma unroll
                    for (int i = 0; i < 32; ++i) { const bool after = (v[i] < pv) || (v[i] == pv && i > pi); if (after && v[i] > bv) { bv = v[i]; bi = i; } }
                    sv[k] = bv; si[k] = bi; pv = bv; pi = bi; }
                const float e1 = __expf(sv[1] - sv[0]), e2 = __expf(sv[2] - sv[0]), e3 = __expf(sv[3] - sv[0]); const float inv = 1.0f / (1.0f + e1 + e2 + e3);
                TOKE[t] = (unsigned)si[0] | ((unsigned)si[1] << 8) | ((unsigned)si[2] << 16) | ((unsigned)si[3] << 24);
                *(f32x4*)(TOKG + (size_t)t * 4) = (f32x4){inv, e1 * inv, e2 * inv, e3 * inv};
#pragma unroll
                for (int k = 0; k < 4; ++k) atomicAdd((int*)(hist + si[k]), 1);
            }
            __syncthreads();
            if (tid < 32) CH[ch * 32 + tid] = hist[tid];
            __syncthreads();
        }
    }
    if (IN(PBASE) && IN(PBASE + 2)) xcd_barrier(bar);
    if (IN(PBASE + 2) && PHON(4)) for (int rep_ = 0; rep_ < NREP(4); ++rep_) {
        FRESH_IDS();
        const int* CH = WSP(int, WS_META); int* TPg = WSP(int, WS_META + 65536); const unsigned* TOKE = WSP(unsigned, WS_TOKE); const float* TOKG = WSP(float, WS_TOKG); int* TOKPOS = WSP(int, WS_TOKPOS);
        float* SLOTG = WSP(float, WS_SLOTG); const float* ss_mix = WSP(float, WS_SS) + (size_t)SSM * SSA; int* SLOTT = WSP(int, WS_SLOTT); float* SLOTR = WSP(float, WS_SLOTR);
        LAS int* ptot = (LAS int*)(lds + RING_OFF); LAS int* pbef = ptot + 256; LAS int* ntile = pbef + 256; LAS int* befl = ntile + 32; LAS int* tpl = befl + 32; LAS int* lcur = tpl + 64; LAS int* lpos = lcur + 32;
        for (int ch = bx; ch < NCHUNK; ch += G) {
            if (tid < 256) { const int e = tid & 31, part = tid >> 5; int tot = 0, bef = 0;
                for (int c2 = part * 32; c2 < part * 32 + 32; ++c2) { const int v = CH[c2 * 32 + e]; tot += v; bef += (c2 < ch) ? v : 0; }
                ptot[part * 32 + e] = tot; pbef[part * 32 + e] = bef; }
            __syncthreads();
            if (tid < 32) { int tot = 0, bef = 0;
#pragma unroll
                for (int q = 0; q < 8; ++q) { tot += ptot[q * 32 + tid]; bef += pbef[q * 32 + tid]; }
                ntile[tid] = (tot + 255) >> 8; befl[tid] = bef; }
            __syncthreads();
            if (tid == 0) { int a = 0; for (int e = 0; e < 32; ++e) { tpl[e] = a; a += ntile[e]; } tpl[32] = a; }
            __syncthreads();
            if (tid < 32) lcur[tid] = tpl[tid] * 256 + befl[tid];
            if (ch == 0 && tid < 33) TPg[tid] = tpl[tid];
            __syncthreads();
            LAS int* wcnt = lpos + 1024;
            unsigned ev = 0u; int rk[4] = {0, 0, 0, 0};
            if (tid < 256) { ev = TOKE[ch * 256 + tid];
                const int e0 = ev & 255, e1 = (ev >> 8) & 255, e2 = (ev >> 16) & 255, e3 = (ev >> 24) & 255;
                const unsigned mask = (1u << e0) | (1u << e1) | (1u << e2) | (1u << e3);
                const unsigned long long below = (1ull << lane) - 1ull;
#pragma unroll 1
                for (int e = 0; e < 32; ++e) { const unsigned long long bal = __ballot((mask >> e) & 1u); const int r = __popcll(bal & below);
                    if (e0 == e) rk[0] = r; if (e1 == e) rk[1] = r; if (e2 == e) rk[2] = r; if (e3 == e) rk[3] = r;
                    if (lane == 0) wcnt[wave * 32 + e] = __popcll(bal); } }
            __syncthreads();
            if (tid < 256) { const int t = ch * 256 + tid; const f32x4 gv = *(const f32x4*)(TOKG + (size_t)t * 4); const float rst = rstd_tok(ss_mix, (size_t)t);
                int ps[4];
#pragma unroll
                for (int k = 0; k < 4; ++k) { const int e = (ev >> (8 * k)) & 255; int pos = lcur[e] + rk[k];
                    for (int w = 0; w < wave; ++w) pos += wcnt[w * 32 + e];
                    ps[k] = pos; SLOTG[pos] = gv[k]; SLOTT[pos] = t; SLOTR[pos] = rst; }
                *(GAS v4u*)(TOKPOS + (size_t)t * 4) = (v4u){(unsigned)ps[0], (unsigned)ps[1], (unsigned)ps[2], (unsigned)ps[3]}; }
            __syncthreads();
        }
    }
    SEAM(PBASE + 2);
    if (IN(PBASE + 3) && PHON(5)) for (int rep_ = 0; rep_ < NREP(5); ++rep_) {
        FRESH_IDS();
        LAS int* tpl = (LAS int*)(lds + TP_OFF);
        if (tid < 33) tpl[tid] = (int)__hip_atomic_load(WSP(gu32, WS_META + 65536) + tid, RLX_AGENT);
        __syncthreads();
        { LAS unsigned char* te = (LAS unsigned char*)(tpl + 64); const int nT = tpl[32];
          for (int j = tid; j < nT; j += NWAVES * 64) { int e = 0; for (int k = 1; k < 32; ++k) e += (tpl[k] <= j) ? 1 : 0; te[j] = (unsigned char)e; } }
        __syncthreads();
        pg8::Gemm g{(const pg8::bf16_t*)WSP(unsigned char, WS_XA8), (const pg8::bf16_t*)(WSP(unsigned char, WS_WGU) + (size_t)LAYER * 32 * 2048 * 1024), D, D, D, STAG_GU, WSP(int, WS_SLOTT), WSP(unsigned char, WS_DUMMY)}; pg8::GroupedOrder S; S.init(tpl, 8, G, bx, D, D, 2048, 1);
        pg8::EpiSwiGLU E{WSP(bf16, WS_BGU16) + (size_t)LAYER * 32 * 2048, WSP(unsigned char, WS_ACT), WSP(float, WS_SLOTR)};
        pg8::gemm_phase<pg8::EpiSwiGLU, pg8::GroupedOrder, true, 1>(lds + RING_OFF, lds + EPI_OFF, g, S, E);
    }
    SEAM(PBASE + 3);
    if (IN(PBASE + 4) && PHON(6)) for (int rep_ = 0; rep_ < NREP(6); ++rep_) {
        FRESH_IDS();
        LAS int* tpl = (LAS int*)(lds + TP_OFF);
        if (tid < 33) tpl[tid] = (int)__hip_atomic_load(WSP(gu32, WS_META + 65536) + tid, RLX_AGENT);
        __syncthreads();
        { LAS unsigned char* te = (LAS unsigned char*)(tpl + 64); const int nT = tpl[32];
          for (int j = tid; j < nT; j += NWAVES * 64) { int e = 0; for (int k = 1; k < 32; ++k) e += (tpl[k] <= j) ? 1 : 0; te[j] = (unsigned char)e; } }
        __syncthreads();
        pg8::Gemm g{(const pg8::bf16_t*)WSP(unsigned char, WS_ACT), (const pg8::bf16_t*)(WSP(unsigned char, WS_WD) + (size_t)LAYER * 32 * 1024 * 1024), D, D, D, STAG_DOWN, nullptr, WSP(unsigned char, WS_DUMMY)}; pg8::GroupedOrder S; S.init(tpl, 4, G, bx, D, D, 1024, 1);
        pg8::EpiDown E{WSP(float, WS_SLOTG), WSP(bf16, WS_BD16) + (size_t)LAYER * 32 * 1024, WSP(unsigned char, WS_HS)};
        pg8::gemm_phase<pg8::EpiDown, pg8::GroupedOrder, false, 1>(lds + RING_OFF, lds + EPI_OFF, g, S, E);
    }
    SEAM(PBASE + 4);
    if (IN(PBASE + 5) && PHON(7)) for (int rep_ = 0; rep_ < NREP(7); ++rep_) {
        FRESH_IDS();
        const int* TOKPOS = WSP(int, WS_TOKPOS); const bf16* Xc = WSP(bf16, XC_OFF); bf16* Xt = WSP(bf16, XT_OFF); const unsigned char* Y8 = WSP(unsigned char, WS_HS); unsigned char* Xt8 = WSP(unsigned char, WS_XT8); float* ss_moe = WSP(float, WS_SS) + (size_t)(SSM + 1) * SSA;
        for (int t = gw; t < NTOK; t += NGW) {
            const v4u ps = *(const GAS v4u*)(TOKPOS + (size_t)t * 4);
            const bf16* xr = Xc + (size_t)t * D + lane * 16; bf16* xo = Xt + (size_t)t * D + lane * 16; float sq = 0.f;
            const v4u xw0 = *(const GAS v4u*)(xr), xw1 = *(const GAS v4u*)(xr + 8);
            v4u yw[4];
#pragma unroll
            for (int k = 0; k < 4; ++k) { const unsigned pos = k == 0 ? ps.x : (k == 1 ? ps.y : (k == 2 ? ps.z : ps.w)); yw[k] = *(const GAS v4u*)(Y8 + (size_t)pos * D + lane * 16); }
            float a[16] = {bflo(xw0.x), bfhi(xw0.x), bflo(xw0.y), bfhi(xw0.y), bflo(xw0.z), bfhi(xw0.z), bflo(xw0.w), bfhi(xw0.w), bflo(xw1.x), bfhi(xw1.x), bflo(xw1.y), bfhi(xw1.y), bflo(xw1.z), bfhi(xw1.z), bflo(xw1.w), bfhi(xw1.w)};
#pragma unroll
            for (int k = 0; k < 4; ++k) {
#pragma unroll
                for (int w = 0; w < 4; ++w) { const unsigned wd = w == 0 ? yw[k].x : (w == 1 ? yw[k].y : (w == 2 ? yw[k].z : yw[k].w));
                    const pg8::f32x2 lo = __builtin_amdgcn_cvt_pk_f32_fp8((int)wd, false), hi = __builtin_amdgcn_cvt_pk_f32_fp8((int)wd, true);
                    a[4 * w] += lo.x * pg8::YSINV; a[4 * w + 1] += lo.y * pg8::YSINV; a[4 * w + 2] += hi.x * pg8::YSINV; a[4 * w + 3] += hi.y * pg8::YSINV; } }
#pragma unroll
            for (int j = 0; j < 16; ++j) sq += a[j] * a[j];
            { v4u o; o.x = pk2(a[0], a[1]); o.y = pk2(a[2], a[3]); o.z = pk2(a[4], a[5]); o.w = pk2(a[6], a[7]); *(GAS v4u*)(xo) = o;
              o.x = pk2(a[8], a[9]); o.y = pk2(a[10], a[11]); o.z = pk2(a[12], a[13]); o.w = pk2(a[14], a[15]); *(GAS v4u*)(xo + 8) = o; }
            sq = wave_sum(sq);
            { const float rs = pg8::rstd_of(sq);
              v4u o8;
#pragma unroll
              for (int w = 0; w < 4; ++w) { unsigned w0 = 0u; w0 = __builtin_amdgcn_cvt_pk_fp8_f32(a[4 * w] * rs, a[4 * w + 1] * rs, w0, false); w0 = __builtin_amdgcn_cvt_pk_fp8_f32(a[4 * w + 2] * rs, a[4 * w + 3] * rs, w0, true);
                if (w == 0) o8.x = w0; else if (w == 1) o8.y = w0; else if (w == 2) o8.z = w0; else o8.w = w0; }
              *(GAS v4u*)(Xt8 + (size_t)t * D + lane * 16) = o8; }
            (void)ss_moe;
        }
    }
    SEAM(PBASE + 5);
    if (IN(PBASE + 6) && PHON(8)) { if (NREP(8) == 2) ple_phase<LAYER>(args, lds); ple_phase<LAYER>(args, lds); }
    SEAM(PBASE + 6);
}

__global__ void __launch_bounds__(NWAVES * 64, 2) yoco_fwd(Args args) {
    extern __shared__ __attribute__((aligned(16))) unsigned char lds_raw[];
    LAS unsigned char* lds = (LAS unsigned char*)lds_raw;
    volatile LAS unsigned* MISC = (volatile LAS unsigned*)(lds + MISC_OFF);
    for (int u = threadIdx.x; u < (LDS_BYTES - LDSCTL_OFF) / 4; u += NWAVES * 64) ((LAS unsigned*)(lds + LDSCTL_OFF))[u] = 0u;
    __syncthreads();
    XcdBarrier bar; bar.bar = (unsigned*)(WSP(gu32, WS_CTL) + CW_BAR); bar.x = 0; bar.st = nullptr;
    if (!MK_PER_PHASE) bar = xcd_barrier_post((unsigned*)(WSP(gu32, WS_CTL) + CW_BAR), MISC + 8);
#if MK_PER_PHASE
    const int lo = args.ph_lo, hi = args.ph_hi;
#else
    constexpr int lo = 0, hi = N_PHASES;
#endif

    if (IN(0) && PHON(0)) for (int rep_ = 0; rep_ < NREP(0); ++rep_) phase_prologue(args, lds);
    SEAM(0);
    if (IN(1) && PHON(1)) for (int rep_ = 0; rep_ < NREP(1); ++rep_) {
        FRESH_IDS();
        pg8::Gemm g{WSP(bf16, WS_ACT), WSP(bf16, WS_WPOOL), D, 256, 256, STAG_POOL}; pg8::DenseOrder S; S.init(NTOK / 256, 4, G, bx, D, 256, 256);
        pg8::EpiPool E{args.in[I_X], args.in[I_POOLS], WSP(bf16, WS_XA), WSP(float, WS_SS), WSP(unsigned char, WS_XA8)};
        pg8::gemm_phase<pg8::EpiPool, pg8::DenseOrder>(lds + RING_OFF, lds + EPI_OFF, g, S, E);
    }
    SEAM(1);
    moe_ple_block<0>(args, lds, bar, lo, hi);
    if (IN(9) && PHON(9)) for (int rep_ = 0; rep_ < NREP(9); ++rep_) {
        FRESH_IDS();
        pg8::Gemm g{(const pg8::bf16_t*)WSP(unsigned char, WS_XB8), (const pg8::bf16_t*)WSP(unsigned char, WS_WQKV), D, D, D, STAG_QKV, nullptr, WSP(unsigned char, WS_DUMMY)}; pg8::DenseOrder S; S.init(NTOK / 256, 13, G, bx, D, D, 0, 1);
        pg8::EpiQkv E{WSP(float, WS_SS) + (size_t)2 * SSA, WSP(bf16, WS_HS), args.in[I_BF], WSP(float, WS_LF), attn_body::C2, WSP(float, WS_NRM)};
        pg8::gemm_phase<pg8::EpiQkv, pg8::DenseOrder, false, 1>(lds + RING_OFF, lds + EPI_OFF, g, S, E);
    }
    SEAM(9);
    if (IN(10) && PHON(10)) for (int rep_ = 0; rep_ < NREP(10); ++rep_) {
        FRESH_IDS();
        const float* LF = WSP(float, WS_LF); float* BIAS = WSP(float, WS_BIAS);
        LAS float* wtot = (LAS float*)(lds + RING_OFF);
        for (int item = bx; item < NB * NH; item += G) {
            const int b = item >> 4, h = item & 15; const int s0 = tid * 16; float v[16]; float run = 0.f;
#pragma unroll
            for (int j = 0; j < 16; ++j) { run += LF[(size_t)(b * SEQ + s0 + j) * 16 + h]; v[j] = run; }
            float incl = run;
#pragma unroll
            for (int o = 1; o < 64; o <<= 1) { const float n = __shfl_up(incl, o); if (lane >= o) incl += n; }
            if (lane == 63) wtot[wave] = incl;
            __syncthreads();
            float base = incl - run;
            for (int w = 0; w < wave; ++w) base += wtot[w];
            float* o = BIAS + (size_t)item * SEQ + s0; LAS float* lb = wtot + 64;
#pragma unroll
            for (int j = 0; j < 16; j += 4) { const f32x4 bv4 = (f32x4){-(base + v[j]) * LOG2E, -(base + v[j + 1]) * LOG2E, -(base + v[j + 2]) * LOG2E, -(base + v[j + 3]) * LOG2E}; *(f32x4*)(o + j) = bv4; *(LAS f32x4*)(lb + s0 + j) = bv4; }
            LAS float* LE = lb + SEQ; LAS float* wm = wtot + 16; LAS float* wsum = wtot + 32;
            float pm_ = -(base + v[15]) * LOG2E, ps_ = 0.f;
#pragma unroll
            for (int j = 0; j < 16; ++j) ps_ += exp2f(-(base + v[j]) * LOG2E - pm_);
#pragma unroll
            for (int o2 = 1; o2 < 64; o2 <<= 1) { const float m2 = __shfl_up(pm_, o2), s2 = __shfl_up(ps_, o2); if (lane >= o2) { const float M = fmaxf(pm_, m2); ps_ = ps_ * exp2f(pm_ - M) + s2 * exp2f(m2 - M); pm_ = M; } }
            if (lane == 63) { wm[wave] = pm_; wsum[wave] = ps_; }
            __syncthreads();
            for (int w = 0; w < wave; ++w) { const float m2 = wm[w], s2 = wsum[w]; const float M = fmaxf(pm_, m2); ps_ = ps_ * exp2f(pm_ - M) + s2 * exp2f(m2 - M); pm_ = M; }
            LE[tid] = pm_ + log2f(ps_);
            __syncthreads();
            if (tid < 32) {
                const float* nr = WSP(float, WS_NRM);
                const size_t e0 = (((size_t)(b * 32 + tid) * 16 + h) * 2) * 2;
                const float qn = sqrtf(fmaxf(nr[e0], nr[e0 + 1]) * 1.02f), kown = sqrtf(fmaxf(nr[e0 + 2], nr[e0 + 3]) * 1.02f);
                const int q0 = tid * 256, ntile = 4 * (tid + 1); const float bq = lb[q0]; int ts = 0; float kn2 = 0.f;
                float kp = fmaxf(nr[e0 + 2], nr[e0 + 3]) * 1.02f;
#pragma unroll
                for (int o = 1; o < 32; o <<= 1) { const float n = __shfl_up(kp, o); if (tid >= o) kp = fmaxf(kp, n); }
                LAS float* kpl = LE + 512; kpl[tid] = kp;
                for (int j = 0; j + 4 < ntile; ++j) {
                    if ((j & 3) == 0) kn2 = kpl[j >> 2];
                    const float bqk = qn * (sqrtf(kn2) + kown);
                    if (LE[4 * j + 3] + bqk - bq < -25.0f) ts = j + 1; else break; }
                const float kall = kp;
                const float bqs = qn * sqrtf(kall), dlt = lb[q0 + 255] - bq;
                const bool sok = (bqs <= 90.0f) && (bqs + dlt <= 100.0f) && (dlt >= 0.0f);
                WSP(int, WS_TS)[item * 32 + tid] = (ts & ~1) | (sok ? 0x10000 : 0);
            }
            __syncthreads();
        }
    }
    SEAM(10);
    if (IN(11) && PHON(11)) for (int rep_ = 0; rep_ < NREP(11); ++rep_) {
        const attn_body::AttnTensors AT{WSP(const attn_body::bf16, WS_HS), WSP(const attn_body::bf16, WS_HS) + (size_t)NTOK * D, WSP(const attn_body::bf16, WS_HS) + (size_t)2 * NTOK * D, WSP(attn_body::bf16, WS_ACT), WSP(const float, WS_BIAS), WSP(const int, WS_TS)};
        const attn_body::StaticOrder S((int)gridDim.x, (int)blockIdx.x);
#ifndef SKIP_ATTN
        attn_body::attn_phase<attn_body::StaticOrder>((char*)lds_raw + RING_OFF, AT, S);
#endif
    }
    SEAM(11);
    if (IN(12) && PHON(12)) for (int rep_ = 0; rep_ < NREP(12); ++rep_) {
        FRESH_IDS();
        pg8::Gemm g{(const pg8::bf16_t*)WSP(unsigned char, WS_ACT), (const pg8::bf16_t*)WSP(unsigned char, WS_WO), D, D, D, STAG_WO, nullptr, WSP(unsigned char, WS_DUMMY)}; pg8::DenseOrder S; S.init(NTOK / 256, 4, G, bx, D, D, 0, 1);
        pg8::EpiWo E{WSP(bf16, WS_XB), WSP(bf16, WS_XA), WSP(float, WS_SS) + (size_t)3 * SSA, WSP(unsigned char, WS_XA8)};
        pg8::gemm_phase<pg8::EpiWo, pg8::DenseOrder, false, 1>(lds + RING_OFF, lds + EPI_OFF, g, S, E);
    }
    SEAM(12);
    moe_ple_block<1>(args, lds, bar, lo, hi);
    if (IN(20) && PHON(20)) for (int rep_ = 0; rep_ < NREP(13); ++rep_) {
        FRESH_IDS();
        const float* ssf = WSP(float, WS_SS) + (size_t)5 * SSA; const bf16* XA = WSP(bf16, WS_XB); const float* norm_final = args.in[I_NFIN];
        for (int t = gw; t < NTOK; t += NGW) {
            const float rs = rstd_tok(ssf, (size_t)t); const bf16* xr = XA + (size_t)t * D; float* orow = args.out + (size_t)t * D;
#pragma unroll
            for (int hf = 0; hf < 2; ++hf) { const int c0 = hf * 512 + lane * 8; const v4u xw = *(const GAS v4u*)(xr + c0);
                const f32x4 g0 = *(const f32x4*)(norm_final + c0), g1 = *(const f32x4*)(norm_final + c0 + 4);
                *(f32x4*)(orow + c0) = (f32x4){bflo(xw.x) * rs * g0[0], bfhi(xw.x) * rs * g0[1], bflo(xw.y) * rs * g0[2], bfhi(xw.y) * rs * g0[3]};
                *(f32x4*)(orow + c0 + 4) = (f32x4){bflo(xw.z) * rs * g1[0], bfhi(xw.z) * rs * g1[1], bflo(xw.w) * rs * g1[2], bfhi(xw.w) * rs * g1[3]}; }
        }
    }
}
#undef IN
#undef SEAM

extern "C" void kernel_launch(void* const* d_in, const int* in_sizes, int n_in, void* d_out, int out_size, void* d_ws, size_t ws_size, hipStream_t stream) {
    static int grid = 0;
    if (grid == 0) {
        if (n_in != 24 || in_sizes[0] != NTOK * D || out_size != NTOK * D || ws_size < WS_END) { fprintf(stderr, "kernel_launch: unexpected shapes (n_in %d, in0 %d, out %d, ws %zu); nothing launched\n", n_in, n_in > 0 ? in_sizes[0] : -1, out_size, ws_size); grid = -1; return; }
        int dev = 0, cus = 0, per_cu = 0;
        if (hipGetDevice(&dev) != hipSuccess || hipDeviceGetAttribute(&cus, hipDeviceAttributeMultiprocessorCount, dev) != hipSuccess) { grid = -1; return; }
        if (hipFuncSetAttribute((const void*)yoco_fwd, hipFuncAttributeMaxDynamicSharedMemorySize, LDS_BYTES) != hipSuccess) { fprintf(stderr, "kernel_launch: hipFuncSetAttribute failed\n"); grid = -1; return; }
        if (hipOccupancyMaxActiveBlocksPerMultiprocessor(&per_cu, (const void*)yoco_fwd, NWAVES * 64, LDS_BYTES) != hipSuccess || per_cu < 1) { fprintf(stderr, "kernel_launch: occupancy query says %d blocks per CU\n", per_cu); }
        (void)hipGetLastError();
        grid = cus > 0 ? cus : 256;
    }
    if (grid < 0) return;
    if (hipMemsetAsync((char*)d_ws + WS_CTL, 0, CTL_ZERO_BYTES, stream) != hipSuccess) return;
    Args a{};
    for (int i = 0; i < 24; ++i) a.in[i] = (const float*)d_in[i];
    a.out = (float*)d_out; a.ws = (unsigned char*)d_ws;
#if MK_PER_PHASE
    for (int ph = 0; ph < N_PHASES; ++ph) { a.ph_lo = ph; a.ph_hi = ph + 1; hipLaunchKernelGGL(yoco_fwd, dim3(grid), dim3(NWAVES * 64), LDS_BYTES, stream, a); }
#else
    a.ph_lo = 0; a.ph_hi = N_PHASES; hipLaunchKernelGGL(yoco_fwd, dim3(grid), dim3(NWAVES * 64), LDS_BYTES, stream, a);
#endif
}
```
